# Optimizing an MI355X kernel written in HIP

```python
import math
import jax
import jax.numpy as jnp
from jax import lax
import numpy as np

D_MODEL = 1024
BATCH = 8
SEQ = 4096
DEPTH = 4

CTX_LEN = 256
GRID_W = 64
N_MIXERS = 3
CHUNK = 128
N_RET = (DEPTH + 2) // 3
N_MLSTM = (DEPTH + 1) // 3
N_RWKV = DEPTH // 3

RET_HEADS = 4
RET_DK = D_MODEL // RET_HEADS
RET_QK = RET_HEADS * RET_DK
RET_V = 2 * D_MODEL
RET_DV = RET_V // RET_HEADS
RET_IN = 2 * RET_QK + 2 * RET_V
ROPE_BASE = 10000.0

MLSTM_INNER = 2 * D_MODEL
MLSTM_HEADS = 4
MLSTM_DH = MLSTM_INNER // MLSTM_HEADS
QKV_BLOCK = 4
N_QKV_BLOCKS = MLSTM_INNER // QKV_BLOCK
MLSTM_CONV = 3

RWKV_N = 64
RWKV_HEADS = D_MODEL // RWKV_N
RWKV_DECAY_LORA = 64
RWKV_A_LORA = 64

DEEPNORM_ALPHA = (2.0 * DEPTH) ** 0.25
DEEPNORM_BETA = (8.0 * DEPTH) ** -0.25
LN_EPS = 1e-5
HEAD_NORM_EPS = 1e-6
RWKV_GN_EPS = 64e-5

kernel_name = "hybrid_retnet_mlstm_rwkv7_deepnorm_dit"


def _layer_norm(x, g, b):
    xf = x.astype(jnp.float32)
    mu = xf.mean(-1, keepdims=True)
    var = jnp.mean(jnp.square(xf - mu), -1, keepdims=True)
    return ((xf - mu) * lax.rsqrt(var + LN_EPS) * g.astype(jnp.float32) + b.astype(jnp.float32)).astype(x.dtype)


def _chunks(t):
    B, H, T = t.shape[:3]
    return jnp.moveaxis(t.reshape(B, H, T // CHUNK, CHUNK, *t.shape[3:]), 2, 0)


def _unchunks(t):
    t = jnp.moveaxis(t, 0, 2)
    return t.reshape(t.shape[0], t.shape[1], -1, *t.shape[4:])


def _rope_2d(x, rows, cols):
    half = x.shape[-1] // 2
    nf = half // 2
    inv = ROPE_BASE ** (-jnp.arange(nf, dtype=jnp.float32) / nf)

    def rot(xa, pos):
        ang = pos[:, None] * inv[None, :]
        cos, sin = jnp.cos(ang), jnp.sin(ang)
        x1, x2 = xa[..., :nf], xa[..., nf:]
        return jnp.concatenate([x1 * cos - x2 * sin, x1 * sin + x2 * cos], -1)

    return jnp.concatenate([rot(x[..., :half], rows), rot(x[..., half:], cols)], -1)


def _retention_scan(q, k, v, log_gamma, state0):
    idx = jnp.arange(CHUNK, dtype=jnp.float32)
    lg = log_gamma[:, None]
    diff = idx[:, None] - idx[None, :]
    decay_mask = jnp.where(diff >= 0, jnp.exp(diff * lg[:, :, None]), 0.0)
    q_decay = jnp.exp((idx + 1.0) * lg)[:, :, None]
    k_decay = jnp.exp((CHUNK - 1.0 - idx) * lg)[:, :, None]
    chunk_decay = jnp.exp(CHUNK * log_gamma)[:, None, None]

    def step(S, inp):
        qc, kc, vc = inp
        s = jnp.einsum('bhid,bhjd->bhij', qc, kc) * decay_mask
        o = jnp.einsum('bhij,bhjv->bhiv', s, vc) + jnp.einsum('bhid,bhdv->bhiv', qc * q_decay, S)
        S = S * chunk_decay + jnp.einsum('bhjd,bhjv->bhdv', kc * k_decay, vc)
        return S, o

    S, o = lax.scan(step, state0, (_chunks(q), _chunks(k), _chunks(v)))
    return _unchunks(o), S


def _retention_mixer(h, hc, w_in, decay_logit, w_out, ctx_out):
    f32 = jnp.float32
    B, T, _ = h.shape

    def project(u):
        p = (u @ w_in).astype(f32)
        q, k, v, g = jnp.split(p, [RET_QK, 2 * RET_QK, 2 * RET_QK + RET_V], axis=-1)
        heads = lambda t, d: t.reshape(t.shape[0], t.shape[1], RET_HEADS, d).transpose(0, 2, 1, 3)
        return heads(q, RET_DK), heads(k, RET_DK) * RET_DK ** -0.5, heads(v, RET_DV), g

    q, k, v, g = project(h)
    qc, kc, vc, gc = project(hc)
    t = jnp.arange(T)
    rows = (t // GRID_W).astype(f32)
    cols = (t % GRID_W).astype(f32)
    q = _rope_2d(q, rows, cols)
    k = _rope_2d(k, rows, cols)
    log_gamma = jax.nn.log_sigmoid(decay_logit.astype(f32))
    zero = jnp.zeros((B, RET_HEADS, RET_DK, RET_DV), f32)

    def direction(d, rev):
        f = (lambda a: jnp.flip(a, axis=2)) if rev else (lambda a: a)
        oc_d, state = _retention_scan(f(qc), f(kc), f(vc), log_gamma[d], zero)
        o_d, _ = _retention_scan(f(q), f(k), f(v), log_gamma[d], state)
        return f(o_d), f(oc_d)

    o_f, oc_f = direction(0, False)
    o_b, oc_b = direction(1, True)

    def finish(o, gate):
        o = o * lax.rsqrt(jnp.mean(o * o, -1, keepdims=True) + HEAD_NORM_EPS)
        o = o.transpose(0, 2, 1, 3).reshape(o.shape[0], o.shape[2], RET_V)
        return (jax.nn.silu(gate) * o).astype(h.dtype) @ w_out

    y = finish(o_f + o_b, g)
    yc = finish(oc_f + oc_b, gc) if ctx_out else None
    return y, yc


def _centred_dwconv(u, w, b):
    K = w.shape[0]
    p = K // 2
    T = u.shape[1]
    up = jnp.pad(u, ((0, 0), (p, p), (0, 0)))
    out = b + up[:, 0:T] * w[0]
    for j in range(1, K):
        out = out + up[:, j:j + T] * w[j]
    return out


def _headwise(u, w):
    B, T, _ = u.shape
    return jnp.einsum('btnc,ncd->btnd', u.reshape(B, T, N_QKV_BLOCKS, QKV_BLOCK), w).reshape(B, T, MLSTM_INNER)


def _mlstm_scan(q, k, v, i_pre, logf, state0):
    tril = jnp.tril(jnp.ones((CHUNK, CHUNK), dtype=bool))

    def step(carry, inp):
        C, n, m = carry
        qc, kc, vc, ic, fc = inp
        b = jnp.cumsum(fc, axis=-1)
        a = b + m[..., None]
        dlog = jnp.where(tril, b[..., :, None] - b[..., None, :] + ic[..., None, :], -jnp.inf)
        m_t = jnp.maximum(a, dlog.max(-1))
        s = jnp.einsum('bhid,bhjd->bhij', qc, kc) * jnp.exp(dlog - m_t[..., None])
        inter = jnp.exp(a - m_t)
        num = jnp.einsum('bhij,bhjv->bhiv', s, vc) + inter[..., None] * jnp.einsum('bhid,bhdv->bhiv', qc, C)
        den = s.sum(-1) + inter * jnp.einsum('bhid,bhd->bhi', qc, n)
        hout = num / jnp.maximum(jnp.abs(den), jnp.exp(-m_t))[..., None]
        bl = b[..., -1]
        wlog = bl[..., None] - b + ic
        m_new = jnp.maximum(bl + m, wlog.max(-1))
        wk = kc * jnp.exp(wlog - m_new[..., None])[..., None]
        decay = jnp.exp(bl + m - m_new)
        C = decay[..., None, None] * C + jnp.einsum('bhjd,bhjv->bhdv', wk, vc)
        n = decay[..., None] * n + wk.sum(2)
        return (C, n, m_new), hout

    carry, hs = lax.scan(step, state0, (_chunks(q), _chunks(k), _chunks(v), _chunks(i_pre), _chunks(logf)))
    return _unchunks(hs), carry


def _mlstm_mixer(h, hc, w_in, conv_w, conv_b, w_qkv, gate_w, gate_b, skip, gn_g, w_out, ctx_out):
    f32 = jnp.float32
    B = h.shape[0]
    heads = lambda t: t.reshape(t.shape[0], t.shape[1], MLSTM_HEADS, MLSTM_DH).transpose(0, 2, 1, 3).astype(f32)

    def prep(u):
        xm, z = jnp.split(u @ w_in, 2, axis=-1)
        xconv = jax.nn.silu(_centred_dwconv(xm, conv_w, conv_b))
        q = _headwise(xconv, w_qkv[0])
        k = _headwise(xconv, w_qkv[1])
        v = _headwise(xm, w_qkv[2])
        qkv = jnp.concatenate([q, k, v], axis=-1)
        gates = [jnp.moveaxis((qkv @ gate_w[d] + gate_b[d]).astype(f32), -1, 1) for d in range(2)]
        ig = [gd[:, :MLSTM_HEADS] for gd in gates]
        lf = [jax.nn.log_sigmoid(gd[:, MLSTM_HEADS:]) for gd in gates]
        return heads(q), heads(k) * MLSTM_DH ** -0.5, heads(v), ig, lf, xconv, z

    q, k, v, ig, lf, xconv, z = prep(h)
    qc, kc, vc, igc, lfc, xconvc, zc = prep(hc)
    zero = (jnp.zeros((B, MLSTM_HEADS, MLSTM_DH, MLSTM_DH), f32),
            jnp.zeros((B, MLSTM_HEADS, MLSTM_DH), f32),
            jnp.zeros((B, MLSTM_HEADS), f32))

    def direction(d, rev):
        f = (lambda a: jnp.flip(a, axis=2)) if rev else (lambda a: a)
        oc_d, state = _mlstm_scan(f(qc), f(kc), f(vc), f(igc[d]), f(lfc[d]), zero)
        o_d, _ = _mlstm_scan(f(q), f(k), f(v), f(ig[d]), f(lf[d]), state)
        return f(o_d), f(oc_d)

    o_f, oc_f = direction(0, False)
    o_b, oc_b = direction(1, True)

    def finish(o, xcv, zz):
        Bn, _, Tn, _ = o.shape
        mu = o.mean(-1, keepdims=True)
        var = jnp.mean(jnp.square(o - mu), -1, keepdims=True)
        o = ((o - mu) * lax.rsqrt(var + LN_EPS)).transpose(0, 2, 1, 3).reshape(Bn, Tn, MLSTM_INNER) * gn_g
        o = (o + skip * xcv.astype(f32)) * jax.nn.silu(zz.astype(f32))
        return o.astype(h.dtype) @ w_out

    y = finish(o_f + o_b, xconv, z)
    yc = finish(oc_f + oc_b, xconvc, zc) if ctx_out else None
    return y, yc


def _qshift_grid(u):
    B, T, D = u.shape
    g = u.reshape(B, T // GRID_W, GRID_W, D)
    q = D // 4
    left = jnp.pad(g[:, :, :-1, :q], ((0, 0), (0, 0), (1, 0), (0, 0)))
    right = jnp.pad(g[:, :, 1:, q:2 * q], ((0, 0), (0, 0), (0, 1), (0, 0)))
    up = jnp.pad(g[:, :-1, :, 2 * q:3 * q], ((0, 0), (1, 0), (0, 0), (0, 0)))
    down = jnp.pad(g[:, 1:, :, 3 * q:], ((0, 0), (0, 1), (0, 0), (0, 0)))
    return jnp.concatenate([left, right, up, down], -1).reshape(B, T, D)


def _shift_seq(u):
    hd = u.shape[-1] // 2
    prev = jnp.pad(u[:, :-1, :hd], ((0, 0), (1, 0), (0, 0)))
    nxt = jnp.pad(u[:, 1:, hd:], ((0, 0), (0, 1), (0, 0)))
    return jnp.concatenate([prev, nxt], -1)


def _rwkv_scan(r, w, k, v, a, b, state0):
    xs = tuple(jnp.moveaxis(t, 1, 0) for t in (r, w, k, v, a, b))

    def step(S, inp):
        rt, wt, kt, vt, at, bt = inp
        sa = jnp.einsum('bhij,bhj->bhi', S, at)
        S = S * wt[:, :, None, :] + sa[..., None] * bt[:, :, None, :] + vt[..., None] * kt[:, :, None, :]
        return S, jnp.einsum('bhij,bhj->bhi', S, rt)

    S, ys = lax.scan(step, state0, xs)
    return jnp.moveaxis(ys, 0, 1), S


def _rwkv7_mixer(h, hc, mix, w_rkvg, w0, w1, w2, a0, a1, a2, k_k, k_a, r_k, gn_g, gn_b, w_out, ctx_out):
    f32 = jnp.float32
    B = h.shape[0]
    heads = lambda t: t.reshape(t.shape[0], t.shape[1], RWKV_HEADS, RWKV_N).astype(f32)

    def prep(u, shifted):
        xx = shifted - u
        xr, xw, xk, xv, xa, xg = (u + xx * mix[j] for j in range(6))
        r, k, v, g = jnp.einsum('nbtd,nde->nbte', jnp.stack([xr, xk, xv, xg]), w_rkvg)
        kk = heads(k * k_k)
        kk = kk / jnp.maximum(jnp.sqrt(jnp.sum(kk * kk, -1, keepdims=True)), 1e-12)
        per_dir = []
        for d in range(2):
            wlog = -jax.nn.softplus(-(w0[d] + jnp.tanh(xw @ w1[d]) @ w2[d]).astype(f32)) - 0.5
            ad = jax.nn.sigmoid((a0[d] + (xa @ a1[d]) @ a2[d]).astype(f32))
            kd = k.astype(f32) * (1.0 + (ad - 1.0) * k_a.astype(f32))
            per_dir.append((heads(jnp.exp(-jnp.exp(wlog))), heads(kd), -kk, kk * heads(ad)))
        return heads(r), heads(v), g, per_dir

    r, v, g, dirs = prep(h, _qshift_grid(h))
    rc, vc, gc, dirs_c = prep(hc, _shift_seq(hc))
    zero = jnp.zeros((B, RWKV_HEADS, RWKV_N, RWKV_N), f32)

    def direction(d, rev):
        f = (lambda t: jnp.flip(t, axis=1)) if rev else (lambda t: t)
        wc_, kc_, ac_, bc_ = dirs_c[d]
        yc_d, state = _rwkv_scan(f(rc), f(wc_), f(kc_), f(vc), f(ac_), f(bc_), zero)
        w_, k_, a_, b_ = dirs[d]
        y_d, _ = _rwkv_scan(f(r), f(w_), f(k_), f(v), f(a_), f(b_), state)
        return f(y_d), f(yc_d)

    y_f, yc_f = direction(0, False)
    y_b, yc_b = direction(1, True)

    def finish(y, r_, v_, k_fwd, k_bwd, gate):
        Bn, Tn = y.shape[:2]
        mu = y.mean(-1, keepdims=True)
        var = jnp.mean(jnp.square(y - mu), -1, keepdims=True)
        o = ((y - mu) * lax.rsqrt(var + RWKV_GN_EPS)).reshape(Bn, Tn, D_MODEL) * gn_g + gn_b
        bonus = ((r_ * k_fwd * r_k).sum(-1, keepdims=True) * v_
                 + (r_ * k_bwd * r_k).sum(-1, keepdims=True) * v_).reshape(Bn, Tn, D_MODEL)
        o = (o + bonus) * jax.nn.silu(gate.astype(f32))
        return o.astype(h.dtype) @ w_out

    y = finish(y_f + y_b, r, v, dirs[0][1], dirs[1][1], g)
    yc = finish(yc_f + yc_b, rc, vc, dirs_c[0][1], dirs_c[1][1], gc) if ctx_out else None
    return y, yc


def setup_inputs(seed: int = 0) -> dict:
    key = jax.random.key(seed)
    ks = iter(jax.random.split(key, 48))
    nrm = lambda shape, s: jax.random.normal(next(ks), shape, jnp.float32) * s
    D, I, H = D_MODEL, MLSTM_INNER, MLSTM_HEADS

    gamma0 = 1.0 - 2.0 ** (-5.0 - np.arange(RET_HEADS))
    ret_decay0 = jnp.asarray(np.log(gamma0 / (1.0 - gamma0)), jnp.float32)

    return {
        "x": nrm((BATCH, SEQ, D), 1.0),
        "c": nrm((BATCH, D), 1.0),
        "ctx": nrm((BATCH, CTX_LEN, D), 1.0),
        "c_ctx": nrm((D,), 1.0),
        "ada_w": nrm((DEPTH, D, 3 * D), D ** -0.5),
        "ada_b": nrm((DEPTH, 3 * D), 0.02),
        "ln_g": 1.0 + nrm((DEPTH, D), 0.02),
        "ln_b": nrm((DEPTH, D), 0.02),
        "ret_w_in": nrm((N_RET, D, RET_IN), D ** -0.5),
        "ret_decay": ret_decay0 + nrm((N_RET, 2, RET_HEADS), 0.05),
        "ret_w_out": nrm((N_RET, RET_V, D), RET_V ** -0.5 * DEEPNORM_BETA),
        "ml_w_in": nrm((N_MLSTM, D, 2 * I), D ** -0.5),
        "ml_conv_w": nrm((N_MLSTM, MLSTM_CONV, I), MLSTM_CONV ** -0.5),
        "ml_conv_b": nrm((N_MLSTM, I), 0.02),
        "ml_w_qkv": nrm((N_MLSTM, 3, N_QKV_BLOCKS, QKV_BLOCK, QKV_BLOCK), QKV_BLOCK ** -0.5),
        "ml_gate_w": nrm((N_MLSTM, 2, 3 * I, 2 * H), 0.1 * (3 * I) ** -0.5),
        "ml_gate_b": jnp.concatenate([nrm((N_MLSTM, 2, H), 0.1),
                                      jnp.linspace(3.0, 6.0, H) + nrm((N_MLSTM, 2, H), 0.05)], axis=-1),
        "ml_skip": 1.0 + nrm((N_MLSTM, I), 0.02),
        "ml_gn_g": 1.0 + nrm((N_MLSTM, I), 0.02),
        "ml_w_out": nrm((N_MLSTM, I, D), I ** -0.5 * DEEPNORM_BETA),
        "rk_mix": jax.random.uniform(next(ks), (N_RWKV, 6, D), jnp.float32, 0.2, 0.8),
        "rk_w_rkvg": nrm((N_RWKV, 4, D, D), D ** -0.5),
        "rk_w0": jnp.linspace(-6.0, -1.0, D) + nrm((N_RWKV, 2, D), 0.1),
        "rk_w1": nrm((N_RWKV, 2, D, RWKV_DECAY_LORA), 0.1 * D ** -0.5),
        "rk_w2": nrm((N_RWKV, 2, RWKV_DECAY_LORA, D), 0.1 * RWKV_DECAY_LORA ** -0.5),
        "rk_a0": nrm((N_RWKV, 2, D), 0.1),
        "rk_a1": nrm((N_RWKV, 2, D, RWKV_A_LORA), 0.1 * D ** -0.5),
        "rk_a2": nrm((N_RWKV, 2, RWKV_A_LORA, D), 0.1 * RWKV_A_LORA ** -0.5),
        "rk_k_k": 0.85 + nrm((N_RWKV, D), 0.02),
        "rk_k_a": 1.0 + nrm((N_RWKV, D), 0.02),
        "rk_r_k": nrm((N_RWKV, RWKV_HEADS, RWKV_N), 0.1),
        "rk_gn_g": 1.0 + nrm((N_RWKV, D), 0.02),
        "rk_gn_b": nrm((N_RWKV, D), 0.02),
        "rk_w_out": nrm((N_RWKV, D, D), D ** -0.5 * DEEPNORM_BETA),
    }


def reference(x, c, ctx, c_ctx, ada_w, ada_b, ln_g, ln_b,
              ret_w_in, ret_decay, ret_w_out,
              ml_w_in, ml_conv_w, ml_conv_b, ml_w_qkv, ml_gate_w, ml_gate_b, ml_skip, ml_gn_g, ml_w_out,
              rk_mix, rk_w_rkvg, rk_w0, rk_w1, rk_w2, rk_a0, rk_a1, rk_a2, rk_k_k, rk_k_a, rk_r_k,
              rk_gn_g, rk_gn_b, rk_w_out):
    sc = jax.nn.silu(c)
    scc = jax.nn.silu(c_ctx)
    xc = ctx
    for i in range(DEPTH):
        last = i == DEPTH - 1
        mod = sc @ ada_w[i] + ada_b[i]
        modc = scc @ ada_w[i] + ada_b[i]
        shift, scale, gate = jnp.split(mod[:, None, :], 3, axis=-1)
        shift_c, scale_c, gate_c = jnp.split(modc, 3)
        h = x * (1.0 + scale) + shift
        hc = xc * (1.0 + scale_c) + shift_c
        kind, j = i % N_MIXERS, i // N_MIXERS
        if kind == 0:
            y, yc = _retention_mixer(h, hc, ret_w_in[j], ret_decay[j], ret_w_out[j], not last)
        elif kind == 1:
            y, yc = _mlstm_mixer(h, hc, ml_w_in[j], ml_conv_w[j], ml_conv_b[j], ml_w_qkv[j], ml_gate_w[j],
                                 ml_gate_b[j], ml_skip[j], ml_gn_g[j], ml_w_out[j], not last)
        else:
            y, yc = _rwkv7_mixer(h, hc, rk_mix[j], rk_w_rkvg[j], rk_w0[j], rk_w1[j], rk_w2[j], rk_a0[j],
                                 rk_a1[j], rk_a2[j], rk_k_k[j], rk_k_a[j], rk_r_k[j], rk_gn_g[j], rk_gn_b[j],
                                 rk_w_out[j], not last)
        x = _layer_norm(DEEPNORM_ALPHA * x + gate * y, ln_g[i], ln_b[i])
        if not last:
            xc = _layer_norm(DEEPNORM_ALPHA * xc + gate_c * yc, ln_g[i], ln_b[i])
    return x
```

```cpp
#include <hip/hip_runtime.h>
#include <cstdio>
#include <cstdint>
#include <cmath>
#define XB_TMO      128
#define XB_XCNT(j)  (256  + 64 * (j))
#define XB_XSUB(j)  (1280 + 64 * (j))
#define XB_XGEN(j)  (2304 + 64 * (j))
#define XB_TOP      3328
#define XB_TOPGEN   3392
#define XCD_BAR_WORDS 3456
#define XB_SPIN_CAP (1u << 18)
#define LAS __attribute__((address_space(3)))

__device__ __forceinline__ unsigned xb_ld(unsigned* p)              { return __hip_atomic_load(p, __ATOMIC_RELAXED, __HIP_MEMORY_SCOPE_AGENT); }
__device__ __forceinline__ unsigned xb_add(unsigned* p, unsigned v) { return __hip_atomic_fetch_add(p, v, __ATOMIC_RELAXED, __HIP_MEMORY_SCOPE_AGENT); }
__device__ __forceinline__ unsigned xb_xcc_id() { return (unsigned)__builtin_amdgcn_s_getreg((3 << 11) | 20) & 0xFu; }
#define XB_SPIN(cond, bar) do { unsigned _sp = 0; while (cond) { __builtin_amdgcn_s_sleep(1); \
    if ((++_sp & 255u) == 0u) { if (xb_ld(&(bar)[XB_TMO])) break; if (_sp > XB_SPIN_CAP) { atomicAdd(&(bar)[XB_TMO], 1u); break; } } } } while (0)

struct XcdBarrier {
    unsigned* bar; unsigned x;
    volatile LAS unsigned* st;
};

__device__ __forceinline__ XcdBarrier xcd_barrier_post(unsigned* bar, volatile LAS unsigned* st) {
    XcdBarrier b; b.bar = bar; b.x = xb_xcc_id(); b.st = st;
    if (threadIdx.x == 0) (void)xb_add(&bar[XB_XCNT(b.x)], 1u);
    return b;
}
__device__ __forceinline__ void xcd_barrier_complete(unsigned* bar, unsigned x, unsigned& nloc, unsigned& nx) {
    const unsigned G = gridDim.x * gridDim.y * gridDim.z;
    unsigned sum, cnt, mine, sp = 0u;
    for (;;) {
        sum = 0u; cnt = 0u; mine = 0u;
#pragma unroll
        for (unsigned j = 0; j < 16; ++j) { const unsigned c = xb_ld(&bar[XB_XCNT(j)]); sum += c; cnt += (c > 0u) ? 1u : 0u; mine = (j == x) ? c : mine; }
        if (sum == G) break;
        __builtin_amdgcn_s_sleep(1);
        if ((++sp & 255u) == 0u) { if (xb_ld(&bar[XB_TMO])) break; if (sp > XB_SPIN_CAP) { atomicAdd(&bar[XB_TMO], 1u); break; } }
    }
    nloc = mine > 0u ? mine : 1u; nx = cnt > 0u ? cnt : 1u;
}

__device__ __forceinline__ void xcd_barrier(const XcdBarrier& b) {
    asm volatile("s_waitcnt vmcnt(0)" ::: "memory");
    __syncthreads();
    if (threadIdx.x == 0) {
        unsigned* bar = b.bar;
        __builtin_amdgcn_s_waitcnt(0);
        unsigned nloc = b.st[0], nx = b.st[1];
        if (nloc == 0u) { xcd_barrier_complete(bar, b.x, nloc, nx); b.st[0] = nloc; b.st[1] = nx; }
        const unsigned old = xb_add(&bar[XB_XSUB(b.x)], 1u);
        const unsigned gen = old / nloc;
        if (old + 1u == (gen + 1u) * nloc) {
            __builtin_amdgcn_fence(__ATOMIC_RELEASE, "agent");
            asm volatile("s_waitcnt vmcnt(0)" ::: "memory");
            const unsigned og = xb_add(&bar[XB_TOP], 1u);
            const unsigned tg = og / nx;
            if (og + 1u == (tg + 1u) * nx) xb_add(&bar[XB_TOPGEN], 1u);
            else XB_SPIN(xb_ld(&bar[XB_TOPGEN]) == tg, bar);
            __builtin_amdgcn_fence(__ATOMIC_ACQUIRE, "agent");
            xb_add(&bar[XB_XGEN(b.x)], 1u);
            asm volatile("s_waitcnt vmcnt(0)" ::: "memory");
        } else {
            XB_SPIN(xb_ld(&bar[XB_XGEN(b.x)]) == gen, bar);
            __builtin_amdgcn_fence(__ATOMIC_ACQUIRE, "agent");
            asm volatile("s_waitcnt vmcnt(0)" ::: "memory");
        }
    }
    __syncthreads();
}
namespace pg8 {
#define PG8_LAS __attribute__((address_space(3)))
typedef unsigned short bf16_t;
typedef short bf16x8 __attribute__((ext_vector_type(8)));
typedef float f32x4 __attribute__((ext_vector_type(4)));
typedef unsigned u32x4 __attribute__((ext_vector_type(4)));
constexpr int BM = 256, BK = 64, HALF = 128, HTB = HALF * BK * 2  , STAGE_BYTES = 8 * HTB, NXCD = 8, WGM = 8;

__host__ __device__ __forceinline__ int lds_byte(int r, int c) { const int st = (r >> 4) * 2 + (c >> 5), rr = r & 15, cc = c & 31, ob = rr * 64 + cc * 2; return st * 1024 + (ob ^ (((ob >> 9) & 1) << 5)); }
__host__ __device__ __forceinline__ void stage_rc(int b, int& R, int& C) { const int st = b / 1024, sb = b % 1024, swz = sb ^ (((sb >> 9) & 1) << 5); R = (st >> 1) * 16 + swz / 64; C = (st & 1) * 32 + (swz % 64) / 2; }
__host__ __device__ __forceinline__ int perm32(int rho) { const int n = rho >> 4, i = rho & 15; return 8 * (i >> 2) + 4 * n + (i & 3); }

struct Unit { int pm, pn; };
struct Gemm { const bf16_t* A; const bf16_t* Bt; int M, N, K; };

struct StaticOrder {
    int nM, nN, nwg, G, c;
    __host__ __device__ void init(int M, int N, int G_, int c_) { nM = M / BM; nN = N / BM; nwg = nM * nN; G = G_; c = c_; }
    __host__ __device__ bool next(int i, Unit& u) const {
        const long L = (long)i * G + c; if (L >= nwg) return false;
        int wgid = (int)L; { const int q = nwg / NXCD, r = nwg % NXCD, xcd = wgid % NXCD, off = wgid / NXCD; wgid = (xcd < r ? xcd * (q + 1) : r * (q + 1) + (xcd - r) * q) + off; }
        const int nig = WGM * nN, gid = wgid / nig, fm = gid * WGM, gsz = (nM - fm) < WGM ? (nM - fm) : WGM;
        u.pm = fm + ((wgid % nig) % gsz); u.pn = (wgid % nig) / gsz; return true;
    }
    __device__ __forceinline__ void a_ready(const Unit&) const {}
    __device__ __forceinline__ void done(const Unit&) const {}
};
__device__ __forceinline__ unsigned cvt_pk_bf16(float lo, float hi) { unsigned r; asm volatile("v_cvt_pk_bf16_f32 %0, %1, %2" : "=v"(r) : "v"(lo), "v"(hi)); return r; }
template <class Epi, class Sched, bool STAMP = false>
__device__ __forceinline__ void gemm_phase(PG8_LAS unsigned char* lds, const Gemm g, const Sched& S, const Epi& E, unsigned long long* stamps) {
    const int tid = threadIdx.x, wid = __builtin_amdgcn_readfirstlane(tid >> 6), lane = tid & 63, wr = wid >> 2, wc = wid & 3, fr = lane & 15, fq = lane >> 4;
    const int K = g.K, nt = K / BK;
    int ts_lo = 0, ts_hi = 0, nts = 0; const unsigned long long rt_entry = STAMP ? (unsigned long long)wall_clock64() : 0ull;
#define PG8_STAMP() do { if (STAMP && wid == 0 && nts < 64) { const unsigned long long _c = (unsigned long long)clock64(); \
        ts_lo = (lane == nts) ? (int)(unsigned)_c : ts_lo; ts_hi = (lane == nts) ? (int)(unsigned)(_c >> 32) : ts_hi; ++nts; } } while (0)
    PG8_STAMP();
    unsigned voffA[2], voffB[2];
#pragma unroll
    for (int i = 0; i < 2; ++i) { int R, C; stage_rc(tid * 16 + i * 8192, R, C); const int Rb = Epi::PERM ? ((R & ~31) + perm32(R & 31)) : R;
        voffA[i] = (unsigned)(R * K + C) * 2u; voffB[i] = (unsigned)(Rb * K + C) * 2u; }
    const size_t kstep = (size_t)(BK * 2);
    const size_t hstep = (size_t)HALF * K * 2;
    const size_t tstep = 2 * hstep;
    const unsigned ldsw = (unsigned)wid * 1024u;
    const int aoff = lds_byte(wr * 64 + fr, fq * 8), boff = lds_byte(wc * 32 + fr, fq * 8);
#define PG8_SA(b, h) (((b) * 2 + (h)) * HTB)
#define PG8_SB(b, h) ((4 + (b) * 2 + (h)) * HTB)
#define PG8_STAGE(bufoff, gbase, voff) do { _Pragma("unroll") for (int _i = 0; _i < 2; ++_i) \
        __builtin_amdgcn_global_load_lds((const unsigned*)((const char*)(gbase) + (voff)[_i]), (PG8_LAS unsigned*)(lds + (bufoff) + ldsw + _i * 8192), 16, 0, 0); } while (0)
#define PG8_LDA(dst, b, h) do { _Pragma("unroll") for (int m = 0; m < 4; ++m) _Pragma("unroll") for (int k = 0; k < 2; ++k) dst[m][k] = *(const PG8_LAS bf16x8*)(lds + PG8_SA(b, h) + aoff + m * 2048 + k * 1024); } while (0)
#define PG8_LDB(dst, b, h) do { _Pragma("unroll") for (int n = 0; n < 2; ++n) _Pragma("unroll") for (int k = 0; k < 2; ++k) dst[n][k] = *(const PG8_LAS bf16x8*)(lds + PG8_SB(b, h) + boff + n * 2048 + k * 1024); } while (0)
#define PG8_MMA(ai, bj, At, Bt) do { __builtin_amdgcn_s_setprio(1); _Pragma("unroll") for (int m = 0; m < 4; ++m) _Pragma("unroll") for (int n = 0; n < 2; ++n) _Pragma("unroll") for (int k = 0; k < 2; ++k) \
        acc[ai][bj][m][n] = __builtin_amdgcn_mfma_f32_16x16x32_bf16(Bt[n][k], At[m][k], acc[ai][bj][m][n], 0, 0, 0); __builtin_amdgcn_s_setprio(0); } while (0)
#define PG8_WAIT_V(n) asm volatile("s_waitcnt vmcnt(" #n ")" ::: "memory")
#define PG8_WAIT_L(n) asm volatile("s_waitcnt lgkmcnt(" #n ")" ::: "memory")
#define PG8_BAR __builtin_amdgcn_s_barrier()
#define PG8_SCHED __builtin_amdgcn_sched_barrier(0)
    Unit cur, nxt; int ui = 0;
    if (!S.next(0, cur)) return;
    f32x4 acc[2][2][4][2];
#pragma unroll
    for (int a = 0; a < 2; ++a)
#pragma unroll
        for (int b = 0; b < 2; ++b)
#pragma unroll
            for (int m = 0; m < 4; ++m)
#pragma unroll
                for (int n = 0; n < 2; ++n) acc[a][b][m][n] = (f32x4){0.f, 0.f, 0.f, 0.f};
    bf16x8 At[4][2], B0[2][2], B1[2][2];
    const char* cA = (const char*)g.A + (size_t)cur.pm * tstep; const char* cB = (const char*)g.Bt + (size_t)cur.pn * tstep;
    S.a_ready(cur);
    PG8_STAGE(PG8_SB(0, 0), cB, voffB); PG8_STAGE(PG8_SA(0, 0), cA, voffA); PG8_STAGE(PG8_SB(0, 1), cB + hstep, voffB); PG8_STAGE(PG8_SA(0, 1), cA + hstep, voffA);
    if (wr == 1) PG8_BAR;
    PG8_WAIT_V(4); PG8_BAR;
    PG8_STAGE(PG8_SB(1, 0), cB + kstep, voffB); PG8_STAGE(PG8_SA(1, 0), cA + kstep, voffA); PG8_STAGE(PG8_SB(1, 1), cB + hstep + kstep, voffB);
    PG8_WAIT_V(6); PG8_BAR;
    PG8_STAMP();
    for (;;) {
        const bool has_next = S.next(ui + 1, nxt);
        const char* nA = has_next ? (const char*)g.A + (size_t)nxt.pm * tstep : cA; const char* nB = has_next ? (const char*)g.Bt + (size_t)nxt.pn * tstep : cB;
        for (int t = 0; t < nt; t += 2) {
            const bool last = (t == nt - 2);
            const char* a1 = cA + (size_t)(t + 1) * kstep;
            const char* a2 = last ? nA : cA + (size_t)(t + 2) * kstep; const char* b2 = last ? nB : cB + (size_t)(t + 2) * kstep;
            const char* a3 = a2 + kstep; const char* b3 = b2 + kstep;
            if (last && has_next) S.a_ready(nxt);
            PG8_LDB(B0, 0, 0); PG8_SCHED; PG8_LDA(At, 0, 0); PG8_STAGE(PG8_SA(1, 1), a1 + hstep, voffA);
            PG8_WAIT_L(8); PG8_BAR; PG8_WAIT_L(0); PG8_MMA(0, 0, At, B0); PG8_BAR; PG8_SCHED;
            PG8_LDB(B1, 0, 1); PG8_STAGE(PG8_SB(0, 0), b2, voffB);
            PG8_BAR; PG8_WAIT_L(0); PG8_MMA(0, 1, At, B1); PG8_BAR;
            PG8_LDA(At, 0, 1); PG8_STAGE(PG8_SA(0, 0), a2, voffA);
            PG8_BAR; PG8_WAIT_L(0); PG8_MMA(1, 0, At, B0); PG8_BAR; PG8_SCHED;
            PG8_STAGE(PG8_SB(0, 1), b2 + hstep, voffB);
            PG8_WAIT_V(6); PG8_BAR; PG8_MMA(1, 1, At, B1); PG8_BAR;
            PG8_LDB(B0, 1, 0); PG8_SCHED; PG8_LDA(At, 1, 0); PG8_STAGE(PG8_SA(0, 1), a2 + hstep, voffA);
            PG8_WAIT_L(8); PG8_BAR; PG8_WAIT_L(0); PG8_MMA(0, 0, At, B0); PG8_BAR; PG8_SCHED;
            PG8_LDB(B1, 1, 1); PG8_STAGE(PG8_SB(1, 0), b3, voffB);
            PG8_BAR; PG8_WAIT_L(0); PG8_MMA(0, 1, At, B1); PG8_BAR;
            PG8_LDA(At, 1, 1); PG8_STAGE(PG8_SA(1, 0), a3, voffA);
            PG8_BAR; PG8_WAIT_L(0); PG8_MMA(1, 0, At, B0); PG8_BAR; PG8_SCHED;
            PG8_STAGE(PG8_SB(1, 1), b3 + hstep, voffB);
            PG8_WAIT_V(6); PG8_BAR; PG8_MMA(1, 1, At, B1); PG8_BAR;
        }
        PG8_STAMP();
        if constexpr (!Epi::AFTER_DRAIN) { E(acc, cur, wr, wc, fr, fq); S.done(cur); }
        PG8_STAMP();
        if (!has_next) break;
#pragma unroll
        for (int a = 0; a < 2; ++a)
#pragma unroll
            for (int b = 0; b < 2; ++b)
#pragma unroll
                for (int m = 0; m < 4; ++m)
#pragma unroll
                    for (int n = 0; n < 2; ++n) acc[a][b][m][n] = (f32x4){0.f, 0.f, 0.f, 0.f};
        cur = nxt; cA = nA; cB = nB; ++ui;
    }
    PG8_WAIT_V(0);
    if (wr == 0) PG8_BAR;
    PG8_BAR;
    if constexpr (Epi::AFTER_DRAIN) { E.fused(acc, cur, wr, wc, fr, fq, lds, wid, lane); S.done(cur); }
    PG8_STAMP();
    if (STAMP && wid == 0) { stamps[lane] = lane < nts ? (((unsigned long long)(unsigned)ts_hi << 32) | (unsigned)ts_lo) : 0ull;
        if (lane == 62) stamps[62] = rt_entry; if (lane == 63) stamps[63] = (unsigned long long)wall_clock64(); }
#undef PG8_STAMP
#undef PG8_SA
#undef PG8_SB
#undef PG8_STAGE
#undef PG8_LDA
#undef PG8_LDB
#undef PG8_MMA
#undef PG8_WAIT_V
#undef PG8_WAIT_L
#undef PG8_BAR
#undef PG8_SCHED
}
}

using pg8::bf16_t; using pg8::bf16x8; using pg8::f32x4; using pg8::u32x4;
typedef unsigned u32x2 __attribute__((ext_vector_type(2)));
constexpr int NB = 8, CTXL = 256, SEQ = 4096, SP = CTXL + SEQ  , NTOK = NB * SP  , NH = NTOK / 2  , DM = 1024;
constexpr int NCH = SP / 128;
constexpr int NTHR = 512;
constexpr float ALPHA = 1.6817928305074290f;
constexpr float LN_EPS = 1e-5f;
constexpr size_t MiB = 1048576;
constexpr size_t WS_BAR = 0;
constexpr size_t WS_MOD = 16384;
constexpr size_t WS_ROPE = WS_MOD + 458752;
constexpr size_t WS_XCTX = 2 * MiB;
constexpr size_t WS_H = 10 * MiB;
constexpr size_t WS_W = 78 * MiB;
constexpr size_t WS_S = 102 * MiB;
constexpr size_t WS_END = 510 * MiB;
constexpr size_t U34 = 34 * MiB, U68 = 68 * MiB;
static_assert((size_t)NH * 1024 * 2 == U34 && (size_t)NTOK * 1024 * 2 == U68, "unit sizes");
constexpr int LDS_BYTES = 155648;

__device__ __forceinline__ float bf2f(unsigned short h) { return __uint_as_float(((unsigned)h) << 16); }
__device__ __forceinline__ float bflo(unsigned w) { return __uint_as_float(w << 16); }
__device__ __forceinline__ float bfhi(unsigned w) { return __uint_as_float(w & 0xffff0000u); }
__device__ __forceinline__ unsigned pk2(float lo, float hi) { return pg8::cvt_pk_bf16(lo, hi); }
__device__ __forceinline__ float siluf(float x) { return x / (1.f + __expf(-x)); }
__device__ __forceinline__ float sigmf(float x) { return 1.f / (1.f + __expf(-x)); }
__device__ __forceinline__ void unpack8(const uint4 v, float (&f)[8]) {
    f[0] = bflo(v.x); f[1] = bfhi(v.x); f[2] = bflo(v.y); f[3] = bfhi(v.y); f[4] = bflo(v.z); f[5] = bfhi(v.z); f[6] = bflo(v.w); f[7] = bfhi(v.w); }
__device__ __forceinline__ uint4 pack8(const float (&f)[8]) { uint4 v; v.x = pk2(f[0], f[1]); v.y = pk2(f[2], f[3]); v.z = pk2(f[4], f[5]); v.w = pk2(f[6], f[7]); return v; }
#define SLABOFF(row, ch) ((row) * 128 + ((((ch) ^ (row)) & 7) << 4))
__device__ __forceinline__ bf16x8 lds_frag(LAS unsigned char* slab, int row, int ch) { return *(const LAS bf16x8*)(slab + SLABOFF(row, ch)); }
__device__ __forceinline__ void lds_st16(LAS unsigned char* slab, int row, int ch, uint4 v) { u32x4 t; t.x = v.x; t.y = v.y; t.z = v.z; t.w = v.w; *(LAS u32x4*)(slab + SLABOFF(row, ch)) = t; }
__device__ __forceinline__ uint4 lds_ld16(LAS unsigned char* slab, int row, int ch) { const u32x4 t = *(const LAS u32x4*)(slab + SLABOFF(row, ch)); return make_uint4(t.x, t.y, t.z, t.w); }
template <int TM, int TN>
__device__ __forceinline__ void mma_slab(f32x4 (&acc)[TM][TN], LAS unsigned char* As, int arow0, LAS unsigned char* Bs, int brow0, int lane) {
#pragma unroll
    for (int ks = 0; ks < 2; ++ks) {
        bf16x8 a[TM], b[TN];
#pragma unroll
        for (int tm = 0; tm < TM; ++tm) a[tm] = lds_frag(As, arow0 + 16 * tm + (lane & 15), (lane >> 4) + 4 * ks);
#pragma unroll
        for (int tn = 0; tn < TN; ++tn) b[tn] = lds_frag(Bs, brow0 + 16 * tn + (lane & 15), (lane >> 4) + 4 * ks);
#pragma unroll
        for (int tm = 0; tm < TM; ++tm)
#pragma unroll
            for (int tn = 0; tn < TN; ++tn) acc[tm][tn] = __builtin_amdgcn_mfma_f32_16x16x32_bf16(a[tm], b[tn], acc[tm][tn], 0, 0, 0);
    }
}
__device__ __forceinline__ int ord_b(int k) { return k == 0 ? 1 : (k == 1 ? 0 : 35 - k); }
__device__ __forceinline__ int pos_b(int c) { return c == 1 ? 0 : (c == 0 ? 1 : 35 - c); }
__device__ __forceinline__ float log2_gamma(float logit) {
    const float sp = (logit > 15.f) ? __expf(-logit) : log1pf(__expf(-logit)); return -sp * 1.4426950408889634f; }

__device__ __forceinline__ void wg_sync() { __builtin_amdgcn_sched_barrier(0); asm volatile("s_waitcnt vmcnt(0) lgkmcnt(0)" ::: "memory"); __builtin_amdgcn_s_barrier(); asm volatile("s_nop 4" ::: "memory"); __builtin_amdgcn_sched_barrier(0); }

struct Prm {
    const float* in[34]; float* out; unsigned char* ws;
};
#define PHASE_FN static __device__ __forceinline__

template <class F>
__device__ __forceinline__ void cvt_tiles(bf16_t* dst, int ld_dst, int koff, int NN, int KK, F f, LAS float* T, int bid, int nb, int& tbase) {
    const int tid = threadIdx.x, tn = NN / 64, tk = KK / 64, nt = tn * tk;
    int first = (bid - (tbase % nb) + nb) % nb;
    for (int t = first; t < nt; t += nb) {
        const int n0 = (t % tn) * 64, k0 = (t / tn) * 64;
        wg_sync();
#pragma unroll
        for (int i = 0; i < 8; ++i) { const int kk = (tid >> 6) + 8 * i, nn = tid & 63; T[kk * 65 + nn] = f(k0 + kk, n0 + nn); }
        wg_sync();
        const int nn2 = tid >> 3, kc = tid & 7; float v[8];
#pragma unroll
        for (int e = 0; e < 8; ++e) v[e] = T[(8 * kc + e) * 65 + nn2];
        *(uint4*)(dst + (size_t)(n0 + nn2) * ld_dst + koff + k0 + 8 * kc) = pack8(v);
    }
    tbase += nt;
}

PHASE_FN void phase_mod(const float* cvec, const float* cctx, const float* ada_w, const float* ada_b, float* mod, float* rope, LAS unsigned char* L, int bid, int nb) {
    const int tid = threadIdx.x;
    LAS float* sc = (LAS float*)L;
    LAS float* red = sc + 9 * 1024;
    for (int i = tid; i < 9 * 1024; i += NTHR) { const int j = i >> 10, k = i & 1023; const float v = (j < 8) ? cvec[j * 1024 + k] : cctx[k]; sc[i] = siluf(v); }
    wg_sync();
    for (int blk = bid; blk < 256; blk += nb) {
        const int l = blk >> 6, c0 = (blk & 63) * 48;
        float a[9];
#pragma unroll
        for (int j = 0; j < 9; ++j) a[j] = 0.f;
        const int col = tid % 48, kg = tid / 48;
        if (tid < 480) {
            for (int k = kg; k < 1024; k += 10) { const float w = ada_w[((size_t)l * 1024 + k) * 3072 + c0 + col];
#pragma unroll
                for (int j = 0; j < 9; ++j) a[j] += sc[j * 1024 + k] * w; }
#pragma unroll
            for (int j = 0; j < 9; ++j) red[(kg * 48 + col) * 9 + j] = a[j];
        }
        wg_sync();
        if (tid < 48 * 9) { const int cc = tid / 9, j = tid % 9; float s = 0.f;
#pragma unroll
            for (int g = 0; g < 10; ++g) s += red[(g * 48 + cc) * 9 + j];
            mod[((size_t)l * 9 + j) * 3072 + c0 + cc] = s + ada_b[l * 3072 + c0 + cc]; }
        wg_sync();
    }
    for (int i = bid * NTHR + tid; i < 4096; i += nb * NTHR) { const int pos = i >> 6, fi = i & 63;
        const double inv = pow(10000.0, -(double)fi / 64.0), ang = (double)pos * inv; rope[2 * i] = (float)cos(ang); rope[2 * i + 1] = (float)sin(ang); }
}

__device__ __forceinline__ const float* xrow_in(const float* xl, const float* xc, int R) { const int b = R / SP, s = R - b * SP; return s < CTXL ? xc + ((size_t)b * CTXL + s) * DM : xl + ((size_t)b * SEQ + (s - CTXL)) * DM; }

PHASE_FN void phase_h0(const float* x, const float* ctx, const float* mod0, bf16_t* H, int bid, int nb) {
    const int tid = threadIdx.x, lane = tid & 63, wv = tid >> 6;
    for (int R = bid * 8 + wv; R < NTOK; R += nb * 8) {
        const int b = R / SP, s = R - b * SP; const float* xr = xrow_in(x, ctx, R); const float* md = mod0 + (size_t)(s < CTXL ? 8 : b) * 3072;
#pragma unroll
        for (int u = 0; u < 2; ++u) { const int c = 8 * lane + 512 * u; float v[8];
            const float4 x0 = *(const float4*)(xr + c), x1 = *(const float4*)(xr + c + 4), s0 = *(const float4*)(md + c), s1 = *(const float4*)(md + c + 4), g0 = *(const float4*)(md + 1024 + c), g1 = *(const float4*)(md + 1024 + c + 4);
            v[0] = x0.x * (1.f + g0.x) + s0.x; v[1] = x0.y * (1.f + g0.y) + s0.y; v[2] = x0.z * (1.f + g0.z) + s0.z; v[3] = x0.w * (1.f + g0.w) + s0.w;
            v[4] = x1.x * (1.f + g1.x) + s1.x; v[5] = x1.y * (1.f + g1.y) + s1.y; v[6] = x1.z * (1.f + g1.z) + s1.z; v[7] = x1.w * (1.f + g1.w) + s1.w;
            *(uint4*)(H + (size_t)R * DM + c) = pack8(v); }
    }
}

PHASE_FN void phase_ln(const float* xl_in, const float* xc_in, float* xl_out, float* xc_out, const float* ymix, const float* modl, const float* modn, const float* lng, const float* lnb,
                       bf16_t* H, int R0, int R1, int last, int bid, int nb, unsigned* cnt = nullptr) {
    const int tid = threadIdx.x, lane = tid & 63, wv = tid >> 6;
    for (int R = R0 + bid * 8 + wv; R < R1; R += nb * 8) {
        const int b = R / SP, s = R - b * SP; if (last && s < CTXL) continue;
        const float* xr = xrow_in(xl_in, xc_in, R); const float* yr = ymix + (size_t)(R - R0) * DM; const int j = (s < CTXL ? 8 : b);
        const float* gt = modl + (size_t)j * 3072 + 2048;
        float z[16]; float sum = 0.f;
#pragma unroll
        for (int u = 0; u < 4; ++u) { const int c = 4 * lane + 256 * u; const float4 xv = *(const float4*)(xr + c), yv = *(const float4*)(yr + c), gv = *(const float4*)(gt + c);
            z[4 * u + 0] = ALPHA * xv.x + gv.x * yv.x; z[4 * u + 1] = ALPHA * xv.y + gv.y * yv.y; z[4 * u + 2] = ALPHA * xv.z + gv.z * yv.z; z[4 * u + 3] = ALPHA * xv.w + gv.w * yv.w;
            sum += z[4 * u] + z[4 * u + 1] + z[4 * u + 2] + z[4 * u + 3]; }
#pragma unroll
        for (int o = 32; o >= 1; o >>= 1) sum += __shfl_xor(sum, o);
        const float mu = sum * (1.f / 1024.f); float sq = 0.f;
#pragma unroll
        for (int e = 0; e < 16; ++e) { const float d = z[e] - mu; sq += d * d; }
#pragma unroll
        for (int o = 32; o >= 1; o >>= 1) sq += __shfl_xor(sq, o);
        const float rs = rsqrtf(sq * (1.f / 1024.f) + LN_EPS);
        if (cnt && lane == 0 && !(fabsf(sq) < 3.0e38f)) atomicAdd(cnt, 1u);
        float* xo = (s < CTXL) ? xc_out + ((size_t)b * CTXL + s) * DM : xl_out + ((size_t)b * SEQ + (s - CTXL)) * DM;
        const float* mn = modn + (size_t)j * 3072;
#pragma unroll
        for (int u = 0; u < 4; ++u) { const int c = 4 * lane + 256 * u; const float4 g = *(const float4*)(lng + c), bb = *(const float4*)(lnb + c);
            float4 o; o.x = (z[4 * u] - mu) * rs * g.x + bb.x; o.y = (z[4 * u + 1] - mu) * rs * g.y + bb.y; o.z = (z[4 * u + 2] - mu) * rs * g.z + bb.z; o.w = (z[4 * u + 3] - mu) * rs * g.w + bb.w;
            *(float4*)(xo + c) = o;
            if (!last) { const float4 sh = *(const float4*)(mn + c), scl = *(const float4*)(mn + 1024 + c);
                u32x2 w; w.x = pk2(o.x * (1.f + scl.x) + sh.x, o.y * (1.f + scl.y) + sh.y); w.y = pk2(o.z * (1.f + scl.z) + sh.z, o.w * (1.f + scl.w) + sh.w);
                *(u32x2*)(H + (size_t)R * DM + c) = w; } }
    }
}

PHASE_FN void phase_probe(float* out, const unsigned* cnt, int bid, int nb) {
    float off = 0.f;
    for (int l = 3; l >= 0; --l) if (cnt[l]) off = 10.f * (l + 1);
    for (size_t i = (size_t)bid * NTHR + threadIdx.x; i < (size_t)NB * SEQ * DM; i += (size_t)nb * NTHR) { out[i] = off; }
}

PHASE_FN void phase_scan(const void* buf, size_t n, int isbf, unsigned* cnt, int idx, int bid, int nb, float thr = 3.0e38f) {
    unsigned bad = 0;
    for (size_t i = (size_t)bid * NTHR + threadIdx.x; i < n; i += (size_t)nb * NTHR) { const float v = isbf ? bf2f(((const bf16_t*)buf)[i]) : ((const float*)buf)[i]; if (!(fabsf(v) < thr)) ++bad; }
    if (bad) atomicAdd(cnt + idx, 1u);
}
PHASE_FN void phase_probe2(float* out, const unsigned* cnt, int bid, int nb) {
    float off = 0.f;
    for (int l = 15; l >= 0; --l) if (cnt[l]) off = 10.f * (l + 1);
    for (size_t i = (size_t)bid * NTHR + threadIdx.x; i < (size_t)NB * SEQ * DM; i += (size_t)nb * NTHR) { out[i] = off; }
}

PHASE_FN void phase_probe3(float* out, const unsigned* cnt, int bid, int nb) {
    const unsigned code = cnt[20]; const float off = (code == 0xFFFFFFFFu) ? 0.f : 10.f * (float)(code + 1u);
    for (size_t i = (size_t)bid * NTHR + threadIdx.x; i < (size_t)NB * SEQ * DM; i += (size_t)nb * NTHR) { out[i] = off; }
}

PHASE_FN void phase_cmp(const void* a, const void* b, size_t nbytes, unsigned* cnt, int idx, int bid, int nb) {
    const uint4* x = (const uint4*)a; const uint4* y = (const uint4*)b; unsigned bad = 0;
    for (size_t i = (size_t)bid * NTHR + threadIdx.x; i < nbytes / 16; i += (size_t)nb * NTHR) { const uint4 u = x[i], v = y[i]; if (u.x != v.x || u.y != v.y || u.z != v.z || u.w != v.w) ++bad; }
    if (bad) atomicAdd(cnt + idx, 1u);
}

PHASE_FN void phase_probe5(float* out, const unsigned* cnt, int bid, int nb) {
    const float off = 10.f * (1.f + (cnt[14] ? 1.f : 0.f) + (cnt[15] ? 2.f : 0.f) + (cnt[16] ? 4.f : 0.f) + (cnt[17] ? 8.f : 0.f));
    for (size_t i = (size_t)bid * NTHR + threadIdx.x; i < (size_t)NB * SEQ * DM; i += (size_t)nb * NTHR) { out[i] = off; }
}

PHASE_FN void phase_chkvt(const bf16_t* v, const bf16_t* Vt, unsigned* cnt, int idx, int bid, int nb) {
    unsigned bad = 0;
    for (size_t i = (size_t)bid * NTHR + threadIdx.x; i < (size_t)16 * 512 * SP; i += (size_t)nb * NTHR) { const int s = (int)(i % SP); const size_t r = i / SP; const int n = (int)(r & 511), bh = (int)(r >> 9);
        const bf16_t a = Vt[i], b = v[((size_t)(bh >> 2) * SP + s) * 2048 + (bh & 3) * 512 + n]; if (a != b) ++bad; }
    if (bad) atomicAdd(cnt + idx, bad);
}
PHASE_FN void phase_probe6(float* out, const unsigned* cnt, int bid, int nb) {
    unsigned a = cnt[18], b = cnt[19]; int da = 0, db = 0; while (a) { ++da; a /= 10; } while (b) { ++db; b /= 10; }
    const float off = 10.f * (float)(1 + da + 10 * db);
    for (size_t i = (size_t)bid * NTHR + threadIdx.x; i < (size_t)NB * SEQ * DM; i += (size_t)nb * NTHR) { out[i] = off; }
}

PHASE_FN void phase_probe7(float* out, const unsigned* seq, int bid, int nb) {
    unsigned a = seq[1]; int da = 0; while (a) { ++da; a /= 10; }
    const float off = 10.f * (float)(1 + da);
    for (size_t i = (size_t)bid * NTHR + threadIdx.x; i < (size_t)NB * SEQ * DM; i += (size_t)nb * NTHR) { out[i] = off; }
}

PHASE_FN void phase_chkvt2(const bf16_t* v, const bf16_t* Vt, unsigned* mask, int bid, int nb) {
    for (size_t i = (size_t)bid * NTHR + threadIdx.x; i < (size_t)16 * 512 * SP; i += (size_t)nb * NTHR) { const int s = (int)(i % SP); const size_t r = i / SP; const int n = (int)(r & 511), bh = (int)(r >> 9);
        const bf16_t a = Vt[i], b = v[((size_t)(bh >> 2) * SP + s) * 2048 + (bh & 3) * 512 + n]; if (a != b) { const int item = bh * NCH + (s >> 7); atomicOr(mask + (item >> 5), 1u << (item & 31)); } }
}
PHASE_FN void phase_probe8(float* out, const unsigned* mask, int bid, int nb) {
    int nbad = 0, first = -1; for (int it = 0; it < 16 * NCH; ++it) if (mask[it >> 5] & (1u << (it & 31))) { ++nbad; if (first < 0) first = it; }
    const float off = 10.f * (float)(1 + (nbad > 60 ? 60 : nbad)); const float off2 = 100.f + 10.f * (float)(first < 0 ? 0 : first);
    for (size_t i = (size_t)bid * NTHR + threadIdx.x; i < (size_t)NB * SEQ * DM; i += (size_t)nb * NTHR) { out[i] = (i == 12345) ? off2 : off; }
}

PHASE_FN void phase_probe9(float* out, const unsigned* cnt, int bid, int nb) {
    int mask = 0; for (int l = 0; l < 5; ++l) if (cnt[20 + l]) mask |= 1 << l;
    const float off = 10.f * (float)(1 + mask);
    for (size_t i = (size_t)bid * NTHR + threadIdx.x; i < (size_t)NB * SEQ * DM; i += (size_t)nb * NTHR) { out[i] = off; }
}

PHASE_FN void phase_probe10(float* out, const unsigned* cnt, int bid, int nb) {
    const float off = 10.f * (float)(1 + (cnt[25] > 100u ? 50u : cnt[25])); const float off2 = 100.f * (float)(1 + (cnt[26] > 100u ? 50u : cnt[26])) ;
    for (size_t i = (size_t)bid * NTHR + threadIdx.x; i < (size_t)NB * SEQ * DM; i += (size_t)nb * NTHR) { out[i] = (i == 12345) ? off2 : off; }
}

struct EpiBf {
    static constexpr bool PERM = true, AFTER_DRAIN = false;
    bf16_t* O; int ld;
    __device__ __forceinline__ void operator()(const f32x4 (&acc)[2][2][4][2], const pg8::Unit& u, int wr, int wc, int fr, int fq) const {
        const int row0 = u.pm * 256 + wr * 64 + fr, col0 = u.pn * 256 + wc * 32 + 8 * fq;
#pragma unroll
        for (int ai = 0; ai < 2; ++ai)
#pragma unroll
            for (int m = 0; m < 4; ++m) { bf16_t* rowp = O + (size_t)(row0 + ai * 128 + m * 16) * ld + col0;
#pragma unroll
                for (int bj = 0; bj < 2; ++bj) { const f32x4 v0 = acc[ai][bj][m][0], v1 = acc[ai][bj][m][1];
                    u32x4 w; w.x = pk2(v0[0], v0[1]); w.y = pk2(v0[2], v0[3]); w.z = pk2(v1[0], v1[1]); w.w = pk2(v1[2], v1[3]);
                    *(u32x4*)(rowp + bj * 128) = w; } }
    }
};
struct EpiF32 {
    static constexpr bool PERM = false, AFTER_DRAIN = false;
    float* C; int ld;
    __device__ __forceinline__ void operator()(const f32x4 (&acc)[2][2][4][2], const pg8::Unit& u, int wr, int wc, int fr, int fq) const {
        const int row0 = u.pm * 256 + wr * 64 + fr, col0 = u.pn * 256 + wc * 32 + 4 * fq;
#pragma unroll
        for (int ai = 0; ai < 2; ++ai)
#pragma unroll
            for (int m = 0; m < 4; ++m) { float* rowp = C + (size_t)(row0 + ai * 128 + m * 16) * ld + col0;
#pragma unroll
                for (int bj = 0; bj < 2; ++bj)
#pragma unroll
                    for (int n = 0; n < 2; ++n) *(f32x4*)(rowp + bj * 128 + n * 16) = acc[ai][bj][m][n]; }
    }
};
struct EpiRetQKV {
    static constexpr bool PERM = true, AFTER_DRAIN = false;
    bf16_t* q; bf16_t* k; bf16_t* v; const float* rope; int rowbase;
    __device__ __forceinline__ void operator()(const f32x4 (&acc)[2][2][4][2], const pg8::Unit& u, int wr, int wc, int fr, int fq) const {
        const int row0 = u.pm * 256 + wr * 64 + fr, pn = u.pn;
        if (pn >= 8) {
            const int col0 = (pn - 8) * 256 + wc * 32 + 8 * fq;
#pragma unroll
            for (int ai = 0; ai < 2; ++ai)
#pragma unroll
                for (int m = 0; m < 4; ++m) { bf16_t* rowp = v + (size_t)(row0 + ai * 128 + m * 16) * 2048 + col0;
#pragma unroll
                    for (int bj = 0; bj < 2; ++bj) { const f32x4 v0 = acc[ai][bj][m][0], v1 = acc[ai][bj][m][1];
                        u32x4 w; w.x = pk2(v0[0], v0[1]); w.y = pk2(v0[2], v0[3]); w.z = pk2(v1[0], v1[1]); w.w = pk2(v1[2], v1[3]);
                        *(u32x4*)(rowp + bj * 128) = w; } }
        } else {
            bf16_t* dst = (pn < 4) ? q : k; const int col0 = (pn & 3) * 256 + wc * 32 + 8 * fq, i0 = 16 * wc + 4 * fq;
#pragma unroll
            for (int ai = 0; ai < 2; ++ai)
#pragma unroll
                for (int m = 0; m < 4; ++m) { const int row = row0 + ai * 128 + m * 16; const int R = rowbase + row, s = R % SP; const bool lat = (s >= CTXL); const int t = s - CTXL;
                    bf16_t* rowp = dst + (size_t)row * 1024 + col0;
#pragma unroll
                    for (int bj = 0; bj < 2; ++bj) { f32x4 v0 = acc[ai][bj][m][0], v1 = acc[ai][bj][m][1];
                        if (lat) { const int pos = (bj == 0) ? (t >> 6) : (t & 63); const float* tb = rope + (size_t)(pos * 64 + i0) * 2;
                            const float4 c01 = *(const float4*)(tb), c23 = *(const float4*)(tb + 4);
                            f32x4 r0, r1;
                            r0[0] = v0[0] * c01.x - v0[1] * c01.y; r0[1] = v0[0] * c01.y + v0[1] * c01.x;
                            r0[2] = v0[2] * c01.z - v0[3] * c01.w; r0[3] = v0[2] * c01.w + v0[3] * c01.z;
                            r1[0] = v1[0] * c23.x - v1[1] * c23.y; r1[1] = v1[0] * c23.y + v1[1] * c23.x;
                            r1[2] = v1[2] * c23.z - v1[3] * c23.w; r1[3] = v1[2] * c23.w + v1[3] * c23.z;
                            v0 = r0; v1 = r1; }
                        u32x4 w; w.x = pk2(v0[0], v0[1]); w.y = pk2(v0[2], v0[3]); w.z = pk2(v1[0], v1[1]); w.w = pk2(v1[2], v1[3]);
                        *(u32x4*)(rowp + bj * 128) = w; } }
        }
    }
};
struct EpiRwkv {
    static constexpr bool PERM = true, AFTER_DRAIN = false;
    bf16_t* rkvg; bf16_t* T;
    __device__ __forceinline__ void operator()(const f32x4 (&acc)[2][2][4][2], const pg8::Unit& u, int wr, int wc, int fr, int fq) const {
        const int row0 = u.pm * 256 + wr * 64 + fr, pn = u.pn;
        if (pn < 16) {
            bf16_t* dst = rkvg + (size_t)(pn >> 2) * ((size_t)NTOK * 1024); const int col0 = (pn & 3) * 256 + wc * 32 + 8 * fq;
#pragma unroll
            for (int ai = 0; ai < 2; ++ai)
#pragma unroll
                for (int m = 0; m < 4; ++m) { bf16_t* rowp = dst + (size_t)(row0 + ai * 128 + m * 16) * 1024 + col0;
#pragma unroll
                    for (int bj = 0; bj < 2; ++bj) { const f32x4 v0 = acc[ai][bj][m][0], v1 = acc[ai][bj][m][1];
                        u32x4 w; w.x = pk2(v0[0], v0[1]); w.y = pk2(v0[2], v0[3]); w.z = pk2(v1[0], v1[1]); w.w = pk2(v1[2], v1[3]);
                        *(u32x4*)(rowp + bj * 128) = w; } }
        } else {
            const int col0 = (pn - 16) * 128 + wc * 32 + 8 * fq; const bool th = (pn == 16);
#pragma unroll
            for (int ai = 0; ai < 2; ++ai)
#pragma unroll
                for (int m = 0; m < 4; ++m) { bf16_t* rowp = T + (size_t)(row0 + ai * 128 + m * 16) * 256 + col0;
                    f32x4 v0 = acc[ai][0][m][0], v1 = acc[ai][0][m][1];
                    if (th) {
#pragma unroll
                        for (int e = 0; e < 4; ++e) { v0[e] = tanhf(v0[e]); v1[e] = tanhf(v1[e]); } }
                    u32x4 w; w.x = pk2(v0[0], v0[1]); w.y = pk2(v0[2], v0[3]); w.z = pk2(v1[0], v1[1]); w.w = pk2(v1[2], v1[3]);
                    *(u32x4*)(rowp) = w; }
        }
    }
};
template <class Epi>
PHASE_FN void gemm_run(const bf16_t* A, const bf16_t* Bt, int M, int N, int K, Epi E, LAS unsigned char* L, int bid, int nb) {
    pg8::Gemm g{A, Bt, M, N, K}; pg8::StaticOrder S; S.init(M, N, nb, bid);
    pg8::gemm_phase<Epi, pg8::StaticOrder, false>((PG8_LAS unsigned char*)L, g, S, E, nullptr);
    wg_sync();
}

struct ChunkArgs {
    const bf16_t* qsrc; const bf16_t* ksrc; const bf16_t* vsrc; int ldq, ldv;
    bf16_t* Kt; bf16_t* Vt; bf16_t* P;
    bf16_t* Of; bf16_t* Ob;
    const float* decay;
    const float* wqkv;
    float* gG; float* gPM; float* gB; float* cBL; float* cPML; float* RS;
};

template <int DK, bool ML>
PHASE_FN void phase_s1(ChunkArgs a, LAS unsigned char* L, int bid, int nb) {
    const int tid = threadIdx.x, lane = tid & 63, wave = __builtin_amdgcn_readfirstlane(tid >> 6), wm = wave & 3, wn = wave >> 2;
    LAS unsigned char* KS = L; LAS unsigned char* QS = L + 16384;
    LAS float* sc = (LAS float*)(L + 32768);
    LAS float* mp = sc + 768;
    for (int item = bid; item < 16 * NCH; item += nb) {
        const int bh = item / NCH, c = item - bh * NCH, h = bh & 3, bl_ = bh >> 2;
        const size_t r0 = (size_t)bl_ * SP + 128 * c;
        float lgf = 0.f, lgb = 0.f;
        if (!ML) { lgf = log2_gamma(a.decay[h]); lgb = log2_gamma(a.decay[4 + h]); }
        wg_sync();
        if (ML) {
            if (tid == 0 || tid == 64) { const int d = tid >> 6; const int npos = d ? pos_b(c) : c; float m = 0.f;
                for (int k = 0; k < npos; ++k) { const int cc = d ? ord_b(k) : k; const float bl = a.cBL[(d * 16 + bh) * NCH + cc], pml = a.cPML[(d * 16 + bh) * NCH + cc]; m = bl + fmaxf(m, pml); }
                mp[d] = m; }
            if (tid < 256) { const int d = tid >> 7, i = tid & 127; sc[d * 128 + i] = a.gG[((size_t)d * 16 + bh) * SP + 128 * c + i]; sc[512 + d * 128 + i] = 0.f; }
            wg_sync();
            if (tid < 256) { const int d = tid >> 7, i = tid & 127; sc[256 + d * 128 + i] = fmaxf(mp[d], a.gPM[((size_t)d * 16 + bh) * SP + 128 * c + i]); }
        }
        f32x4 acc[2][4];
#pragma unroll
        for (int x = 0; x < 2; ++x)
#pragma unroll
            for (int y = 0; y < 4; ++y) acc[x][y] = (f32x4){0.f, 0.f, 0.f, 0.f};
        for (int ds = 0; ds < DK / 64; ++ds) {
            wg_sync();
#pragma unroll
            for (int u = 0; u < 2; ++u) { const int e = tid + 512 * u, row = e >> 3, ch = e & 7;
                if (!ML) {
                    lds_st16(KS, row, ch, *(const uint4*)(a.ksrc + (r0 + row) * a.ldq + h * DK + ds * 64 + ch * 8));
                    lds_st16(QS, row, ch, *(const uint4*)(a.qsrc + (r0 + row) * a.ldq + h * DK + ds * 64 + ch * 8));
                } else {
                    const int col = h * DK + ds * 64 + ch * 8; float x[8], qv[8], kv[8];
                    unpack8(*(const uint4*)(a.qsrc + (r0 + row) * a.ldq + col), x);
#pragma unroll
                    for (int gi = 0; gi < 2; ++gi) { const float* wq = a.wqkv + (size_t)((col >> 2) + gi) * 16; const float* wk = wq + 512 * 16;
#pragma unroll
                        for (int eo = 0; eo < 4; ++eo) { float sq = 0.f, sk = 0.f;
#pragma unroll
                            for (int ei = 0; ei < 4; ++ei) { sq += x[4 * gi + ei] * wq[ei * 4 + eo]; sk += x[4 * gi + ei] * wk[ei * 4 + eo]; }
                            qv[4 * gi + eo] = sq; kv[4 * gi + eo] = sk * 0.04419417382415922f; } }
                    lds_st16(QS, row, ch, pack8(qv)); lds_st16(KS, row, ch, pack8(kv));
                } }
            wg_sync();
            { const int d = tid >> 3, jg = tid & 7; unsigned w[8];
#pragma unroll
                for (int u = 0; u < 8; ++u) { const int j = 16 * jg + 2 * u;
                    const unsigned lo = *(const LAS unsigned short*)(KS + SLABOFF(j, d >> 3) + (d & 7) * 2), hi = *(const LAS unsigned short*)(KS + SLABOFF(j + 1, d >> 3) + (d & 7) * 2);
                    w[u] = lo | (hi << 16); }
                bf16_t* dst = a.Kt + ((size_t)bh * DK + ds * 64 + d) * SP + 128 * c + 16 * jg;
                *(uint4*)dst = make_uint4(w[0], w[1], w[2], w[3]); *(uint4*)(dst + 8) = make_uint4(w[4], w[5], w[6], w[7]); }
            mma_slab<2, 4>(acc, KS, 32 * wm, QS, 64 * wn, lane);
        }
        float rsf[4] = {0.f, 0.f, 0.f, 0.f}, rsb[4] = {0.f, 0.f, 0.f, 0.f};
        bf16_t* Pf = a.P + ((size_t)(0 * 16 + bh) * NCH + c) * 16384; bf16_t* Pb = a.P + ((size_t)(1 * 16 + bh) * NCH + c) * 16384;
#pragma unroll
        for (int tj = 0; tj < 2; ++tj)
#pragma unroll
            for (int ti = 0; ti < 4; ++ti) { const int i = 64 * wn + 16 * ti + (lane & 15), j0 = 32 * wm + 16 * tj + 4 * (lane >> 4); float pf[4], pb[4];
                float Mfi = 0.f, Mbi = 0.f; if (ML) { Mfi = sc[256 + i]; Mbi = sc[384 + i]; }
#pragma unroll
                for (int e = 0; e < 4; ++e) { const int j = j0 + e; const float s = acc[tj][ti][e]; float wf, wb;
                    if (!ML) { wf = (j <= i) ? exp2f((float)(i - j) * lgf) : 0.f; wb = (j >= i) ? exp2f((float)(j - i) * lgb) : 0.f; }
                    else { wf = (j <= i) ? __expf(sc[j] - Mfi) : 0.f; wb = (j >= i) ? __expf(sc[128 + j] - Mbi) : 0.f; }
                    pf[e] = s * wf; pb[e] = s * wb; rsf[ti] += pf[e]; rsb[ti] += pb[e]; }
                u32x2 w; w.x = pk2(pf[0], pf[1]); w.y = pk2(pf[2], pf[3]); *(u32x2*)(Pf + i * 128 + j0) = w;
                w.x = pk2(pb[0], pb[1]); w.y = pk2(pb[2], pb[3]); *(u32x2*)(Pb + i * 128 + j0) = w; }
        if (ML) {
#pragma unroll
            for (int ti = 0; ti < 4; ++ti) { float f = rsf[ti], b = rsb[ti]; f += __shfl_xor(f, 16); f += __shfl_xor(f, 32); b += __shfl_xor(b, 16); b += __shfl_xor(b, 32);
                if ((lane >> 4) == 0) { const int i = 64 * wn + 16 * ti + (lane & 15); atomicAdd((float*)(sc + 512 + i), f); atomicAdd((float*)(sc + 640 + i), b); } }
            wg_sync();
            if (tid < 256) { const int d = tid >> 7, i = tid & 127; a.RS[((size_t)d * 16 + bh) * SP + 128 * c + i] = sc[512 + d * 128 + i]; }
        }
        for (int ns = 0; ns < 8; ++ns) {
            wg_sync();
#pragma unroll
            for (int u = 0; u < 2; ++u) { const int e = tid + 512 * u, row = e >> 3, ch = e & 7; const int col = h * 512 + ns * 64 + ch * 8;
                uint4 raw = *(const uint4*)(a.vsrc + (r0 + row) * a.ldv + col);
                if (ML) { float x[8], vv[8]; unpack8(raw, x);
#pragma unroll
                    for (int gi = 0; gi < 2; ++gi) { const float* wv = a.wqkv + (size_t)(2 * 512 + (col >> 2) + gi) * 16;
#pragma unroll
                        for (int eo = 0; eo < 4; ++eo) { float sv = 0.f;
#pragma unroll
                            for (int ei = 0; ei < 4; ++ei) sv += x[4 * gi + ei] * wv[ei * 4 + eo];
                            vv[4 * gi + eo] = sv; } }
                    raw = pack8(vv); }
                lds_st16(KS, row, ch, raw); }
            wg_sync();
            { const int n = tid >> 3, jg = tid & 7; unsigned w[8];
#pragma unroll
                for (int u = 0; u < 8; ++u) { const int j = 16 * jg + 2 * u;
                    const unsigned lo = *(const LAS unsigned short*)(KS + SLABOFF(j, n >> 3) + (n & 7) * 2), hi = *(const LAS unsigned short*)(KS + SLABOFF(j + 1, n >> 3) + (n & 7) * 2);
                    w[u] = lo | (hi << 16); }
                bf16_t* dst = a.Vt + ((size_t)bh * 512 + ns * 64 + n) * SP + 128 * c + 16 * jg;
                *(uint4*)dst = make_uint4(w[0], w[1], w[2], w[3]); *(uint4*)(dst + 8) = make_uint4(w[4], w[5], w[6], w[7]); }
        }
    }
}
#ifndef S2VAR
#define S2VAR 0
#endif

template <int DK, bool ML>
PHASE_FN void phase_s2(ChunkArgs a, LAS unsigned char* L, int bid, int nb) {
    constexpr int DB = DK / 256, NDS = DK / 64;
    const int tid = threadIdx.x, lane = tid & 63, wave = __builtin_amdgcn_readfirstlane(tid >> 6), wm = wave & 1, wn = wave >> 1;
    if (bid >= 256) return;
    const int xq = bid & 7, tt = bid >> 3, gI = xq + 8 * (tt >> 3), slice = tt & 7, bh = gI >> 1, dir = gI & 1, h = bh & 3, bl_ = bh >> 2, n0 = 64 * slice;
    LAS unsigned char* CST = L;
    LAS unsigned char* VTS = L + 65536;
    LAS unsigned char* ABUF = L + 81920;
    LAS unsigned char* BBUF = L + 114688;
    LAS float* sc = (LAS float*)(L + 131072);
    LAS float* rho = sc, *kap = sc + 128, *rsv = sc + 256, *emt = sc + 384, *qn = sc + 512, *nt = sc + 640, *wql = sc + 1152;
    for (int i = tid; i < NDS * 8192 / 16; i += NTHR) ((LAS u32x4*)CST)[i] = (u32x4){0u, 0u, 0u, 0u};
    if (ML) { for (int i = tid; i < 512; i += NTHR) nt[i] = 0.f; for (int i = tid; i < 2048; i += NTHR) wql[i] = a.wqkv[(size_t)(h * 128) * 16 + i]; }
    f32x4 Cacc[DB][2][4]; f32x4 nacc[DB][2];
#pragma unroll
    for (int db = 0; db < DB; ++db)
#pragma unroll
        for (int tm = 0; tm < 2; ++tm) { nacc[db][tm] = (f32x4){0.f, 0.f, 0.f, 0.f};
#pragma unroll
            for (int tn = 0; tn < 4; ++tn) Cacc[db][tm][tn] = (f32x4){0.f, 0.f, 0.f, 0.f}; }
    float lg = 0.f; if (!ML) lg = log2_gamma(a.decay[dir * 4 + h]);
    float m_run = 0.f;
    bf16_t* Od = dir ? a.Ob : a.Of;
    const bf16_t* Pd = a.P + (size_t)(dir * 16 + bh) * NCH * 16384;
    for (int step = 0; step < NCH; ++step) {
        const int c = dir ? ord_b(step) : step;
        const size_t r0 = (size_t)bl_ * SP + 128 * c;
        float delta;
        wg_sync();
        if (!ML) { delta = exp2f(128.f * lg);
            if (tid < 128) { const int i = tid; rho[i] = dir ? exp2f((float)(128 - i) * lg) : exp2f((float)(i + 1) * lg); kap[i] = dir ? exp2f((float)i * lg) : exp2f((float)(127 - i) * lg); }
        } else {
            const float bl = a.cBL[(dir * 16 + bh) * NCH + c], pml = a.cPML[(dir * 16 + bh) * NCH + c]; const float mx = fmaxf(m_run, pml);
            delta = __expf(m_run - mx);
            if (tid < 128) { const int i = tid; const size_t gi = ((size_t)dir * 16 + bh) * SP + 128 * c + i; const float g = a.gG[gi], pm = a.gPM[gi], bb = a.gB[gi];
                const float Mi = fmaxf(m_run, pm); kap[i] = __expf(g - mx); rho[i] = __expf(m_run - Mi); emt[i] = __expf(-(bb + Mi)); rsv[i] = a.RS[gi]; }
            m_run = bl + mx;
        }
#pragma unroll
        for (int js = 0; js < 2; ++js) { const int n = tid >> 3, ch = tid & 7;
            lds_st16(VTS + js * 8192, n, ch, *(const uint4*)(a.Vt + ((size_t)bh * 512 + n0 + n) * SP + 128 * c + js * 64 + ch * 8)); }
        wg_sync();
        f32x4 acc[2][2];
#pragma unroll
        for (int x = 0; x < 2; ++x)
#pragma unroll
            for (int y = 0; y < 2; ++y) acc[x][y] = (f32x4){0.f, 0.f, 0.f, 0.f};
        float qnp = 0.f;
        for (int ds = 0; ds < NDS; ++ds) {
            wg_sync();
#pragma unroll
            for (int u = 0; u < 2; ++u) { const int e = tid + 512 * u, row = e >> 3, ch = e & 7;
                lds_st16(BBUF, row, ch, *(const uint4*)(a.qsrc + (r0 + row) * a.ldq + h * DK + ds * 64 + ch * 8)); }
            wg_sync();
#if S2VAR != 1 && S2VAR != 2
            mma_slab<2, 2>(acc, CST + ds * 8192, 32 * wm, BBUF, 32 * wn, lane);
#endif
            if (ML) { const int i = tid >> 2, part = tid & 3; float x[8];
#pragma unroll
                for (int cc = 0; cc < 2; ++cc) { unpack8(lds_ld16(BBUF, i, 2 * part + cc), x);
#pragma unroll
                    for (int e = 0; e < 8; ++e) qnp += x[e] * nt[ds * 64 + 16 * part + 8 * cc + e]; } }
        }
        if (ML) { qnp += __shfl_xor(qnp, 1); qnp += __shfl_xor(qnp, 2); if ((tid & 3) == 0) qn[tid >> 2] = qnp; }
#pragma unroll
        for (int ti = 0; ti < 2; ++ti) { const float r = rho[32 * wn + 16 * ti + (lane & 15)];
#pragma unroll
            for (int tm = 0; tm < 2; ++tm) acc[tm][ti] *= r; }
        for (int js = 0; js < 2; ++js) {
            wg_sync();
#pragma unroll
            for (int u = 0; u < 2; ++u) { const int e = tid + 512 * u, row = e >> 3, ch = e & 7;
                lds_st16(BBUF, row, ch, *(const uint4*)(Pd + (size_t)c * 16384 + row * 128 + js * 64 + ch * 8)); }
            wg_sync();
#if S2VAR != 3
            mma_slab<2, 2>(acc, VTS + js * 8192, 32 * wm, BBUF, 32 * wn, lane);
#endif
        }
        wg_sync();
#pragma unroll
        for (int ti = 0; ti < 2; ++ti) { const int i = 32 * wn + 16 * ti + (lane & 15); float sc_ = 1.f;
            if (ML) { const float den = rsv[i] + rho[i] * qn[i]; sc_ = 1.f / fmaxf(fabsf(den), emt[i]); }
#pragma unroll
            for (int tm = 0; tm < 2; ++tm) { const f32x4 v = acc[tm][ti] * sc_; u32x2 w; w.x = pk2(v[0], v[1]); w.y = pk2(v[2], v[3]);
                *(u32x2*)(Od + (r0 + i) * 2048 + h * 512 + n0 + 32 * wm + 16 * tm + 4 * (lane >> 4)) = w; } }
        wg_sync();
#pragma unroll
        for (int db = 0; db < DB; ++db)
#pragma unroll
            for (int tm = 0; tm < 2; ++tm) { nacc[db][tm] *= delta;
#pragma unroll
                for (int tn = 0; tn < 4; ++tn) Cacc[db][tm][tn] *= delta; }
        bf16x8 ones;
#pragma unroll
        for (int e = 0; e < 8; ++e) ones[e] = (short)0x3F80;
#pragma unroll
        for (int db = 0; db < DB; ++db)
            for (int js = 0; js < 2; ++js) {
                wg_sync();
#pragma unroll
                for (int u = 0; u < 4; ++u) { const int e = tid + 512 * u, row = e >> 3, ch = e & 7; float x[8];
                    unpack8(*(const uint4*)(a.Kt + ((size_t)bh * DK + db * 256 + row) * SP + 128 * c + js * 64 + ch * 8), x);
#pragma unroll
                    for (int q = 0; q < 8; ++q) x[q] *= kap[js * 64 + ch * 8 + q];
                    lds_st16(ABUF, row, ch, pack8(x)); }
                wg_sync();
#pragma unroll
                for (int ks = 0; ks < 2; ++ks) { bf16x8 af[2], bfr[4];
#pragma unroll
                    for (int tm = 0; tm < 2; ++tm) af[tm] = lds_frag(ABUF, 32 * wave + 16 * tm + (lane & 15), (lane >> 4) + 4 * ks);
#pragma unroll
                    for (int tn = 0; tn < 4; ++tn) bfr[tn] = lds_frag(VTS + js * 8192, 16 * tn + (lane & 15), (lane >> 4) + 4 * ks);
#pragma unroll
                    for (int tm = 0; tm < 2; ++tm) {
#if S2VAR != 1
#pragma unroll
                        for (int tn = 0; tn < 4; ++tn) Cacc[db][tm][tn] = __builtin_amdgcn_mfma_f32_16x16x32_bf16(af[tm], bfr[tn], Cacc[db][tm][tn], 0, 0, 0);
#endif
                        if (ML) nacc[db][tm] = __builtin_amdgcn_mfma_f32_16x16x32_bf16(af[tm], ones, nacc[db][tm], 0, 0, 0); } }
            }
        wg_sync();
#pragma unroll
        for (int db = 0; db < DB; ++db)
#pragma unroll
            for (int tm = 0; tm < 2; ++tm) { const int d0 = db * 256 + 32 * wave + 16 * tm + 4 * (lane >> 4);
                float w16[16];
                if (ML) {
#pragma unroll
                    for (int q = 0; q < 16; ++q) w16[q] = wql[(d0 >> 2) * 16 + q]; }
#pragma unroll
                for (int tn = 0; tn < 4; ++tn) { f32x4 v = Cacc[db][tm][tn];
                    if (ML) { f32x4 t;
#pragma unroll
                        for (int e = 0; e < 4; ++e) t[e] = w16[e * 4 + 0] * v[0] + w16[e * 4 + 1] * v[1] + w16[e * 4 + 2] * v[2] + w16[e * 4 + 3] * v[3];
                        v = t; }
                    u32x2 w; w.x = pk2(v[0], v[1]); w.y = pk2(v[2], v[3]);
                    const int n = 16 * tn + (lane & 15);
                    *(LAS u32x2*)(CST + (d0 >> 6) * 8192 + SLABOFF(n, (d0 & 63) >> 3) + (d0 & 7) * 2) = w; }
                if (ML && (lane & 15) == 0) { const f32x4 v = nacc[db][tm];
#pragma unroll
                    for (int e = 0; e < 4; ++e) nt[d0 + e] = w16[e * 4 + 0] * v[0] + w16[e * 4 + 1] * v[1] + w16[e * 4 + 2] * v[2] + w16[e * 4 + 3] * v[3]; } }
    }
}

PHASE_FN void phase_fin_ret(const bf16_t* Of, const bf16_t* Ob, bf16_t* G, int bid, int nb) {
    const int tid = threadIdx.x, lane = tid & 63, wv = tid >> 6;
    for (int r = bid * 8 + wv; r < NH; r += nb * 8) {
        const size_t base = (size_t)r * 2048 + (lane >> 4) * 512 + (lane & 15) * 8;
        float o[32]; float ss = 0.f;
#pragma unroll
        for (int u = 0; u < 4; ++u) { float a[8], b[8]; unpack8(*(const uint4*)(Of + base + u * 128), a); unpack8(*(const uint4*)(Ob + base + u * 128), b);
#pragma unroll
            for (int e = 0; e < 8; ++e) { o[8 * u + e] = a[e] + b[e]; ss += o[8 * u + e] * o[8 * u + e]; } }
#pragma unroll
        for (int m = 8; m >= 1; m >>= 1) ss += __shfl_xor(ss, m);
        const float rn = rsqrtf(ss * (1.f / 512.f) + 1e-6f);
#pragma unroll
        for (int u = 0; u < 4; ++u) { float g[8], w[8]; unpack8(*(const uint4*)(G + base + u * 128), g);
#pragma unroll
            for (int e = 0; e < 8; ++e) w[e] = siluf(g[e]) * o[8 * u + e] * rn;
            *(uint4*)(G + base + u * 128) = pack8(w); }
    }
}
PHASE_FN void phase_fin_ml(const bf16_t* Of, const bf16_t* Ob, const bf16_t* XC, bf16_t* Z, const float* gng, const float* skip, int bid, int nb) {
    const int tid = threadIdx.x, lane = tid & 63, wv = tid >> 6;
    for (int r = bid * 8 + wv; r < NH; r += nb * 8) {
        const int cb = (lane >> 4) * 512 + (lane & 15) * 8; const size_t base = (size_t)r * 2048 + cb;
        float o[32]; float s1 = 0.f;
#pragma unroll
        for (int u = 0; u < 4; ++u) { float a[8], b[8]; unpack8(*(const uint4*)(Of + base + u * 128), a); unpack8(*(const uint4*)(Ob + base + u * 128), b);
#pragma unroll
            for (int e = 0; e < 8; ++e) { o[8 * u + e] = a[e] + b[e]; s1 += o[8 * u + e]; } }
#pragma unroll
        for (int m = 8; m >= 1; m >>= 1) s1 += __shfl_xor(s1, m);
        const float mu = s1 * (1.f / 512.f); float s2 = 0.f;
#pragma unroll
        for (int e = 0; e < 32; ++e) { const float d = o[e] - mu; s2 += d * d; }
#pragma unroll
        for (int m = 8; m >= 1; m >>= 1) s2 += __shfl_xor(s2, m);
        const float rn = rsqrtf(s2 * (1.f / 512.f) + LN_EPS);
#pragma unroll
        for (int u = 0; u < 4; ++u) { float z[8], xc[8], w[8]; unpack8(*(const uint4*)(Z + base + u * 128), z); unpack8(*(const uint4*)(XC + base + u * 128), xc);
            const int c = cb + u * 128;
            const float4 g0 = *(const float4*)(gng + c), g1 = *(const float4*)(gng + c + 4), k0 = *(const float4*)(skip + c), k1 = *(const float4*)(skip + c + 4);
            const float gg[8] = {g0.x, g0.y, g0.z, g0.w, g1.x, g1.y, g1.z, g1.w}, kk[8] = {k0.x, k0.y, k0.z, k0.w, k1.x, k1.y, k1.z, k1.w};
#pragma unroll
            for (int e = 0; e < 8; ++e) w[e] = ((o[8 * u + e] - mu) * rn * gg[e] + kk[e] * xc[e]) * siluf(z[e]);
            *(uint4*)(Z + base + u * 128) = pack8(w); }
    }
}

PHASE_FN void phase_mlprep(const bf16_t* XM, bf16_t* XCONV, const bf16_t* Gt, const float* convw, const float* convb, const float* gateb,
                           float* gG, float* gPM, float* gB, float* cBL, float* cPML, LAS unsigned char* L, int bid, int nb) {
    const int tid = threadIdx.x, lane = tid & 63, wave = __builtin_amdgcn_readfirstlane(tid >> 6);
    LAS unsigned char* XMS = L; LAS unsigned char* XCS = L + 16896; LAS unsigned char* GT1 = L + 33280; LAS unsigned char* GT2 = L + 35328; LAS float* GOUT = (LAS float*)(L + 37376);
    for (int item = bid; item < 4 * NCH; item += nb) {
        const int bl_ = item / NCH, c = item - bl_ * NCH; const size_t r0 = (size_t)bl_ * SP + 128 * c;
        const bool has_prev = (c != 0 && c != 2), has_next = (c != 1 && c != NCH - 1);
        f32x4 acc[1][1]; acc[0][0] = (f32x4){0.f, 0.f, 0.f, 0.f};
        for (int cs = 0; cs < 32; ++cs) {
            wg_sync();
#pragma unroll
            for (int u = 0; u < 3; ++u) { const int e = tid + 512 * u; if (e < 1040) { const int lrow = e >> 3, ch = e & 7, tr = lrow - 1;
                const bool ok = (tr >= 0 && tr < 128) || (tr < 0 && has_prev) || (tr >= 128 && has_next);
                uint4 v = make_uint4(0u, 0u, 0u, 0u); if (ok) v = *(const uint4*)(XM + (size_t)((long)r0 + tr) * 2048 + cs * 64 + ch * 8);
                lds_st16(XMS, lrow, ch, v); } }
            if (tid < 128) { const int o = tid >> 3, ch = tid & 7; lds_st16(GT1, o, ch, *(const uint4*)(Gt + (size_t)o * 4096 + cs * 64 + ch * 8)); lds_st16(GT2, o, ch, *(const uint4*)(Gt + (size_t)o * 4096 + 2048 + cs * 64 + ch * 8)); }
            wg_sync();
#pragma unroll
            for (int u = 0; u < 2; ++u) { const int e = tid + 512 * u, row = e >> 3, ch = e & 7, cg = cs * 64 + ch * 8; float xa[8], xb[8], xc[8], o[8];
                unpack8(lds_ld16(XMS, row, ch), xa); unpack8(lds_ld16(XMS, row + 1, ch), xb); unpack8(lds_ld16(XMS, row + 2, ch), xc);
#pragma unroll
                for (int q = 0; q < 8; ++q) { const float pre = convb[cg + q] + convw[cg + q] * xa[q] + convw[2048 + cg + q] * xb[q] + convw[4096 + cg + q] * xc[q]; o[q] = siluf(pre); }
                const uint4 pk = pack8(o); lds_st16(XCS, row, ch, pk); *(uint4*)(XCONV + (r0 + row) * 2048 + cg) = pk; }
            wg_sync();
            mma_slab<1, 1>(acc, XCS, 16 * wave, GT1, 0, lane);
            mma_slab<1, 1>(acc, XMS, 16 * wave + 1, GT2, 0, lane);
        }
        { const int o = lane & 15;
#pragma unroll
            for (int e = 0; e < 4; ++e) GOUT[(16 * wave + 4 * (lane >> 4) + e) * 16 + o] = acc[0][0][e] + gateb[o]; }
        wg_sync();
        { const int d = wave >> 2, hh = wave & 3, bh = bl_ * 4 + hh;
            const int u0 = 2 * lane, u1 = u0 + 1, t0 = d ? 127 - u0 : u0, t1 = d ? 127 - u1 : u1;
            const float i0 = GOUT[t0 * 16 + d * 8 + hh], i1 = GOUT[t1 * 16 + d * 8 + hh], f0 = GOUT[t0 * 16 + d * 8 + 4 + hh], f1 = GOUT[t1 * 16 + d * 8 + 4 + hh];
            const float l0 = fminf(f0, 0.f) - log1pf(__expf(-fabsf(f0))), l1 = fminf(f1, 0.f) - log1pf(__expf(-fabsf(f1)));
            float tot = l0 + l1, inc = tot;
#pragma unroll
            for (int s = 1; s < 64; s <<= 1) { const float v = __shfl_up(inc, s); if (lane >= s) inc += v; }
            const float off = inc - tot, b0 = off + l0, b1 = off + l0 + l1, g0 = i0 - b0, g1 = i1 - b1;
            float pmx = fmaxf(g0, g1), pinc = pmx;
#pragma unroll
            for (int s = 1; s < 64; s <<= 1) { const float v = __shfl_up(pinc, s); if (lane >= s) pinc = fmaxf(pinc, v); }
            float pexc = __shfl_up(pinc, 1); if (lane == 0) pexc = -3.0e38f;
            const float pm0 = fmaxf(pexc, g0), pm1 = fmaxf(pexc, pmx);
            const size_t gb = ((size_t)d * 16 + bh) * SP + 128 * c;
            gG[gb + t0] = g0; gG[gb + t1] = g1; gPM[gb + t0] = pm0; gPM[gb + t1] = pm1; gB[gb + t0] = b0; gB[gb + t1] = b1;
            if (lane == 63) { cBL[(d * 16 + bh) * NCH + c] = b1; cPML[(d * 16 + bh) * NCH + c] = pm1; } }
    }
}

template <int CTRL> __device__ __forceinline__ float dppf(float v) { return __int_as_float(__builtin_amdgcn_update_dpp(0, __float_as_int(v), CTRL, 0xF, 0xF, true)); }
__device__ __forceinline__ float red4(float v) { v += dppf<0xB1>(v); v += dppf<0x4E>(v); return v; }
__device__ __forceinline__ float red8(float v) { v = red4(v); v += dppf<0x141>(v); return v; }
__device__ __forceinline__ float red16(float v) { v = red8(v); v += dppf<0x140>(v); return v; }

PHASE_FN void phase_rkmix(const bf16_t* H, bf16_t* A2, int bid, int nb) {
    const int tid = threadIdx.x, lane = tid & 63, wv = tid >> 6;
    for (int R = bid * 8 + wv; R < NTOK; R += nb * 8) {
        const int b = R / SP, s = R - b * SP;
#pragma unroll
        for (int u = 0; u < 2; ++u) { const int c = 8 * lane + 512 * u; int src = -1;
            if (s < CTXL) { if (u == 0) { if (s > 0) src = R - 1; } else { if (s < CTXL - 1) src = R + 1; } }
            else { const int t = s - CTXL, row = t >> 6, col = t & 63, qd = c >> 8;
                if (qd == 0) { if (col > 0) src = R - 1; } else if (qd == 1) { if (col < 63) src = R + 1; } else if (qd == 2) { if (row > 0) src = R - 64; } else { if (row < 63) src = R + 64; } }
            const uint4 hv = *(const uint4*)(H + (size_t)R * DM + c); uint4 sv = make_uint4(0u, 0u, 0u, 0u); if (src >= 0) sv = *(const uint4*)(H + (size_t)src * DM + c);
            *(uint4*)(A2 + (size_t)R * 2048 + c) = hv; *(uint4*)(A2 + (size_t)R * 2048 + 1024 + c) = sv; }
    }
}

PHASE_FN void phase_rkscan(const bf16_t* Rr, const bf16_t* Kk, const bf16_t* Vv, const bf16_t* T, const float* w0, const float* w2, const float* a0, const float* a2,
                           const float* k_k, const float* k_a, const float* r_k, bf16_t* Yf, bf16_t* Yb, float* bon, LAS unsigned char* L, int bid, int nb) {
    if (bid >= 256) return;
    const int tid = threadIdx.x, lane = tid & 63, wave = __builtin_amdgcn_readfirstlane(tid >> 6);
    const int b = bid >> 5, h = (bid >> 1) & 15, d = bid & 1;
    LAS float* WB = (LAS float*)L; LAS float* AD = WB + 2048; LAS float* RB = AD + 2048; LAS float* KD = RB + 2048; LAS float* VB = KD + 2048; LAS float* AB = VB + 2048; LAS float* BB = AB + 2048; LAS float* YB = BB + 2048;
    bf16_t* Y = d ? Yb : Yf;
    const int tt = wave >> 2, ct = wave & 3;
    bf16x8 bw[2], ba[2];
#pragma unroll
    for (int ks = 0; ks < 2; ++ks) { float fw[8], fa[8];
#pragma unroll
        for (int j = 0; j < 8; ++j) { const int m = 8 * (lane >> 4) + j + 32 * ks, cc = 64 * h + 16 * ct + (lane & 15); fw[j] = w2[((size_t)d * 64 + m) * 1024 + cc]; fa[j] = a2[((size_t)d * 64 + m) * 1024 + cc]; }
        const uint4 pw = pack8(fw), pa = pack8(fa); bw[ks] = *(const bf16x8*)&pw; ba[ks] = *(const bf16x8*)&pa; }
    const int cch = 64 * h + 16 * ct + (lane & 15);
    const float w0c = w0[d * 1024 + cch], a0c = a0[d * 1024 + cch];
    const int etok = tid >> 4, ecg = tid & 15, ec = 64 * h + 4 * ecg;
    const float4 kk4 = *(const float4*)(k_k + ec), ka4 = *(const float4*)(k_a + ec), rk4 = *(const float4*)(r_k + ec);
    const int ri = tid >> 3, rq = tid & 7;
    float S[8];
#pragma unroll
    for (int e = 0; e < 8; ++e) S[e] = 0.f;
    for (int kb = 0; kb < SP / 32; ++kb) {
        const int slo = d ? (kb < 8 ? CTXL - 32 * (kb + 1) : SP - 32 * (kb - 8 + 1)) : 32 * kb;
        const size_t Rb = (size_t)b * SP + slo;
        wg_sync();
        { f32x4 dw = (f32x4){0.f, 0.f, 0.f, 0.f}, da = (f32x4){0.f, 0.f, 0.f, 0.f};
            const bf16_t* trow = T + (Rb + 16 * tt + (lane & 15)) * 256 + 8 * (lane >> 4);
#pragma unroll
            for (int ks = 0; ks < 2; ++ks) { const uint4 tw = *(const uint4*)(trow + 64 * d + 32 * ks), ta = *(const uint4*)(trow + 128 + 64 * d + 32 * ks);
                dw = __builtin_amdgcn_mfma_f32_16x16x32_bf16(*(const bf16x8*)&tw, bw[ks], dw, 0, 0, 0);
                da = __builtin_amdgcn_mfma_f32_16x16x32_bf16(*(const bf16x8*)&ta, ba[ks], da, 0, 0, 0); }
#pragma unroll
            for (int e = 0; e < 4; ++e) { const int tok = 16 * tt + 4 * (lane >> 4) + e, cc = 16 * ct + (lane & 15);
                const float x = -(w0c + dw[e]);
                const float sp = fmaxf(x, 0.f) + log1pf(__expf(-fabsf(x)));
                WB[tok * 64 + cc] = __expf(-__expf(-sp - 0.5f));
                AD[tok * 64 + cc] = sigmf(a0c + da[e]); } }
        wg_sync();
        { const size_t g = (Rb + etok) * 1024 + ec;
            const u32x2 rw = *(const u32x2*)(Rr + g), kw = *(const u32x2*)(Kk + g), vw = *(const u32x2*)(Vv + g);
            const float r[4] = {bflo(rw.x), bfhi(rw.x), bflo(rw.y), bfhi(rw.y)}, k[4] = {bflo(kw.x), bfhi(kw.x), bflo(kw.y), bfhi(kw.y)}, v[4] = {bflo(vw.x), bfhi(vw.x), bflo(vw.y), bfhi(vw.y)};
            const float kkc[4] = {kk4.x, kk4.y, kk4.z, kk4.w}, kac[4] = {ka4.x, ka4.y, ka4.z, ka4.w}, rkc[4] = {rk4.x, rk4.y, rk4.z, rk4.w};
            float kr[4], ss = 0.f;
#pragma unroll
            for (int e = 0; e < 4; ++e) { kr[e] = k[e] * kkc[e]; ss += kr[e] * kr[e]; }
            ss = red16(ss); const float inv = 1.f / fmaxf(sqrtf(ss), 1e-12f); float bs = 0.f;
#pragma unroll
            for (int e = 0; e < 4; ++e) { const int o = etok * 64 + 4 * ecg + e; const float ad = AD[o], kkn = kr[e] * inv, kd = k[e] * (1.f + (ad - 1.f) * kac[e]);
                RB[o] = r[e]; KD[o] = kd; VB[o] = v[e]; AB[o] = -kkn; BB[o] = kkn * ad; bs += r[e] * kd * rkc[e]; }
            bs = red16(bs); if (ecg == 0) bon[((size_t)d * NTOK + Rb + etok) * 16 + h] = bs; }
        wg_sync();
        for (int t2 = 0; t2 < 32; ++t2) { const int u = d ? 31 - t2 : t2; const int o = u * 64 + 8 * rq;
            const f32x4 a0_ = *(const LAS f32x4*)(AB + o), a1_ = *(const LAS f32x4*)(AB + o + 4), w0_ = *(const LAS f32x4*)(WB + o), w1_ = *(const LAS f32x4*)(WB + o + 4);
            const f32x4 k0_ = *(const LAS f32x4*)(KD + o), k1_ = *(const LAS f32x4*)(KD + o + 4), b0_ = *(const LAS f32x4*)(BB + o), b1_ = *(const LAS f32x4*)(BB + o + 4);
            const f32x4 r0_ = *(const LAS f32x4*)(RB + o), r1_ = *(const LAS f32x4*)(RB + o + 4); const float vi = VB[u * 64 + ri];
            const float av[8] = {a0_.x, a0_.y, a0_.z, a0_.w, a1_.x, a1_.y, a1_.z, a1_.w}, wv[8] = {w0_.x, w0_.y, w0_.z, w0_.w, w1_.x, w1_.y, w1_.z, w1_.w};
            const float kv[8] = {k0_.x, k0_.y, k0_.z, k0_.w, k1_.x, k1_.y, k1_.z, k1_.w}, bv[8] = {b0_.x, b0_.y, b0_.z, b0_.w, b1_.x, b1_.y, b1_.z, b1_.w};
            const float rv[8] = {r0_.x, r0_.y, r0_.z, r0_.w, r1_.x, r1_.y, r1_.z, r1_.w};
            float sa = 0.f;
#pragma unroll
            for (int e = 0; e < 8; ++e) sa += S[e] * av[e];
            sa = red8(sa); float y = 0.f;
#pragma unroll
            for (int e = 0; e < 8; ++e) { S[e] = S[e] * wv[e] + sa * bv[e] + vi * kv[e]; y += S[e] * rv[e]; }
            y = red8(y); if (rq == 0) YB[u * 64 + ri] = y; }
        wg_sync();
        { const int o = etok * 64 + 4 * ecg; u32x2 w; w.x = pk2(YB[o], YB[o + 1]); w.y = pk2(YB[o + 2], YB[o + 3]); *(u32x2*)(Y + (Rb + etok) * 1024 + ec) = w; }
    }
}

PHASE_FN void phase_fin_rk(const bf16_t* Yf, const bf16_t* Yb, const bf16_t* Vv, bf16_t* G, const float* bon, const float* gng, const float* gnb, int bid, int nb) {
    const int tid = threadIdx.x, lane = tid & 63, wv = tid >> 6;
    for (int R = bid * 8 + wv; R < NTOK; R += nb * 8) {
        const int hd = lane >> 2, c0 = 64 * hd + 16 * (lane & 3); const size_t base = (size_t)R * 1024 + c0;
        float y[16]; float s1 = 0.f;
#pragma unroll
        for (int u = 0; u < 2; ++u) { float a[8], b[8]; unpack8(*(const uint4*)(Yf + base + 8 * u), a); unpack8(*(const uint4*)(Yb + base + 8 * u), b);
#pragma unroll
            for (int e = 0; e < 8; ++e) { y[8 * u + e] = a[e] + b[e]; s1 += y[8 * u + e]; } }
        s1 = red4(s1); const float mu = s1 * (1.f / 64.f); float s2 = 0.f;
#pragma unroll
        for (int e = 0; e < 16; ++e) { const float dd = y[e] - mu; s2 += dd * dd; }
        s2 = red4(s2); const float rn = rsqrtf(s2 * (1.f / 64.f) + 64e-5f);
        const float bsum = bon[(size_t)R * 16 + hd] + bon[((size_t)NTOK + R) * 16 + hd];
#pragma unroll
        for (int u = 0; u < 2; ++u) { float v[8], g[8], w[8]; unpack8(*(const uint4*)(Vv + base + 8 * u), v); unpack8(*(const uint4*)(G + base + 8 * u), g);
#pragma unroll
            for (int e = 0; e < 8; ++e) { const int c = c0 + 8 * u + e; w[e] = ((y[8 * u + e] - mu) * rn * gng[c] + gnb[c] + bsum * v[e]) * siluf(g[e]); }
            *(uint4*)(G + base + 8 * u) = pack8(w); }
    }
}

PHASE_FN void wcvt_ret(const float* w_in, const float* w_out, bf16_t* W, LAS unsigned char* L, int bid, int nb) {
    LAS float* T = (LAS float*)L; int tb = 0;
    cvt_tiles(W, 1024, 0, 6144, 1024, [=](int k, int n) -> float {
        int col = n; float sc = 1.f;
        if (n < 2048) { const int sec = n >> 10, hn = n & 1023, hh = hn >> 8, pp = hn & 255, hb = pp & 128, i2 = pp & 127, i = i2 >> 1; col = sec * 1024 + hh * 256 + hb + ((i2 & 1) ? 64 + i : i); if (sec == 1) sc = 0.0625f; }
        return w_in[(size_t)k * 6144 + col] * sc; }, T, bid, nb, tb);
    cvt_tiles(W + (size_t)6144 * 1024, 2048, 0, 1024, 2048, [=](int k, int n) -> float { return w_out[(size_t)k * 1024 + n]; }, T, bid, nb, tb);
}
PHASE_FN void wcvt_ml(const float* w_in, const float* w_out, const float* wqkv, const float* gw, bf16_t* W, LAS unsigned char* L, int bid, int nb) {
    LAS float* T = (LAS float*)L; int tb = 0;
    cvt_tiles(W, 1024, 0, 4096, 1024, [=](int k, int n) -> float { return w_in[(size_t)k * 4096 + n]; }, T, bid, nb, tb);
    cvt_tiles(W + (size_t)4096 * 1024, 2048, 0, 1024, 2048, [=](int k, int n) -> float { return w_out[(size_t)k * 1024 + n]; }, T, bid, nb, tb);
    bf16_t* Gt = W + (size_t)6144 * 1024;
    for (int idx = bid * NTHR + threadIdx.x; idx < 65536; idx += nb * NTHR) { const int o = idx >> 12, c = idx & 4095, d = o >> 3, gi = o & 7; float val = 0.f;
        if (c < 2048) { const int grp = c >> 2, ci = c & 3;
#pragma unroll
            for (int eo = 0; eo < 4; ++eo) val += wqkv[(size_t)(grp) * 16 + ci * 4 + eo] * gw[((size_t)d * 6144 + 4 * grp + eo) * 8 + gi] + wqkv[(size_t)(512 + grp) * 16 + ci * 4 + eo] * gw[((size_t)d * 6144 + 2048 + 4 * grp + eo) * 8 + gi];
        } else { const int c2 = c - 2048, grp = c2 >> 2, ci = c2 & 3;
#pragma unroll
            for (int eo = 0; eo < 4; ++eo) val += wqkv[(size_t)(1024 + grp) * 16 + ci * 4 + eo] * gw[((size_t)d * 6144 + 4096 + 4 * grp + eo) * 8 + gi]; }
        Gt[idx] = (bf16_t)(pk2(val, 0.f) & 0xffffu); }
}
PHASE_FN void wcvt_rk(const float* mix, const float* wrkvg, const float* w1, const float* a1, const float* w_out, bf16_t* W, LAS unsigned char* L, int bid, int nb) {
    LAS float* T = (LAS float*)L; int tb = 0;
    cvt_tiles(W, 2048, 0, 4608, 2048, [=](int k, int n) -> float {
        const int kk = k & 1023; float w, mx;
        if (n < 4096) { const int j = n >> 10, cc = n & 1023; const int mj = (j == 0) ? 0 : (j == 1 ? 2 : (j == 2 ? 3 : 5)); w = wrkvg[((size_t)j * 1024 + kk) * 1024 + cc]; mx = mix[mj * 1024 + kk]; }
        else { const int n2 = n - 4096, blk = n2 >> 8, cc = n2 & 255; if (cc >= 128) return 0.f; const int d = cc >> 6, m = cc & 63;
            w = (blk == 0 ? w1 : a1)[((size_t)d * 1024 + kk) * 64 + m]; mx = mix[(blk == 0 ? 1 : 4) * 1024 + kk]; }
        return w * (k < 1024 ? 1.f - mx : mx); }, T, bid, nb, tb);
    cvt_tiles(W + (size_t)4608 * 2048, 1024, 0, 1024, 1024, [=](int k, int n) -> float { return w_out[(size_t)k * 1024 + n]; }, T, bid, nb, tb);
}

#define RET_LAYER(LI, JJ, XL_IN, XC_IN, LAST, NEXT_WCVT) \
    for (int half = 0; half < 2; ++half) { \
        bf16_t* q = (bf16_t*)(S); bf16_t* k = (bf16_t*)(S + U34); bf16_t* v = (bf16_t*)(S + U68); bf16_t* Pm = (bf16_t*)(S + 2 * U68); \
        bf16_t* Kt = (bf16_t*)(S + 2 * U68 + U34); bf16_t* Vt = (bf16_t*)(S + 3 * U68); bf16_t* Of = (bf16_t*)(S + 4 * U68); bf16_t* Ob = (bf16_t*)(S + 5 * U68); \
        ChunkArgs ca{}; ca.qsrc = q; ca.ksrc = k; ca.vsrc = v; ca.ldq = 1024; ca.ldv = 2048; ca.Kt = Kt; ca.Vt = Vt; ca.P = Pm; ca.Of = Of; ca.Ob = Ob; ca.decay = in[9] + (JJ) * 8; \
        const bf16_t* Ah = H + (size_t)half * NH * DM; const long long hb = (long long)half * NH; const float* modl = mod + (size_t)(LI) * 9 * 3072; const float* modn = mod + (size_t)((LI) + 1 < 4 ? (LI) + 1 : 3) * 9 * 3072; \
        const float* xl_in = (XL_IN); const float* xc_in = (XC_IN); const float* lg_ = in[6] + (LI) * 1024; const float* lb_ = in[7] + (LI) * 1024; \
        PH(gemm_run<EpiRetQKV>(Ah, W, NH, 4096, 1024, EpiRetQKV{q, k, v, rope, (int)hb}, L, bid, nb)); \
        PH((phase_s1<256, false>(ca, L, bid, nb))); \
        PH((phase_s2<256, false>(ca, L, bid, nb))); \
        PH(gemm_run<EpiBf>(Ah, W + (size_t)4096 * 1024, NH, 2048, 1024, EpiBf{v, 2048}, L, bid, nb)); \
        PH(phase_fin_ret(Of, Ob, v, bid, nb)); \
        PH(gemm_run<EpiF32>(v, W + (size_t)6144 * 1024, NH, 1024, 2048, EpiF32{(float*)S, 1024}, L, bid, nb)); \
        if (half == 0) { PH(phase_ln(xl_in, xc_in, out, xctx, (const float*)S, modl, modn, lg_, lb_, H, (int)hb, (int)hb + NH, LAST, bid, nb)); } \
        else { PH(phase_ln(xl_in, xc_in, out, xctx, (const float*)S, modl, modn, lg_, lb_, H, (int)hb, (int)hb + NH, LAST, bid, nb); NEXT_WCVT); } \
    }

#define FORWARD_PROGRAM() \
    PH(phase_mod(in[1], in[3], in[4], in[5], mod, rope, L, bid, nb); wcvt_ret(in[8], in[10], W, L, bid, nb)); \
    PH(phase_h0(in[0], in[2], mod, H, bid, nb)); \
    RET_LAYER(0, 0, in[0], in[2], 0, wcvt_ml(in[11], in[19], in[14], in[15], W, L, bid, nb)) \
    for (int half = 0; half < 2; ++half) { \
        bf16_t* xm = (bf16_t*)(S); bf16_t* xcv = (bf16_t*)(S + U68); bf16_t* Kt = (bf16_t*)(S + 2 * U68); bf16_t* Vt = (bf16_t*)(S + 3 * U68); bf16_t* Pm = (bf16_t*)(S + 4 * U68); bf16_t* Ob = (bf16_t*)(S + 4 * U68 + U34); \
        float* gar = (float*)(S + 5 * U68 + U34); \
        float* gG = gar; float* gPM = gar + 2 * 16 * SP; float* gB = gar + 4 * 16 * SP; float* RSv = gar + 6 * 16 * SP; float* cBL = gar + 8 * 16 * SP; float* cPML = cBL + 2 * 16 * NCH; \
        ChunkArgs ca{}; ca.qsrc = xcv; ca.ksrc = xcv; ca.vsrc = xm; ca.ldq = 2048; ca.ldv = 2048; ca.Kt = Kt; ca.Vt = Vt; ca.P = Pm; ca.Of = xm; ca.Ob = Ob; ca.wqkv = in[14]; \
        ca.gG = gG; ca.gPM = gPM; ca.gB = gB; ca.cBL = cBL; ca.cPML = cPML; ca.RS = RSv; \
        const bf16_t* Ah = H + (size_t)half * NH * DM; const long long hb = (long long)half * NH; const bf16_t* Gt = W + (size_t)6144 * 1024; \
        PH(gemm_run<EpiBf>(Ah, W, NH, 2048, 1024, EpiBf{xm, 2048}, L, bid, nb)); \
        PH(phase_mlprep(xm, xcv, Gt, in[12], in[13], in[16], gG, gPM, gB, cBL, cPML, L, bid, nb)); \
        PH((phase_s1<512, true>(ca, L, bid, nb))); \
        PH((phase_s2<512, true>(ca, L, bid, nb))); \
        PH(gemm_run<EpiBf>(Ah, W + (size_t)2048 * 1024, NH, 2048, 1024, EpiBf{Kt, 2048}, L, bid, nb)); \
        PH(phase_fin_ml(xm, Ob, xcv, Kt, in[18], in[17], bid, nb)); \
        PH(gemm_run<EpiF32>(Kt, W + (size_t)4096 * 1024, NH, 1024, 2048, EpiF32{(float*)Vt, 1024}, L, bid, nb)); \
        if (half == 0) { PH(phase_ln(out, xctx, out, xctx, (const float*)Vt, mod + (size_t)1 * 9 * 3072, mod + (size_t)2 * 9 * 3072, in[6] + 1024, in[7] + 1024, H, (int)hb, (int)hb + NH, 0, bid, nb)); } \
        else { PH(phase_ln(out, xctx, out, xctx, (const float*)Vt, mod + (size_t)1 * 9 * 3072, mod + (size_t)2 * 9 * 3072, in[6] + 1024, in[7] + 1024, H, (int)hb, (int)hb + NH, 0, bid, nb); wcvt_rk(in[20], in[21], in[23], in[26], in[33], W, L, bid, nb)); } \
    } \
    { \
        bf16_t* A2 = (bf16_t*)(S); bf16_t* rkvg = (bf16_t*)(S + 2 * U68); bf16_t* Tm = H; float* bon = (float*)((unsigned char*)H + 17 * MiB); \
        bf16_t* Rr = rkvg; bf16_t* Kk = rkvg + (size_t)NTOK * 1024; bf16_t* Vv = rkvg + (size_t)2 * NTOK * 1024; bf16_t* Gg = rkvg + (size_t)3 * NTOK * 1024; \
        bf16_t* Yf = (bf16_t*)(S); bf16_t* Yb = (bf16_t*)(S + U68); \
        PH(phase_rkmix(H, A2, bid, nb)); \
        PH(gemm_run<EpiRwkv>(A2, W, NTOK, 4608, 2048, EpiRwkv{rkvg, Tm}, L, bid, nb)); \
        PH(phase_rkscan(Rr, Kk, Vv, Tm, in[22], in[24], in[25], in[27], in[28], in[29], in[30], Yf, Yb, bon, L, bid, nb)); \
        PH(phase_fin_rk(Yf, Yb, Vv, Gg, bon, in[31], in[32], bid, nb)); \
        PH(gemm_run<EpiF32>(Gg, W + (size_t)4608 * 2048, NTOK, 1024, 1024, EpiF32{(float*)S, 1024}, L, bid, nb)); \
        PH(phase_ln(out, xctx, out, xctx, (const float*)S, mod + (size_t)2 * 9 * 3072, mod + (size_t)3 * 9 * 3072, in[6] + 2048, in[7] + 2048, H, 0, NTOK, 0, bid, nb); \
           wcvt_ret(in[8] + (size_t)1024 * 6144, in[10] + (size_t)2048 * 1024, W, L, bid, nb)); \
    } \
    RET_LAYER(3, 1, out, xctx, 1, (void)0)

#ifndef MK_MULTI
#define MK_MULTI 1
#endif

#if MK_MULTI
template <class F> __global__ void __launch_bounds__(NTHR, 2) kphase(F f) {
    extern __shared__ __attribute__((aligned(16))) unsigned char lds_raw[];
    f((LAS unsigned char*)lds_raw, (int)blockIdx.x, (int)gridDim.x);
}
template <class F> static void launch_phase(hipStream_t st, F f) {
    static int attr_done = 0;
    if (!attr_done) { (void)hipFuncSetAttribute((const void*)kphase<F>, hipFuncAttributeMaxDynamicSharedMemorySize, LDS_BYTES); attr_done = 1; }
    hipLaunchKernelGGL(kphase<F>, dim3(256), dim3(NTHR), LDS_BYTES, st, f);
}
extern "C" void kernel_launch(void* const* d_in, const int* in_sizes, int n_in, void* d_out, int out_size, void* d_ws, size_t ws_size, hipStream_t stream) {
    if (n_in != 34 || ws_size < WS_END) { fprintf(stderr, "kernel_launch: expected 34 inputs and >= %zu bytes of workspace (got %d, %zu)\n", (size_t)WS_END, n_in, ws_size); return; }
    (void)in_sizes; (void)out_size;
    const float* in[34]; for (int i = 0; i < 34; ++i) in[i] = (const float*)d_in[i];
    float* out = (float*)d_out; unsigned char* ws = (unsigned char*)d_ws;
    float* mod = (float*)(ws + WS_MOD); float* rope = (float*)(ws + WS_ROPE); float* xctx = (float*)(ws + WS_XCTX);
    bf16_t* H = (bf16_t*)(ws + WS_H); bf16_t* W = (bf16_t*)(ws + WS_W); unsigned char* S = ws + WS_S; unsigned* dbgcnt = (unsigned*)(ws + WS_ROPE + 32768);
#define PH(...) launch_phase(stream, [=] __device__ (LAS unsigned char* L, int bid, int nb) { __VA_ARGS__; })
    FORWARD_PROGRAM()
#undef PH
}
#else
__global__ void __launch_bounds__(NTHR, 2) hybrid_fwd(Prm p) {
    extern __shared__ __attribute__((aligned(16))) unsigned char lds_raw[];
    LAS unsigned char* L = (LAS unsigned char*)lds_raw;
    const int bid = blockIdx.x, nb = gridDim.x;
    volatile LAS unsigned* st = (volatile LAS unsigned*)(L + LDS_BYTES - 16);
    if (threadIdx.x == 0) { st[0] = 0u; st[1] = 0u; st[2] = 0u; st[3] = 0u; }
    __syncthreads();
    unsigned char* ws = p.ws;
    XcdBarrier bar = xcd_barrier_post((unsigned*)(ws + WS_BAR), st);
    const float* const* in = p.in; float* out = p.out;
    float* mod = (float*)(ws + WS_MOD); float* rope = (float*)(ws + WS_ROPE); float* xctx = (float*)(ws + WS_XCTX);
    bf16_t* H = (bf16_t*)(ws + WS_H); bf16_t* W = (bf16_t*)(ws + WS_W); unsigned char* S = ws + WS_S; unsigned* dbgcnt = (unsigned*)(ws + WS_ROPE + 32768);
#define PH(...) { __VA_ARGS__; xcd_barrier(bar); }
    FORWARD_PROGRAM()
#undef PH
}
extern "C" void kernel_launch(void* const* d_in, const int* in_sizes, int n_in, void* d_out, int out_size, void* d_ws, size_t ws_size, hipStream_t stream) {
    static int ready = 0;
    if (!ready) {
        if (n_in != 34 || ws_size < WS_END) { fprintf(stderr, "kernel_launch: expected 34 inputs and >= %zu bytes of workspace (got %d, %zu)\n", (size_t)WS_END, n_in, ws_size); ready = -1; return; }
        if (hipFuncSetAttribute((const void*)hybrid_fwd, hipFuncAttributeMaxDynamicSharedMemorySize, LDS_BYTES) != hipSuccess) { fprintf(stderr, "kernel_launch: hipFuncSetAttribute failed\n"); ready = -1; return; }
        ready = 1;
    }
    if (ready < 0) return;
    (void)in_sizes; (void)out_size;
    (void)hipMemsetAsync((char*)d_ws + WS_BAR, 0, 16384, stream);
    Prm p{};
    for (int i = 0; i < 34; ++i) p.in[i] = (const float*)d_in[i];
    p.out = (float*)d_out; p.ws = (unsigned char*)d_ws;
    hipLaunchKernelGGL(hybrid_fwd, dim3(256), dim3(NTHR), LDS_BYTES, stream, p);
}
#endif
```

```cpp
#include <hip/hip_runtime.h>
#include <cstdio>
#include <cstdint>
#include <cmath>
#ifndef MK_MULTI
#define MK_MULTI 0
#endif
#ifndef PG8_KROT
#define PG8_KROT 0
#endif
#ifndef TP_SCALE
#define TP_SCALE 10.f
#endif
#ifndef GSTAMP
#define GSTAMP 0
#define HOTPROBE 0
#endif
#define TID_TICKET_LDS 163808
__device__ __forceinline__ int tid_opq() {
#if MK_MULTI
    int t = (int)threadIdx.x; asm volatile("" : "+v"(t)); return t;
#else
    const int lane = (int)__builtin_amdgcn_mbcnt_hi(~0u, __builtin_amdgcn_mbcnt_lo(~0u, 0u));
    unsigned id = 0u;
    if (lane == 0) id = __hip_atomic_fetch_add((__attribute__((address_space(3))) unsigned*)TID_TICKET_LDS, 1u, __ATOMIC_RELAXED, __HIP_MEMORY_SCOPE_WORKGROUP);
    id = (unsigned)__builtin_amdgcn_readfirstlane((int)id) & 7u;
    asm volatile("s_waitcnt lgkmcnt(0)" ::: "memory"); __builtin_amdgcn_s_barrier(); asm volatile("" ::: "memory");
    int t = (int)(id * 64u) + lane; asm volatile("" : "+v"(t)); return t;
#endif
}
__device__ __forceinline__ int bid_opq() { int b = (int)blockIdx.x; asm volatile("" : "+s"(b)); return b; }
#define XB_TMO      128
#define XB_XCNT(j)  (256  + 64 * (j))
#define XB_XSUB(j)  (1280 + 64 * (j))
#define XB_XGEN(j)  (2304 + 64 * (j))
#define XB_TOP      3328
#define XB_TOPGEN   3392
#define XCD_BAR_WORDS 3456
#define XB_SPIN_CAP (1u << 18)
#define LAS __attribute__((address_space(3)))

__device__ __forceinline__ unsigned xb_ld(unsigned* p)              { return __hip_atomic_load(p, __ATOMIC_RELAXED, __HIP_MEMORY_SCOPE_AGENT); }
__device__ __forceinline__ unsigned xb_add(unsigned* p, unsigned v) { return __hip_atomic_fetch_add(p, v, __ATOMIC_RELAXED, __HIP_MEMORY_SCOPE_AGENT); }
__device__ __forceinline__ unsigned xb_xcc_id() { return (unsigned)__builtin_amdgcn_s_getreg((3 << 11) | 20) & 0xFu; }
#define XB_SPIN(cond, bar) do { unsigned _sp = 0; while (cond) { __builtin_amdgcn_s_sleep(1); \
    if ((++_sp & 255u) == 0u) { if (xb_ld(&(bar)[XB_TMO])) break; if (_sp > XB_SPIN_CAP) { atomicAdd(&(bar)[XB_TMO], 1u); break; } } } } while (0)

struct XcdBarrier {
    unsigned* bar; unsigned x;
    volatile LAS unsigned* st;
};

__device__ __forceinline__ XcdBarrier xcd_barrier_post(unsigned* bar, volatile LAS unsigned* st) {
    XcdBarrier b; b.bar = bar; b.x = xb_xcc_id(); b.st = st;
    if (threadIdx.x == 0) (void)xb_add(&bar[XB_XCNT(b.x)], 1u);
    return b;
}
__device__ __forceinline__ void xcd_barrier_complete(unsigned* bar, unsigned x, unsigned& nloc, unsigned& nx) {
    const unsigned G = gridDim.x * gridDim.y * gridDim.z;
    unsigned sum, cnt, mine, sp = 0u;
    for (;;) {
        sum = 0u; cnt = 0u; mine = 0u;
#pragma unroll
        for (unsigned j = 0; j < 16; ++j) { const unsigned c = xb_ld(&bar[XB_XCNT(j)]); sum += c; cnt += (c > 0u) ? 1u : 0u; mine = (j == x) ? c : mine; }
        if (sum == G) break;
        __builtin_amdgcn_s_sleep(1);
        if ((++sp & 255u) == 0u) { if (xb_ld(&bar[XB_TMO])) break; if (sp > XB_SPIN_CAP) { atomicAdd(&bar[XB_TMO], 1u); break; } }
    }
    nloc = mine > 0u ? mine : 1u; nx = cnt > 0u ? cnt : 1u;
}

__device__ __forceinline__ void xcd_barrier(const XcdBarrier& b, const int tid0 = (int)threadIdx.x) {
    asm volatile("s_waitcnt vmcnt(0)" ::: "memory");
    __syncthreads();
    if (tid0 == 0) {
        unsigned* bar = b.bar;
        __builtin_amdgcn_s_waitcnt(0);
        unsigned nloc = b.st[0], nx = b.st[1];
        if (nloc == 0u) { xcd_barrier_complete(bar, b.x, nloc, nx); b.st[0] = nloc; b.st[1] = nx; }
        const unsigned old = xb_add(&bar[XB_XSUB(b.x)], 1u);
        const unsigned gen = old / nloc;
        if (old + 1u == (gen + 1u) * nloc) {
            __builtin_amdgcn_fence(__ATOMIC_RELEASE, "agent");
            asm volatile("s_waitcnt vmcnt(0)" ::: "memory");
            const unsigned og = xb_add(&bar[XB_TOP], 1u);
            const unsigned tg = og / nx;
            if (og + 1u == (tg + 1u) * nx) xb_add(&bar[XB_TOPGEN], 1u);
            else XB_SPIN(xb_ld(&bar[XB_TOPGEN]) == tg, bar);
            __builtin_amdgcn_fence(__ATOMIC_ACQUIRE, "agent");
            xb_add(&bar[XB_XGEN(b.x)], 1u);
            asm volatile("s_waitcnt vmcnt(0)" ::: "memory");
        } else {
            XB_SPIN(xb_ld(&bar[XB_XGEN(b.x)]) == gen, bar);
            __builtin_amdgcn_fence(__ATOMIC_ACQUIRE, "agent");
            asm volatile("s_waitcnt vmcnt(0)" ::: "memory");
        }
    }
    __syncthreads();
}
namespace pg8 {
#define PG8_LAS __attribute__((address_space(3)))
typedef unsigned short bf16_t;
typedef short bf16x8 __attribute__((ext_vector_type(8)));
typedef float f32x4 __attribute__((ext_vector_type(4)));
typedef unsigned u32x4 __attribute__((ext_vector_type(4)));
constexpr int BM = 256, BK = 64, HALF = 128, HTB = HALF * BK * 2  , STAGE_BYTES = 8 * HTB, NXCD = 8, WGM = 8;

__host__ __device__ __forceinline__ int lds_byte(int r, int c) { const int st = (r >> 4) * 2 + (c >> 5), rr = r & 15, cc = c & 31, ob = rr * 64 + cc * 2; return st * 1024 + (ob ^ (((ob >> 9) & 1) << 5)); }
__host__ __device__ __forceinline__ void stage_rc(int b, int& R, int& C) { const int st = b / 1024, sb = b % 1024, swz = sb ^ (((sb >> 9) & 1) << 5); R = (st >> 1) * 16 + swz / 64; C = (st & 1) * 32 + (swz % 64) / 2; }
__host__ __device__ __forceinline__ int perm32(int rho) { const int n = rho >> 4, i = rho & 15; return 8 * (i >> 2) + 4 * n + (i & 3); }

struct Unit { int pm, pn; };
struct Gemm { const bf16_t* A; const bf16_t* Bt; int M, N, K, ld; };

struct StaticOrder {
    int nM, nN, nwg, G, c;
    __host__ __device__ void init(int M, int N, int G_, int c_) { nM = M / BM; nN = N / BM; nwg = nM * nN; G = G_; c = c_; }
    __host__ __device__ bool unit_of(long L, Unit& u) const {
        if (L >= nwg) return false;
        int wgid = (int)L; { const int q = nwg / NXCD, r = nwg % NXCD, xcd = wgid % NXCD, off = wgid / NXCD; wgid = (xcd < r ? xcd * (q + 1) : r * (q + 1) + (xcd - r) * q) + off; }
        const int nig = WGM * nN, gid = wgid / nig, fm = gid * WGM, gsz = (nM - fm) < WGM ? (nM - fm) : WGM;
        u.pm = fm + ((wgid % nig) % gsz); u.pn = (wgid % nig) / gsz; return true;
    }
    __host__ __device__ bool next(int i, Unit& u) const { return unit_of((long)i * G + c, u); }
    __device__ __forceinline__ void a_ready(const Unit&) const {}
    __device__ __forceinline__ void done(const Unit&) const {}
};
__device__ __forceinline__ unsigned cvt_pk_bf16(float lo, float hi) { unsigned r; asm volatile("v_cvt_pk_bf16_f32 %0, %1, %2" : "=v"(r) : "v"(lo), "v"(hi)); return r; }
template <class Epi, class Sched, bool STAMP = false>
__device__ __forceinline__ void gemm_phase(PG8_LAS unsigned char* lds, const Gemm g, const Sched& S, const Epi& E, unsigned long long* stamps) {
    const int tid = tid_opq(), wid = __builtin_amdgcn_readfirstlane(tid >> 6), lane = tid & 63, wr = wid >> 2, wc = wid & 3, fr = lane & 15, fq = lane >> 4;
    const int nt = g.K / BK, K = g.ld ? g.ld : g.K;
    int ts_lo = 0, ts_hi = 0, nts = 0; const unsigned long long rt_entry = STAMP ? (unsigned long long)wall_clock64() : 0ull;
#define PG8_STAMP() do { if (STAMP && wid == 0 && nts < 64) { const unsigned long long _c = (unsigned long long)clock64(); \
        ts_lo = (lane == nts) ? (int)(unsigned)_c : ts_lo; ts_hi = (lane == nts) ? (int)(unsigned)(_c >> 32) : ts_hi; ++nts; } } while (0)
    PG8_STAMP();
    unsigned voffA[2], voffB[2];
#pragma unroll
    for (int i = 0; i < 2; ++i) { int R, C; stage_rc(tid * 16 + i * 8192, R, C); const int Rb = Epi::PERM ? ((R & ~31) + perm32(R & 31)) : R;
        voffA[i] = (unsigned)(R * K + C) * 2u; voffB[i] = (unsigned)(Rb * K + C) * 2u; }
    const size_t kstep = (size_t)(BK * 2);
    const size_t hstep = (size_t)HALF * K * 2;
    const size_t tstep = 2 * hstep;
    const unsigned ldsw = (unsigned)wid * 1024u;
    const int aoff = lds_byte(wr * 64 + fr, fq * 8), boff = lds_byte(wc * 32 + fr, fq * 8);
#define PG8_SA(b, h) (((b) * 2 + (h)) * HTB)
#define PG8_SB(b, h) ((4 + (b) * 2 + (h)) * HTB)
#define PG8_STAGE(bufoff, gbase, voff) do { _Pragma("unroll") for (int _i = 0; _i < 2; ++_i) \
        __builtin_amdgcn_global_load_lds((const unsigned*)((const char*)(gbase) + (voff)[_i]), (PG8_LAS unsigned*)(lds + (bufoff) + ldsw + _i * 8192), 16, 0, 0); } while (0)
#define PG8_LDA(dst, b, h) do { _Pragma("unroll") for (int m = 0; m < 4; ++m) _Pragma("unroll") for (int k = 0; k < 2; ++k) dst[m][k] = *(const PG8_LAS bf16x8*)(lds + PG8_SA(b, h) + aoff + m * 2048 + k * 1024); } while (0)
#define PG8_LDB(dst, b, h) do { _Pragma("unroll") for (int n = 0; n < 2; ++n) _Pragma("unroll") for (int k = 0; k < 2; ++k) dst[n][k] = *(const PG8_LAS bf16x8*)(lds + PG8_SB(b, h) + boff + n * 2048 + k * 1024); } while (0)
#define PG8_MMA(ai, bj, At, Bt) do { __builtin_amdgcn_s_setprio(1); _Pragma("unroll") for (int m = 0; m < 4; ++m) _Pragma("unroll") for (int n = 0; n < 2; ++n) _Pragma("unroll") for (int k = 0; k < 2; ++k) \
        acc[ai][bj][m][n] = __builtin_amdgcn_mfma_f32_16x16x32_bf16(Bt[n][k], At[m][k], acc[ai][bj][m][n], 0, 0, 0); __builtin_amdgcn_s_setprio(0); } while (0)
#define PG8_WAIT_V(n) asm volatile("s_waitcnt vmcnt(" #n ")" ::: "memory")
#define PG8_WAIT_L(n) asm volatile("s_waitcnt lgkmcnt(" #n ")" ::: "memory")
#define PG8_WAIT_VL(v, l) asm volatile("s_waitcnt vmcnt(" #v ") lgkmcnt(" #l ")" ::: "memory")
#define PG8_BAR __builtin_amdgcn_s_barrier()
#define PG8_SCHED __builtin_amdgcn_sched_barrier(0)
    Unit cur, nxt; int ui = 0;
    if (!S.next(0, cur)) return;
    const int ntm = nt - 1;
#define PG8_ROT(u) ((PG8_KROT) ? ((2 * ((u).pm & 7) + 4 * ((u).pn & 3)) & ntm) : 0)
#define PG8_KO(off, t) ((size_t)(((t) + (off)) & ntm) * kstep)
    int coff = PG8_ROT(cur);
    f32x4 acc[2][2][4][2];
#pragma unroll
    for (int a = 0; a < 2; ++a)
#pragma unroll
        for (int b = 0; b < 2; ++b)
#pragma unroll
            for (int m = 0; m < 4; ++m)
#pragma unroll
                for (int n = 0; n < 2; ++n) acc[a][b][m][n] = (f32x4){0.f, 0.f, 0.f, 0.f};
    bf16x8 At[4][2], B0[2][2], B1[2][2];
    const char* cA = (const char*)g.A + (size_t)cur.pm * tstep; const char* cB = (const char*)g.Bt + (size_t)cur.pn * tstep;
    S.a_ready(cur);
    { const size_t k0 = PG8_KO(coff, 0), k1 = PG8_KO(coff, 1);
    PG8_STAGE(PG8_SB(0, 0), cB + k0, voffB); PG8_STAGE(PG8_SA(0, 0), cA + k0, voffA); PG8_STAGE(PG8_SB(0, 1), cB + hstep + k0, voffB); PG8_STAGE(PG8_SA(0, 1), cA + hstep + k0, voffA);
    if (wr == 1) PG8_BAR;
    PG8_WAIT_V(4); PG8_BAR;
    PG8_STAGE(PG8_SB(1, 0), cB + k1, voffB); PG8_STAGE(PG8_SA(1, 0), cA + k1, voffA); PG8_STAGE(PG8_SB(1, 1), cB + hstep + k1, voffB); }
    PG8_WAIT_V(6); PG8_BAR;
    PG8_STAMP();
    for (;;) {
        const bool has_next = S.next(ui + 1, nxt);
        const char* nA = has_next ? (const char*)g.A + (size_t)nxt.pm * tstep : cA; const char* nB = has_next ? (const char*)g.Bt + (size_t)nxt.pn * tstep : cB;
        const int noff = has_next ? PG8_ROT(nxt) : coff;
        for (int t = 0; t < nt; t += 2) {
            const bool last = (t == nt - 2);
            const char* a1 = cA + PG8_KO(coff, t + 1);
            const size_t k2 = last ? PG8_KO(noff, 0) : PG8_KO(coff, t + 2), k3 = last ? PG8_KO(noff, 1) : PG8_KO(coff, t + 3);
            const char* a2 = (last ? nA : cA) + k2; const char* b2 = (last ? nB : cB) + k2;
            const char* a3 = (last ? nA : cA) + k3; const char* b3 = (last ? nB : cB) + k3;
            if (last && has_next) S.a_ready(nxt);
            PG8_LDB(B0, 0, 0); PG8_SCHED; PG8_LDA(At, 0, 0); PG8_STAGE(PG8_SA(1, 1), a1 + hstep, voffA);
            PG8_WAIT_VL(10, 8); PG8_BAR; PG8_WAIT_L(0); PG8_MMA(0, 0, At, B0); PG8_BAR; PG8_SCHED;
            PG8_LDB(B1, 0, 1); PG8_STAGE(PG8_SB(0, 0), b2, voffB);
            PG8_WAIT_V(10); PG8_BAR; PG8_WAIT_L(0); PG8_MMA(0, 1, At, B1); PG8_BAR;
            PG8_LDA(At, 0, 1); PG8_STAGE(PG8_SA(0, 0), a2, voffA);
            PG8_WAIT_V(10); PG8_BAR; PG8_WAIT_L(0); PG8_MMA(1, 0, At, B0); PG8_BAR; PG8_SCHED;
            PG8_STAGE(PG8_SB(0, 1), b2 + hstep, voffB);
            PG8_WAIT_V(10); PG8_BAR; PG8_MMA(1, 1, At, B1); PG8_BAR;
            PG8_LDB(B0, 1, 0); PG8_SCHED; PG8_LDA(At, 1, 0); PG8_STAGE(PG8_SA(0, 1), a2 + hstep, voffA);
            PG8_WAIT_VL(10, 8); PG8_BAR; PG8_WAIT_L(0); PG8_MMA(0, 0, At, B0); PG8_BAR; PG8_SCHED;
            PG8_LDB(B1, 1, 1); PG8_STAGE(PG8_SB(1, 0), b3, voffB);
            PG8_WAIT_V(10); PG8_BAR; PG8_WAIT_L(0); PG8_MMA(0, 1, At, B1); PG8_BAR;
            PG8_LDA(At, 1, 1); PG8_STAGE(PG8_SA(1, 0), a3, voffA);
            PG8_WAIT_V(10); PG8_BAR; PG8_WAIT_L(0); PG8_MMA(1, 0, At, B0); PG8_BAR; PG8_SCHED;
            PG8_STAGE(PG8_SB(1, 1), b3 + hstep, voffB);
            PG8_WAIT_V(10); PG8_BAR; PG8_MMA(1, 1, At, B1); PG8_BAR;
        }
        PG8_STAMP();
        if constexpr (!Epi::AFTER_DRAIN) { E(acc, cur, wr, wc, fr, fq); S.done(cur); }
        PG8_STAMP();
        if (!has_next) break;
#pragma unroll
        for (int a = 0; a < 2; ++a)
#pragma unroll
            for (int b = 0; b < 2; ++b)
#pragma unroll
                for (int m = 0; m < 4; ++m)
#pragma unroll
                    for (int n = 0; n < 2; ++n) acc[a][b][m][n] = (f32x4){0.f, 0.f, 0.f, 0.f};
        cur = nxt; cA = nA; cB = nB; coff = noff; ++ui;
    }
    PG8_WAIT_V(0);
    if (wr == 0) PG8_BAR;
    PG8_BAR;
    if constexpr (Epi::AFTER_DRAIN) { E.fused(acc, cur, wr, wc, fr, fq, lds, wid, lane); S.done(cur); }
    PG8_STAMP();
    if (STAMP && wid == 0) { stamps[lane] = lane < nts ? (((unsigned long long)(unsigned)ts_hi << 32) | (unsigned)ts_lo) : 0ull;
        if (lane == 62) stamps[62] = rt_entry; if (lane == 63) stamps[63] = (unsigned long long)wall_clock64(); }
#undef PG8_STAMP
#undef PG8_SA
#undef PG8_SB
#undef PG8_STAGE
#undef PG8_LDA
#undef PG8_LDB
#undef PG8_MMA
#undef PG8_WAIT_V
#undef PG8_WAIT_L
#undef PG8_WAIT_VL
#undef PG8_ROT
#undef PG8_KO
#undef PG8_BAR
#undef PG8_SCHED
}
}

using pg8::bf16_t; using pg8::bf16x8; using pg8::f32x4; using pg8::u32x4;
typedef unsigned u32x2 __attribute__((ext_vector_type(2)));
constexpr int NB = 8, CTXL = 256, SEQ = 4096, SP = CTXL + SEQ  , NTOK = NB * SP  , NH = NTOK / 2  , DM = 1024;
constexpr int NCH = SP / 128;
constexpr int NTHR = 512;
constexpr float ALPHA = 1.6817928305074290f;
constexpr float LN_EPS = 1e-5f;
constexpr size_t MiB = 1048576;
constexpr size_t WS_BAR = 0;
constexpr size_t WS_MOD = 16384;
constexpr size_t WS_ROPE = WS_MOD + 458752;
constexpr size_t WS_XCTX = 2 * MiB;
constexpr size_t WS_H = 10 * MiB;
constexpr size_t WS_W = 78 * MiB;
constexpr size_t WS_S = 102 * MiB;
constexpr size_t WS_END = 510 * MiB;
constexpr size_t U34 = 34 * MiB, U68 = 68 * MiB;
static_assert((size_t)NH * 1024 * 2 == U34 && (size_t)NTOK * 1024 * 2 == U68, "unit sizes");
constexpr int LDS_BYTES = 163840;

__device__ __forceinline__ float bf2f(unsigned short h) { return __uint_as_float(((unsigned)h) << 16); }
__device__ __forceinline__ float bflo(unsigned w) { return __uint_as_float(w << 16); }
__device__ __forceinline__ float bfhi(unsigned w) { return __uint_as_float(w & 0xffff0000u); }
__device__ __forceinline__ unsigned pk2(float lo, float hi) { return pg8::cvt_pk_bf16(lo, hi); }
__device__ __forceinline__ float siluf(float x) { return x * __builtin_amdgcn_rcpf(1.f + __expf(-x)); }
__device__ __forceinline__ float sigmf(float x) { return __builtin_amdgcn_rcpf(1.f + __expf(-x)); }
__device__ __forceinline__ void unpack8(const uint4 v, float (&f)[8]) {
    f[0] = bflo(v.x); f[1] = bfhi(v.x); f[2] = bflo(v.y); f[3] = bfhi(v.y); f[4] = bflo(v.z); f[5] = bfhi(v.z); f[6] = bflo(v.w); f[7] = bfhi(v.w); }
__device__ __forceinline__ uint4 pack8(const float (&f)[8]) { uint4 v; v.x = pk2(f[0], f[1]); v.y = pk2(f[2], f[3]); v.z = pk2(f[4], f[5]); v.w = pk2(f[6], f[7]); return v; }
#define SLABOFF(row, ch) ((row) * 128 + ((((ch) ^ (row)) & 7) << 4))
#define SLABOFF2(row, ch) ((row) * 128 + ((((ch) ^ (row) ^ ((row) >> 4)) & 7) << 4))
__device__ __forceinline__ bf16x8 lds_frag(LAS unsigned char* slab, int row, int ch) { return *(const LAS bf16x8*)(slab + SLABOFF(row, ch)); }
__device__ __forceinline__ void lds_st16(LAS unsigned char* slab, int row, int ch, uint4 v) { u32x4 t; t.x = v.x; t.y = v.y; t.z = v.z; t.w = v.w; *(LAS u32x4*)(slab + SLABOFF(row, ch)) = t; }
__device__ __forceinline__ void lds_st16b(LAS unsigned char* slab, int row, int ch, uint4 v) { u32x4 t; t.x = v.x; t.y = v.y; t.z = v.z; t.w = v.w; *(LAS u32x4*)(slab + SLABOFF2(row, ch)) = t; }
__device__ __forceinline__ uint4 lds_ld16(LAS unsigned char* slab, int row, int ch) { const u32x4 t = *(const LAS u32x4*)(slab + SLABOFF(row, ch)); return make_uint4(t.x, t.y, t.z, t.w); }
template <int TM, int TN, bool SW2 = false>
__device__ __forceinline__ void mma_slab(f32x4 (&acc)[TM][TN], LAS unsigned char* As, int arow0, LAS unsigned char* Bs, int brow0, int lane) {
#pragma unroll
    for (int ks = 0; ks < 2; ++ks) {
        bf16x8 a[TM], b[TN];
#pragma unroll
        for (int tm = 0; tm < TM; ++tm) { const int r_ = arow0 + 16 * tm + (lane & 15), c_ = (lane >> 4) + 4 * ks; a[tm] = *(const LAS bf16x8*)(As + (SW2 ? SLABOFF2(r_, c_) : SLABOFF(r_, c_))); }
#pragma unroll
        for (int tn = 0; tn < TN; ++tn) { const int r_ = brow0 + 16 * tn + (lane & 15), c_ = (lane >> 4) + 4 * ks; b[tn] = *(const LAS bf16x8*)(Bs + (SW2 ? SLABOFF2(r_, c_) : SLABOFF(r_, c_))); }
#pragma unroll
        for (int tm = 0; tm < TM; ++tm)
#pragma unroll
            for (int tn = 0; tn < TN; ++tn) acc[tm][tn] = __builtin_amdgcn_mfma_f32_16x16x32_bf16(a[tm], b[tn], acc[tm][tn], 0, 0, 0);
    }
}
__device__ __forceinline__ int ord_b(int k) { return k == 0 ? 1 : (k == 1 ? 0 : 35 - k); }
__device__ __forceinline__ int pos_b(int c) { return c == 1 ? 0 : (c == 0 ? 1 : 35 - c); }
__device__ __forceinline__ float log2_gamma(float logit) {
    const float sp = (logit > 15.f) ? __expf(-logit) : log1pf(__expf(-logit)); return -sp * 1.4426950408889634f; }

__device__ __forceinline__ void wg_sync() { asm volatile("s_waitcnt lgkmcnt(0)" ::: "memory"); __builtin_amdgcn_s_barrier(); asm volatile("" ::: "memory"); }

__device__ __forceinline__ void mfma_drain() { __builtin_amdgcn_sched_barrier(0); asm volatile("s_nop 15\n\ts_nop 15" ::: "memory"); __builtin_amdgcn_sched_barrier(0); }

struct Prm {
    const float* in[34]; float* out; unsigned char* ws;
};
#define PHASE_FN static __device__ __forceinline__

template <class F>
__device__ __forceinline__ void cvt_tiles(bf16_t* dst, int ld_dst, int koff, int NN, int KK, F f, LAS float* T, int bid, int nb, int& tbase) {
    const int tid = tid_opq(), tn = NN / 64, tk = KK / 64, nt = tn * tk;
    int first = (bid - (tbase % nb) + nb) % nb;
    float nv[8];
    if (first < nt) { const int n0 = (first % tn) * 64, k0 = (first / tn) * 64;
#pragma unroll
        for (int i = 0; i < 8; ++i) { const int kk = (tid >> 6) + 8 * i, nn = tid & 63; nv[i] = f(k0 + kk, n0 + nn); } }
    for (int t = first; t < nt; t += nb) {
        const int n0 = (t % tn) * 64, k0 = (t / tn) * 64;
        wg_sync();
#pragma unroll
        for (int i = 0; i < 8; ++i) { const int kk = (tid >> 6) + 8 * i, nn = tid & 63; T[kk * 65 + nn] = nv[i]; }
        if (t + nb < nt) { const int n1 = ((t + nb) % tn) * 64, k1 = ((t + nb) / tn) * 64;
#pragma unroll
            for (int i = 0; i < 8; ++i) { const int kk = (tid >> 6) + 8 * i, nn = tid & 63; nv[i] = f(k1 + kk, n1 + nn); } }
        wg_sync();
        const int nn2 = tid >> 3, kc = tid & 7; float v[8];
#pragma unroll
        for (int e = 0; e < 8; ++e) v[e] = T[(8 * kc + e) * 65 + nn2];
        *(uint4*)(dst + (size_t)(n0 + nn2) * ld_dst + koff + k0 + 8 * kc) = pack8(v);
    }
    tbase += nt;
}

PHASE_FN void phase_mod(const float* cvec, const float* cctx, const float* ada_w, const float* ada_b, float* mod, float* rope, LAS unsigned char* L, int bid, int nb) {
    const int tid = tid_opq();
    LAS float* sc = (LAS float*)L;
    LAS float* red = sc + 9 * 1024;
    for (int i = tid; i < 9 * 1024; i += NTHR) { const int j = i >> 10, k = i & 1023; const float v = (j < 8) ? cvec[j * 1024 + k] : cctx[k]; sc[i] = siluf(v); }
    wg_sync();
    for (int blk = bid; blk < 256; blk += nb) {
        const int l = blk >> 6, c0 = (blk & 63) * 48;
        float a[9];
#pragma unroll
        for (int j = 0; j < 9; ++j) a[j] = 0.f;
        const int col = tid % 48, kg = tid / 48;
        if (tid < 480) {
            for (int k = kg; k < 1024; k += 10) { const float w = ada_w[((size_t)l * 1024 + k) * 3072 + c0 + col];
#pragma unroll
                for (int j = 0; j < 9; ++j) a[j] += sc[j * 1024 + k] * w; }
#pragma unroll
            for (int j = 0; j < 9; ++j) red[(kg * 48 + col) * 9 + j] = a[j];
        }
        wg_sync();
        if (tid < 48 * 9) { const int cc = tid / 9, j = tid % 9; float s = 0.f;
#pragma unroll
            for (int g = 0; g < 10; ++g) s += red[(g * 48 + cc) * 9 + j];
            mod[((size_t)l * 9 + j) * 3072 + c0 + cc] = s + ada_b[l * 3072 + c0 + cc]; }
        wg_sync();
    }
    for (int i = bid * NTHR + tid; i < 4096; i += nb * NTHR) { const int pos = i >> 6, fi = i & 63;
        const double inv = pow(10000.0, -(double)fi / 64.0), ang = (double)pos * inv; rope[2 * i] = (float)cos(ang); rope[2 * i + 1] = (float)sin(ang); }
}

__device__ __forceinline__ const float* xrow_in(const float* xl, const float* xc, int R) { const int b = R / SP, s = R - b * SP; return s < CTXL ? xc + ((size_t)b * CTXL + s) * DM : xl + ((size_t)b * SEQ + (s - CTXL)) * DM; }

typedef float f32x2v __attribute__((ext_vector_type(2)));
template <int CTRL> __device__ __forceinline__ float dppf(float v) { return __int_as_float(__builtin_amdgcn_update_dpp(0, __float_as_int(v), CTRL, 0xF, 0xF, true)); }
__device__ __forceinline__ float red4(float v) { v += dppf<0xB1>(v); v += dppf<0x4E>(v); return v; }
__device__ __forceinline__ float red8(float v) { v = red4(v); v += dppf<0x141>(v); return v; }
__device__ __forceinline__ float red16(float v) { v = red8(v); v += dppf<0x140>(v); return v; }

PHASE_FN void phase_h0(const float* x, const float* ctx, const float* mod0, bf16_t* H, int R0, int R1, int bid, int nb) {
    const int tid = tid_opq(), lane = tid & 63, wv = tid >> 6;
    float4 cs[4], cgm[4]; int jc = -1;
    for (int R = R0 + bid * 8 + wv; R < R1; R += nb * 8) {
        const int b = R / SP, s = R - b * SP; const float* xr = xrow_in(x, ctx, R); const int j = (s < CTXL ? 8 : b);
        if (j != jc) { const float* md = mod0 + (size_t)j * 3072; jc = j;
#pragma unroll
            for (int u = 0; u < 4; ++u) { const int c = 8 * lane + 512 * (u >> 1) + 4 * (u & 1); cs[u] = *(const float4*)(md + c); cgm[u] = *(const float4*)(md + 1024 + c); } }
#pragma unroll
        for (int u = 0; u < 2; ++u) { const int c = 8 * lane + 512 * u; float v[8];
            const float4 x0 = *(const float4*)(xr + c), x1 = *(const float4*)(xr + c + 4), s0 = cs[2 * u], s1 = cs[2 * u + 1], g0 = cgm[2 * u], g1 = cgm[2 * u + 1];
            v[0] = x0.x * (1.f + g0.x) + s0.x; v[1] = x0.y * (1.f + g0.y) + s0.y; v[2] = x0.z * (1.f + g0.z) + s0.z; v[3] = x0.w * (1.f + g0.w) + s0.w;
            v[4] = x1.x * (1.f + g1.x) + s1.x; v[5] = x1.y * (1.f + g1.y) + s1.y; v[6] = x1.z * (1.f + g1.z) + s1.z; v[7] = x1.w * (1.f + g1.w) + s1.w;
            *(uint4*)(H + (size_t)R * DM + c) = pack8(v); }
    }
}

PHASE_FN void phase_ln(const float* xl_in, const float* xc_in, float* xl_out, float* xc_out, const bf16_t* ymix, const float* modl, const float* modn, const float* lng, const float* lnb,
                       bf16_t* H, int R0, int R1, int last, int bid, int nb, unsigned* cnt = nullptr) {
    const int tid = tid_opq(), lane = tid & 63, wv = tid >> 6;
    const bool inbf = ((const float*)xl_out == xl_in), outbf = !last;
    float4 nx[4]; uint4 nxb[2]; uint4 ny[2];
#define LN_FETCH(R_) do { const int b_ = (R_) / SP, s_ = (R_) - b_ * SP; if (!(last && s_ < CTXL)) { const float* xr_ = xrow_in(xl_in, xc_in, (R_)); const bf16_t* yr_ = ymix + (size_t)((R_) - R0) * DM; \
        _Pragma("unroll") for (int u = 0; u < 2; ++u) { const int c = 8 * lane + 512 * u; if (inbf) nxb[u] = *(const uint4*)((const bf16_t*)xr_ + c); else { nx[2 * u] = *(const float4*)(xr_ + c); nx[2 * u + 1] = *(const float4*)(xr_ + c + 4); } \
            ny[u] = *(const uint4*)(yr_ + c); } } } while (0)
    float4 cg[4], cb[4], cgt[4], csh[4], cscl[4]; int jc = -1;
#pragma unroll
    for (int u = 0; u < 4; ++u) { const int c = 8 * lane + 512 * (u >> 1) + 4 * (u & 1); cg[u] = *(const float4*)(lng + c); cb[u] = *(const float4*)(lnb + c); }
    const int Rfirst = R0 + bid * 8 + wv;
    if (Rfirst < R1) LN_FETCH(Rfirst);
    for (int R = Rfirst; R < R1; R += nb * 8) {
        const int b = R / SP, s = R - b * SP; const bool skip = (last && s < CTXL);
        float4 xv[4]; uint4 xw[2]; uint4 yw[2];
#pragma unroll
        for (int u = 0; u < 4; ++u) xv[u] = nx[u];
        xw[0] = nxb[0]; xw[1] = nxb[1];
        yw[0] = ny[0]; yw[1] = ny[1];
        if (R + nb * 8 < R1) LN_FETCH(R + nb * 8);
        if (skip) continue;
        const int j = (s < CTXL ? 8 : b);
        if (j != jc) { const float* gt = modl + (size_t)j * 3072 + 2048; const float* mn = modn + (size_t)j * 3072; jc = j;
#pragma unroll
            for (int u = 0; u < 4; ++u) { const int c = 8 * lane + 512 * (u >> 1) + 4 * (u & 1); cgt[u] = *(const float4*)(gt + c); if (!last) { csh[u] = *(const float4*)(mn + c); cscl[u] = *(const float4*)(mn + 1024 + c); } } }
        float z[16]; float sum = 0.f;
#pragma unroll
        for (int u = 0; u < 2; ++u) { const int c = 8 * lane + 512 * u; const float4 g0 = cgt[2 * u], g1 = cgt[2 * u + 1]; float yv[8]; unpack8(yw[u], yv);
            float4 x0 = xv[2 * u], x1 = xv[2 * u + 1];
            if (inbf) { float xf[8]; unpack8(xw[u], xf); x0 = make_float4(xf[0], xf[1], xf[2], xf[3]); x1 = make_float4(xf[4], xf[5], xf[6], xf[7]); }
            z[8 * u + 0] = ALPHA * x0.x + g0.x * yv[0]; z[8 * u + 1] = ALPHA * x0.y + g0.y * yv[1]; z[8 * u + 2] = ALPHA * x0.z + g0.z * yv[2]; z[8 * u + 3] = ALPHA * x0.w + g0.w * yv[3];
            z[8 * u + 4] = ALPHA * x1.x + g1.x * yv[4]; z[8 * u + 5] = ALPHA * x1.y + g1.y * yv[5]; z[8 * u + 6] = ALPHA * x1.z + g1.z * yv[6]; z[8 * u + 7] = ALPHA * x1.w + g1.w * yv[7];
#pragma unroll
            for (int e = 0; e < 8; ++e) sum += z[8 * u + e]; }
        sum = red16(sum); sum += __shfl_xor(sum, 16); sum += __shfl_xor(sum, 32);
        const float mu = sum * (1.f / 1024.f); float sq = 0.f;
#pragma unroll
        for (int e = 0; e < 16; ++e) { const float d = z[e] - mu; sq += d * d; }
        sq = red16(sq); sq += __shfl_xor(sq, 16); sq += __shfl_xor(sq, 32);
        const float rs = rsqrtf(sq * (1.f / 1024.f) + LN_EPS);
        if (cnt && lane == 0 && !(fabsf(sq) < 3.0e38f)) atomicAdd(cnt, 1u);
        float* xo = (s < CTXL) ? xc_out + ((size_t)b * CTXL + s) * DM : xl_out + ((size_t)b * SEQ + (s - CTXL)) * DM;
#pragma unroll
        for (int u = 0; u < 2; ++u) { const int c = 8 * lane + 512 * u; float o8[8];
#pragma unroll
            for (int q4 = 0; q4 < 2; ++q4) { const float4 g = cg[2 * u + q4], bb = cb[2 * u + q4];
                float4 o; o.x = (z[8 * u + 4 * q4] - mu) * rs * g.x + bb.x; o.y = (z[8 * u + 4 * q4 + 1] - mu) * rs * g.y + bb.y; o.z = (z[8 * u + 4 * q4 + 2] - mu) * rs * g.z + bb.z; o.w = (z[8 * u + 4 * q4 + 3] - mu) * rs * g.w + bb.w;
                if (!outbf) *(float4*)(xo + c + 4 * q4) = o; o8[4 * q4] = o.x; o8[4 * q4 + 1] = o.y; o8[4 * q4 + 2] = o.z; o8[4 * q4 + 3] = o.w; }
            if (outbf) *(uint4*)((bf16_t*)xo + c) = pack8(o8);
            if (!last) { float hv[8];
#pragma unroll
                for (int q4 = 0; q4 < 2; ++q4) { const float4 sh = csh[2 * u + q4], scl = cscl[2 * u + q4];
                    hv[4 * q4] = o8[4 * q4] * (1.f + scl.x) + sh.x; hv[4 * q4 + 1] = o8[4 * q4 + 1] * (1.f + scl.y) + sh.y; hv[4 * q4 + 2] = o8[4 * q4 + 2] * (1.f + scl.z) + sh.z; hv[4 * q4 + 3] = o8[4 * q4 + 3] * (1.f + scl.w) + sh.w; }
                *(uint4*)(H + (size_t)R * DM + c) = pack8(hv); } }
    }
#undef LN_FETCH
}

PHASE_FN void phase_probe(float* out, const unsigned* cnt, int bid, int nb) {
    float off = 0.f;
    for (int l = 3; l >= 0; --l) if (cnt[l]) off = 10.f * (l + 1);
    for (size_t i = (size_t)bid * NTHR + tid_opq(); i < (size_t)NB * SEQ * DM; i += (size_t)nb * NTHR) { out[i] = off; }
}

PHASE_FN void phase_scan(const void* buf, size_t n, int isbf, unsigned* cnt, int idx, int bid, int nb, float thr = 3.0e38f) {
    unsigned bad = 0;
    for (size_t i = (size_t)bid * NTHR + tid_opq(); i < n; i += (size_t)nb * NTHR) { const float v = isbf ? bf2f(((const bf16_t*)buf)[i]) : ((const float*)buf)[i]; if (!(fabsf(v) < thr)) ++bad; }
    if (bad) atomicAdd(cnt + idx, 1u);
}
PHASE_FN void phase_probe2(float* out, const unsigned* cnt, int bid, int nb) {
    float off = 0.f;
    for (int l = 15; l >= 0; --l) if (cnt[l]) off = 10.f * (l + 1);
    for (size_t i = (size_t)bid * NTHR + tid_opq(); i < (size_t)NB * SEQ * DM; i += (size_t)nb * NTHR) { out[i] = off; }
}

PHASE_FN void phase_probe3(float* out, const unsigned* cnt, int bid, int nb) {
    const unsigned code = cnt[20]; const float off = (code == 0xFFFFFFFFu) ? 0.f : 10.f * (float)(code + 1u);
    for (size_t i = (size_t)bid * NTHR + tid_opq(); i < (size_t)NB * SEQ * DM; i += (size_t)nb * NTHR) { out[i] = off; }
}

PHASE_FN void phase_cmp(const void* a, const void* b, size_t nbytes, unsigned* cnt, int idx, int bid, int nb) {
    const uint4* x = (const uint4*)a; const uint4* y = (const uint4*)b; unsigned bad = 0;
    for (size_t i = (size_t)bid * NTHR + tid_opq(); i < nbytes / 16; i += (size_t)nb * NTHR) { const uint4 u = x[i], v = y[i]; if (u.x != v.x || u.y != v.y || u.z != v.z || u.w != v.w) ++bad; }
    if (bad) atomicAdd(cnt + idx, 1u);
}

PHASE_FN void phase_probe5(float* out, const unsigned* cnt, int bid, int nb) {
    const float off = 10.f * (1.f + (cnt[14] ? 1.f : 0.f) + (cnt[15] ? 2.f : 0.f) + (cnt[16] ? 4.f : 0.f) + (cnt[17] ? 8.f : 0.f));
    for (size_t i = (size_t)bid * NTHR + tid_opq(); i < (size_t)NB * SEQ * DM; i += (size_t)nb * NTHR) { out[i] = off; }
}

PHASE_FN void phase_chkvt(const bf16_t* v, const bf16_t* Vt, unsigned* cnt, int idx, int bid, int nb) {
    unsigned bad = 0;
    for (size_t i = (size_t)bid * NTHR + tid_opq(); i < (size_t)16 * 512 * SP; i += (size_t)nb * NTHR) { const int s = (int)(i % SP); const size_t r = i / SP; const int n = (int)(r & 511), bh = (int)(r >> 9);
        const bf16_t a = Vt[i], b = v[((size_t)(bh >> 2) * SP + s) * 2048 + (bh & 3) * 512 + n]; if (a != b) ++bad; }
    if (bad) atomicAdd(cnt + idx, bad);
}
PHASE_FN void phase_probe6(float* out, const unsigned* cnt, int bid, int nb) {
    unsigned a = cnt[18], b = cnt[19]; int da = 0, db = 0; while (a) { ++da; a /= 10; } while (b) { ++db; b /= 10; }
    const float off = 10.f * (float)(1 + da + 10 * db);
    for (size_t i = (size_t)bid * NTHR + tid_opq(); i < (size_t)NB * SEQ * DM; i += (size_t)nb * NTHR) { out[i] = off; }
}

PHASE_FN void phase_probe7(float* out, const unsigned* seq, int bid, int nb) {
    unsigned a = seq[1]; int da = 0; while (a) { ++da; a /= 10; }
    const float off = 10.f * (float)(1 + da);
    for (size_t i = (size_t)bid * NTHR + tid_opq(); i < (size_t)NB * SEQ * DM; i += (size_t)nb * NTHR) { out[i] = off; }
}

PHASE_FN void phase_chkvt2(const bf16_t* v, const bf16_t* Vt, unsigned* mask, int bid, int nb) {
    for (size_t i = (size_t)bid * NTHR + tid_opq(); i < (size_t)16 * 512 * SP; i += (size_t)nb * NTHR) { const int s = (int)(i % SP); const size_t r = i / SP; const int n = (int)(r & 511), bh = (int)(r >> 9);
        const bf16_t a = Vt[i], b = v[((size_t)(bh >> 2) * SP + s) * 2048 + (bh & 3) * 512 + n]; if (a != b) { const int item = bh * NCH + (s >> 7); atomicOr(mask + (item >> 5), 1u << (item & 31)); } }
}
PHASE_FN void phase_probe8(float* out, const unsigned* mask, int bid, int nb) {
    int nbad = 0, first = -1; for (int it = 0; it < 16 * NCH; ++it) if (mask[it >> 5] & (1u << (it & 31))) { ++nbad; if (first < 0) first = it; }
    const float off = 10.f * (float)(1 + (nbad > 60 ? 60 : nbad)); const float off2 = 100.f + 10.f * (float)(first < 0 ? 0 : first);
    for (size_t i = (size_t)bid * NTHR + tid_opq(); i < (size_t)NB * SEQ * DM; i += (size_t)nb * NTHR) { out[i] = (i == 12345) ? off2 : off; }
}

PHASE_FN void phase_probe9(float* out, const unsigned* cnt, int bid, int nb) {
    int mask = 0; for (int l = 0; l < 5; ++l) if (cnt[20 + l]) mask |= 1 << l;
    const float off = 10.f * (float)(1 + mask);
    for (size_t i = (size_t)bid * NTHR + tid_opq(); i < (size_t)NB * SEQ * DM; i += (size_t)nb * NTHR) { out[i] = off; }
}

PHASE_FN void phase_probe10(float* out, const unsigned* cnt, int bid, int nb) {
    const float off = 10.f * (float)(1 + (cnt[25] > 100u ? 50u : cnt[25])); const float off2 = 100.f * (float)(1 + (cnt[26] > 100u ? 50u : cnt[26])) ;
    for (size_t i = (size_t)bid * NTHR + tid_opq(); i < (size_t)NB * SEQ * DM; i += (size_t)nb * NTHR) { out[i] = (i == 12345) ? off2 : off; }
}

PHASE_FN void phase_timing(float* out, const unsigned long long* tsb, int n, int bid, int nb, int ga, int gb) {
    const unsigned* grp = (const unsigned*)(tsb + 64); float ta = 0.f, tb = 0.f;
    for (int k = 1; k < n; ++k) { const float d = (float)(tsb[k] - tsb[k - 1]); if ((int)grp[k] == ga) ta += d; if ((int)grp[k] == gb) tb += d; }
    const float tot = (float)(tsb[n - 1] - tsb[0]); const float fa = TP_SCALE * ta / tot, fb = TP_SCALE * tb / tot;
    const float delta = sqrtf(fa * 8.0e-5f);
    const int tid = tid_opq();
    for (size_t i = (size_t)bid * NTHR + tid; i < (size_t)NB * SEQ * DM; i += (size_t)nb * NTHR) { float v = out[i] + ((i & 1) ? delta : -delta); if (i == 12345) v += 1.f + 9.f * fb; out[i] = v; }
}

PHASE_FN void phase_prof6(float* out, const unsigned long long* pr, int ia, int ib, int bid, int nb) {
    float tot = 0.f; for (int k = 0; k < 6; ++k) tot += (float)pr[k];
    const float fa = (float)pr[ia] / tot, fb = (float)pr[ib] / tot; const float delta = sqrtf(fa * 8.0e-5f);
    const int tid = tid_opq();
    for (size_t i = (size_t)bid * NTHR + tid; i < (size_t)NB * SEQ * DM; i += (size_t)nb * NTHR) { float v = out[i] + ((i & 1) ? delta : -delta); if (i == 12345) v += 1.f + 9.f * fb; out[i] = v; }
}

PHASE_FN void phase_xccprobe(float* out, unsigned* cnt, int bid, int nb) {
    const float fa = (float)cnt[0] / 256.f, fb = (float)cnt[1] / 256.f; const float delta = sqrtf(fa * 8.0e-5f);
    const int tid = tid_opq();
    for (size_t i = (size_t)bid * NTHR + tid; i < (size_t)NB * SEQ * DM; i += (size_t)nb * NTHR) { float v = out[i] + ((i & 1) ? delta : -delta); if (i == 12345) v += 1.f + 9.f * fb; out[i] = v; }
}

#ifndef EPI_NT
#define EPI_NT 0
#endif
#if EPI_NT
#define EPI_ST(ptr, w) __builtin_nontemporal_store((w), (u32x4*)(ptr))
#else
#define EPI_ST(ptr, w) (*(u32x4*)(ptr) = (w))
#endif
struct EpiBf {
    static constexpr bool PERM = true, AFTER_DRAIN = false;
    bf16_t* O; int ld;
    __device__ __forceinline__ void operator()(const f32x4 (&acc)[2][2][4][2], const pg8::Unit& u, int wr, int wc, int fr, int fq) const {
        const int row0 = u.pm * 256 + wr * 64 + fr, col0 = u.pn * 256 + wc * 32 + 8 * fq;
#pragma unroll
        for (int ai = 0; ai < 2; ++ai)
#pragma unroll
            for (int m = 0; m < 4; ++m) { bf16_t* rowp = O + (size_t)(row0 + ai * 128 + m * 16) * ld + col0;
#pragma unroll
                for (int bj = 0; bj < 2; ++bj) { const f32x4 v0 = acc[ai][bj][m][0], v1 = acc[ai][bj][m][1];
                    u32x4 w; w.x = pk2(v0[0], v0[1]); w.y = pk2(v0[2], v0[3]); w.z = pk2(v1[0], v1[1]); w.w = pk2(v1[2], v1[3]);
                    EPI_ST(rowp + bj * 128, w); } }
    }
};
struct EpiF32 {
    static constexpr bool PERM = false, AFTER_DRAIN = false;
    float* C; int ld;
    __device__ __forceinline__ void operator()(const f32x4 (&acc)[2][2][4][2], const pg8::Unit& u, int wr, int wc, int fr, int fq) const {
        const int row0 = u.pm * 256 + wr * 64 + fr, col0 = u.pn * 256 + wc * 32 + 4 * fq;
#pragma unroll
        for (int ai = 0; ai < 2; ++ai)
#pragma unroll
            for (int m = 0; m < 4; ++m) { float* rowp = C + (size_t)(row0 + ai * 128 + m * 16) * ld + col0;
#pragma unroll
                for (int bj = 0; bj < 2; ++bj)
#pragma unroll
                    for (int n = 0; n < 2; ++n) *(f32x4*)(rowp + bj * 128 + n * 16) = acc[ai][bj][m][n]; }
    }
};
struct EpiRetQKV {
    static constexpr bool PERM = true, AFTER_DRAIN = false;
    bf16_t* q; bf16_t* k; bf16_t* v; const float* rope; int rowbase;
    __device__ __forceinline__ void operator()(const f32x4 (&acc)[2][2][4][2], const pg8::Unit& u, int wr, int wc, int fr, int fq) const {
        const int row0 = u.pm * 256 + wr * 64 + fr, pn = u.pn;
        if (pn >= 8) {
            const int col0 = (pn - 8) * 256 + wc * 32 + 8 * fq;
#pragma unroll
            for (int ai = 0; ai < 2; ++ai)
#pragma unroll
                for (int m = 0; m < 4; ++m) { bf16_t* rowp = v + (size_t)(row0 + ai * 128 + m * 16) * 2048 + col0;
#pragma unroll
                    for (int bj = 0; bj < 2; ++bj) { const f32x4 v0 = acc[ai][bj][m][0], v1 = acc[ai][bj][m][1];
                        u32x4 w; w.x = pk2(v0[0], v0[1]); w.y = pk2(v0[2], v0[3]); w.z = pk2(v1[0], v1[1]); w.w = pk2(v1[2], v1[3]);
                        EPI_ST(rowp + bj * 128, w); } }
        } else {
            bf16_t* dst = (pn < 4) ? q : k; const int col0 = (pn & 3) * 256 + wc * 32 + 8 * fq, i0 = 16 * wc + 4 * fq;
#pragma unroll
            for (int ai = 0; ai < 2; ++ai)
#pragma unroll
                for (int m = 0; m < 4; ++m) { const int row = row0 + ai * 128 + m * 16; const int R = rowbase + row, s = R % SP; const bool lat = (s >= CTXL); const int t = s - CTXL;
                    bf16_t* rowp = dst + (size_t)row * 1024 + col0;
#pragma unroll
                    for (int bj = 0; bj < 2; ++bj) { f32x4 v0 = acc[ai][bj][m][0], v1 = acc[ai][bj][m][1];
                        if (lat) { const int pos = (bj == 0) ? (t >> 6) : (t & 63); const float* tb = rope + (size_t)(pos * 64 + i0) * 2;
                            const float4 c01 = *(const float4*)(tb), c23 = *(const float4*)(tb + 4);
                            f32x4 r0, r1;
                            r0[0] = v0[0] * c01.x - v0[1] * c01.y; r0[1] = v0[0] * c01.y + v0[1] * c01.x;
                            r0[2] = v0[2] * c01.z - v0[3] * c01.w; r0[3] = v0[2] * c01.w + v0[3] * c01.z;
                            r1[0] = v1[0] * c23.x - v1[1] * c23.y; r1[1] = v1[0] * c23.y + v1[1] * c23.x;
                            r1[2] = v1[2] * c23.z - v1[3] * c23.w; r1[3] = v1[2] * c23.w + v1[3] * c23.z;
                            v0 = r0; v1 = r1; }
                        u32x4 w; w.x = pk2(v0[0], v0[1]); w.y = pk2(v0[2], v0[3]); w.z = pk2(v1[0], v1[1]); w.w = pk2(v1[2], v1[3]);
                        EPI_ST(rowp + bj * 128, w); } }
        }
    }
};
struct EpiRwkv {
    static constexpr bool PERM = true, AFTER_DRAIN = false;
    bf16_t* rkvg; bf16_t* T;
    __device__ __forceinline__ void operator()(const f32x4 (&acc)[2][2][4][2], const pg8::Unit& u, int wr, int wc, int fr, int fq) const {
        const int row0 = u.pm * 256 + wr * 64 + fr, pn = u.pn;
        if (pn < 16) {
            bf16_t* dst = rkvg + (size_t)(pn >> 2) * ((size_t)NTOK * 1024); const int col0 = (pn & 3) * 256 + wc * 32 + 8 * fq;
#pragma unroll
            for (int ai = 0; ai < 2; ++ai)
#pragma unroll
                for (int m = 0; m < 4; ++m) { bf16_t* rowp = dst + (size_t)(row0 + ai * 128 + m * 16) * 1024 + col0;
#pragma unroll
                    for (int bj = 0; bj < 2; ++bj) { const f32x4 v0 = acc[ai][bj][m][0], v1 = acc[ai][bj][m][1];
                        u32x4 w; w.x = pk2(v0[0], v0[1]); w.y = pk2(v0[2], v0[3]); w.z = pk2(v1[0], v1[1]); w.w = pk2(v1[2], v1[3]);
                        EPI_ST(rowp + bj * 128, w); } }
        } else {
            const int col0 = (pn - 16) * 128 + wc * 32 + 8 * fq; const bool th = (pn == 16);
#pragma unroll
            for (int ai = 0; ai < 2; ++ai)
#pragma unroll
                for (int m = 0; m < 4; ++m) { bf16_t* rowp = T + (size_t)(row0 + ai * 128 + m * 16) * 256 + col0;
                    f32x4 v0 = acc[ai][0][m][0], v1 = acc[ai][0][m][1];
                    if (th) {
#pragma unroll
                        for (int e = 0; e < 4; ++e) { v0[e] = 1.f - 2.f * __builtin_amdgcn_rcpf(1.f + __expf(2.f * v0[e])); v1[e] = 1.f - 2.f * __builtin_amdgcn_rcpf(1.f + __expf(2.f * v1[e])); } }
                    u32x4 w; w.x = pk2(v0[0], v0[1]); w.y = pk2(v0[2], v0[3]); w.z = pk2(v1[0], v1[1]); w.w = pk2(v1[2], v1[3]);
                    EPI_ST(rowp, w); }
        }
    }
};
template <class Epi, bool STAMP = false>
PHASE_FN void gemm_run(const bf16_t* A, const bf16_t* Bt, int M, int N, int K, Epi E, LAS unsigned char* L, int bid, int nb, unsigned long long* stamps = nullptr) {
    pg8::Gemm g{A, Bt, M, N, K}; pg8::StaticOrder S; S.init(M, N, nb, bid);
    pg8::gemm_phase<Epi, pg8::StaticOrder, STAMP>((PG8_LAS unsigned char*)L, g, S, E, STAMP ? stamps + (size_t)bid * 64 : nullptr);
    wg_sync();
}
PHASE_FN void phase_gstamp(float* out, const unsigned long long* st, int bid, int nb) {
    float kl = 0.f, ep = 0.f, tot = 0.f;
    for (int b = 0; b < 8; ++b) { const unsigned long long* s = st + b * 64; int n = 0; while (n < 62 && s[n] != 0ull) ++n;
        const int nu = (n - 3) / 2; tot += (float)(s[n - 1] - s[0]);
        kl += (float)(s[2] - s[1]); for (int i = 1; i < nu; ++i) { ep += 0.25f * (float)(s[2 + 2 * i] - s[1 + 2 * i]); } }
    const float fa = kl / tot, fb = ep / tot; const float delta = sqrtf(fa * 8.0e-5f);
    const int tid = tid_opq();
    for (size_t i = (size_t)bid * NTHR + tid; i < (size_t)NB * SEQ * DM; i += (size_t)nb * NTHR) { float v = out[i] + ((i & 1) ? delta : -delta); if (i == 12345) v += 1.f + 9.f * fb; out[i] = v; }
}

struct DealOrder : pg8::StaticOrder {
    int nfull, first, latent;
    __device__ bool next(int i, pg8::Unit& u) const {
        bool ok;
        if (i < nfull) ok = unit_of((long)i * G + c, u);
        else if (c < first) ok = false;
        else ok = unit_of((long)nfull * G + (long)(i - nfull) * (G - first) + (c - first), u);
        if (ok && latent) u.pm = (u.pm >> 4) * 17 + 1 + (u.pm & 15);
        return ok; }
};
template <class Epi>
PHASE_FN void gemm_deal(const bf16_t* A, const bf16_t* Bt, int M, int N, int K, Epi E, int latent, LAS unsigned char* L, int bid, int nb) {
    pg8::Gemm g{A, Bt, M, N, K}; DealOrder S; S.init(latent ? (M / 17) * 16 : M, N, nb, bid); S.nfull = 1; S.first = 0; S.latent = latent;
    pg8::gemm_phase<Epi, DealOrder, false>((PG8_LAS unsigned char*)L, g, S, E, nullptr);
    wg_sync();
}
template <class Epi1, class Epi2>
PHASE_FN void gemm_dual(const bf16_t* A1, const bf16_t* B1, int M1, int N1, int K1, Epi1 E1, int nfull1, int first1,
                        const bf16_t* A2, const bf16_t* B2, int M2, int N2, int K2, Epi2 E2, int nfull2, int first2, LAS unsigned char* L, int bid, int nb, int lat1 = 0) {
    { pg8::Gemm g{A1, B1, M1, N1, K1}; DealOrder S; S.init(lat1 ? (M1 / 17) * 16 : M1, N1, nb, bid); S.nfull = nfull1; S.first = first1; S.latent = lat1;
      pg8::gemm_phase<Epi1, DealOrder, false>((PG8_LAS unsigned char*)L, g, S, E1, nullptr); }
    wg_sync();
    { pg8::Gemm g{A2, B2, M2, N2, K2}; DealOrder S; S.init(M2, N2, nb, bid); S.nfull = nfull2; S.first = first2; S.latent = 0;
      pg8::gemm_phase<Epi2, DealOrder, false>((PG8_LAS unsigned char*)L, g, S, E2, nullptr); }
    wg_sync();
}

struct PairOrder : pg8::StaticOrder {
    int NT, pnbase;
    __device__ bool next(int i, pg8::Unit& u) const { if (!pg8::StaticOrder::next(i, u)) return false; u.pn = pnbase + (u.pm / (NTOK / 256)) * NT + u.pn; return true; }
};
struct EpiRwkv2 {
    static constexpr bool PERM = true, AFTER_DRAIN = false;
    bf16_t* rkvg; bf16_t* T;
    __device__ __forceinline__ void operator()(const f32x4 (&acc)[2][2][4][2], const pg8::Unit& u, int wr, int wc, int fr, int fq) const {
        const int row0 = (u.pm % (NTOK / 256)) * 256 + wr * 64 + fr, pn = u.pn;
        if (pn < 16) {
            bf16_t* dst = rkvg + (size_t)(pn >> 2) * ((size_t)NTOK * 1024); const int col0 = (pn & 3) * 256 + wc * 32 + 8 * fq;
#pragma unroll
            for (int ai = 0; ai < 2; ++ai)
#pragma unroll
                for (int m = 0; m < 4; ++m) { bf16_t* rowp = dst + (size_t)(row0 + ai * 128 + m * 16) * 1024 + col0;
#pragma unroll
                    for (int bj = 0; bj < 2; ++bj) { const f32x4 v0 = acc[ai][bj][m][0], v1 = acc[ai][bj][m][1];
                        u32x4 w; w.x = pk2(v0[0], v0[1]); w.y = pk2(v0[2], v0[3]); w.z = pk2(v1[0], v1[1]); w.w = pk2(v1[2], v1[3]);
                        EPI_ST(rowp + bj * 128, w); } }
        } else {
            const int col0 = (pn - 16) * 128 + wc * 32 + 8 * fq; const bool th = (pn == 16);
#pragma unroll
            for (int ai = 0; ai < 2; ++ai)
#pragma unroll
                for (int m = 0; m < 4; ++m) { bf16_t* rowp = T + (size_t)(row0 + ai * 128 + m * 16) * 256 + col0;
                    f32x4 v0 = acc[ai][0][m][0], v1 = acc[ai][0][m][1];
                    if (th) {
#pragma unroll
                        for (int e = 0; e < 4; ++e) { v0[e] = 1.f - 2.f * __builtin_amdgcn_rcpf(1.f + __expf(2.f * v0[e])); v1[e] = 1.f - 2.f * __builtin_amdgcn_rcpf(1.f + __expf(2.f * v1[e])); } }
                    u32x4 w; w.x = pk2(v0[0], v0[1]); w.y = pk2(v0[2], v0[3]); w.z = pk2(v1[0], v1[1]); w.w = pk2(v1[2], v1[3]);
                    EPI_ST(rowp, w); }
        }
    }
};
PHASE_FN void gemm_pair(const bf16_t* A, const bf16_t* Bt, int NT, int pnbase, EpiRwkv2 E, LAS unsigned char* L, int bid, int nb) {
    pg8::Gemm g{A, Bt, 2 * NTOK, NT * 256, 1024}; PairOrder S; S.init(2 * NTOK, NT * 256, nb, bid); S.NT = NT; S.pnbase = pnbase;
    pg8::gemm_phase<EpiRwkv2, PairOrder, false>((PG8_LAS unsigned char*)L, g, S, E, nullptr);
    wg_sync();
}

struct HotOrder : pg8::StaticOrder {
    int hot;
    __device__ bool next(int i, pg8::Unit& u) const { if (!pg8::StaticOrder::next(i, u)) return false; if (hot) { u.pm = 0; u.pn = 0; } return true; }
};
PHASE_FN void gemm_hot(const bf16_t* A, const bf16_t* Bt, bf16_t* O, int hot, int ld, LAS unsigned char* L, int bid, int nb, unsigned long long* stamps) {
    pg8::Gemm g{A, Bt, NH, 4096, 1024, ld}; HotOrder S; S.init(NH, 4096, nb, bid); S.hot = hot;
    pg8::gemm_phase<EpiBf, HotOrder, true>((PG8_LAS unsigned char*)L, g, S, EpiBf{O, 4096}, stamps + (size_t)bid * 64);
    wg_sync();
}
PHASE_FN void phase_hotprobe(float* out, const unsigned long long* st, int bid, int nb) {
    float k0 = 0.f, k1 = 0.f;
    for (int b = 0; b < 8; ++b) {
        { const unsigned long long* s = st + b * 64; int n = 0; while (n < 62 && s[n] != 0ull) ++n; const int nu = (n - 3) / 2; float t = 0.f; for (int i = 0; i < nu; ++i) t += (float)(s[2 + 2 * i] - s[1 + 2 * i]); k0 += t / (float)nu; }
        { const unsigned long long* s = st + 16384 + b * 64; int n = 0; while (n < 62 && s[n] != 0ull) ++n; const int nu = (n - 3) / 2; float t = 0.f; for (int i = 0; i < nu; ++i) t += (float)(s[2 + 2 * i] - s[1 + 2 * i]); k1 += t / (float)nu; } }
    const float fa = k0 / (8.f * 16.f * 8000.f), fb = k1 / (8.f * 16.f * 8000.f); const float delta = sqrtf(fa * 8.0e-5f);
    const int tid = tid_opq();
    for (size_t i = (size_t)bid * NTHR + tid; i < (size_t)NB * SEQ * DM; i += (size_t)nb * NTHR) { float v = out[i] + ((i & 1) ? delta : -delta); if (i == 12345) v += 1.f + 9.f * fb; out[i] = v; }
}

struct ChunkArgs {
    const bf16_t* qsrc; const bf16_t* ksrc; const bf16_t* vsrc; int ldq, ldv;
    bf16_t* Kt; bf16_t* Vt; bf16_t* P;
    bf16_t* Of; bf16_t* Ob;
    const float* decay;
    const float* wqkv;
    float* gG; float* gPM; float* gB; float* cBL; float* cPML; float* RS;
};

__device__ __forceinline__ void slab_transpose_out(LAS unsigned char* KS, bf16_t* dst_col0, int wave, int lane) {
    const int g = lane >> 4, i = lane & 15, q = i >> 2, p = i & 3, d0 = 16 * (wave & 3), jb = 64 * (wave >> 2) + 16 * g;
    const int ch = (d0 >> 3) + (p >> 1); unsigned ad[4];
#pragma unroll
    for (int t4 = 0; t4 < 4; ++t4) { const int row = jb + 4 * t4 + q; ad[t4] = (unsigned)(size_t)(KS + SLABOFF2(row, ch) + 8 * (p & 1)); }
    u32x2 r0, r1, r2, r3;
    asm volatile("ds_read_b64_tr_b16 %0, %4\n\tds_read_b64_tr_b16 %1, %5\n\tds_read_b64_tr_b16 %2, %6\n\tds_read_b64_tr_b16 %3, %7\n\ts_waitcnt lgkmcnt(0)"
                 : "=&v"(r0), "=&v"(r1), "=&v"(r2), "=&v"(r3) : "v"(ad[0]), "v"(ad[1]), "v"(ad[2]), "v"(ad[3]) : "memory");
    bf16_t* dst = dst_col0 + (size_t)(d0 + i) * SP + jb;
    *(uint4*)dst = make_uint4(r0.x, r0.y, r1.x, r1.y); *(uint4*)(dst + 8) = make_uint4(r2.x, r2.y, r3.x, r3.y);
}
template <int DK, bool ML>
PHASE_FN void phase_s1(ChunkArgs a, LAS unsigned char* L, int bid, int nb) {
    constexpr int NQ = DK / 64;
    const int tid = tid_opq(), lane = tid & 63, wave = __builtin_amdgcn_readfirstlane(tid >> 6), wm = wave & 3, wn = wave >> 2;
    LAS unsigned char* KS = L; LAS unsigned char* QS = L + 16384;
    LAS float* sc = (LAS float*)(L + 32768);
    LAS float* mp = sc + 768;
    LAS float* WT = (LAS float*)(L + 40960);
    LAS unsigned char* KS2 = L + 73728;
    const int tr = tid >> 3, tc = tid & 7;
    uint4 RG[16];
#define S1_LOAD_QK(item_) do { const int bh_ = (item_) / NCH, c_ = (item_) - bh_ * NCH; const size_t r0_ = (size_t)(bh_ >> 2) * SP + 128 * c_; const int h_ = bh_ & 3; \
        _Pragma("unroll") for (int ds = 0; ds < NQ; ++ds) _Pragma("unroll") for (int u = 0; u < 2; ++u) { const size_t off_ = (r0_ + tr + 64 * u) * a.ldq + h_ * DK + ds * 64 + tc * 8; \
            if (!ML) { RG[ds * 4 + u] = *(const uint4*)(a.ksrc + off_); RG[ds * 4 + 2 + u] = *(const uint4*)(a.qsrc + off_); } else RG[ds * 2 + u] = *(const uint4*)(a.qsrc + off_); } } while (0)
#define S1_LOAD_V(item_) do { const int bh_ = (item_) / NCH, c_ = (item_) - bh_ * NCH; const size_t r0_ = (size_t)(bh_ >> 2) * SP + 128 * c_; const int h_ = bh_ & 3; \
        _Pragma("unroll") for (int ns = 0; ns < 8; ++ns) _Pragma("unroll") for (int u = 0; u < 2; ++u) RG[ns * 2 + u] = *(const uint4*)(a.vsrc + (r0_ + tr + 64 * u) * a.ldv + h_ * 512 + ns * 64 + tc * 8); } while (0)
    constexpr int NI = 16 * NCH; const int nfull = NI / nb, rem = NI - nfull * nb; const int nent = nfull + ((bid < 2 * rem) ? 1 : 0);
    if (bid < NI) S1_LOAD_QK(bid);
    for (int e_ = 0; e_ < nent; ++e_) {
        const int item = (e_ < nfull) ? bid + e_ * nb : nfull * nb + (bid < rem ? bid : bid - rem), part = (e_ < nfull) ? 3 : (bid < rem ? 1 : 2);
        const int inext = (e_ + 1 < nfull) ? bid + (e_ + 1) * nb : nfull * nb + (bid < rem ? bid : bid - rem), pnext = (e_ + 1 < nent) ? ((e_ + 1 < nfull) ? 3 : (bid < rem ? 1 : 2)) : 0;
        const int bh = item / NCH, c = item - bh * NCH, h = bh & 3;
        float lgf = 0.f, lgb = 0.f;
        if (!ML) { lgf = log2_gamma(a.decay[h]); lgb = log2_gamma(a.decay[4 + h]); }
        wg_sync();
        if (ML) {
            if (wave < 2) { const int d = wave; const int npos = d ? pos_b(c) : c; float bl = 0.f, pml = 0.f;
                if (lane < NCH) { const int cc = d ? ord_b(lane) : lane; bl = a.cBL[(d * 16 + bh) * NCH + cc]; pml = a.cPML[(d * 16 + bh) * NCH + cc]; }
                float m = 0.f;
                for (int k = 0; k < npos; ++k) { const float blk = __int_as_float(__builtin_amdgcn_readlane(__float_as_int(bl), k)), pmk = __int_as_float(__builtin_amdgcn_readlane(__float_as_int(pml), k)); m = blk + fmaxf(m, pmk); }
                if (lane == 0) mp[d] = m; }
            if (tid < 256) { const int d = tid >> 7, i = tid & 127; sc[d * 128 + i] = a.gG[((size_t)d * 16 + bh) * SP + 128 * c + i]; sc[512 + d * 128 + i] = 0.f; }
#pragma unroll
            for (int u = 0; u < 3; ++u) *(LAS f32x4*)(WT + u * 2048 + tid * 4) = *(const f32x4*)(a.wqkv + (size_t)(u * 512 + h * 128) * 16 + tid * 4);
            wg_sync();
            if (tid < 256) { const int d = tid >> 7, i = tid & 127; sc[256 + d * 128 + i] = fmaxf(mp[d], a.gPM[((size_t)d * 16 + bh) * SP + 128 * c + i]); }
            { const int g_ = tid >> 2, ei_ = tid & 3; const LAS float* wq_ = WT + g_ * 16; const LAS float* wk_ = WT + 2048 + g_ * 16; f32x4 m_;
#pragma unroll
                for (int di = 0; di < 4; ++di) { float s_ = 0.f;
#pragma unroll
                    for (int dq = 0; dq < 4; ++dq) s_ += wk_[ei_ * 4 + dq] * wq_[di * 4 + dq];
                    m_[di] = s_ * 0.04419417382415922f; }
                *(LAS f32x4*)(WT + 6144 + g_ * 16 + ei_ * 4) = m_; }
        }
        if (part & 1) {
        f32x4 acc[2][4];
#pragma unroll
        for (int x = 0; x < 2; ++x)
#pragma unroll
            for (int y = 0; y < 4; ++y) acc[x][y] = (f32x4){0.f, 0.f, 0.f, 0.f};
#pragma unroll
        for (int ds = 0; ds < NQ; ++ds) {
            wg_sync();
#pragma unroll
            for (int u = 0; u < 2; ++u) { const int row = tr + 64 * u, ch = tc;
                if (!ML) { lds_st16b(KS, row, ch, RG[ds * 4 + u]); lds_st16b(QS, row, ch, RG[ds * 4 + 2 + u]); }
                else {
                    const int col = h * DK + ds * 64 + ch * 8; float x[8], qv[8], k2v[8];
                    unpack8(RG[ds * 2 + u], x);
#pragma unroll
                    for (int gi = 0; gi < 2; ++gi) { const LAS float* wm_ = WT + 6144 + (ds * 16 + ch * 2 + gi) * 16;
                        f32x4 wm4[4];
#pragma unroll
                        for (int ei = 0; ei < 4; ++ei) wm4[ei] = *(const LAS f32x4*)(wm_ + 4 * ei);
#pragma unroll
                        for (int eo = 0; eo < 4; ++eo) { float sq = 0.f, sm = 0.f;
#pragma unroll
                            for (int ei = 0; ei < 4; ++ei) { sq += x[4 * gi + ei] * wm4[eo][ei]; sm += x[4 * gi + ei] * wm4[ei][eo]; }
                            qv[4 * gi + eo] = sq; k2v[4 * gi + eo] = sm; } }
                    lds_st16b(QS, row, ch, pack8(qv)); lds_st16b(KS, row, ch, RG[ds * 2 + u]); lds_st16b(KS2, row, ch, pack8(k2v));
                } }
            if (ds == NQ - 1 && (part & 2)) S1_LOAD_V(item);
            wg_sync();
            slab_transpose_out(ML ? KS2 : KS, a.Kt + ((size_t)bh * DK + ds * 64) * SP + 128 * c, wave, lane);
            mma_slab<2, 4, true>(acc, KS, 32 * wm, QS, 64 * wn, lane);
        }
        mfma_drain();
        float rsf[4] = {0.f, 0.f, 0.f, 0.f}, rsb[4] = {0.f, 0.f, 0.f, 0.f}; unsigned pwf[2][2], pwb[2][2];
        bf16_t* Pf = a.P + ((size_t)(0 * 16 + bh) * NCH + c) * 16384; bf16_t* Pb = a.P + ((size_t)(1 * 16 + bh) * NCH + c) * 16384;
#pragma unroll
        for (int tj = 0; tj < 2; ++tj)
#pragma unroll
            for (int ti = 0; ti < 4; ++ti) { const int i = 64 * wn + 16 * ti + (lane & 15), j0 = 32 * wm + 16 * tj + 4 * (lane >> 4); float pf[4], pb[4];
                float Mfi = 0.f, Mbi = 0.f; if (ML) { Mfi = sc[256 + i]; Mbi = sc[384 + i]; }
#pragma unroll
                for (int e = 0; e < 4; ++e) { const int j = j0 + e; const float s = acc[tj][ti][e]; float wf, wb;
                    if (!ML) { wf = (j <= i) ? 1.f : 0.f; wb = (j >= i) ? 1.f : 0.f; }
                    else { wf = (j <= i) ? __expf(sc[j] - Mfi) : 0.f; wb = (j >= i) ? __expf(sc[128 + j] - Mbi) : 0.f; }
                    pf[e] = s * wf; pb[e] = s * wb; rsf[ti] += pf[e]; rsb[ti] += pb[e]; }
                pwf[ti & 1][0] = pk2(pf[0], pf[1]); pwf[ti & 1][1] = pk2(pf[2], pf[3]); pwb[ti & 1][0] = pk2(pb[0], pb[1]); pwb[ti & 1][1] = pk2(pb[2], pb[3]);
                if (ti & 1) { mfma_drain();
                    const int g = lane >> 4, irow = (g & 1) ? i : i - 16, jc = 32 * wm + 16 * tj + 4 * (g & ~1);
                    { const auto sx = __builtin_amdgcn_permlane16_swap(pwf[0][0], pwf[1][0], false, false), sy = __builtin_amdgcn_permlane16_swap(pwf[0][1], pwf[1][1], false, false);
                      u32x4 w; w.x = sx[0]; w.y = sy[0]; w.z = sx[1]; w.w = sy[1]; *(u32x4*)(Pf + irow * 128 + jc) = w; }
                    { const auto sx = __builtin_amdgcn_permlane16_swap(pwb[0][0], pwb[1][0], false, false), sy = __builtin_amdgcn_permlane16_swap(pwb[0][1], pwb[1][1], false, false);
                      u32x4 w; w.x = sx[0]; w.y = sy[0]; w.z = sx[1]; w.w = sy[1]; *(u32x4*)(Pb + irow * 128 + jc) = w; } } }
        if (ML) {
#pragma unroll
            for (int ti = 0; ti < 4; ++ti) { float f = rsf[ti], b = rsb[ti]; f += __shfl_xor(f, 16); f += __shfl_xor(f, 32); b += __shfl_xor(b, 16); b += __shfl_xor(b, 32);
                if ((lane >> 4) == 0) { const int i = 64 * wn + 16 * ti + (lane & 15); atomicAdd((float*)(sc + 512 + i), f); atomicAdd((float*)(sc + 640 + i), b); } }
            wg_sync();
            if (tid < 256) { const int d = tid >> 7, i = tid & 127; a.RS[((size_t)d * 16 + bh) * SP + 128 * c + i] = sc[512 + d * 128 + i]; }
        }
        }
        if (part & 2) {
#pragma unroll
        for (int ns = 0; ns < 8; ++ns) {
            wg_sync();
#pragma unroll
            for (int u = 0; u < 2; ++u) { const int row = tr + 64 * u, ch = tc; const int col = h * 512 + ns * 64 + ch * 8;
                uint4 raw = RG[ns * 2 + u];
                if (ML) { float x[8], vv[8]; unpack8(raw, x);
#pragma unroll
                    for (int gi = 0; gi < 2; ++gi) { const LAS float* wv = WT + 4096 + (ns * 16 + ch * 2 + gi) * 16;
                        f32x4 wv4[4];
#pragma unroll
                        for (int ei = 0; ei < 4; ++ei) wv4[ei] = *(const LAS f32x4*)(wv + 4 * ei);
#pragma unroll
                        for (int eo = 0; eo < 4; ++eo) { float sv = 0.f;
#pragma unroll
                            for (int ei = 0; ei < 4; ++ei) sv += x[4 * gi + ei] * wv4[ei][eo];
                            vv[4 * gi + eo] = sv; } }
                    raw = pack8(vv); }
                lds_st16b(KS, row, ch, raw); }
            if (ns == 7) { if (pnext & 1) S1_LOAD_QK(inext); else if (pnext & 2) S1_LOAD_V(inext); }
            wg_sync();
            slab_transpose_out(KS, a.Vt + ((size_t)bh * 512 + ns * 64) * SP + 128 * c, wave, lane);
        }
        }
    }
#undef S1_LOAD_QK
#undef S1_LOAD_V
}

template <int DK, bool ML>
PHASE_FN void phase_s2(ChunkArgs a, LAS unsigned char* L, int bid, int nb, unsigned long long* prof = nullptr) {
    unsigned long long psec0 = 0, psec1 = 0, psec2 = 0, psec3 = 0, psec4 = 0, psec5 = 0, pt = 0;
#define PSTAMP(k) do { if (prof) { const unsigned long long n_ = clock64(); psec##k += n_ - pt; pt = n_; } } while (0)
    constexpr int DB = DK / 256;
    const int tid = tid_opq(), lane = tid & 63, wave = __builtin_amdgcn_readfirstlane(tid >> 6), wm = wave & 1, wn = wave >> 1;
    if (bid >= 256) return;
    const int xq = bid & 7, tt = bid >> 3, gI = xq + 8 * (tt >> 3), slice = tt & 7, bh = gI >> 1, dir = gI & 1, h = bh & 3, bl_ = bh >> 2, n0 = 64 * slice;
    LAS unsigned char* BUF = L;
    LAS unsigned char* VTS = L + 65536;
    LAS unsigned char* CST = L + 81920;
    LAS float* sc = (LAS float*)(L + 81920 + 65536);
    LAS float* rho = sc, *kap = sc + 128, *rsv = sc + 256, *emt = sc + 384, *qn = sc + 512, *nt = sc + 640, *wql = sc + 1152;
    LAS unsigned short* kapb = (LAS unsigned short*)(sc + 3200);
    for (int i = tid; i < (DK / 64) * 8192 / 16; i += NTHR) ((LAS u32x4*)CST)[i] = (u32x4){0u, 0u, 0u, 0u};
    if (ML) { for (int i = tid; i < 512; i += NTHR) nt[i] = 0.f; for (int i = tid; i < 2048; i += NTHR) wql[i] = a.wqkv[(size_t)(h * 128) * 16 + i]; }
    f32x4 Cacc[DB][2][4]; f32x4 nacc[DB][2];
#pragma unroll
    for (int db = 0; db < DB; ++db)
#pragma unroll
        for (int tm = 0; tm < 2; ++tm) { nacc[db][tm] = (f32x4){0.f, 0.f, 0.f, 0.f};
#pragma unroll
            for (int tn = 0; tn < 4; ++tn) Cacc[db][tm][tn] = (f32x4){0.f, 0.f, 0.f, 0.f}; }
    float lg = 0.f; if (!ML) lg = log2_gamma(a.decay[dir * 4 + h]);
    float m_run = 0.f;
    bf16_t* Od = dir ? a.Ob : a.Of;
    const bf16_t* Pd = a.P + (size_t)(dir * 16 + bh) * NCH * 16384;
    u32x4 RA[8], RB[8];
    const __amdgpu_buffer_rsrc_t rsQ = __builtin_amdgcn_make_buffer_rsrc((void*)a.qsrc, 0, 0x7fffffff, 0x00020000), rsP = __builtin_amdgcn_make_buffer_rsrc((void*)a.P, 0, 0x7fffffff, 0x00020000);
    const __amdgpu_buffer_rsrc_t rsV = __builtin_amdgcn_make_buffer_rsrc((void*)a.Vt, 0, 0x7fffffff, 0x00020000), rsK = __builtin_amdgcn_make_buffer_rsrc((void*)a.Kt, 0, 0x7fffffff, 0x00020000);
    const int tr = tid >> 3, tc = tid & 7;
    const int voQ = (tr * a.ldq + tc * 8) * 2, voP = (tr * 128 + tc * 8) * 2, voT = (tr * SP + tc * 8) * 2;
    const int lbase = SLABOFF(tr, tc);
#define S2_LOAD_Q(R, c_, kb_) do { const int sb_ = (int)((((size_t)bl_ * SP + 128 * (c_)) * a.ldq + h * DK + (kb_) * 256) * 2); _Pragma("unroll") for (int u = 0; u < 8; ++u) \
        R[u] = __builtin_amdgcn_raw_buffer_load_b128(rsQ, voQ, sb_ + (64 * (u & 1) * a.ldq + (u >> 1) * 64) * 2, 0); } while (0)
#define S2_STORE_Q(R) do { _Pragma("unroll") for (int u = 0; u < 8; ++u) *(LAS u32x4*)(BUF + (u >> 1) * 16384 + (u & 1) * 8192 + lbase) = R[u]; } while (0)
#define S2_LOAD_PV(R, c_) do { const int sp_ = (int)((((size_t)(dir * 16 + bh) * NCH + (c_)) * 16384) * 2), sv_ = (int)((((size_t)bh * 512 + n0) * SP + 128 * (c_)) * 2); \
        _Pragma("unroll") for (int u = 0; u < 4; ++u) R[u] = __builtin_amdgcn_raw_buffer_load_b128(rsP, voP, sp_ + ((u & 1) * 64 * 128 + (u >> 1) * 64) * 2, 0); \
        _Pragma("unroll") for (int u = 0; u < 2; ++u) R[4 + u] = __builtin_amdgcn_raw_buffer_load_b128(rsV, voT, sv_ + u * 128, 0); } while (0)
#define S2_STORE_PV(R) do { _Pragma("unroll") for (int u = 0; u < 4; ++u) *(LAS u32x4*)(BUF + (u >> 1) * 16384 + (u & 1) * 8192 + lbase) = R[u]; \
        _Pragma("unroll") for (int u = 0; u < 2; ++u) *(LAS u32x4*)(VTS + u * 8192 + lbase) = R[4 + u]; } while (0)
#define S2_LOAD_KT(R, c_, db_) do { const int sk_ = (int)((((size_t)bh * DK + (db_) * 256) * SP + 128 * (c_)) * 2); _Pragma("unroll") for (int u = 0; u < 8; ++u) \
        R[u] = __builtin_amdgcn_raw_buffer_load_b128(rsK, voT, sk_ + ((u & 3) * 64 * SP + (u >> 2) * 64) * 2, 0); } while (0)
#define S2_STORE_KT(R) do { _Pragma("unroll") for (int u = 0; u < 8; ++u) { u32x4 t_ = R[u]; \
        if (!ML) { float x[8]; unpack8(make_uint4(R[u].x, R[u].y, R[u].z, R[u].w), x); \
            _Pragma("unroll") for (int q = 0; q < 8; ++q) x[q] *= kap[(u >> 2) * 64 + tc * 8 + q]; const uint4 pk_ = pack8(x); t_.x = pk_.x; t_.y = pk_.y; t_.z = pk_.z; t_.w = pk_.w; } \
        *(LAS u32x4*)(BUF + (u >> 2) * 32768 + (u & 3) * 8192 + lbase) = t_; } } while (0)
#define S2_SCALE_VTS() do { _Pragma("unroll") for (int js = 0; js < 2; ++js) { LAS u32x4* p_ = (LAS u32x4*)(VTS + js * 8192 + lbase); const u32x4 r_ = *p_; float x[8]; unpack8(make_uint4(r_.x, r_.y, r_.z, r_.w), x); \
        _Pragma("unroll") for (int q = 0; q < 8; ++q) x[q] *= kap[js * 64 + tc * 8 + q]; const uint4 pk_ = pack8(x); u32x4 t_; t_.x = pk_.x; t_.y = pk_.y; t_.z = pk_.z; t_.w = pk_.w; *p_ = t_; } } while (0)
#define S2_MMA_Q(kb_) do { _Pragma("unroll") for (int ds = 0; ds < 4; ++ds) { mma_slab<2, 2>(acc, CST + ((kb_) * 4 + ds) * 8192, 32 * wm, BUF + ds * 16384, 32 * wn, lane); \
        if (ML) { const int i = tid >> 2, part = tid & 3; float x[8]; _Pragma("unroll") for (int cc = 0; cc < 2; ++cc) { unpack8(lds_ld16(BUF + ds * 16384, i, 2 * part + cc), x); \
            _Pragma("unroll") for (int e = 0; e < 8; ++e) qnp += x[e] * nt[(kb_) * 256 + ds * 64 + 16 * part + 8 * cc + e]; } } } } while (0)
#define S2_MMA_KT(db_) do { _Pragma("unroll") for (int js = 0; js < 2; ++js) _Pragma("unroll") for (int ks = 0; ks < 2; ++ks) { bf16x8 af[2], bfr[4]; bf16x8 kfr = ones; \
        if (ML) kfr = *(const LAS bf16x8*)(kapb + js * 64 + ks * 32 + 8 * (lane >> 4)); \
        _Pragma("unroll") for (int tm = 0; tm < 2; ++tm) af[tm] = lds_frag(BUF + js * 32768, 32 * wave + 16 * tm + (lane & 15), (lane >> 4) + 4 * ks); \
        _Pragma("unroll") for (int tn = 0; tn < 4; ++tn) bfr[tn] = lds_frag(VTS + js * 8192, 16 * tn + (lane & 15), (lane >> 4) + 4 * ks); \
        _Pragma("unroll") for (int tm = 0; tm < 2; ++tm) { _Pragma("unroll") for (int tn = 0; tn < 4; ++tn) Cacc[db_][tm][tn] = __builtin_amdgcn_mfma_f32_16x16x32_bf16(af[tm], bfr[tn], Cacc[db_][tm][tn], 0, 0, 0); \
            if (ML) nacc[db_][tm] = __builtin_amdgcn_mfma_f32_16x16x32_bf16(af[tm], kfr, nacc[db_][tm], 0, 0, 0); } } } while (0)
    bf16x8 ones;
#pragma unroll
    for (int e = 0; e < 8; ++e) ones[e] = (short)0x3F80;
    { const int c0 = dir ? ord_b(0) : 0; S2_LOAD_Q(RA, c0, 0); if (DB == 1) S2_LOAD_PV(RB, c0); }
#define S2_STEP_BODY(X, Y, step) { \
        if (prof) pt = clock64(); \
        const int c = dir ? ord_b(step) : step; \
        const int cn = (step + 1 < NCH) ? (dir ? ord_b(step + 1) : step + 1) : c;       \
        const size_t r0 = (size_t)bl_ * SP + 128 * c; \
        float delta; \
        wg_sync(); \
        S2_STORE_Q(X); \
        if (!ML) { delta = exp2f(128.f * lg); \
            if (tid < 128) { const int i = tid; rho[i] = dir ? exp2f((float)(128 - i) * lg) : exp2f((float)(i + 1) * lg); kap[i] = dir ? exp2f((float)i * lg) : exp2f((float)(127 - i) * lg); } \
        } else { \
            const float bl = a.cBL[(dir * 16 + bh) * NCH + c], pml = a.cPML[(dir * 16 + bh) * NCH + c]; const float mx = fmaxf(m_run, pml); \
            delta = __expf(m_run - mx); \
            if (tid < 128) { const int i = tid; const size_t gi = ((size_t)dir * 16 + bh) * SP + 128 * c + i; const float g = a.gG[gi], pm = a.gPM[gi], bb = a.gB[gi]; \
                const float Mi = fmaxf(m_run, pm); const float kp_ = __expf(g - mx); kap[i] = kp_; kapb[i] = (unsigned short)(pk2(kp_, 0.f) & 0xffffu); rho[i] = __expf(m_run - Mi); emt[i] = __expf(-(bb + Mi)); rsv[i] = a.RS[gi]; } \
            m_run = bl + mx; \
        } \
        if (DB == 2) S2_LOAD_Q(X, c, 1); else S2_LOAD_KT(X, c, 0); \
        wg_sync(); \
        PSTAMP(0); \
        f32x4 acc[2][2]; \
_Pragma("unroll") \
        for (int x = 0; x < 2; ++x) \
_Pragma("unroll") \
            for (int y = 0; y < 2; ++y) acc[x][y] = (f32x4){0.f, 0.f, 0.f, 0.f}; \
        float qnp = 0.f; \
        S2_MMA_Q(0); \
        if (DB == 2) {       \
            wg_sync(); \
            S2_STORE_Q(X); \
            S2_LOAD_PV(X, c); \
            wg_sync(); \
            S2_MMA_Q(1); \
        } \
        mfma_drain(); \
        if (ML) { qnp += __shfl_xor(qnp, 1); qnp += __shfl_xor(qnp, 2); if ((tid & 3) == 0) qn[tid >> 2] = qnp; } \
_Pragma("unroll") \
        for (int ti = 0; ti < 2; ++ti) { const float r = rho[32 * wn + 16 * ti + (lane & 15)]; \
_Pragma("unroll") \
            for (int tm = 0; tm < 2; ++tm) acc[tm][ti] *= r; } \
        PSTAMP(1); \
        wg_sync(); \
        PSTAMP(2); \
        if (DB == 2) { S2_STORE_PV(X); S2_LOAD_KT(X, c, 0); } else { S2_STORE_PV(Y); S2_LOAD_Q(Y, cn, 0); } \
        wg_sync(); \
_Pragma("unroll") \
        for (int js = 0; js < 2; ++js) mma_slab<2, 2>(acc, VTS + js * 8192, 32 * wm, BUF + js * 16384, 32 * wn, lane); \
        mfma_drain(); \
        {   \
            const int g_ = lane >> 4, ia = 32 * wn + (lane & 15), ib = ia + 16; float sa_ = 1.f, sb_ = 1.f; \
            if (ML) { const float da_ = rsv[ia] + rho[ia] * qn[ia], db_ = rsv[ib] + rho[ib] * qn[ib]; sa_ = 1.f / fmaxf(fabsf(da_), emt[ia]); sb_ = 1.f / fmaxf(fabsf(db_), emt[ib]); } \
            unsigned ax_[2], ay_[2], bx_[2], by_[2]; \
_Pragma("unroll") \
            for (int tm = 0; tm < 2; ++tm) { const f32x4 va = acc[tm][0] * sa_, vb = acc[tm][1] * sb_; \
                ax_[tm] = pk2(va[0], va[1]); ay_[tm] = pk2(va[2], va[3]); bx_[tm] = pk2(vb[0], vb[1]); by_[tm] = pk2(vb[2], vb[3]); } \
            mfma_drain(); \
            const int irow_ = (g_ & 1) ? ib : ia; \
_Pragma("unroll") \
            for (int tm = 0; tm < 2; ++tm) { \
                const auto sx_ = __builtin_amdgcn_permlane16_swap(ax_[tm], bx_[tm], false, false), sy_ = __builtin_amdgcn_permlane16_swap(ay_[tm], by_[tm], false, false); \
                u32x4 w; w.x = sx_[0]; w.y = sy_[0]; w.z = sx_[1]; w.w = sy_[1]; \
                *(u32x4*)(Od + (r0 + irow_) * 2048 + h * 512 + n0 + 32 * wm + 16 * tm + 4 * (g_ & ~1)) = w; } } \
_Pragma("unroll") \
        for (int db = 0; db < DB; ++db) \
_Pragma("unroll") \
            for (int tm = 0; tm < 2; ++tm) { nacc[db][tm] *= delta; \
_Pragma("unroll") \
                for (int tn = 0; tn < 4; ++tn) Cacc[db][tm][tn] *= delta; } \
        PSTAMP(3); \
        wg_sync(); \
        PSTAMP(4); \
        S2_STORE_KT(X); if (ML) S2_SCALE_VTS(); \
        if (DB == 2) S2_LOAD_KT(X, c, 1); else S2_LOAD_PV(X, cn); \
        wg_sync(); \
        S2_MMA_KT(0); \
        if (DB == 2) { \
            wg_sync(); \
            S2_STORE_KT(X); \
            S2_LOAD_Q(X, cn, 0); \
            wg_sync(); \
            S2_MMA_KT(DB - 1); \
        } \
        mfma_drain(); \
_Pragma("unroll") \
        for (int db = 0; db < DB; ++db) \
_Pragma("unroll") \
            for (int tm = 0; tm < 2; ++tm) { const int d0 = db * 256 + 32 * wave + 16 * tm + 4 * (lane >> 4); \
                float w16[16]; \
                (void)w16; \
_Pragma("unroll") \
                for (int tn = 0; tn < 4; ++tn) { f32x4 v = Cacc[db][tm][tn]; \
                    if (false) { f32x4 t; \
_Pragma("unroll") \
                        for (int e = 0; e < 4; ++e) t[e] = w16[e * 4 + 0] * v[0] + w16[e * 4 + 1] * v[1] + w16[e * 4 + 2] * v[2] + w16[e * 4 + 3] * v[3]; \
                        v = t; } \
                    u32x2 w; w.x = pk2(v[0], v[1]); w.y = pk2(v[2], v[3]); \
                    const int n = 16 * tn + (lane & 15); \
                    *(LAS u32x2*)(CST + (d0 >> 6) * 8192 + SLABOFF(n, (d0 & 63) >> 3) + (d0 & 7) * 2) = w; } \
                if (ML && (lane & 15) == 0) { const f32x4 v = nacc[db][tm]; \
_Pragma("unroll") \
                    for (int e = 0; e < 4; ++e) nt[d0 + e] = v[e];     } } \
        PSTAMP(5); \
    }
    if constexpr (DB == 1) { for (int step2 = 0; step2 < NCH; step2 += 2) { S2_STEP_BODY(RA, RB, step2) S2_STEP_BODY(RB, RA, (step2 + 1)) } }
    else { for (int step1 = 0; step1 < NCH; ++step1) { S2_STEP_BODY(RA, RA, step1) } }
#undef S2_STEP_BODY
    if (prof && bid == 0 && tid == 0) { prof[0] = psec0; prof[1] = psec1; prof[2] = psec2; prof[3] = psec3; prof[4] = psec4; prof[5] = psec5; }
#undef PSTAMP
#undef S2_LOAD_Q
#undef S2_STORE_Q
#undef S2_LOAD_PV
#undef S2_STORE_PV
#undef S2_LOAD_KT
#undef S2_STORE_KT
#undef S2_SCALE_VTS
#undef S2_MMA_Q
#undef S2_MMA_KT
}

PHASE_FN void phase_s2r(ChunkArgs a, LAS unsigned char* L, int bid, int nb) {
    constexpr int DK = 256;
    const int tid = tid_opq(), lane = tid & 63, wave = __builtin_amdgcn_readfirstlane(tid >> 6), wm = wave & 1, wn = wave >> 1;
    if (bid >= 256) return;
    const int xq = bid & 7, tt = bid >> 3, gI = xq + 8 * (tt >> 3), slice = tt & 7, bh = gI >> 1, dir = gI & 1, h = bh & 3, bl_ = bh >> 2, n0 = 64 * slice;
    LAS unsigned char* CST = L;
    LAS unsigned char* VTS = L + 32768;
    LAS unsigned char* VT2 = L + 49152;
    LAS float* rho = (LAS float*)(L + 65536); LAS float* kap = rho + 128;
    for (int i = tid; i < 4 * 8192 / 16; i += NTHR) ((LAS u32x4*)CST)[i] = (u32x4){0u, 0u, 0u, 0u};
    const float lg = log2_gamma(a.decay[dir * 4 + h]); const float delta = exp2f(128.f * lg);
    if (tid < 128) { const int i = tid; rho[i] = dir ? exp2f((float)(128 - i) * lg) : exp2f((float)(i + 1) * lg); kap[i] = dir ? exp2f((float)i * lg) : exp2f((float)(127 - i) * lg); }
    f32x4 Cacc[2][4];
#pragma unroll
    for (int tm = 0; tm < 2; ++tm)
#pragma unroll
        for (int tn = 0; tn < 4; ++tn) Cacc[tm][tn] = (f32x4){0.f, 0.f, 0.f, 0.f};
    bf16_t* Od = dir ? a.Ob : a.Of;
    const __amdgpu_buffer_rsrc_t rsQ = __builtin_amdgcn_make_buffer_rsrc((void*)a.qsrc, 0, 0x7fffffff, 0x00020000), rsP = __builtin_amdgcn_make_buffer_rsrc((void*)a.P, 0, 0x7fffffff, 0x00020000);
    const __amdgpu_buffer_rsrc_t rsV = __builtin_amdgcn_make_buffer_rsrc((void*)a.Vt, 0, 0x7fffffff, 0x00020000), rsK = __builtin_amdgcn_make_buffer_rsrc((void*)a.Kt, 0, 0x7fffffff, 0x00020000);
    const int fr = lane & 15, fq = lane >> 4, tr = tid >> 3, tc = tid & 7;
    const int voQ = ((32 * wn + fr) * 1024 + 8 * fq) * 2, voP = ((32 * wn + fr) * 128 + 8 * fq) * 2, voK = ((32 * wave + fr) * SP + 8 * fq) * 2, voT = (tr * SP + tc * 8) * 2;
    const int lbase = SLABOFF(tr, tc);
    u32x4 QF[2][8], PF[2][4], KF[2][4], VR[2];
#define S2R_LOAD_Q(c_) do { const int sb_ = (int)((((size_t)bl_ * SP + 128 * (c_)) * 1024 + h * DK) * 2); _Pragma("unroll") for (int ti = 0; ti < 2; ++ti) _Pragma("unroll") for (int ks = 0; ks < 8; ++ks) \
        QF[ti][ks] = __builtin_amdgcn_raw_buffer_load_b128(rsQ, voQ, sb_ + (16 * ti * 1024 + 32 * ks) * 2, 0); } while (0)
#define S2R_LOAD_P(c_) do { const int sp_ = (int)((((size_t)(dir * 16 + bh) * NCH + (c_)) * 16384) * 2); _Pragma("unroll") for (int ti = 0; ti < 2; ++ti) _Pragma("unroll") for (int ks = 0; ks < 4; ++ks) \
        PF[ti][ks] = __builtin_amdgcn_raw_buffer_load_b128(rsP, voP, sp_ + (16 * ti * 128 + 32 * ks) * 2, 0); } while (0)
#define S2R_LOAD_K(c_) do { const int sk_ = (int)((((size_t)bh * DK) * SP + 128 * (c_)) * 2); _Pragma("unroll") for (int tm = 0; tm < 2; ++tm) _Pragma("unroll") for (int ks = 0; ks < 4; ++ks) \
        KF[tm][ks] = __builtin_amdgcn_raw_buffer_load_b128(rsK, voK, sk_ + (16 * tm * SP + 32 * ks) * 2, 0); } while (0)
#define S2R_LOAD_V(c_) do { const int sv_ = (int)((((size_t)bh * 512 + n0) * SP + 128 * (c_)) * 2); _Pragma("unroll") for (int u = 0; u < 2; ++u) VR[u] = __builtin_amdgcn_raw_buffer_load_b128(rsV, voT, sv_ + u * 128, 0); } while (0)
    { const int c0 = dir ? ord_b(0) : 0; S2R_LOAD_V(c0); S2R_LOAD_Q(c0); S2R_LOAD_P(c0); S2R_LOAD_K(c0); }
    for (int step = 0; step < NCH; ++step) {
        const int c = dir ? ord_b(step) : step;
        const int cn = (step + 1 < NCH) ? (dir ? ord_b(step + 1) : step + 1) : c;
        const size_t r0 = (size_t)bl_ * SP + 128 * c;
        wg_sync();
#pragma unroll
        for (int u = 0; u < 2; ++u) { *(LAS u32x4*)(VTS + u * 8192 + lbase) = VR[u]; float x[8]; unpack8(make_uint4(VR[u].x, VR[u].y, VR[u].z, VR[u].w), x);
#pragma unroll
            for (int q = 0; q < 8; ++q) x[q] *= kap[u * 64 + tc * 8 + q];
            const uint4 pk_ = pack8(x); u32x4 t_; t_.x = pk_.x; t_.y = pk_.y; t_.z = pk_.z; t_.w = pk_.w; *(LAS u32x4*)(VT2 + u * 8192 + lbase) = t_; }
        S2R_LOAD_V(cn);
        wg_sync();
        f32x4 acc[2][2];
#pragma unroll
        for (int x = 0; x < 2; ++x)
#pragma unroll
            for (int y = 0; y < 2; ++y) acc[x][y] = (f32x4){0.f, 0.f, 0.f, 0.f};
#pragma unroll
        for (int ks = 0; ks < 8; ++ks) { bf16x8 af[2];
#pragma unroll
            for (int tm = 0; tm < 2; ++tm) af[tm] = lds_frag(CST + (ks >> 1) * 8192, 32 * wm + 16 * tm + fr, fq + 4 * (ks & 1));
#pragma unroll
            for (int tm = 0; tm < 2; ++tm)
#pragma unroll
                for (int ti = 0; ti < 2; ++ti) acc[tm][ti] = __builtin_amdgcn_mfma_f32_16x16x32_bf16(af[tm], *(const bf16x8*)&QF[ti][ks], acc[tm][ti], 0, 0, 0); }
        S2R_LOAD_Q(cn);
        mfma_drain();
#pragma unroll
        for (int ti = 0; ti < 2; ++ti) { const float r = rho[32 * wn + 16 * ti + fr];
#pragma unroll
            for (int tm = 0; tm < 2; ++tm) acc[tm][ti] *= r; }
#pragma unroll
        for (int ks = 0; ks < 4; ++ks) { bf16x8 af[2];
#pragma unroll
            for (int tm = 0; tm < 2; ++tm) af[tm] = lds_frag(VTS + (ks >> 1) * 8192, 32 * wm + 16 * tm + fr, fq + 4 * (ks & 1));
#pragma unroll
            for (int tm = 0; tm < 2; ++tm)
#pragma unroll
                for (int ti = 0; ti < 2; ++ti) acc[tm][ti] = __builtin_amdgcn_mfma_f32_16x16x32_bf16(af[tm], *(const bf16x8*)&PF[ti][ks], acc[tm][ti], 0, 0, 0); }
        S2R_LOAD_P(cn);
        mfma_drain();
#pragma unroll
        for (int ti = 0; ti < 2; ++ti) { const int i = 32 * wn + 16 * ti + fr;
#pragma unroll
            for (int tm = 0; tm < 2; ++tm) { const f32x4 v = acc[tm][ti]; u32x2 w; w.x = pk2(v[0], v[1]); w.y = pk2(v[2], v[3]);
                *(u32x2*)(Od + (r0 + i) * 2048 + h * 512 + n0 + 32 * wm + 16 * tm + 4 * fq) = w; } }
#pragma unroll
        for (int tm = 0; tm < 2; ++tm)
#pragma unroll
            for (int tn = 0; tn < 4; ++tn) Cacc[tm][tn] *= delta;
#pragma unroll
        for (int ks = 0; ks < 4; ++ks) { bf16x8 bfr[4];
#pragma unroll
            for (int tn = 0; tn < 4; ++tn) bfr[tn] = lds_frag(VT2 + (ks >> 1) * 8192, 16 * tn + fr, fq + 4 * (ks & 1));
#pragma unroll
            for (int tm = 0; tm < 2; ++tm)
#pragma unroll
                for (int tn = 0; tn < 4; ++tn) Cacc[tm][tn] = __builtin_amdgcn_mfma_f32_16x16x32_bf16(*(const bf16x8*)&KF[tm][ks], bfr[tn], Cacc[tm][tn], 0, 0, 0); }
        S2R_LOAD_K(cn);
        wg_sync();
        mfma_drain();
#pragma unroll
        for (int tm = 0; tm < 2; ++tm) { const int d0 = 32 * wave + 16 * tm + 4 * fq;
#pragma unroll
            for (int tn = 0; tn < 4; ++tn) { const f32x4 v = Cacc[tm][tn]; u32x2 w; w.x = pk2(v[0], v[1]); w.y = pk2(v[2], v[3]); const int n = 16 * tn + fr;
                *(LAS u32x2*)(CST + (d0 >> 6) * 8192 + SLABOFF(n, (d0 & 63) >> 3) + (d0 & 7) * 2) = w; } }
    }
#undef S2R_LOAD_Q
#undef S2R_LOAD_P
#undef S2R_LOAD_K
#undef S2R_LOAD_V
}

PHASE_FN void phase_s2p(ChunkArgs a, LAS unsigned char* L, int bid, int nb) {
    constexpr int DK = 256;
    const int tid = tid_opq(), lane = tid & 63, wave = __builtin_amdgcn_readfirstlane(tid >> 6), wm = wave & 1, wn = wave >> 1;
    if (bid >= 256) return;
    const int xq = bid & 7, tt = bid >> 3, gI = xq + 8 * (tt >> 3), slice = tt & 7, bh = gI >> 1, dir = gI & 1, h = bh & 3, bl_ = bh >> 2, n0 = 64 * slice;
    LAS unsigned char* BUFA = L; LAS unsigned char* BUFB = L + 32768;
    LAS unsigned char* VTS = L + 65536;
    LAS unsigned char* CST = L + 81920;
    LAS float* rho = (LAS float*)(L + 114688); LAS float* kap = rho + 128;
    for (int i = tid; i < 4 * 8192 / 16; i += NTHR) ((LAS u32x4*)CST)[i] = (u32x4){0u, 0u, 0u, 0u};
    const float lg = log2_gamma(a.decay[dir * 4 + h]); const float delta = exp2f(128.f * lg);
    if (tid < 128) { const int i = tid; rho[i] = dir ? exp2f((float)(128 - i) * lg) : exp2f((float)(i + 1) * lg); kap[i] = dir ? exp2f((float)i * lg) : exp2f((float)(127 - i) * lg); }
    f32x4 Cacc[2][4];
#pragma unroll
    for (int tm = 0; tm < 2; ++tm)
#pragma unroll
        for (int tn = 0; tn < 4; ++tn) Cacc[tm][tn] = (f32x4){0.f, 0.f, 0.f, 0.f};
    bf16_t* Od = dir ? a.Ob : a.Of;
    const __amdgpu_buffer_rsrc_t rsQ = __builtin_amdgcn_make_buffer_rsrc((void*)a.qsrc, 0, 0x7fffffff, 0x00020000), rsP = __builtin_amdgcn_make_buffer_rsrc((void*)a.P, 0, 0x7fffffff, 0x00020000);
    const __amdgpu_buffer_rsrc_t rsV = __builtin_amdgcn_make_buffer_rsrc((void*)a.Vt, 0, 0x7fffffff, 0x00020000), rsK = __builtin_amdgcn_make_buffer_rsrc((void*)a.Kt, 0, 0x7fffffff, 0x00020000);
    const int tr = tid >> 3, tc = tid & 7;
    const int voQ = (tr * 1024 + tc * 8) * 2, voP = (tr * 128 + tc * 8) * 2, voT = (tr * SP + tc * 8) * 2;
    const int lbase = SLABOFF(tr, tc);
    u32x4 RQa[4], RQb[4], RP[6], RK0[4], RK1[4];
#define P_LOAD_Q(R, c_, kbh_) do { const int sb_ = (int)((((size_t)bl_ * SP + 128 * (c_)) * 1024 + h * DK + (kbh_) * 128) * 2); _Pragma("unroll") for (int u = 0; u < 4; ++u) \
        R[u] = __builtin_amdgcn_raw_buffer_load_b128(rsQ, voQ, sb_ + (64 * (u & 1) * 1024 + (u >> 1) * 64) * 2, 0); } while (0)
#define P_LOAD_PV(R, c_) do { const int sp_ = (int)((((size_t)(dir * 16 + bh) * NCH + (c_)) * 16384) * 2), sv_ = (int)((((size_t)bh * 512 + n0) * SP + 128 * (c_)) * 2); \
        _Pragma("unroll") for (int u = 0; u < 4; ++u) R[u] = __builtin_amdgcn_raw_buffer_load_b128(rsP, voP, sp_ + ((u & 1) * 64 * 128 + (u >> 1) * 64) * 2, 0); \
        _Pragma("unroll") for (int u = 0; u < 2; ++u) R[4 + u] = __builtin_amdgcn_raw_buffer_load_b128(rsV, voT, sv_ + u * 128, 0); } while (0)
#define P_LOAD_KT(R, c_, js_) do { const int sk_ = (int)((((size_t)bh * DK) * SP + 128 * (c_) + (js_) * 64) * 2); _Pragma("unroll") for (int u = 0; u < 4; ++u) \
        R[u] = __builtin_amdgcn_raw_buffer_load_b128(rsK, voT, sk_ + (u * 64 * SP) * 2, 0); } while (0)
#define P_STORE_QP(R, BUF) do { _Pragma("unroll") for (int u = 0; u < 4; ++u) *(LAS u32x4*)((BUF) + (u >> 1) * 16384 + (u & 1) * 8192 + lbase) = R[u]; } while (0)
#define P_STORE_V(R) do { _Pragma("unroll") for (int u = 0; u < 2; ++u) *(LAS u32x4*)(VTS + u * 8192 + lbase) = R[4 + u]; } while (0)
#define P_STORE_KT(R, BUF, js_) do { _Pragma("unroll") for (int u = 0; u < 4; ++u) { float x[8]; unpack8(make_uint4(R[u].x, R[u].y, R[u].z, R[u].w), x); \
        _Pragma("unroll") for (int q = 0; q < 8; ++q) x[q] *= kap[(js_) * 64 + tc * 8 + q]; const uint4 pk_ = pack8(x); u32x4 t_; t_.x = pk_.x; t_.y = pk_.y; t_.z = pk_.z; t_.w = pk_.w; \
        *(LAS u32x4*)((BUF) + u * 8192 + lbase) = t_; } } while (0)
#define P_MMA_Q(BUF, kbh_) do { _Pragma("unroll") for (int sl = 0; sl < 2; ++sl) mma_slab<2, 2>(acc, CST + ((kbh_) * 2 + sl) * 8192, 32 * wm, (BUF) + sl * 16384, 32 * wn, lane); } while (0)
#define P_MMA_P(BUF) do { _Pragma("unroll") for (int js = 0; js < 2; ++js) mma_slab<2, 2>(acc, VTS + js * 8192, 32 * wm, (BUF) + js * 16384, 32 * wn, lane); } while (0)
#define P_MMA_KT(BUF, js_) do { _Pragma("unroll") for (int ks = 0; ks < 2; ++ks) { bf16x8 af[2], bfr[4]; \
        _Pragma("unroll") for (int tm = 0; tm < 2; ++tm) af[tm] = lds_frag((BUF), 32 * wave + 16 * tm + (lane & 15), (lane >> 4) + 4 * ks); \
        _Pragma("unroll") for (int tn = 0; tn < 4; ++tn) bfr[tn] = lds_frag(VTS + (js_) * 8192, 16 * tn + (lane & 15), (lane >> 4) + 4 * ks); \
        _Pragma("unroll") for (int tm = 0; tm < 2; ++tm) _Pragma("unroll") for (int tn = 0; tn < 4; ++tn) Cacc[tm][tn] = __builtin_amdgcn_mfma_f32_16x16x32_bf16(af[tm], bfr[tn], Cacc[tm][tn], 0, 0, 0); } } while (0)
#define P_STEP(BX, BY, step) { \
        const int c = dir ? ord_b(step) : step; \
        const int cn = (step + 1 < NCH) ? (dir ? ord_b(step + 1) : step + 1) : c; \
        const int cnn = (step + 2 < NCH) ? (dir ? ord_b(step + 2) : step + 2) : cn; \
        const size_t r0 = (size_t)bl_ * SP + 128 * c; \
        f32x4 acc[2][2]; \
        _Pragma("unroll") for (int x = 0; x < 2; ++x) _Pragma("unroll") for (int y = 0; y < 2; ++y) acc[x][y] = (f32x4){0.f, 0.f, 0.f, 0.f}; \
        wg_sync(); P_STORE_QP(RQb, BY); P_LOAD_Q(RQb, cn, 1); P_MMA_Q(BX, 0); \
        wg_sync(); P_STORE_QP(RP, BX); P_STORE_V(RP); P_LOAD_PV(RP, cn); P_MMA_Q(BY, 1); \
        mfma_drain(); \
        _Pragma("unroll") for (int ti = 0; ti < 2; ++ti) { const float r = rho[32 * wn + 16 * ti + (lane & 15)]; _Pragma("unroll") for (int tm = 0; tm < 2; ++tm) acc[tm][ti] *= r; } \
        wg_sync(); P_STORE_KT(RK0, BY, 0); P_LOAD_KT(RK0, cn, 0); P_MMA_P(BX); \
        mfma_drain(); \
        _Pragma("unroll") for (int ti = 0; ti < 2; ++ti) { const int i = 32 * wn + 16 * ti + (lane & 15); \
            _Pragma("unroll") for (int tm = 0; tm < 2; ++tm) { const f32x4 v = acc[tm][ti]; u32x2 w; w.x = pk2(v[0], v[1]); w.y = pk2(v[2], v[3]); \
                *(u32x2*)(Od + (r0 + i) * 2048 + h * 512 + n0 + 32 * wm + 16 * tm + 4 * (lane >> 4)) = w; } } \
        _Pragma("unroll") for (int tm = 0; tm < 2; ++tm) _Pragma("unroll") for (int tn = 0; tn < 4; ++tn) Cacc[tm][tn] *= delta; \
        wg_sync(); P_STORE_KT(RK1, BX, 1); P_LOAD_KT(RK1, cn, 1); P_MMA_KT(BY, 0); \
        wg_sync(); P_STORE_QP(RQa, BY); P_LOAD_Q(RQa, cnn, 0); P_MMA_KT(BX, 1); \
        mfma_drain(); \
        _Pragma("unroll") for (int tm = 0; tm < 2; ++tm) { const int d0 = 32 * wave + 16 * tm + 4 * (lane >> 4); \
            _Pragma("unroll") for (int tn = 0; tn < 4; ++tn) { const f32x4 v = Cacc[tm][tn]; u32x2 w; w.x = pk2(v[0], v[1]); w.y = pk2(v[2], v[3]); const int n = 16 * tn + (lane & 15); \
                *(LAS u32x2*)(CST + (d0 >> 6) * 8192 + SLABOFF(n, (d0 & 63) >> 3) + (d0 & 7) * 2) = w; } } \
    }
    { const int c0 = dir ? ord_b(0) : 0, c1 = dir ? ord_b(1) : 1; P_LOAD_Q(RQa, c0, 0); P_LOAD_Q(RQb, c0, 1); P_LOAD_PV(RP, c0); P_LOAD_KT(RK0, c0, 0); P_LOAD_KT(RK1, c0, 1); wg_sync(); P_STORE_QP(RQa, BUFA); P_LOAD_Q(RQa, c1, 0); }
    for (int step2 = 0; step2 < NCH; step2 += 2) { P_STEP(BUFA, BUFB, step2) P_STEP(BUFB, BUFA, (step2 + 1)) }
#undef P_STEP
#undef P_LOAD_Q
#undef P_LOAD_PV
#undef P_LOAD_KT
#undef P_STORE_QP
#undef P_STORE_V
#undef P_STORE_KT
#undef P_MMA_Q
#undef P_MMA_P
#undef P_MMA_KT
}

PHASE_FN void phase_s2w(ChunkArgs a, LAS unsigned char* L, int bid, int nb) {
    constexpr int DK = 256;
    const int tid = tid_opq(), lane = tid & 63, wave = __builtin_amdgcn_readfirstlane(tid >> 6), wm = wave & 3, wn = wave >> 2;
    if (bid >= 128) return;
    const int xq = bid & 7, tt = bid >> 3, gI = xq + 8 * (tt >> 2), slice = tt & 3, bh = gI >> 1, dir = gI & 1, h = bh & 3, bl_ = bh >> 2, n0 = 128 * slice;
    LAS unsigned char* BUF = L;
    LAS unsigned char* VTS = L + 32768;
    LAS unsigned char* CST = L + 65536;
    LAS float* rho = (LAS float*)(L + 131072); LAS float* kap = rho + 128;
    for (int i = tid; i < 4 * 16384 / 16; i += NTHR) ((LAS u32x4*)CST)[i] = (u32x4){0u, 0u, 0u, 0u};
    const float lg = log2_gamma(a.decay[dir * 4 + h]); const float delta = exp2f(128.f * lg);
    if (tid < 128) { const int i = tid; rho[i] = dir ? exp2f(-(float)i * lg) : exp2f((float)(i - 127) * lg); kap[i] = dir ? exp2f((float)i * lg) : exp2f((float)(127 - i) * lg); }
    f32x4 Cacc[2][8];
#pragma unroll
    for (int tm = 0; tm < 2; ++tm)
#pragma unroll
        for (int tn = 0; tn < 8; ++tn) Cacc[tm][tn] = (f32x4){0.f, 0.f, 0.f, 0.f};
    bf16_t* Od = dir ? a.Ob : a.Of;
    const __amdgpu_buffer_rsrc_t rsQ = __builtin_amdgcn_make_buffer_rsrc((void*)a.qsrc, 0, 0x7fffffff, 0x00020000), rsP = __builtin_amdgcn_make_buffer_rsrc((void*)a.P, 0, 0x7fffffff, 0x00020000);
    const __amdgpu_buffer_rsrc_t rsV = __builtin_amdgcn_make_buffer_rsrc((void*)a.Vt, 0, 0x7fffffff, 0x00020000), rsK = __builtin_amdgcn_make_buffer_rsrc((void*)a.Kt, 0, 0x7fffffff, 0x00020000);
    const int tr = tid >> 3, tc = tid & 7;
    const int voQ = (tr * 1024 + tc * 8) * 2, voP = (tr * 128 + tc * 8) * 2, voT = (tr * SP + tc * 8) * 2;
    const int lbase = SLABOFF(tr, tc);
    u32x4 RA[4], RB[4], RC[4];
#define W_LOAD_Q(R, c_, kbh_) do { const int sb_ = (int)((((size_t)bl_ * SP + 128 * (c_)) * 1024 + h * DK + (kbh_) * 128) * 2); _Pragma("unroll") for (int u = 0; u < 4; ++u) \
        R[u] = __builtin_amdgcn_raw_buffer_load_b128(rsQ, voQ, sb_ + (64 * (u & 1) * 1024 + (u >> 1) * 64) * 2, 0); } while (0)
#define W_LOAD_P(R, c_) do { const int sp_ = (int)((((size_t)(dir * 16 + bh) * NCH + (c_)) * 16384) * 2); \
        _Pragma("unroll") for (int u = 0; u < 4; ++u) R[u] = __builtin_amdgcn_raw_buffer_load_b128(rsP, voP, sp_ + ((u & 1) * 64 * 128 + (u >> 1) * 64) * 2, 0); } while (0)
#define W_LOAD_V(R, c_) do { const int sv_ = (int)((((size_t)bh * 512 + n0) * SP + 128 * (c_)) * 2); \
        _Pragma("unroll") for (int u = 0; u < 4; ++u) R[u] = __builtin_amdgcn_raw_buffer_load_b128(rsV, voT, sv_ + ((u & 1) * 64 * SP + (u >> 1) * 64) * 2, 0); } while (0)
#define W_LOAD_KT(R, c_, js_) do { const int sk_ = (int)((((size_t)bh * DK) * SP + 128 * (c_) + (js_) * 64) * 2); _Pragma("unroll") for (int u = 0; u < 4; ++u) \
        R[u] = __builtin_amdgcn_raw_buffer_load_b128(rsK, voT, sk_ + (u * 64 * SP) * 2, 0); } while (0)
#define W_STORE_2S(R, DST) do { _Pragma("unroll") for (int u = 0; u < 4; ++u) *(LAS u32x4*)((DST) + (u >> 1) * 16384 + (u & 1) * 8192 + lbase) = R[u]; } while (0)
#define W_STORE_KT(R, js_) do { _Pragma("unroll") for (int u = 0; u < 4; ++u) *(LAS u32x4*)(BUF + u * 8192 + lbase) = R[u]; } while (0)
#define W_STORE_VS(R) do { _Pragma("unroll") for (int u = 0; u < 4; ++u) { float x[8]; unpack8(make_uint4(R[u].x, R[u].y, R[u].z, R[u].w), x); \
        _Pragma("unroll") for (int q = 0; q < 8; ++q) x[q] *= kap[(u >> 1) * 64 + tc * 8 + q]; const uint4 pk_ = pack8(x); u32x4 t_; t_.x = pk_.x; t_.y = pk_.y; t_.z = pk_.z; t_.w = pk_.w; \
        *(LAS u32x4*)(VTS + (u >> 1) * 16384 + (u & 1) * 8192 + lbase) = t_; } } while (0)
#define W_MMA_Q(kbh_) do { _Pragma("unroll") for (int sl = 0; sl < 2; ++sl) mma_slab<2, 4>(acc, CST + ((kbh_) * 2 + sl) * 16384, 32 * wm, BUF + sl * 16384, 64 * wn, lane); } while (0)
#define W_MMA_P() do { _Pragma("unroll") for (int js = 0; js < 2; ++js) mma_slab<2, 4>(acc, VTS + js * 16384, 32 * wm, BUF + js * 16384, 64 * wn, lane); } while (0)
#define W_MMA_KT(js_) do { _Pragma("unroll") for (int ks = 0; ks < 2; ++ks) { bf16x8 af[2]; \
        _Pragma("unroll") for (int tm = 0; tm < 2; ++tm) af[tm] = lds_frag(BUF, 32 * wave + 16 * tm + (lane & 15), (lane >> 4) + 4 * ks); \
        _Pragma("unroll") for (int tn = 0; tn < 8; ++tn) { const bf16x8 bfr = lds_frag(VTS + (js_) * 16384, 16 * tn + (lane & 15), (lane >> 4) + 4 * ks); \
            _Pragma("unroll") for (int tm = 0; tm < 2; ++tm) Cacc[tm][tn] = __builtin_amdgcn_mfma_f32_16x16x32_bf16(af[tm], bfr, Cacc[tm][tn], 0, 0, 0); } } } while (0)
    { const int c0 = dir ? ord_b(0) : 0; W_LOAD_Q(RA, c0, 0); W_LOAD_Q(RB, c0, 1); W_LOAD_P(RC, c0); }
    for (int step = 0; step < NCH; ++step) {
        const int c = dir ? ord_b(step) : step;
        const int cn = (step + 1 < NCH) ? (dir ? ord_b(step + 1) : step + 1) : c;
        const size_t r0 = (size_t)bl_ * SP + 128 * c;
        f32x4 acc[2][4];
#pragma unroll
        for (int x = 0; x < 2; ++x)
#pragma unroll
            for (int y = 0; y < 4; ++y) acc[x][y] = (f32x4){0.f, 0.f, 0.f, 0.f};
        wg_sync(); W_STORE_2S(RA, BUF); W_LOAD_V(RA, c); wg_sync(); W_MMA_Q(0);
        wg_sync(); W_STORE_2S(RB, BUF); W_LOAD_KT(RB, c, 0); wg_sync(); W_MMA_Q(1);
        mfma_drain();
#pragma unroll
        for (int ti = 0; ti < 4; ++ti) {
#pragma unroll
            for (int tm = 0; tm < 2; ++tm) acc[tm][ti] *= delta; }
        wg_sync(); W_STORE_2S(RC, BUF); W_STORE_VS(RA); W_LOAD_KT(RC, c, 1); W_LOAD_Q(RA, cn, 0); wg_sync(); W_MMA_P();
        mfma_drain();
#pragma unroll
        for (int tp = 0; tp < 2; ++tp) { const int g = lane >> 4; const int ia = 64 * wn + 32 * tp + (lane & 15), ib = ia + 16; const float rsa = rho[ia], rsb = rho[ib]; const int irow = (g & 1) ? ib : ia;
            unsigned ax[2], ay[2], bx[2], by[2];
#pragma unroll
            for (int tm = 0; tm < 2; ++tm) { const f32x4 va = acc[tm][2 * tp] * rsa, vb = acc[tm][2 * tp + 1] * rsb;
                ax[tm] = pk2(va[0], va[1]); ay[tm] = pk2(va[2], va[3]); bx[tm] = pk2(vb[0], vb[1]); by[tm] = pk2(vb[2], vb[3]); }
            mfma_drain();
#pragma unroll
            for (int tm = 0; tm < 2; ++tm) {
                const auto sx = __builtin_amdgcn_permlane16_swap(ax[tm], bx[tm], false, false), sy = __builtin_amdgcn_permlane16_swap(ay[tm], by[tm], false, false);
                u32x4 w; w.x = sx[0]; w.y = sy[0]; w.z = sx[1]; w.w = sy[1];
                *(u32x4*)(Od + (r0 + irow) * 2048 + h * 512 + n0 + 32 * wm + 16 * tm + 4 * (g & ~1)) = w; } }
#pragma unroll
        for (int tm = 0; tm < 2; ++tm)
#pragma unroll
            for (int tn = 0; tn < 8; ++tn) Cacc[tm][tn] *= delta;
        wg_sync(); W_STORE_KT(RB, 0); W_LOAD_Q(RB, cn, 1); wg_sync(); W_MMA_KT(0);
        wg_sync(); W_STORE_KT(RC, 1); W_LOAD_P(RC, cn); wg_sync(); W_MMA_KT(1);
        mfma_drain();
#pragma unroll
        for (int tm = 0; tm < 2; ++tm) { const int d0 = 32 * wave + 16 * tm + 4 * (lane >> 4);
#pragma unroll
            for (int tn = 0; tn < 8; ++tn) { const f32x4 v = Cacc[tm][tn]; u32x2 w; w.x = pk2(v[0], v[1]); w.y = pk2(v[2], v[3]); const int n = 16 * tn + (lane & 15);
                *(LAS u32x2*)(CST + (d0 >> 6) * 16384 + SLABOFF(n, (d0 & 63) >> 3) + (d0 & 7) * 2) = w; } }
    }
#undef W_LOAD_Q
#undef W_LOAD_P
#undef W_LOAD_V
#undef W_LOAD_KT
#undef W_STORE_2S
#undef W_STORE_KT
#undef W_STORE_VS
#undef W_MMA_Q
#undef W_MMA_P
#undef W_MMA_KT
}

PHASE_FN void phase_fin_ret(const bf16_t* Of, const bf16_t* Ob, const bf16_t* G, bf16_t* Dst, int last, int bid, int nb) {
    const int tid = tid_opq(), lane = tid & 63, wv = tid >> 6;
    for (int r = bid * 8 + wv; r < NH; r += nb * 8) {
        if (last && (r % SP) < CTXL) continue;
        const size_t base = (size_t)r * 2048 + (lane >> 4) * 512 + (lane & 15) * 8;
        float o[32]; float ss = 0.f;
#pragma unroll
        for (int u = 0; u < 4; ++u) { float a[8], b[8]; unpack8(*(const uint4*)(Of + base + u * 128), a); unpack8(*(const uint4*)(Ob + base + u * 128), b);
#pragma unroll
            for (int e = 0; e < 8; ++e) { o[8 * u + e] = a[e] + b[e]; ss += o[8 * u + e] * o[8 * u + e]; } }
        ss = red16(ss);
        const float rn = rsqrtf(ss * (1.f / 512.f) + 1e-6f);
#pragma unroll
        for (int u = 0; u < 4; ++u) { float g[8], w[8]; unpack8(*(const uint4*)(G + base + u * 128), g);
#pragma unroll
            for (int e = 0; e < 8; ++e) w[e] = siluf(g[e]) * o[8 * u + e] * rn;
            *(uint4*)(Dst + base + u * 128) = pack8(w); }
    }
}
PHASE_FN void phase_fin_ml(const bf16_t* Of, const bf16_t* Ob, const bf16_t* XC, bf16_t* Z, const float* gng, const float* skip, int bid, int nb) {
    const int tid = tid_opq(), lane = tid & 63, wv = tid >> 6;
    const int cb = (lane >> 4) * 512 + (lane & 15) * 8;
    float4 gq[8], kq[8];
#pragma unroll
    for (int u = 0; u < 4; ++u) { gq[2 * u] = *(const float4*)(gng + cb + u * 128); gq[2 * u + 1] = *(const float4*)(gng + cb + u * 128 + 4); kq[2 * u] = *(const float4*)(skip + cb + u * 128); kq[2 * u + 1] = *(const float4*)(skip + cb + u * 128 + 4); }
    for (int r = bid * 8 + wv; r < NH; r += nb * 8) {
        const size_t base = (size_t)r * 2048 + cb;
        float o[32]; float s1 = 0.f;
#pragma unroll
        for (int u = 0; u < 4; ++u) { float a[8], b[8]; unpack8(*(const uint4*)(Of + base + u * 128), a); unpack8(*(const uint4*)(Ob + base + u * 128), b);
#pragma unroll
            for (int e = 0; e < 8; ++e) { o[8 * u + e] = a[e] + b[e]; s1 += o[8 * u + e]; } }
#pragma unroll
        for (int m = 8; m >= 1; m >>= 1) s1 += __shfl_xor(s1, m);
        const float mu = s1 * (1.f / 512.f); float s2 = 0.f;
#pragma unroll
        for (int e = 0; e < 32; ++e) { const float d = o[e] - mu; s2 += d * d; }
#pragma unroll
        for (int m = 8; m >= 1; m >>= 1) s2 += __shfl_xor(s2, m);
        const float rn = rsqrtf(s2 * (1.f / 512.f) + LN_EPS);
#pragma unroll
        for (int u = 0; u < 4; ++u) { float z[8], xc[8], w[8]; unpack8(*(const uint4*)(Z + base + u * 128), z); unpack8(*(const uint4*)(XC + base + u * 128), xc);
            const float4 g0 = gq[2 * u], g1 = gq[2 * u + 1], k0 = kq[2 * u], k1 = kq[2 * u + 1];
            const float gg[8] = {g0.x, g0.y, g0.z, g0.w, g1.x, g1.y, g1.z, g1.w}, kk[8] = {k0.x, k0.y, k0.z, k0.w, k1.x, k1.y, k1.z, k1.w};
#pragma unroll
            for (int e = 0; e < 8; ++e) w[e] = ((o[8 * u + e] - mu) * rn * gg[e] + kk[e] * xc[e]) * siluf(z[e]);
            *(uint4*)(Z + base + u * 128) = pack8(w); }
    }
}

PHASE_FN void phase_mlprep(const bf16_t* XM, bf16_t* XCONV, const bf16_t* Gt, const float* convw, const float* convb, const float* gateb,
                           float* gG, float* gPM, float* gB, float* cBL, float* cPML, LAS unsigned char* L, int bid, int nb) {
    const int tid = tid_opq(), lane = tid & 63, wave = __builtin_amdgcn_readfirstlane(tid >> 6);
    LAS unsigned char* XMS = L; LAS unsigned char* XCS = L + 16896; LAS unsigned char* GT1 = L + 33280; LAS unsigned char* GT2 = L + 35328; LAS float* GOUT = (LAS float*)(L + 37376);
    LAS float* CW = (LAS float*)(L + 45568);
    for (int i = tid; i < 2048; i += NTHR) { *(LAS f32x4*)(CW + 4 * i) = (i < 1536) ? *(const f32x4*)(convw + 4 * i) : *(const f32x4*)(convb + 4 * (i - 1536)); }
    const int tr = tid >> 3, tc = tid & 7;
    for (int item = bid; item < 4 * NCH; item += nb) {
        const int bl_ = item / NCH, c = item - bl_ * NCH; const size_t r0 = (size_t)bl_ * SP + 128 * c;
        const bool has_prev = (c != 0 && c != 2), has_next = (c != 1 && c != NCH - 1);
        f32x4 acc[1][1]; acc[0][0] = (f32x4){0.f, 0.f, 0.f, 0.f};
        uint4 RX[3], RGt[2];
#define MLP_LOAD(cs_) do { _Pragma("unroll") for (int u = 0; u < 3; ++u) { const int e = tid + 512 * u; RX[u] = make_uint4(0u, 0u, 0u, 0u); if (e < 1040) { const int tr_ = (e >> 3) - 1; \
            const bool ok = (tr_ >= 0 && tr_ < 128) || (tr_ < 0 && has_prev) || (tr_ >= 128 && has_next); if (ok) RX[u] = *(const uint4*)(XM + (size_t)((long)r0 + tr_) * 2048 + (cs_) * 64 + (e & 7) * 8); } } \
            if (tid < 128) { RGt[0] = *(const uint4*)(Gt + (size_t)tr * 4096 + (cs_) * 64 + tc * 8); RGt[1] = *(const uint4*)(Gt + (size_t)tr * 4096 + 2048 + (cs_) * 64 + tc * 8); } } while (0)
        MLP_LOAD(0);
        for (int cs = 0; cs < 32; ++cs) {
            LAS unsigned char* XMSp = XMS + (cs & 1) * 78336; LAS unsigned char* XCSp = XCS + (cs & 1) * 78336; LAS unsigned char* GT1p = GT1 + (cs & 1) * 78336; LAS unsigned char* GT2p = GT2 + (cs & 1) * 78336;
#pragma unroll
            for (int u = 0; u < 3; ++u) { const int e = tid + 512 * u; if (e < 1040) lds_st16(XMSp, e >> 3, e & 7, RX[u]); }
            if (tid < 128) { lds_st16(GT1p, tr, tc, RGt[0]); lds_st16(GT2p, tr, tc, RGt[1]); }
            { const int cn = (cs + 1 < 32) ? cs + 1 : cs; MLP_LOAD(cn); }
            wg_sync();
#pragma unroll
            for (int u = 0; u < 2; ++u) { const int e = tid + 512 * u, row = e >> 3, ch = e & 7, cg = cs * 64 + ch * 8; float xa[8], xb[8], xc[8], o[8];
                unpack8(lds_ld16(XMSp, row, ch), xa); unpack8(lds_ld16(XMSp, row + 1, ch), xb); unpack8(lds_ld16(XMSp, row + 2, ch), xc);
#pragma unroll
                for (int q4 = 0; q4 < 2; ++q4) { const f32x4 wb_ = *(const LAS f32x4*)(CW + 6144 + cg + 4 * q4), w0_ = *(const LAS f32x4*)(CW + cg + 4 * q4), w1_ = *(const LAS f32x4*)(CW + 2048 + cg + 4 * q4), w2_ = *(const LAS f32x4*)(CW + 4096 + cg + 4 * q4);
#pragma unroll
                    for (int qq = 0; qq < 4; ++qq) { const int q = 4 * q4 + qq; const float pre = wb_[qq] + w0_[qq] * xa[q] + w1_[qq] * xb[q] + w2_[qq] * xc[q]; o[q] = siluf(pre); } }
                const uint4 pk = pack8(o); lds_st16(XCSp, row, ch, pk); *(uint4*)(XCONV + (r0 + row) * 2048 + cg) = pk; }
            wg_sync();
            mma_slab<1, 1>(acc, XCSp, 16 * wave, GT1p, 0, lane);
            mma_slab<1, 1>(acc, XMSp, 16 * wave + 1, GT2p, 0, lane);
        }
#undef MLP_LOAD
        mfma_drain();
        { const int o = lane & 15;
#pragma unroll
            for (int e = 0; e < 4; ++e) GOUT[(16 * wave + 4 * (lane >> 4) + e) * 16 + o] = acc[0][0][e] + gateb[o]; }
        wg_sync();
        { const int d = wave >> 2, hh = wave & 3, bh = bl_ * 4 + hh;
            const int u0 = 2 * lane, u1 = u0 + 1, t0 = d ? 127 - u0 : u0, t1 = d ? 127 - u1 : u1;
            const float i0 = GOUT[t0 * 16 + d * 8 + hh], i1 = GOUT[t1 * 16 + d * 8 + hh], f0 = GOUT[t0 * 16 + d * 8 + 4 + hh], f1 = GOUT[t1 * 16 + d * 8 + 4 + hh];
            const float l0 = fminf(f0, 0.f) - log1pf(__expf(-fabsf(f0))), l1 = fminf(f1, 0.f) - log1pf(__expf(-fabsf(f1)));
            float tot = l0 + l1, inc = tot;
#pragma unroll
            for (int s = 1; s < 64; s <<= 1) { const float v = __shfl_up(inc, s); if (lane >= s) inc += v; }
            const float off = inc - tot, b0 = off + l0, b1 = off + l0 + l1, g0 = i0 - b0, g1 = i1 - b1;
            float pmx = fmaxf(g0, g1), pinc = pmx;
#pragma unroll
            for (int s = 1; s < 64; s <<= 1) { const float v = __shfl_up(pinc, s); if (lane >= s) pinc = fmaxf(pinc, v); }
            float pexc = __shfl_up(pinc, 1); if (lane == 0) pexc = -3.0e38f;
            const float pm0 = fmaxf(pexc, g0), pm1 = fmaxf(pexc, pmx);
            const size_t gb = ((size_t)d * 16 + bh) * SP + 128 * c;
            gG[gb + t0] = g0; gG[gb + t1] = g1; gPM[gb + t0] = pm0; gPM[gb + t1] = pm1; gB[gb + t0] = b0; gB[gb + t1] = b1;
            if (lane == 63) { cBL[(d * 16 + bh) * NCH + c] = b1; cPML[(d * 16 + bh) * NCH + c] = pm1; } }
    }
}

PHASE_FN void phase_rkmix(const bf16_t* H, bf16_t* A2, int bid, int nb) {
    const int tid = tid_opq(), lane = tid & 63, wv = tid >> 6;
    for (int R = bid * 8 + wv; R < NTOK; R += nb * 8) {
        const int b = R / SP, s = R - b * SP;
#pragma unroll
        for (int u = 0; u < 2; ++u) { const int c = 8 * lane + 512 * u; int src = -1;
            if (s < CTXL) { if (u == 0) { if (s > 0) src = R - 1; } else { if (s < CTXL - 1) src = R + 1; } }
            else { const int t = s - CTXL, row = t >> 6, col = t & 63, qd = c >> 8;
                if (qd == 0) { if (col > 0) src = R - 1; } else if (qd == 1) { if (col < 63) src = R + 1; } else if (qd == 2) { if (row > 0) src = R - 64; } else { if (row < 63) src = R + 64; } }
            const uint4 hv = *(const uint4*)(H + (size_t)R * DM + c); uint4 sv = make_uint4(0u, 0u, 0u, 0u); if (src >= 0) sv = *(const uint4*)(H + (size_t)src * DM + c);
            *(uint4*)(A2 + (size_t)R * 2048 + c) = hv; *(uint4*)(A2 + (size_t)R * 2048 + 1024 + c) = sv; }
    }
}

PHASE_FN void phase_rkmix2(const bf16_t* H, bf16_t* X2, const float* mix, int j1, int j2, int bid, int nb) {
    const int tid = tid_opq(), lane = tid & 63, wv = tid >> 6;
    float4 mq[2][4];
#pragma unroll
    for (int u = 0; u < 2; ++u) { const int c = 8 * lane + 512 * u; mq[u][0] = *(const float4*)(mix + j1 * 1024 + c); mq[u][1] = *(const float4*)(mix + j1 * 1024 + c + 4); mq[u][2] = *(const float4*)(mix + j2 * 1024 + c); mq[u][3] = *(const float4*)(mix + j2 * 1024 + c + 4); }
    for (int R = bid * 8 + wv; R < NTOK; R += nb * 8) {
        const int b = R / SP, s = R - b * SP;
#pragma unroll
        for (int u = 0; u < 2; ++u) { const int c = 8 * lane + 512 * u; int src = -1;
            if (s < CTXL) { if (u == 0) { if (s > 0) src = R - 1; } else { if (s < CTXL - 1) src = R + 1; } }
            else { const int t = s - CTXL, row = t >> 6, col = t & 63, qd = c >> 8;
                if (qd == 0) { if (col > 0) src = R - 1; } else if (qd == 1) { if (col < 63) src = R + 1; } else if (qd == 2) { if (row > 0) src = R - 64; } else { if (row < 63) src = R + 64; } }
            float hv[8], sv[8], o1[8], o2[8]; unpack8(*(const uint4*)(H + (size_t)R * DM + c), hv);
            if (src >= 0) unpack8(*(const uint4*)(H + (size_t)src * DM + c), sv); else {
#pragma unroll
                for (int e = 0; e < 8; ++e) sv[e] = 0.f; }
            const float4 m1a = mq[u][0], m1b = mq[u][1], m2a = mq[u][2], m2b = mq[u][3];
            const float m1[8] = {m1a.x, m1a.y, m1a.z, m1a.w, m1b.x, m1b.y, m1b.z, m1b.w}, m2[8] = {m2a.x, m2a.y, m2a.z, m2a.w, m2b.x, m2b.y, m2b.z, m2b.w};
#pragma unroll
            for (int e = 0; e < 8; ++e) { const float xx = sv[e] - hv[e]; o1[e] = hv[e] + xx * m1[e]; o2[e] = hv[e] + xx * m2[e]; }
            *(uint4*)(X2 + (size_t)R * DM + c) = pack8(o1); *(uint4*)(X2 + ((size_t)NTOK + R) * DM + c) = pack8(o2); }
    }
}

PHASE_FN void phase_rkscan(const bf16_t* Rr, const bf16_t* Kk, const bf16_t* Vv, const bf16_t* T, const float* w0, const float* w2, const float* a0, const float* a2,
                           const float* k_k, const float* k_a, const float* r_k, bf16_t* Yf, bf16_t* Yb, float* bon, LAS unsigned char* L, int bid, int nb) {
    if (bid >= 256) return;
    const int tid = tid_opq(), lane = tid & 63, wave = __builtin_amdgcn_readfirstlane(tid >> 6);
    const int b = bid >> 5, h = (bid >> 1) & 15, d = bid & 1;
    LAS float* WB = (LAS float*)L; LAS float* AD = WB + 2048; LAS float* RB = AD + 2048; LAS float* KD = RB + 2048; LAS float* VB = KD + 2048; LAS float* AB = VB + 2048; LAS float* BB = AB + 2048; LAS float* YB = BB + 2048;
    bf16_t* Y = d ? Yb : Yf;
    const int tt = wave >> 2, ct = wave & 3;
    bf16x8 bw[2], ba[2];
#pragma unroll
    for (int ks = 0; ks < 2; ++ks) { float fw[8], fa[8];
#pragma unroll
        for (int j = 0; j < 8; ++j) { const int m = 8 * (lane >> 4) + j + 32 * ks, cc = 64 * h + 16 * ct + (lane & 15); fw[j] = w2[((size_t)d * 64 + m) * 1024 + cc]; fa[j] = a2[((size_t)d * 64 + m) * 1024 + cc]; }
        const uint4 pw = pack8(fw), pa = pack8(fa); bw[ks] = *(const bf16x8*)&pw; ba[ks] = *(const bf16x8*)&pa; }
    const int cch = 64 * h + 16 * ct + (lane & 15);
    const float w0c = w0[d * 1024 + cch], a0c = a0[d * 1024 + cch];
    const int etok = tid >> 4, ecg = tid & 15, ec = 64 * h + 4 * ecg;
    const float4 kk4 = *(const float4*)(k_k + ec), ka4 = *(const float4*)(k_a + ec), rk4 = *(const float4*)(r_k + ec);
    const int pr = tid >> 4, rq = tid & 15;
    float S[2][4];
#pragma unroll
    for (int r = 0; r < 2; ++r)
#pragma unroll
        for (int e = 0; e < 4; ++e) S[r][e] = 0.f;
#define RK_SLO(kb_) (d ? ((kb_) < 8 ? CTXL - 32 * ((kb_) + 1) : SP - 32 * ((kb_) - 8 + 1)) : 32 * (kb_))
    uint4 tw[2], ta[2]; u32x2 rw, kw, vw;
#define RK_GLOAD(kb_) do { const size_t Rn_ = (size_t)b * SP + RK_SLO(kb_); const bf16_t* trow_ = T + (Rn_ + 16 * tt + (lane & 15)) * 256 + 8 * (lane >> 4); \
        _Pragma("unroll") for (int ks = 0; ks < 2; ++ks) { tw[ks] = *(const uint4*)(trow_ + 64 * d + 32 * ks); ta[ks] = *(const uint4*)(trow_ + 128 + 64 * d + 32 * ks); } \
        const size_t g_ = (Rn_ + etok) * 1024 + ec; rw = *(const u32x2*)(Rr + g_); kw = *(const u32x2*)(Kk + g_); vw = *(const u32x2*)(Vv + g_); } while (0)
    RK_GLOAD(0);
    for (int kb = 0; kb < SP / 32; ++kb) {
        const int slo = RK_SLO(kb);
        const size_t Rb = (size_t)b * SP + slo;
        wg_sync();
        { f32x4 dw = (f32x4){0.f, 0.f, 0.f, 0.f}, da = (f32x4){0.f, 0.f, 0.f, 0.f};
#pragma unroll
            for (int ks = 0; ks < 2; ++ks) {
                dw = __builtin_amdgcn_mfma_f32_16x16x32_bf16(*(const bf16x8*)&tw[ks], bw[ks], dw, 0, 0, 0);
                da = __builtin_amdgcn_mfma_f32_16x16x32_bf16(*(const bf16x8*)&ta[ks], ba[ks], da, 0, 0, 0); }
            mfma_drain();
#pragma unroll
            for (int e = 0; e < 4; ++e) { const int tok = 16 * tt + 4 * (lane >> 4) + e, cc = 16 * ct + (lane & 15);
                const float x = -(w0c + dw[e]);
                const float sp = fmaxf(x, 0.f) + log1pf(__expf(-fabsf(x)));
                WB[tok * 64 + cc] = __expf(-__expf(-sp - 0.5f));
                AD[tok * 64 + cc] = sigmf(a0c + da[e]); } }
        const float r[4] = {bflo(rw.x), bfhi(rw.x), bflo(rw.y), bfhi(rw.y)}, k[4] = {bflo(kw.x), bfhi(kw.x), bflo(kw.y), bfhi(kw.y)}, v[4] = {bflo(vw.x), bfhi(vw.x), bflo(vw.y), bfhi(vw.y)};
        { const int kn = (kb + 1 < SP / 32) ? kb + 1 : kb; RK_GLOAD(kn); }
        wg_sync();
        {   const float kkc[4] = {kk4.x, kk4.y, kk4.z, kk4.w}, kac[4] = {ka4.x, ka4.y, ka4.z, ka4.w}, rkc[4] = {rk4.x, rk4.y, rk4.z, rk4.w};
            float kr[4], ss = 0.f;
#pragma unroll
            for (int e = 0; e < 4; ++e) { kr[e] = k[e] * kkc[e]; ss += kr[e] * kr[e]; }
            ss = red16(ss); const float inv = 1.f / fmaxf(sqrtf(ss), 1e-12f); float bs = 0.f;
#pragma unroll
            for (int e = 0; e < 4; ++e) { const int o = etok * 64 + 4 * ecg + e; const float ad = AD[o], kkn = kr[e] * inv, kd = k[e] * (1.f + (ad - 1.f) * kac[e]);
                RB[o] = r[e]; KD[o] = kd; VB[o] = v[e]; AB[o] = -kkn; BB[o] = kkn * ad; bs += r[e] * kd * rkc[e]; }
            bs = red16(bs); if (ecg == 0) bon[((size_t)d * NTOK + Rb + etok) * 16 + h] = bs; }
        wg_sync();
#define RK_LOAD(SET, u_) do { const int o_ = (u_) * 64 + 4 * rq; SET##a = *(const LAS f32x4*)(AB + o_); SET##w = *(const LAS f32x4*)(WB + o_); SET##k = *(const LAS f32x4*)(KD + o_); SET##b = *(const LAS f32x4*)(BB + o_); \
            SET##r = *(const LAS f32x4*)(RB + o_); SET##v = *(const LAS f32x2v*)(VB + (u_) * 64 + 2 * pr); } while (0)
#define RK_STEP(SET, u_) do { \
            const float sa0 = red16((S[0][0] * SET##a[0] + S[0][1] * SET##a[1]) + (S[0][2] * SET##a[2] + S[0][3] * SET##a[3])); \
            const float sa1 = red16((S[1][0] * SET##a[0] + S[1][1] * SET##a[1]) + (S[1][2] * SET##a[2] + S[1][3] * SET##a[3])); \
            _Pragma("unroll") for (int e = 0; e < 4; ++e) { S[0][e] = S[0][e] * SET##w[e] + sa0 * SET##b[e] + SET##v[0] * SET##k[e]; S[1][e] = S[1][e] * SET##w[e] + sa1 * SET##b[e] + SET##v[1] * SET##k[e]; } \
            const float y0 = red16((S[0][0] * SET##r[0] + S[0][1] * SET##r[1]) + (S[0][2] * SET##r[2] + S[0][3] * SET##r[3])); \
            const float y1 = red16((S[1][0] * SET##r[0] + S[1][1] * SET##r[1]) + (S[1][2] * SET##r[2] + S[1][3] * SET##r[3])); \
            if (rq == 0) { f32x2v yy; yy[0] = y0; yy[1] = y1; *(LAS f32x2v*)(YB + (u_) * 64 + 2 * pr) = yy; } } while (0)
        { f32x4 Aa, Aw, Ak, Ab, Ar, Ba, Bw, Bk, Bb, Br; f32x2v Av, Bv;
            RK_LOAD(A, d ? 31 : 0);
            for (int t2 = 0; t2 < 32; t2 += 2) { const int u0 = d ? 31 - t2 : t2, u1 = d ? 30 - t2 : t2 + 1, u2 = d ? (t2 + 2 < 32 ? 29 - t2 : 0) : (t2 + 2 < 32 ? t2 + 2 : 31);
                RK_LOAD(B, u1); RK_STEP(A, u0);
                RK_LOAD(A, u2); RK_STEP(B, u1); } }
#undef RK_LOAD
#undef RK_STEP
        wg_sync();
        { const int o = etok * 64 + 4 * ecg; u32x2 w; w.x = pk2(YB[o], YB[o + 1]); w.y = pk2(YB[o + 2], YB[o + 3]); *(u32x2*)(Y + (Rb + etok) * 1024 + ec) = w; }
    }
#undef RK_GLOAD
#undef RK_SLO
}

template <int CTRL> __device__ __forceinline__ float dppz(float v) { return __int_as_float(__builtin_amdgcn_update_dpp(0, __float_as_int(v), CTRL, 0xF, 0xF, true)); }
__device__ __forceinline__ unsigned short f2bf(float x) { return (unsigned short)(pk2(x, 0.f) & 0xffffu); }
PHASE_FN void phase_rkscan2(const bf16_t* Rr, const bf16_t* Kk, const bf16_t* Vv, const bf16_t* T, const float* w0, const float* w2, const float* a0, const float* a2,
                            const float* k_k, const float* k_a, const float* r_k, bf16_t* Yf, bf16_t* Yb, float* bon, LAS unsigned char* L, int bid, int nb, unsigned long long* prof = nullptr) {
    unsigned long long psec0 = 0, psec1 = 0, psec2 = 0, psec3 = 0, psec4 = 0, psec5 = 0, pt = 0;
#define PSTAMP(k) do { if (prof) { const unsigned long long n_ = clock64(); psec##k += n_ - pt; pt = n_; } } while (0)
    if (bid >= 256) return;
    const int tid = tid_opq(), lane = tid & 63, wave = __builtin_amdgcn_readfirstlane(tid >> 6);
    const int b = bid >> 5, h = (bid >> 1) & 15, d = bid & 1;
    LAS float* WB = (LAS float*)L; LAS float* AD = WB + 2112; LAS float* RB = AD + 2112; LAS float* KD = RB + 2112; LAS float* VB = KD + 2112; LAS float* AB = VB + 2112; LAS float* BB = AB + 2112;
    LAS float* YB = (LAS float*)(L + 121856);
    LAS unsigned char* AT = L + 65536; LAS unsigned char* RT = L + 70144; LAS unsigned char* BT = L + 74752; LAS unsigned char* KT = L + 79360;
    LAS unsigned char* BKt = L + 83968; LAS unsigned char* UVt = L + 94208;
    LAS unsigned char* SB = L + 104448;
    LAS unsigned char* ARK = L + 113664; LAS unsigned char* AK0 = L + 114944;
    LAS float* AAB = (LAS float*)(L + 116224); LAS float* XF = (LAS float*)(L + 117248); LAS float* GL = (LAS float*)(L + 121344);
    bf16_t* Y = d ? Yb : Yf;
    const int tt = wave >> 2, ct = wave & 3;
    bf16x8 bw[2], ba[2];
#pragma unroll
    for (int ks = 0; ks < 2; ++ks) { float fw[8], fa[8];
#pragma unroll
        for (int j = 0; j < 8; ++j) { const int m = 8 * (lane >> 4) + j + 32 * ks, cc = 64 * h + 16 * ct + (lane & 15); fw[j] = w2[((size_t)d * 64 + m) * 1024 + cc]; fa[j] = a2[((size_t)d * 64 + m) * 1024 + cc]; }
        const uint4 pw = pack8(fw), pa = pack8(fa); bw[ks] = *(const bf16x8*)&pw; ba[ks] = *(const bf16x8*)&pa; }
    const int cch = 64 * h + 16 * ct + (lane & 15);
    const float w0c = w0[d * 1024 + cch], a0c = a0[d * 1024 + cch];
    const int etok = tid >> 4, ecg = tid & 15, ec = 64 * h + 4 * ecg;
    const float4 kk4 = *(const float4*)(k_k + ec), ka4 = *(const float4*)(k_a + ec), rk4 = *(const float4*)(r_k + ec);
    for (int i = tid; i < (121856 - 83968) / 4; i += NTHR) ((LAS unsigned*)(L + 83968))[i] = 0u;
    f32x4 Sacc[2];
    Sacc[0] = (f32x4){0.f, 0.f, 0.f, 0.f}; Sacc[1] = (f32x4){0.f, 0.f, 0.f, 0.f};
#define RK_SLO(kb_) (d ? ((kb_) < 8 ? CTXL - 32 * ((kb_) + 1) : SP - 32 * ((kb_) - 8 + 1)) : 32 * (kb_))
    uint4 tw[2], ta[2]; u32x2 rw, kw, vw;
#define RK_GLOAD(kb_) do { const size_t Rn_ = (size_t)b * SP + RK_SLO(kb_); const bf16_t* trow_ = T + (Rn_ + 16 * tt + (lane & 15)) * 256 + 8 * (lane >> 4); \
        _Pragma("unroll") for (int ks = 0; ks < 2; ++ks) { tw[ks] = *(const uint4*)(trow_ + 64 * d + 32 * ks); ta[ks] = *(const uint4*)(trow_ + 128 + 64 * d + 32 * ks); } \
        const size_t g_ = (Rn_ + etok) * 1024 + ec; rw = *(const u32x2*)(Rr + g_); kw = *(const u32x2*)(Kk + g_); vw = *(const u32x2*)(Vv + g_); } while (0)
#define FRAG(base, row, pitchB, koffB) (*(const LAS bf16x8*)((base) + (row) * (pitchB) + (koffB) + (lane >> 4) * 16))
    RK_GLOAD(0);
    for (int kb = 0; kb < SP / 32; ++kb) {
        const int slo = RK_SLO(kb);
        const size_t Rb = (size_t)b * SP + slo;
        if (prof) pt = clock64();
        wg_sync();
        { f32x4 dw = (f32x4){0.f, 0.f, 0.f, 0.f}, da = (f32x4){0.f, 0.f, 0.f, 0.f};
#pragma unroll
            for (int ks = 0; ks < 2; ++ks) {
                dw = __builtin_amdgcn_mfma_f32_16x16x32_bf16(*(const bf16x8*)&tw[ks], bw[ks], dw, 0, 0, 0);
                da = __builtin_amdgcn_mfma_f32_16x16x32_bf16(*(const bf16x8*)&ta[ks], ba[ks], da, 0, 0, 0); }
            mfma_drain();
#pragma unroll
            for (int e = 0; e < 4; ++e) { const int tok = 16 * tt + 4 * (lane >> 4) + e, cc = 16 * ct + (lane & 15);
                const float x = -(w0c + dw[e]);
                const float sp = fmaxf(x, 0.f) + log1pf(__expf(-fabsf(x)));
                WB[tok * 65 + cc] = -__expf(-sp - 0.5f) * 1.4426950408889634f;
                AD[tok * 65 + cc] = sigmf(a0c + da[e]); } }
        const float r[4] = {bflo(rw.x), bfhi(rw.x), bflo(rw.y), bfhi(rw.y)}, k[4] = {bflo(kw.x), bfhi(kw.x), bflo(kw.y), bfhi(kw.y)}, v[4] = {bflo(vw.x), bfhi(vw.x), bflo(vw.y), bfhi(vw.y)};
        { const int kn = (kb + 1 < SP / 32) ? kb + 1 : kb; RK_GLOAD(kn); }
        wg_sync();
        {   const float kkc[4] = {kk4.x, kk4.y, kk4.z, kk4.w}, kac[4] = {ka4.x, ka4.y, ka4.z, ka4.w}, rkc[4] = {rk4.x, rk4.y, rk4.z, rk4.w};
            float kr[4], ss = 0.f;
#pragma unroll
            for (int e = 0; e < 4; ++e) { kr[e] = k[e] * kkc[e]; ss += kr[e] * kr[e]; }
            ss = red16(ss); const float inv = 1.f / fmaxf(sqrtf(ss), 1e-12f); float bs = 0.f;
#pragma unroll
            for (int e = 0; e < 4; ++e) { const int o = etok * 65 + 4 * ecg + e; const float ad = AD[o], kkn = kr[e] * inv, kd = k[e] * (1.f + (ad - 1.f) * kac[e]);
                RB[o] = r[e]; KD[o] = kd; VB[o] = v[e]; AB[o] = -kkn; BB[o] = kkn * ad; bs += r[e] * kd * rkc[e]; }
            bs = red16(bs); if (ecg == 0) bon[((size_t)d * NTOK + Rb + etok) * 16 + h] = bs; }
        wg_sync();
        PSTAMP(0);
        { const int kq = tid >> 4, t = tid & 15;
#pragma unroll
            for (int c = 0; c < 2; ++c) { const int u = d ? 31 - 16 * c - t : 16 * c + t;
#pragma unroll
                for (int hh = 0; hh < 2; ++hh) { const int kk = kq + 32 * hh, o = u * 65 + kk;
                    const float lw = WB[o]; float cs = lw;
                    cs += dppz<0x111>(cs); cs += dppz<0x112>(cs); cs += dppz<0x114>(cs); cs += dppz<0x118>(cs);
                    const float g = exp2f(cs), gp = exp2f(cs - lw), ig = exp2f(-cs);
                    const float av = AB[o] * gp, rv = RB[o] * g, bv = BB[o] * ig, kv = KD[o] * ig;
                    const int ro = c * 2304 + t * 144 + kk * 2;
                    *(LAS unsigned short*)(AT + ro) = f2bf(av); *(LAS unsigned short*)(RT + ro) = f2bf(rv); *(LAS unsigned short*)(BT + ro) = f2bf(bv); *(LAS unsigned short*)(KT + ro) = f2bf(kv);
                    *(LAS unsigned short*)(BKt + c * 5120 + kk * 80 + t * 2) = f2bf(bv); *(LAS unsigned short*)(BKt + c * 5120 + kk * 80 + 32 + t * 2) = f2bf(kv);
                    *(LAS unsigned short*)(UVt + c * 5120 + kk * 80 + 32 + t * 2) = f2bf(VB[o]);
                    if (t == 15) GL[c * 64 + kk] = g; } } }
        wg_sync();
        PSTAMP(1);
#pragma unroll
        for (int c = 0; c < 2; ++c) {
            f32x4 accx = (f32x4){0.f, 0.f, 0.f, 0.f}, acca = (f32x4){0.f, 0.f, 0.f, 0.f};
            if (wave < 4) {
                LAS unsigned char* Aa = (wave < 2) ? AT : RT; LAS unsigned char* Bb = (wave & 1) ? KT : BT;
#pragma unroll
                for (int ks = 0; ks < 2; ++ks) { const bf16x8 fa = FRAG(AT + c * 2304, lane & 15, 144, ks * 64), fs = FRAG(SB, 16 * wave + (lane & 15), 144, ks * 64);
                    accx = __builtin_amdgcn_mfma_f32_16x16x32_bf16(fa, fs, accx, 0, 0, 0);
                    const bf16x8 f1 = FRAG(Aa + c * 2304, lane & 15, 144, ks * 64), f2 = FRAG(Bb + c * 2304, lane & 15, 144, ks * 64);
                    acca = __builtin_amdgcn_mfma_f32_16x16x32_bf16(f1, f2, acca, 0, 0, 0); }
                mfma_drain();
#pragma unroll
                for (int e = 0; e < 4; ++e) { const int t = 4 * (lane >> 4) + e, ta_ = lane & 15; const bool strict = ta_ < t, incl = ta_ <= t; const float val = acca[e];
                    if (wave == 0) AAB[ta_ * 16 + t] = strict ? val : 0.f;
                    else if (wave == 1) *(LAS unsigned short*)(AK0 + t * 80 + 32 + ta_ * 2) = f2bf(strict ? val : 0.f);
                    else if (wave == 2) *(LAS unsigned short*)(ARK + t * 80 + ta_ * 2) = f2bf(incl ? val : 0.f);
                    else *(LAS unsigned short*)(ARK + t * 80 + 32 + ta_ * 2) = f2bf(incl ? val : 0.f); }
            } else {
#pragma unroll
                for (int ks = 0; ks < 2; ++ks) { const bf16x8 fr = FRAG(RT + c * 2304, lane & 15, 144, ks * 64), fs = FRAG(SB, 16 * (wave - 4) + (lane & 15), 144, ks * 64);
                    accx = __builtin_amdgcn_mfma_f32_16x16x32_bf16(fr, fs, accx, 0, 0, 0); }
            }
            wg_sync();
            PSTAMP(2);
            if (wave < 4) { const bf16x8 fk = FRAG(AK0, lane & 15, 80, 0), fv = FRAG(UVt + c * 5120, 16 * wave + (lane & 15), 80, 0);
                accx = __builtin_amdgcn_mfma_f32_16x16x32_bf16(fk, fv, accx, 0, 0, 0);
                mfma_drain();
#pragma unroll
                for (int e = 0; e < 4; ++e) XF[(4 * (lane >> 4) + e) * 64 + 16 * wave + (lane & 15)] = accx[e]; }
            wg_sync();
            PSTAMP(3);
            if (wave == 0) { float uu[16];
#pragma unroll
                for (int t = 0; t < 16; ++t) uu[t] = XF[t * 64 + lane];
#pragma unroll
                for (int q = 0; q < 15; ++q) { const f32x4 c0 = *(const LAS f32x4*)(AAB + q * 16), c1 = *(const LAS f32x4*)(AAB + q * 16 + 4), c2 = *(const LAS f32x4*)(AAB + q * 16 + 8), c3 = *(const LAS f32x4*)(AAB + q * 16 + 12);
                    const float col[16] = {c0[0], c0[1], c0[2], c0[3], c1[0], c1[1], c1[2], c1[3], c2[0], c2[1], c2[2], c2[3], c3[0], c3[1], c3[2], c3[3]};
#pragma unroll
                    for (int t = q + 1; t < 16; ++t) uu[t] += col[t] * uu[q];
                    if (q & 1) asm volatile("" ::: "memory"); }
                uint4 p0, p1; p0.x = pk2(uu[0], uu[1]); p0.y = pk2(uu[2], uu[3]); p0.z = pk2(uu[4], uu[5]); p0.w = pk2(uu[6], uu[7]); p1.x = pk2(uu[8], uu[9]); p1.y = pk2(uu[10], uu[11]); p1.z = pk2(uu[12], uu[13]); p1.w = pk2(uu[14], uu[15]);
                u32x4 q0, q1; q0.x = p0.x; q0.y = p0.y; q0.z = p0.z; q0.w = p0.w; q1.x = p1.x; q1.y = p1.y; q1.z = p1.z; q1.w = p1.w;
                *(LAS u32x4*)(UVt + c * 5120 + lane * 80) = q0; *(LAS u32x4*)(UVt + c * 5120 + lane * 80 + 16) = q1; }
            wg_sync();
            PSTAMP(4);
            if (wave >= 4) { const bf16x8 fr = FRAG(ARK, lane & 15, 80, 0), fu = FRAG(UVt + c * 5120, 16 * (wave - 4) + (lane & 15), 80, 0);
                accx = __builtin_amdgcn_mfma_f32_16x16x32_bf16(fr, fu, accx, 0, 0, 0);
                mfma_drain();
#pragma unroll
                for (int e = 0; e < 4; ++e) { const int t = 4 * (lane >> 4) + e, u = d ? 31 - 16 * c - t : 16 * c + t; YB[u * 64 + 16 * (wave - 4) + (lane & 15)] = accx[e]; } }
            { const int kt = wave & 3; const bf16x8 fb = FRAG(BKt + c * 5120, 16 * kt + (lane & 15), 80, 0);
#pragma unroll
                for (int x = 0; x < 2; ++x) { const int it = 2 * (wave >> 2) + x; const bf16x8 fu = FRAG(UVt + c * 5120, 16 * it + (lane & 15), 80, 0);
                    Sacc[x] = __builtin_amdgcn_mfma_f32_16x16x32_bf16(fb, fu, Sacc[x], 0, 0, 0); }
                mfma_drain();
                const f32x4 gl = *(const LAS f32x4*)(GL + c * 64 + 16 * kt + 4 * (lane >> 4));
#pragma unroll
                for (int x = 0; x < 2; ++x) { const int it = 2 * (wave >> 2) + x; Sacc[x] *= gl;
                    u32x2 w_; w_.x = pk2(Sacc[x][0], Sacc[x][1]); w_.y = pk2(Sacc[x][2], Sacc[x][3]);
                    *(LAS u32x2*)(SB + (16 * it + (lane & 15)) * 144 + (16 * kt + 4 * (lane >> 4)) * 2) = w_; } }
            wg_sync();
            PSTAMP(5);
        }
        { const int o = etok * 64 + 4 * ecg; u32x2 w; w.x = pk2(YB[o], YB[o + 1]); w.y = pk2(YB[o + 2], YB[o + 3]); *(u32x2*)(Y + (Rb + etok) * 1024 + ec) = w; }
    }
    if (prof && bid == 0 && tid == 0) { prof[0] = psec0; prof[1] = psec1; prof[2] = psec2; prof[3] = psec3; prof[4] = psec4; prof[5] = psec5; }
#undef PSTAMP
#undef FRAG
#undef RK_GLOAD
#undef RK_SLO
}

PHASE_FN void phase_rkscan3(const bf16_t* Rr, const bf16_t* Kk, const bf16_t* Vv, const bf16_t* T, const float* w0, const float* w2, const float* a0, const float* a2,
                            const float* k_k, const float* k_a, const float* r_k, bf16_t* Yf, bf16_t* Yb, float* bon, LAS unsigned char* L, int bid, int nb) {
    if (bid >= 256) return;
    const int tid = tid_opq(), lane = tid & 63, wave = __builtin_amdgcn_readfirstlane(tid >> 6);
    const int b = bid >> 5, h = (bid >> 1) & 15, d = bid & 1;
    LAS float* WB = (LAS float*)L; LAS float* AD = WB + 2112; LAS float* RB = AD + 2112; LAS float* KD = RB + 2112; LAS float* VB = KD + 2112; LAS float* AB = VB + 2112; LAS float* BB = AB + 2112;
    LAS float* YB = (LAS float*)(L + 121856);
    LAS unsigned char* AT = L + 65536; LAS unsigned char* RT = L + 70144; LAS unsigned char* BT = L + 74752; LAS unsigned char* KT = L + 79360;
    LAS unsigned char* BKt = L + 83968; LAS unsigned char* UVt = L + 94208;
    LAS unsigned char* SB = L + 104448;
    LAS unsigned char* ARK = L + 113664; LAS unsigned char* AK0 = L + 114944;
    LAS float* AAB = (LAS float*)(L + 116224); LAS float* XF = (LAS float*)(L + 117248); LAS float* GL = (LAS float*)(L + 121344);
    bf16_t* Y = d ? Yb : Yf;
    const int tt = wave >> 2, ct = wave & 3;
    bf16x8 bw[2], ba[2];
#pragma unroll
    for (int ks = 0; ks < 2; ++ks) { float fw[8], fa[8];
#pragma unroll
        for (int j = 0; j < 8; ++j) { const int m = 8 * (lane >> 4) + j + 32 * ks, cc = 64 * h + 16 * ct + (lane & 15); fw[j] = w2[((size_t)d * 64 + m) * 1024 + cc]; fa[j] = a2[((size_t)d * 64 + m) * 1024 + cc]; }
        const uint4 pw = pack8(fw), pa = pack8(fa); bw[ks] = *(const bf16x8*)&pw; ba[ks] = *(const bf16x8*)&pa; }
    const int cch = 64 * h + 16 * ct + (lane & 15);
    const float w0c = w0[d * 1024 + cch], a0c = a0[d * 1024 + cch];
    const int etok = tid >> 4, ecg = tid & 15, ec = 64 * h + 4 * ecg;
    const float4 kk4 = *(const float4*)(k_k + ec), ka4 = *(const float4*)(k_a + ec), rk4 = *(const float4*)(r_k + ec);
    for (int i = tid; i < (121856 - 83968) / 4; i += NTHR) ((LAS unsigned*)(L + 83968))[i] = 0u;
    f32x4 Sacc[2];
    Sacc[0] = (f32x4){0.f, 0.f, 0.f, 0.f}; Sacc[1] = (f32x4){0.f, 0.f, 0.f, 0.f};
#define RK_SLO(kb_) (d ? ((kb_) < 8 ? CTXL - 32 * ((kb_) + 1) : SP - 32 * ((kb_) - 8 + 1)) : 32 * (kb_))
    uint4 tw[2], ta[2]; u32x2 rw, kw, vw;
#define RK_GLOAD(kb_) do { const size_t Rn_ = (size_t)b * SP + RK_SLO(kb_); const bf16_t* trow_ = T + (Rn_ + 16 * tt + (lane & 15)) * 256 + 8 * (lane >> 4); \
        _Pragma("unroll") for (int ks = 0; ks < 2; ++ks) { tw[ks] = *(const uint4*)(trow_ + 64 * d + 32 * ks); ta[ks] = *(const uint4*)(trow_ + 128 + 64 * d + 32 * ks); } \
        const size_t g_ = (Rn_ + etok) * 1024 + ec; rw = *(const u32x2*)(Rr + g_); kw = *(const u32x2*)(Kk + g_); vw = *(const u32x2*)(Vv + g_); } while (0)
#define FRAG(base, row, pitchB, koffB) (*(const LAS bf16x8*)((base) + (row) * (pitchB) + (koffB) + (lane >> 4) * 16))
#define RK_PREP_A() do { f32x4 dw = (f32x4){0.f, 0.f, 0.f, 0.f}, da = (f32x4){0.f, 0.f, 0.f, 0.f}; \
        _Pragma("unroll") for (int ks = 0; ks < 2; ++ks) { \
            dw = __builtin_amdgcn_mfma_f32_16x16x32_bf16(*(const bf16x8*)&tw[ks], bw[ks], dw, 0, 0, 0); \
            da = __builtin_amdgcn_mfma_f32_16x16x32_bf16(*(const bf16x8*)&ta[ks], ba[ks], da, 0, 0, 0); } \
        mfma_drain(); \
        _Pragma("unroll") for (int e = 0; e < 4; ++e) { const int tok = 16 * tt + 4 * (lane >> 4) + e, cc = 16 * ct + (lane & 15); \
            WB[tok * 65 + cc] = -0.8750388f * sigmf(w0c + dw[e]);     \
            AD[tok * 65 + cc] = sigmf(a0c + da[e]); } } while (0)
#define RK_PREP_B1(Rb_, kl_) do { \
        const float r[4] = {bflo(rw.x), bfhi(rw.x), bflo(rw.y), bfhi(rw.y)}, k[4] = {bflo(kw.x), bfhi(kw.x), bflo(kw.y), bfhi(kw.y)}, v[4] = {bflo(vw.x), bfhi(vw.x), bflo(vw.y), bfhi(vw.y)}; \
        if ((kl_) >= 0) RK_GLOAD(kl_); \
        const float kkc[4] = {kk4.x, kk4.y, kk4.z, kk4.w}, kac[4] = {ka4.x, ka4.y, ka4.z, ka4.w}, rkc[4] = {rk4.x, rk4.y, rk4.z, rk4.w}; \
        float kr[4], ss = 0.f; \
        _Pragma("unroll") for (int e = 0; e < 4; ++e) { kr[e] = k[e] * kkc[e]; ss += kr[e] * kr[e]; } \
        ss = red16(ss); const float inv = 1.f / fmaxf(sqrtf(ss), 1e-12f); float bs = 0.f; \
        _Pragma("unroll") for (int e = 0; e < 4; ++e) { const int o = etok * 65 + 4 * ecg + e; const float ad = AD[o], kkn = kr[e] * inv, kd = k[e] * (1.f + (ad - 1.f) * kac[e]); \
            RB[o] = r[e]; KD[o] = kd; VB[o] = v[e]; AB[o] = -kkn; BB[o] = kkn * ad; bs += r[e] * kd * rkc[e]; } \
        bs = red16(bs); if (ecg == 0) bon[((size_t)d * NTOK + (Rb_) + etok) * 16 + h] = bs; } while (0)
#define RK_PREP_B2(c_) do { const int kq = tid >> 4, t = tid & 15; const int u = d ? 31 - 16 * (c_) - t : 16 * (c_) + t; \
        _Pragma("unroll") for (int hh = 0; hh < 2; ++hh) { const int kk = kq + 32 * hh, o = u * 65 + kk; \
            const float lw = WB[o]; float cs = lw; \
            cs += dppz<0x111>(cs); cs += dppz<0x112>(cs); cs += dppz<0x114>(cs); cs += dppz<0x118>(cs); \
            const float g = __builtin_amdgcn_exp2f(cs), gp = __builtin_amdgcn_exp2f(cs - lw), ig = __builtin_amdgcn_exp2f(-cs); \
            const float av = AB[o] * gp, rv = RB[o] * g, bv = BB[o] * ig, kv = KD[o] * ig; \
            const int ro = (c_) * 2304 + t * 144 + kk * 2; \
            *(LAS unsigned short*)(AT + ro) = f2bf(av); *(LAS unsigned short*)(RT + ro) = f2bf(rv); *(LAS unsigned short*)(BT + ro) = f2bf(bv); *(LAS unsigned short*)(KT + ro) = f2bf(kv); \
            *(LAS unsigned short*)(BKt + (c_) * 5120 + kk * 80 + t * 2) = f2bf(bv); *(LAS unsigned short*)(BKt + (c_) * 5120 + kk * 80 + 32 + t * 2) = f2bf(kv); \
            *(LAS unsigned short*)(UVt + (c_) * 5120 + kk * 80 + 32 + t * 2) = f2bf(VB[o]); \
            if (t == 15) GL[(c_) * 64 + kk] = g; } } while (0)
    RK_GLOAD(0);
    wg_sync();
    RK_PREP_A();
    wg_sync();
    { const size_t Rb0 = (size_t)b * SP + RK_SLO(0); RK_PREP_B1(Rb0, 1); }
    wg_sync();
    RK_PREP_B2(0);
    wg_sync();
    constexpr int NBLK = SP / 32;
    for (int kb = 0; kb < NBLK; ++kb) {
        const int slo = RK_SLO(kb);
        const size_t Rb = (size_t)b * SP + slo;
        const bool more = (kb + 1 < NBLK);
#pragma unroll
        for (int c = 0; c < 2; ++c) {
            f32x4 accx = (f32x4){0.f, 0.f, 0.f, 0.f}, acca = (f32x4){0.f, 0.f, 0.f, 0.f};
            if (wave < 4) {
                LAS unsigned char* Aa = (wave < 2) ? AT : RT; LAS unsigned char* Bb = (wave & 1) ? KT : BT;
#pragma unroll
                for (int ks = 0; ks < 2; ++ks) { const bf16x8 fa = FRAG(AT + c * 2304, lane & 15, 144, ks * 64), fs = FRAG(SB, 16 * wave + (lane & 15), 144, ks * 64);
                    accx = __builtin_amdgcn_mfma_f32_16x16x32_bf16(fa, fs, accx, 0, 0, 0);
                    const bf16x8 f1 = FRAG(Aa + c * 2304, lane & 15, 144, ks * 64), f2 = FRAG(Bb + c * 2304, lane & 15, 144, ks * 64);
                    acca = __builtin_amdgcn_mfma_f32_16x16x32_bf16(f1, f2, acca, 0, 0, 0); }
                mfma_drain();
#pragma unroll
                for (int e = 0; e < 4; ++e) { const int t = 4 * (lane >> 4) + e, ta_ = lane & 15; const bool strict = ta_ < t, incl = ta_ <= t; const float val = acca[e];
                    if (wave == 0) AAB[ta_ * 16 + t] = strict ? val : 0.f;
                    else if (wave == 1) *(LAS unsigned short*)(AK0 + t * 80 + 32 + ta_ * 2) = f2bf(strict ? val : 0.f);
                    else if (wave == 2) *(LAS unsigned short*)(ARK + t * 80 + ta_ * 2) = f2bf(incl ? val : 0.f);
                    else *(LAS unsigned short*)(ARK + t * 80 + 32 + ta_ * 2) = f2bf(incl ? val : 0.f); }
            } else {
#pragma unroll
                for (int ks = 0; ks < 2; ++ks) { const bf16x8 fr = FRAG(RT + c * 2304, lane & 15, 144, ks * 64), fs = FRAG(SB, 16 * (wave - 4) + (lane & 15), 144, ks * 64);
                    accx = __builtin_amdgcn_mfma_f32_16x16x32_bf16(fr, fs, accx, 0, 0, 0); }
            }
            if (c == 0) { RK_PREP_B2(1); }
            else if (more) { RK_PREP_B2(0); }
            wg_sync();
            if (wave < 4) { const bf16x8 fk = FRAG(AK0, lane & 15, 80, 0), fv = FRAG(UVt + c * 5120, 16 * wave + (lane & 15), 80, 0);
                accx = __builtin_amdgcn_mfma_f32_16x16x32_bf16(fk, fv, accx, 0, 0, 0);
                mfma_drain();
#pragma unroll
                for (int e = 0; e < 4; ++e) XF[(4 * (lane >> 4) + e) * 64 + 16 * wave + (lane & 15)] = accx[e]; }
            if (c == 0 && more) { RK_PREP_A(); }
            wg_sync();
            if (wave == 0) { float uu[16];
#pragma unroll
                for (int t = 0; t < 16; ++t) uu[t] = XF[t * 64 + lane];
#pragma unroll
                for (int q = 0; q < 15; ++q) { const f32x4 c0 = *(const LAS f32x4*)(AAB + q * 16), c1 = *(const LAS f32x4*)(AAB + q * 16 + 4), c2 = *(const LAS f32x4*)(AAB + q * 16 + 8), c3 = *(const LAS f32x4*)(AAB + q * 16 + 12);
                    const float col[16] = {c0[0], c0[1], c0[2], c0[3], c1[0], c1[1], c1[2], c1[3], c2[0], c2[1], c2[2], c2[3], c3[0], c3[1], c3[2], c3[3]};
#pragma unroll
                    for (int t = q + 1; t < 16; ++t) uu[t] += col[t] * uu[q];
                    if (q & 1) asm volatile("" ::: "memory"); }
                uint4 p0, p1; p0.x = pk2(uu[0], uu[1]); p0.y = pk2(uu[2], uu[3]); p0.z = pk2(uu[4], uu[5]); p0.w = pk2(uu[6], uu[7]); p1.x = pk2(uu[8], uu[9]); p1.y = pk2(uu[10], uu[11]); p1.z = pk2(uu[12], uu[13]); p1.w = pk2(uu[14], uu[15]);
                u32x4 q0, q1; q0.x = p0.x; q0.y = p0.y; q0.z = p0.z; q0.w = p0.w; q1.x = p1.x; q1.y = p1.y; q1.z = p1.z; q1.w = p1.w;
                *(LAS u32x4*)(UVt + c * 5120 + lane * 80) = q0; *(LAS u32x4*)(UVt + c * 5120 + lane * 80 + 16) = q1; }
            wg_sync();
            if (wave >= 4) { const bf16x8 fr = FRAG(ARK, lane & 15, 80, 0), fu = FRAG(UVt + c * 5120, 16 * (wave - 4) + (lane & 15), 80, 0);
                accx = __builtin_amdgcn_mfma_f32_16x16x32_bf16(fr, fu, accx, 0, 0, 0);
                mfma_drain();
#pragma unroll
                for (int e = 0; e < 4; ++e) { const int t = 4 * (lane >> 4) + e, u = d ? 31 - 16 * c - t : 16 * c + t; YB[u * 64 + 16 * (wave - 4) + (lane & 15)] = accx[e]; } }
            { const int kt = wave & 3; const bf16x8 fb = FRAG(BKt + c * 5120, 16 * kt + (lane & 15), 80, 0);
#pragma unroll
                for (int x = 0; x < 2; ++x) { const int it = 2 * (wave >> 2) + x; const bf16x8 fu = FRAG(UVt + c * 5120, 16 * it + (lane & 15), 80, 0);
                    Sacc[x] = __builtin_amdgcn_mfma_f32_16x16x32_bf16(fb, fu, Sacc[x], 0, 0, 0); }
                mfma_drain();
                const f32x4 gl = *(const LAS f32x4*)(GL + c * 64 + 16 * kt + 4 * (lane >> 4));
#pragma unroll
                for (int x = 0; x < 2; ++x) { const int it = 2 * (wave >> 2) + x; Sacc[x] *= gl;
                    u32x2 w_; w_.x = pk2(Sacc[x][0], Sacc[x][1]); w_.y = pk2(Sacc[x][2], Sacc[x][3]);
                    *(LAS u32x2*)(SB + (16 * it + (lane & 15)) * 144 + (16 * kt + 4 * (lane >> 4)) * 2) = w_; } }
            if (c == 0 && more) { const size_t Rb1 = (size_t)b * SP + RK_SLO(kb + 1); const int kl = (kb + 2 < NBLK) ? kb + 2 : -1; RK_PREP_B1(Rb1, kl); }
            wg_sync();
        }
        { const int o = etok * 64 + 4 * ecg; u32x2 w; w.x = pk2(YB[o], YB[o + 1]); w.y = pk2(YB[o + 2], YB[o + 3]); *(u32x2*)(Y + (Rb + etok) * 1024 + ec) = w; }
    }
#undef RK_PREP_A
#undef RK_PREP_B1
#undef RK_PREP_B2
#undef FRAG
#undef RK_GLOAD
#undef RK_SLO
}

#define RK_CENSUS_LDS 163812
PHASE_FN void phase_rkscan4(const bf16_t* Rr, const bf16_t* Kk, const bf16_t* Vv, const bf16_t* T, const float* w0, const float* w2, const float* a0, const float* a2,
                            const float* k_k, const float* k_a, const float* r_k, bf16_t* Yf, bf16_t* Yb, float* bon, LAS unsigned char* L, int bid, int nb, unsigned long long* prof = nullptr) {
    if (bid >= 256) return;
    unsigned long long ps0 = 0, ps1 = 0, ps2 = 0, ps3 = 0, ps4 = 0, ps5 = 0, pt = 0;
#define RKP(k) do { if (prof) { const unsigned long long n_ = clock64(); ps##k += n_ - pt; pt = n_; } } while (0)
    const int tid0 = tid_opq(), lane = tid0 & 63, lane0 = lane;
    int role, widx;
    {   const unsigned simd = ((unsigned)__builtin_amdgcn_s_getreg((1 << 11) | (4 << 6) | 4)) & 3u;
        unsigned old = 0u;
        if (lane == 0) old = __hip_atomic_fetch_add((LAS unsigned*)RK_CENSUS_LDS, 1u << (8u * simd), __ATOMIC_RELAXED, __HIP_MEMORY_SCOPE_WORKGROUP);
        old = (unsigned)__builtin_amdgcn_readfirstlane((int)old);
        wg_sync();
        const unsigned all = *(volatile LAS unsigned*)RK_CENSUS_LDS;
        const unsigned mine = (old >> (8u * simd)) & 0xffu;
        if (all == 0x02020202u) { role = (int)mine; widx = (int)simd; } else { role = (tid0 >> 6) >> 2; widx = (tid0 >> 6) & 3; }
        role = __builtin_amdgcn_readfirstlane(role); widx = __builtin_amdgcn_readfirstlane(widx); }
    const int gtid = role * 256 + widx * 64 + lane;
    const int b = bid >> 5, h = (bid >> 1) & 15, d = bid & 1;
    LAS float* WB = (LAS float*)L; LAS float* AD = WB + 2176; LAS float* RB = AD + 2176; LAS float* KD = RB + 2176; LAS float* VB = KD + 2176; LAS float* AB = VB + 2176; LAS float* BB = AB + 2176;
    LAS float* WB2 = (LAS float*)(L + 130048);
    LAS float* YB = (LAS float*)(L + 121856);
    LAS unsigned char* AT = L + 65536; LAS unsigned char* RT = L + 70144; LAS unsigned char* BT = L + 74752; LAS unsigned char* KT = L + 79360;
    LAS unsigned char* BKt = L + 83968; LAS unsigned char* UVt = L + 94208;
    LAS unsigned char* SB = L + 104448;
    LAS unsigned char* ARK = L + 113664; LAS unsigned char* AK0 = L + 114944;
    LAS float* AAB = (LAS float*)(L + 116224); LAS float* XF = (LAS float*)(L + 117248); LAS float* GL = (LAS float*)(L + 121344);
    bf16_t* Y = d ? Yb : Yf;
    const int ptid = widx * 64 + lane, ct = widx;
    bf16x8 bw[2], ba[2];
    float w0c = 0.f, a0c = 0.f;
    const int ecg = ptid & 15, ec = 64 * h + 4 * ecg, etok0 = ptid >> 4;
    float4 kk4 = make_float4(0.f, 0.f, 0.f, 0.f), ka4 = kk4, rk4 = kk4;
    if (role == 1) {
#pragma unroll
        for (int ks = 0; ks < 2; ++ks) { float fw[8], fa[8];
#pragma unroll
            for (int j = 0; j < 8; ++j) { const int m = 8 * (lane >> 4) + j + 32 * ks, cc = 64 * h + 16 * ct + (lane & 15); fw[j] = w2[((size_t)d * 64 + m) * 1024 + cc]; fa[j] = a2[((size_t)d * 64 + m) * 1024 + cc]; }
            const uint4 pw = pack8(fw), pa = pack8(fa); bw[ks] = *(const bf16x8*)&pw; ba[ks] = *(const bf16x8*)&pa; }
        const int cch = 64 * h + 16 * ct + (lane & 15);
        w0c = w0[d * 1024 + cch]; a0c = a0[d * 1024 + cch];
        kk4 = *(const float4*)(k_k + ec); ka4 = *(const float4*)(k_a + ec); rk4 = *(const float4*)(r_k + ec);
    } else { const uint4 z = make_uint4(0u, 0u, 0u, 0u); bw[0] = *(const bf16x8*)&z; bw[1] = bw[0]; ba[0] = bw[0]; ba[1] = bw[0]; }
    for (int i = gtid; i < (121856 - 83968) / 4; i += NTHR) ((LAS unsigned*)(L + 83968))[i] = 0u;
    f32x4 Sacc[4];
#pragma unroll
    for (int x = 0; x < 4; ++x) Sacc[x] = (f32x4){0.f, 0.f, 0.f, 0.f};
#define RK_SLO(kb_) (d ? ((kb_) < 8 ? CTXL - 32 * ((kb_) + 1) : SP - 32 * ((kb_) - 8 + 1)) : 32 * (kb_))
    uint4 tw[2][2], ta[2][2]; u32x2 rw[2], kw[2], vw[2];
#define RK_GLOAD_T(kb_) do { const size_t Rn_ = (size_t)b * SP + RK_SLO(kb_); \
        _Pragma("unroll") for (int tt = 0; tt < 2; ++tt) { const bf16_t* trow_ = T + (Rn_ + 16 * tt + (lane & 15)) * 256 + 8 * (lane >> 4); \
            _Pragma("unroll") for (int ks = 0; ks < 2; ++ks) { tw[tt][ks] = *(const uint4*)(trow_ + 64 * d + 32 * ks); ta[tt][ks] = *(const uint4*)(trow_ + 128 + 64 * d + 32 * ks); } } } while (0)
#define RK_GLOAD_RKV(kb_) do { const size_t Rn_ = (size_t)b * SP + RK_SLO(kb_); \
        _Pragma("unroll") for (int j = 0; j < 2; ++j) { const size_t g_ = (Rn_ + etok0 + 16 * j) * 1024 + ec; rw[j] = *(const u32x2*)(Rr + g_); kw[j] = *(const u32x2*)(Kk + g_); vw[j] = *(const u32x2*)(Vv + g_); } } while (0)
#define FRAG(base, row, pitchB, koffB) (*(const LAS bf16x8*)((base) + (row) * (pitchB) + (koffB) + (lane >> 4) * 16))
#define RK_SHADOW int lane = lane0; asm volatile("" : "+v"(lane)); const int ptid = widx * 64 + lane, ecg = ptid & 15, ec = 64 * h + 4 * ecg, etok0 = ptid >> 4; (void)ec; (void)etok0; (void)ecg
#define RK_PREP_A(WBD) do { _Pragma("unroll") for (int tt = 0; tt < 2; ++tt) { f32x4 dw = (f32x4){0.f, 0.f, 0.f, 0.f}, da = (f32x4){0.f, 0.f, 0.f, 0.f}; \
        _Pragma("unroll") for (int ks = 0; ks < 2; ++ks) { \
            dw = __builtin_amdgcn_mfma_f32_16x16x32_bf16(*(const bf16x8*)&tw[tt][ks], bw[ks], dw, 0, 0, 0); \
            da = __builtin_amdgcn_mfma_f32_16x16x32_bf16(*(const bf16x8*)&ta[tt][ks], ba[ks], da, 0, 0, 0); } \
        mfma_drain(); \
        _Pragma("unroll") for (int e = 0; e < 4; ++e) { const int tok = 16 * tt + 4 * (lane >> 4) + e, cc = 16 * ct + (lane & 15); \
            (WBD)[tok * 68 + cc] = -0.8750388f * __builtin_amdgcn_rcpf(1.f + __expf(-(w0c + dw[e])));     \
            AD[tok * 68 + cc] = __builtin_amdgcn_rcpf(1.f + __expf(-(a0c + da[e]))); } } } while (0)
#define RK_PREP_B1(Rb_, kl_) do { \
        float r[2][4], k[2][4], v[2][4]; \
        _Pragma("unroll") for (int j = 0; j < 2; ++j) { r[j][0] = bflo(rw[j].x); r[j][1] = bfhi(rw[j].x); r[j][2] = bflo(rw[j].y); r[j][3] = bfhi(rw[j].y); k[j][0] = bflo(kw[j].x); k[j][1] = bfhi(kw[j].x); k[j][2] = bflo(kw[j].y); k[j][3] = bfhi(kw[j].y); \
            v[j][0] = bflo(vw[j].x); v[j][1] = bfhi(vw[j].x); v[j][2] = bflo(vw[j].y); v[j][3] = bfhi(vw[j].y); } \
        if ((kl_) >= 0) RK_GLOAD_RKV(kl_); \
        const float kkc[4] = {kk4.x, kk4.y, kk4.z, kk4.w}, kac[4] = {ka4.x, ka4.y, ka4.z, ka4.w}, rkc[4] = {rk4.x, rk4.y, rk4.z, rk4.w}; \
        _Pragma("unroll") for (int j = 0; j < 2; ++j) { const int etok = etok0 + 16 * j; float kr[4], ss = 0.f; \
            _Pragma("unroll") for (int e = 0; e < 4; ++e) { kr[e] = k[j][e] * kkc[e]; ss += kr[e] * kr[e]; } \
            ss = red16(ss); const float inv = __builtin_amdgcn_rsqf(fmaxf(ss, 1e-24f)); float bs = 0.f; \
            const int o4 = etok * 68 + 4 * ecg; const f32x4 ad4 = *(const LAS f32x4*)(AD + o4); f32x4 r4, kd4, v4, a4, b4; \
            _Pragma("unroll") for (int e = 0; e < 4; ++e) { const float ad = ad4[e], kkn = kr[e] * inv, kd = k[j][e] * (1.f + (ad - 1.f) * kac[e]); \
                r4[e] = r[j][e]; kd4[e] = kd; v4[e] = v[j][e]; a4[e] = -kkn; b4[e] = kkn * ad; bs += r[j][e] * kd * rkc[e]; } \
            *(LAS f32x4*)(RB + o4) = r4; *(LAS f32x4*)(KD + o4) = kd4; *(LAS f32x4*)(VB + o4) = v4; *(LAS f32x4*)(AB + o4) = a4; *(LAS f32x4*)(BB + o4) = b4; \
            bs = red16(bs); if (ecg == 0) bon[((size_t)d * NTOK + (Rb_) + etok) * 16 + h] = bs; } } while (0)
    typedef float f32x2w __attribute__((ext_vector_type(2)));
#define RK_PREP_B2(c_, half_, WBS) do { const int t = ptid & 15, kk0 = 2 * ((ptid >> 4) + 16 * (half_)); const int u = d ? 31 - 16 * (c_) - t : 16 * (c_) + t; const int o = u * 68 + kk0; \
        const f32x2w lw = *(const LAS f32x2w*)((WBS) + o), a2_ = *(const LAS f32x2w*)(AB + o), r2_ = *(const LAS f32x2w*)(RB + o), b2_ = *(const LAS f32x2w*)(BB + o), k2_ = *(const LAS f32x2w*)(KD + o), v2_ = *(const LAS f32x2w*)(VB + o); \
        float cs0 = lw[0], cs1 = lw[1]; \
        cs0 += dppz<0x111>(cs0); cs1 += dppz<0x111>(cs1); cs0 += dppz<0x112>(cs0); cs1 += dppz<0x112>(cs1); cs0 += dppz<0x114>(cs0); cs1 += dppz<0x114>(cs1); cs0 += dppz<0x118>(cs0); cs1 += dppz<0x118>(cs1); \
        const float g0 = __builtin_amdgcn_exp2f(cs0), gp0 = __builtin_amdgcn_exp2f(cs0 - lw[0]), ig0 = __builtin_amdgcn_exp2f(-cs0), g1 = __builtin_amdgcn_exp2f(cs1), gp1 = __builtin_amdgcn_exp2f(cs1 - lw[1]), ig1 = __builtin_amdgcn_exp2f(-cs1); \
        const unsigned avp = pk2(a2_[0] * gp0, a2_[1] * gp1), rvp = pk2(r2_[0] * g0, r2_[1] * g1), bvp = pk2(b2_[0] * ig0, b2_[1] * ig1), kvp = pk2(k2_[0] * ig0, k2_[1] * ig1), vvp = pk2(v2_[0], v2_[1]); \
        const int ro = (c_) * 2304 + t * 144 + kk0 * 2; \
        *(LAS unsigned*)(AT + ro) = avp; *(LAS unsigned*)(RT + ro) = rvp; *(LAS unsigned*)(BT + ro) = bvp; *(LAS unsigned*)(KT + ro) = kvp; \
        LAS unsigned char* bk_ = BKt + (c_) * 5120 + kk0 * 80 + t * 2; LAS unsigned char* uv_ = UVt + (c_) * 5120 + kk0 * 80 + 32 + t * 2; \
        *(LAS unsigned short*)(bk_) = (unsigned short)(bvp & 0xffffu); *(LAS unsigned short*)(bk_ + 80) = (unsigned short)(bvp >> 16); \
        *(LAS unsigned short*)(bk_ + 32) = (unsigned short)(kvp & 0xffffu); *(LAS unsigned short*)(bk_ + 112) = (unsigned short)(kvp >> 16); \
        *(LAS unsigned short*)(uv_) = (unsigned short)(vvp & 0xffffu); *(LAS unsigned short*)(uv_ + 80) = (unsigned short)(vvp >> 16); \
        if (t == 15) { f32x2w gg; gg[0] = g0; gg[1] = g1; *(LAS f32x2w*)(GL + (c_) * 64 + kk0) = gg; } } while (0)
    if (role == 1) { RK_SHADOW; RK_GLOAD_T(0); RK_GLOAD_RKV(0); }
    wg_sync();
    if (role == 1) { RK_SHADOW; RK_PREP_A(WB); RK_GLOAD_T(1); }
    wg_sync();
    if (role == 1) { RK_SHADOW; const size_t Rb0 = (size_t)b * SP + RK_SLO(0); RK_PREP_B1(Rb0, 1); }
    wg_sync();
    if (role == 1) { { RK_SHADOW; RK_PREP_A(WB2); RK_GLOAD_T(2); } { RK_SHADOW; RK_PREP_B2(0, 0, WB); } { RK_SHADOW; RK_PREP_B2(0, 1, WB); } }
    wg_sync();
    constexpr int NBLK = SP / 32;
    for (int kb = 0; kb < NBLK; ++kb) {
        const int slo = RK_SLO(kb);
        const size_t Rb = (size_t)b * SP + slo;
        const bool more = (kb + 1 < NBLK);
        LAS float* WBc = (kb & 1) ? WB2 : WB; LAS float* WBn = (kb & 1) ? WB : WB2;
        if (prof) { if (kb == 0) pt = clock64(); else RKP(5); }
#pragma unroll
        for (int c = 0; c < 2; ++c) {
            f32x4 accx = (f32x4){0.f, 0.f, 0.f, 0.f}, acca = (f32x4){0.f, 0.f, 0.f, 0.f}, accy = (f32x4){0.f, 0.f, 0.f, 0.f};
            if (role == 0) { RK_SHADOW;
                LAS unsigned char* Aa = (widx < 2) ? AT : RT; LAS unsigned char* Bb = (widx & 1) ? KT : BT;
#pragma unroll
                for (int ks = 0; ks < 2; ++ks) { const bf16x8 fa = FRAG(AT + c * 2304, lane & 15, 144, ks * 64), fs = FRAG(SB, 16 * widx + (lane & 15), 144, ks * 64), fr = FRAG(RT + c * 2304, lane & 15, 144, ks * 64);
                    accx = __builtin_amdgcn_mfma_f32_16x16x32_bf16(fa, fs, accx, 0, 0, 0);
                    accy = __builtin_amdgcn_mfma_f32_16x16x32_bf16(fr, fs, accy, 0, 0, 0);
                    const bf16x8 f1 = FRAG(Aa + c * 2304, lane & 15, 144, ks * 64), f2 = FRAG(Bb + c * 2304, lane & 15, 144, ks * 64);
                    acca = __builtin_amdgcn_mfma_f32_16x16x32_bf16(f1, f2, acca, 0, 0, 0); }
                mfma_drain();
#pragma unroll
                for (int e = 0; e < 4; ++e) { const int t = 4 * (lane >> 4) + e, ta_ = lane & 15; const bool strict = ta_ < t, incl = ta_ <= t; const float val = acca[e];
                    if (widx == 0) { }
                    else if (widx == 1) *(LAS unsigned short*)(AK0 + t * 80 + 32 + ta_ * 2) = f2bf(strict ? val : 0.f);
                    else if (widx == 2) *(LAS unsigned short*)(ARK + t * 80 + ta_ * 2) = f2bf(incl ? val : 0.f);
                    else *(LAS unsigned short*)(ARK + t * 80 + 32 + ta_ * 2) = f2bf(incl ? val : 0.f); }
            } else { RK_SHADOW;
                if (c == 0) { RK_PREP_B2(1, 0, WBc); }
                else if (more) { RK_PREP_B2(0, 0, WBn); }
            }
            wg_sync(); RKP(0);
            if (role == 0) { RK_SHADOW; const bf16x8 fk = FRAG(AK0, lane & 15, 80, 0), fv = FRAG(UVt + c * 5120, 16 * widx + (lane & 15), 80, 0);
                accx = __builtin_amdgcn_mfma_f32_16x16x32_bf16(fk, fv, accx, 0, 0, 0);
                mfma_drain();
#pragma unroll
                for (int e = 0; e < 4; ++e) XF[(4 * (lane >> 4) + e) * 64 + 16 * widx + (lane & 15)] = accx[e];
            } else { RK_SHADOW;
                if (c == 0) { RK_PREP_B2(1, 1, WBc); }
                else if (more) { RK_PREP_B2(0, 1, WBn); }
            }
            wg_sync(); RKP(1);
            if (role == 0) { RK_SHADOW;
                if (widx == 0) { float uu[16];
#pragma unroll
                    for (int t = 0; t < 16; ++t) uu[t] = XF[t * 64 + lane];
#pragma unroll
                    for (int q = 0; q < 15; ++q) {
#pragma unroll
                        for (int t = q + 1; t < 16; ++t) { const float aq = __int_as_float(__builtin_amdgcn_readlane(__float_as_int(acca[t & 3]), q + 16 * (t >> 2))); uu[t] += aq * uu[q]; } }
                    uint4 p0, p1; p0.x = pk2(uu[0], uu[1]); p0.y = pk2(uu[2], uu[3]); p0.z = pk2(uu[4], uu[5]); p0.w = pk2(uu[6], uu[7]); p1.x = pk2(uu[8], uu[9]); p1.y = pk2(uu[10], uu[11]); p1.z = pk2(uu[12], uu[13]); p1.w = pk2(uu[14], uu[15]);
                    u32x4 q0, q1; q0.x = p0.x; q0.y = p0.y; q0.z = p0.z; q0.w = p0.w; q1.x = p1.x; q1.y = p1.y; q1.z = p1.z; q1.w = p1.w;
                    *(LAS u32x4*)(UVt + c * 5120 + lane * 80) = q0; *(LAS u32x4*)(UVt + c * 5120 + lane * 80 + 16) = q1; }
            } else { RK_SHADOW;
                if (c == 0) { if (more) { const size_t Rb1 = (size_t)b * SP + RK_SLO(kb + 1); const int kl = (kb + 2 < NBLK) ? kb + 2 : -1; RK_PREP_B1(Rb1, kl); } }
                else if (kb + 2 < NBLK) { RK_PREP_A(WBc); if (kb + 3 < NBLK) RK_GLOAD_T(kb + 3); }
            }
            wg_sync(); RKP(2);
            if (role == 0) { RK_SHADOW;
                { const bf16x8 fr = FRAG(ARK, lane & 15, 80, 0), fu = FRAG(UVt + c * 5120, 16 * widx + (lane & 15), 80, 0);
                    accy = __builtin_amdgcn_mfma_f32_16x16x32_bf16(fr, fu, accy, 0, 0, 0); }
                const int kt = widx; const bf16x8 fb = FRAG(BKt + c * 5120, 16 * kt + (lane & 15), 80, 0);
#pragma unroll
                for (int x = 0; x < 4; ++x) { const bf16x8 fu = FRAG(UVt + c * 5120, 16 * x + (lane & 15), 80, 0);
                    Sacc[x] = __builtin_amdgcn_mfma_f32_16x16x32_bf16(fb, fu, Sacc[x], 0, 0, 0); }
                mfma_drain();
#pragma unroll
                for (int e = 0; e < 4; ++e) { const int t = 4 * (lane >> 4) + e, u = d ? 31 - 16 * c - t : 16 * c + t; YB[u * 64 + 16 * widx + (lane & 15)] = accy[e]; }
                const f32x4 gl = *(const LAS f32x4*)(GL + c * 64 + 16 * kt + 4 * (lane >> 4));
#pragma unroll
                for (int x = 0; x < 4; ++x) { Sacc[x] *= gl;
                    u32x2 w_; w_.x = pk2(Sacc[x][0], Sacc[x][1]); w_.y = pk2(Sacc[x][2], Sacc[x][3]);
                    *(LAS u32x2*)(SB + (16 * x + (lane & 15)) * 144 + (16 * kt + 4 * (lane >> 4)) * 2) = w_; }
            } else { RK_SHADOW;
            }
            wg_sync(); if (c == 0) RKP(3); else RKP(4);
        }
        { const int etok = gtid >> 4, eg = gtid & 15; const int o = etok * 64 + 4 * eg; u32x2 w; w.x = pk2(YB[o], YB[o + 1]); w.y = pk2(YB[o + 2], YB[o + 3]); *(u32x2*)(Y + (Rb + etok) * 1024 + 64 * h + 4 * eg) = w; }
    }
#undef RK_PREP_A
#undef RK_PREP_B1
#undef RK_PREP_B2
#undef FRAG
#undef RK_SHADOW
#undef RK_GLOAD_T
#undef RK_GLOAD_RKV
    if (prof && bid == 0 && gtid == 0) { prof[0] = ps0; prof[1] = ps1; prof[2] = ps2; prof[3] = ps3; prof[4] = ps4; prof[5] = ps5; }
#undef RKP
#undef RK_SLO
}


PHASE_FN void phase_fin_rk(const bf16_t* Yf, const bf16_t* Yb, const bf16_t* Vv, bf16_t* G, const float* bon, const float* gng, const float* gnb, int bid, int nb) {
    const int tid = tid_opq(), lane = tid & 63, wv = tid >> 6;
    const int hd = lane >> 2, c0 = 64 * hd + 16 * (lane & 3);
    float gqv[16], bqv[16];
#pragma unroll
    for (int u = 0; u < 4; ++u) { const float4 g_ = *(const float4*)(gng + c0 + 4 * u), b_ = *(const float4*)(gnb + c0 + 4 * u);
        gqv[4 * u] = g_.x; gqv[4 * u + 1] = g_.y; gqv[4 * u + 2] = g_.z; gqv[4 * u + 3] = g_.w; bqv[4 * u] = b_.x; bqv[4 * u + 1] = b_.y; bqv[4 * u + 2] = b_.z; bqv[4 * u + 3] = b_.w; }
    for (int R = bid * 8 + wv; R < NTOK; R += nb * 8) {
        const size_t base = (size_t)R * 1024 + c0;
        float y[16]; float s1 = 0.f;
#pragma unroll
        for (int u = 0; u < 2; ++u) { float a[8], b[8]; unpack8(*(const uint4*)(Yf + base + 8 * u), a); unpack8(*(const uint4*)(Yb + base + 8 * u), b);
#pragma unroll
            for (int e = 0; e < 8; ++e) { y[8 * u + e] = a[e] + b[e]; s1 += y[8 * u + e]; } }
        s1 = red4(s1); const float mu = s1 * (1.f / 64.f); float s2 = 0.f;
#pragma unroll
        for (int e = 0; e < 16; ++e) { const float dd = y[e] - mu; s2 += dd * dd; }
        s2 = red4(s2); const float rn = rsqrtf(s2 * (1.f / 64.f) + 64e-5f);
        const float bsum = bon[(size_t)R * 16 + hd] + bon[((size_t)NTOK + R) * 16 + hd];
#pragma unroll
        for (int u = 0; u < 2; ++u) { float v[8], g[8], w[8]; unpack8(*(const uint4*)(Vv + base + 8 * u), v); unpack8(*(const uint4*)(G + base + 8 * u), g);
#pragma unroll
            for (int e = 0; e < 8; ++e) { w[e] = ((y[8 * u + e] - mu) * rn * gqv[8 * u + e] + bqv[8 * u + e] + bsum * v[e]) * siluf(g[e]); }
            *(uint4*)(G + base + 8 * u) = pack8(w); }
    }
}

PHASE_FN void wcvt_ret(const float* w_in, const float* w_out, bf16_t* W, LAS unsigned char* L, int bid, int nb) {
    LAS float* T = (LAS float*)L; int tb = 0;
    cvt_tiles(W, 1024, 0, 6144, 1024, [=](int k, int n) -> float {
        int col = n; float sc = 1.f;
        if (n < 2048) { const int sec = n >> 10, hn = n & 1023, hh = hn >> 8, pp = hn & 255, hb = pp & 128, i2 = pp & 127, i = i2 >> 1; col = sec * 1024 + hh * 256 + hb + ((i2 & 1) ? 64 + i : i); if (sec == 1) sc = 0.0625f; }
        return w_in[(size_t)k * 6144 + col] * sc; }, T, bid, nb, tb);
    cvt_tiles(W + (size_t)6144 * 1024, 2048, 0, 1024, 2048, [=](int k, int n) -> float { return w_out[(size_t)k * 1024 + n]; }, T, bid, nb, tb);
}
PHASE_FN void wcvt_ml_in(const float* w_in, bf16_t* Wdst, LAS unsigned char* L, int bid, int nb) {
    LAS float* T = (LAS float*)L; int tb = 0;
    cvt_tiles(Wdst, 1024, 0, 4096, 1024, [=](int k, int n) -> float { return w_in[(size_t)k * 4096 + n]; }, T, bid, nb, tb);
}
PHASE_FN void wcvt_ml(const float* w_out, const float* wqkv, const float* gw, bf16_t* W, LAS unsigned char* L, int bid, int nb) {
    LAS float* T = (LAS float*)L; int tb = 0;
    cvt_tiles(W + (size_t)4096 * 1024, 2048, 0, 1024, 2048, [=](int k, int n) -> float { return w_out[(size_t)k * 1024 + n]; }, T, bid, nb, tb);
    bf16_t* Gt = W + (size_t)6144 * 1024;
    for (int idx = bid * NTHR + tid_opq(); idx < 65536; idx += nb * NTHR) { const int o = idx >> 12, c = idx & 4095, d = o >> 3, gi = o & 7; float val = 0.f;
        if (c < 2048) { const int grp = c >> 2, ci = c & 3;
#pragma unroll
            for (int eo = 0; eo < 4; ++eo) val += wqkv[(size_t)(grp) * 16 + ci * 4 + eo] * gw[((size_t)d * 6144 + 4 * grp + eo) * 8 + gi] + wqkv[(size_t)(512 + grp) * 16 + ci * 4 + eo] * gw[((size_t)d * 6144 + 2048 + 4 * grp + eo) * 8 + gi];
        } else { const int c2 = c - 2048, grp = c2 >> 2, ci = c2 & 3;
#pragma unroll
            for (int eo = 0; eo < 4; ++eo) val += wqkv[(size_t)(1024 + grp) * 16 + ci * 4 + eo] * gw[((size_t)d * 6144 + 4096 + 4 * grp + eo) * 8 + gi]; }
        Gt[idx] = (bf16_t)(pk2(val, 0.f) & 0xffffu); }
}
PHASE_FN void wcvt_rk(const float* mix, const float* wrkvg, const float* w1, const float* a1, const float* w_out, bf16_t* W, LAS unsigned char* L, int bid, int nb) {
    LAS float* T = (LAS float*)L; int tb = 0;
    cvt_tiles(W, 2048, 0, 4608, 2048, [=](int k, int n) -> float {
        const int kk = k & 1023; float w, mx;
        if (n < 4096) { const int j = n >> 10, cc = n & 1023; const int mj = (j == 0) ? 0 : (j == 1 ? 2 : (j == 2 ? 3 : 5)); w = wrkvg[((size_t)j * 1024 + kk) * 1024 + cc]; mx = mix[mj * 1024 + kk]; }
        else { const int n2 = n - 4096, blk = n2 >> 8, cc = n2 & 255; if (cc >= 128) return 0.f; const int d = cc >> 6, m = cc & 63;
            w = (blk == 0 ? w1 : a1)[((size_t)d * 1024 + kk) * 64 + m]; mx = mix[(blk == 0 ? 1 : 4) * 1024 + kk]; }
        return w * (k < 1024 ? 1.f - mx : mx); }, T, bid, nb, tb);
    cvt_tiles(W + (size_t)4608 * 2048, 1024, 0, 1024, 1024, [=](int k, int n) -> float { return w_out[(size_t)k * 1024 + n]; }, T, bid, nb, tb);
}

PHASE_FN void wcvt_rk2(const float* wrkvg, const float* w1, const float* a1, const float* w_out, bf16_t* W, LAS unsigned char* L, int bid, int nb) {
    LAS float* T = (LAS float*)L; int tb = 0;
    cvt_tiles(W, 1024, 0, 4608, 1024, [=](int k, int n) -> float {
        if (n < 4096) { const int j = n >> 10, cc = n & 1023; return wrkvg[((size_t)j * 1024 + k) * 1024 + cc]; }
        const int n2 = n - 4096, blk = n2 >> 8, cc = n2 & 255; if (cc >= 128) return 0.f; const int d = cc >> 6, mm = cc & 63;
        return (blk == 0 ? w1 : a1)[((size_t)d * 1024 + k) * 64 + mm]; }, T, bid, nb, tb);
    cvt_tiles(W + (size_t)4608 * 1024, 1024, 0, 1024, 1024, [=](int k, int n) -> float { return w_out[(size_t)k * 1024 + n]; }, T, bid, nb, tb);
}
PHASE_FN void wcvt_rk2a(const float* wrkvg, bf16_t* W, int nlo, LAS unsigned char* L, int bid, int nb) {
    LAS float* T = (LAS float*)L; int tb = 0;
    cvt_tiles(W + (size_t)nlo * 1024, 1024, 0, 2048, 1024, [=](int k, int n) -> float { const int n2 = n + nlo, j = n2 >> 10, cc = n2 & 1023; return wrkvg[((size_t)j * 1024 + k) * 1024 + cc]; }, T, bid, nb, tb);
}
PHASE_FN void wcvt_rk2b(const float* w1, const float* a1, const float* w_out, bf16_t* W, LAS unsigned char* L, int bid, int nb) {
    LAS float* T = (LAS float*)L; int tb = 0;
    cvt_tiles(W + (size_t)4096 * 1024, 1024, 0, 512, 1024, [=](int k, int n2) -> float {
        const int blk = n2 >> 8, cc = n2 & 255; if (cc >= 128) return 0.f; const int d = cc >> 6, mm = cc & 63;
        return (blk == 0 ? w1 : a1)[((size_t)d * 1024 + k) * 64 + mm]; }, T, bid, nb, tb);
    cvt_tiles(W + (size_t)4608 * 1024, 1024, 0, 1024, 1024, [=](int k, int n) -> float { return w_out[(size_t)k * 1024 + n]; }, T, bid, nb, tb);
}

#define R_Q ((bf16_t*)(S))
#define R_K ((bf16_t*)(S + U34))
#define R_V ((bf16_t*)(S + U68))
#define R_P ((bf16_t*)(S + 2 * U68))
#define R_KT ((bf16_t*)(S + 2 * U68 + U34))
#define R_VT ((bf16_t*)(S + 3 * U68))
#define R_OF ((bf16_t*)(S + 4 * U68))
#define R_OB ((bf16_t*)(S + 5 * U68))
#define R_CA(JJ) ChunkArgs ca{}; ca.qsrc = R_Q; ca.ksrc = R_K; ca.vsrc = R_V; ca.ldq = 1024; ca.ldv = 2048; ca.Kt = R_KT; ca.Vt = R_VT; ca.P = R_P; ca.Of = R_OF; ca.Ob = R_OB; ca.decay = IN(9) + (JJ) * 8
#define AH(half) (H + (size_t)(half) * NH * DM)
#define HB(half) ((half) * NH)
#define RET_QKV_ARGS(half) AH(half), W, NH, 4096, 1024, EpiRetQKV{R_Q, R_K, R_V, rope, HB(half)}
#define RET_OUT_ARGS(YM) R_VT, W + (size_t)6144 * 1024, NH, 1024, 2048, EpiBf{YM, 1024}
#define RET_MID(half, JJ, EXTRA, LASTF) \
        PHG(1, R_CA(JJ); (phase_s1<256, false>(ca, L, bid, nb))); \
        PHG(2, R_CA(JJ); if (bid < 128) phase_s2w(ca, L, bid, 128); else { gemm_run<EpiBf>(AH(half), W + (size_t)4096 * 1024, NH, 2048, 1024, EpiBf{R_V, 2048}, L, bid - 128, 128); EXTRA; }); \
        PHG(5, phase_fin_ret(R_OF, R_OB, R_V, R_VT, LASTF, bid, nb));
#define RET_LN_ROWS(half, YM, LI, XL_IN, XC_IN, RA, RB_, BID, NBL) \
        phase_ln(XL_IN, XC_IN, out, xctx, (const bf16_t*)(YM) + (size_t)(RA) * DM, mod + (size_t)(LI) * 9 * 3072, mod + (size_t)((LI) + 1) * 9 * 3072, IN(6) + (LI) * 1024, IN(7) + (LI) * 1024, H, HB(half) + (RA), HB(half) + (RB_), 0, BID, NBL)
#define RET_LN_CALL(half, YM, LI, XL_IN, XC_IN, LAST, BID, NBL) \
        phase_ln(XL_IN, XC_IN, out, xctx, (const bf16_t*)(YM), mod + (size_t)(LI) * 9 * 3072, mod + (size_t)((LI) + 1 < 4 ? (LI) + 1 : 3) * 9 * 3072, IN(6) + (LI) * 1024, IN(7) + (LI) * 1024, H, HB(half), HB(half) + NH, LAST, BID, NBL)
#define RET_LAYER(LI, JJ, XL_IN, XC_IN, LAST, NEXT_WCVT, PRE_EXTRA, FINAL_LN, OUT1) \
    { \
        PHG(10, gemm_run<EpiRetQKV, GSTAMP != 0>(RET_QKV_ARGS(0), L, bid, nb, GSTAMP_PTR)); \
        RET_MID(0, JJ, PRE_EXTRA, LAST) \
        PHG(12, gemm_dual(RET_OUT_ARGS(AH(0)), 1, 0, RET_QKV_ARGS(1), 3, 16, L, bid, nb, LAST)); \
        RET_MID(1, JJ, RET_LN_CALL(0, AH(0), LI, XL_IN, XC_IN, LAST, bid - 128, 128), LAST) \
        PHG(12, OUT1); \
        PHG(6, FINAL_LN; NEXT_WCVT); \
    }
#define M_XM ((bf16_t*)(S))
#define M_XC ((bf16_t*)(S + U68))
#define M_KT ((bf16_t*)(S + 2 * U68))
#define M_VT ((bf16_t*)(S + 3 * U68))
#define M_P ((bf16_t*)(S + 4 * U68))
#define M_OB ((bf16_t*)(S + 4 * U68 + U34))
#define M_GAR ((float*)(S + 5 * U68 + U34))
#define M_GG (M_GAR)
#define M_GPM (M_GAR + 2 * 16 * SP)
#define M_GB (M_GAR + 4 * 16 * SP)
#define M_RS (M_GAR + 6 * 16 * SP)
#define M_CBL (M_GAR + 8 * 16 * SP)
#define M_CPML (M_GAR + 8 * 16 * SP + 2 * 16 * NCH)
#define M_CA ChunkArgs ca{}; ca.qsrc = M_XC; ca.ksrc = M_XC; ca.vsrc = M_XM; ca.ldq = 2048; ca.ldv = 2048; ca.Kt = M_KT; ca.Vt = M_VT; ca.P = M_P; ca.Of = M_XM; ca.Ob = M_OB; ca.wqkv = IN(14); \
        ca.gG = M_GG; ca.gPM = M_GPM; ca.gB = M_GB; ca.cBL = M_CBL; ca.cPML = M_CPML; ca.RS = M_RS
#define K_A2 ((bf16_t*)(S))
#define K_RKVG ((bf16_t*)(S + 2 * U68))
#define K_T (H)
#define K_BON ((float*)((unsigned char*)H + 17 * MiB))
#define K_R (K_RKVG)
#define K_K (K_RKVG + (size_t)NTOK * 1024)
#define K_V (K_RKVG + (size_t)2 * NTOK * 1024)
#define K_G (K_RKVG + (size_t)3 * NTOK * 1024)
#define K_YF ((bf16_t*)(S))
#define K_YB ((bf16_t*)(S + U68))

#define ML_MID(half, PREP) \
        PHG(4, PREP); \
        PHG(17, M_CA; (phase_s1<512, true>(ca, L, bid, nb))); \
        PHG(18, M_CA; (phase_s2<512, true>(ca, L, bid, nb))); \
        PHG(16, gemm_run<EpiBf>(AH(half), W_MLIN + (size_t)2048 * 1024, NH, 2048, 1024, EpiBf{M_KT, 2048}, L, bid, nb)); \
        PHG(5, phase_fin_ml(M_XM, M_OB, M_XC, M_KT, IN(18), IN(17), bid, nb));
#define ML_PREP(BID, NBL) phase_mlprep(M_XM, M_XC, W + (size_t)6144 * 1024, IN(12), IN(13), IN(16), M_GG, M_GPM, M_GB, M_CBL, M_CPML, L, BID, NBL)
#define W_MLIN (W + (size_t)8192 * 1024)
#define ML_XM_ARGS(half) AH(half), W_MLIN, NH, 2048, 1024, EpiBf{M_XM, 2048}
#define ML_OUT_ARGS(YM) M_KT, W + (size_t)4096 * 1024, NH, 1024, 2048, EpiBf{YM, 1024}
#define ML_LN_CALL(half, YM, BID, NBL) \
        phase_ln(out, xctx, out, xctx, (const bf16_t*)(YM), mod + (size_t)1 * 9 * 3072, mod + (size_t)2 * 9 * 3072, IN(6) + 1024, IN(7) + 1024, H, HB(half), HB(half) + NH, 0, BID, NBL)
#define LN_SPLIT 17408
#define ML_LN_ROWS(half, YM, RA, RB_, BID, NBL) \
        phase_ln(out, xctx, out, xctx, (const bf16_t*)(YM) + (size_t)(RA) * DM, mod + (size_t)1 * 9 * 3072, mod + (size_t)2 * 9 * 3072, IN(6) + 1024, IN(7) + 1024, H, HB(half) + (RA), HB(half) + (RB_), 0, BID, NBL)
#define ML_LAYER(NEXT_WCVT, PREV_LN, PREV_LN_TAIL) \
    { \
        ML_MID(0, if (bid < 136) { ML_PREP(bid, 136); PREV_LN_TAIL; } else { PREV_LN; }) \
        PHG(15, gemm_dual(ML_OUT_ARGS(AH(0)), 1, 0, ML_XM_ARGS(1), 1, 16, L, bid, nb)); \
        ML_MID(1, if (bid < 136) { ML_PREP(bid, 136); ML_LN_ROWS(0, AH(0), LN_SPLIT, NH, bid, 136); } else { ML_LN_ROWS(0, AH(0), 0, LN_SPLIT, bid - 136, 120); wcvt_rk2a(IN(21), W, 2048, L, bid - 136, 120); }) \
        PHG(15, gemm_run<EpiBf>(ML_OUT_ARGS(M_VT), L, bid, nb)); \
        PHG(6, ML_LN_CALL(1, M_VT, bid, nb); NEXT_WCVT); \
    }

#ifndef HOTPROBE
#define HOTPROBE 0
#endif
#if HOTPROBE
#define HOTPHASE PHG(7, gemm_hot(H, W, (bf16_t*)(S + 64 * MiB), 0, 1024, L, bid, nb, GSTAMP_PTR)); \
    PHG(7, gemm_hot((const bf16_t*)S, (const bf16_t*)(S + 40 * MiB), (bf16_t*)(S + 64 * MiB), 0, 1024, L, bid, nb, GSTAMP_PTR + 16384));
#else
#define HOTPHASE
#endif
#define FORWARD_PROGRAM() \
    PHG(7, phase_mod(IN(1), IN(3), IN(4), IN(5), mod, rope, L, bid, nb); wcvt_ret(IN(8), IN(10), W, L, bid, nb)); \
    PHG(7, phase_h0(IN(0), IN(2), mod, H, 0, NH, bid, nb)); \
    HOTPHASE \
    RET_LAYER(0, 0, IN(0), IN(2), 0, wcvt_ml(IN(19), IN(14), IN(15), W, L, bid, nb), phase_h0(IN(0), IN(2), mod, H, NH, NTOK, bid - 128, 128); wcvt_ml_in(IN(11), W_MLIN, L, bid - 128, 128), (void)0, \
              gemm_dual(RET_OUT_ARGS(R_P), 1, 0, ML_XM_ARGS(0), 1, 16, L, bid, nb)) \
    ML_LAYER(wcvt_rk2b(IN(23), IN(26), IN(33), W, L, bid, nb), RET_LN_ROWS(1, R_P, 0, IN(0), IN(2), 0, LN_SPLIT, bid - 136, 120); wcvt_rk2a(IN(21), W, 0, L, bid - 136, 120), RET_LN_ROWS(1, R_P, 0, IN(0), IN(2), LN_SPLIT, NH, bid, 136)) \
    PHG(7, phase_rkmix2(H, K_A2, IN(20), 0, 2, bid, nb)); \
    PHG(13, gemm_pair(K_A2, W, 4, 0, EpiRwkv2{K_RKVG, K_T}, L, bid, nb)); \
    PHG(7, phase_rkmix2(H, K_A2, IN(20), 3, 5, bid, nb)); \
    PHG(13, gemm_pair(K_A2, W, 4, 8, EpiRwkv2{K_RKVG, K_T}, L, bid, nb)); \
    PHG(7, phase_rkmix2(H, K_A2, IN(20), 1, 4, bid, nb)); \
    PHG(13, gemm_pair(K_A2, W, 1, 16, EpiRwkv2{K_RKVG, K_T}, L, bid, nb)); \
    PHG(3, phase_rkscan4(K_R, K_K, K_V, K_T, IN(22), IN(24), IN(25), IN(27), IN(28), IN(29), IN(30), K_YF, K_YB, K_BON, L, bid, nb, S2PROF_PTR)); \
    PHG(5, phase_fin_rk(K_YF, K_YB, K_V, K_G, K_BON, IN(31), IN(32), bid, nb)); \
    PHG(14, gemm_run<EpiBf>(K_G, W + (size_t)4608 * 1024, NTOK, 1024, 1024, EpiBf{H, 1024}, L, bid, nb)); \
    PHG(6, phase_ln(out, xctx, out, xctx, (const bf16_t*)H, mod + (size_t)2 * 9 * 3072, mod + (size_t)3 * 9 * 3072, IN(6) + 2048, IN(7) + 2048, H, 0, NH, 0, bid, nb); \
       wcvt_ret(IN(8) + (size_t)1024 * 6144, IN(10) + (size_t)2048 * 1024, W, L, bid, nb)); \
    RET_LAYER(3, 1, out, xctx, 1, (void)0, phase_ln(out, xctx, out, xctx, (const bf16_t*)(H + (size_t)NH * DM), mod + (size_t)2 * 9 * 3072, mod + (size_t)3 * 9 * 3072, IN(6) + 2048, IN(7) + 2048, H, NH, NTOK, 0, bid - 128, 128), RET_LN_CALL(1, R_P, 3, out, xctx, 1, bid, nb), gemm_deal<EpiBf>(RET_OUT_ARGS(R_P), 1, L, bid, nb))


#if MK_MULTI
template <class F> __global__ void __launch_bounds__(NTHR, 2) kphase(F f) {
    extern __shared__ __attribute__((aligned(16))) unsigned char lds_raw[];
    f((LAS unsigned char*)lds_raw, (int)blockIdx.x, (int)gridDim.x);
}
template <class F> static void launch_phase(hipStream_t st, F f) {
    static int attr_done = 0;
    if (!attr_done) { (void)hipFuncSetAttribute((const void*)kphase<F>, hipFuncAttributeMaxDynamicSharedMemorySize, LDS_BYTES); attr_done = 1; }
    hipLaunchKernelGGL(kphase<F>, dim3(256), dim3(NTHR), LDS_BYTES, st, f);
}
extern "C" void kernel_launch(void* const* d_in, const int* in_sizes, int n_in, void* d_out, int out_size, void* d_ws, size_t ws_size, hipStream_t stream) {
    if (n_in != 34 || ws_size < WS_END) { fprintf(stderr, "kernel_launch: expected 34 inputs and >= %zu bytes of workspace (got %d, %zu)\n", (size_t)WS_END, n_in, ws_size); return; }
    (void)in_sizes; (void)out_size;
    const float* in[34]; for (int i = 0; i < 34; ++i) in[i] = (const float*)d_in[i];
    float* out = (float*)d_out; unsigned char* ws = (unsigned char*)d_ws;
    float* mod = (float*)(ws + WS_MOD); float* rope = (float*)(ws + WS_ROPE); float* xctx = (float*)(ws + WS_XCTX);
    bf16_t* H = (bf16_t*)(ws + WS_H); bf16_t* W = (bf16_t*)(ws + WS_W); unsigned char* S = ws + WS_S; unsigned* dbgcnt = (unsigned*)(ws + WS_ROPE + 32768);
#define IN(i) in[i]
#define S2PROF_PTR ((unsigned long long*)nullptr)
#define GSTAMP_PTR ((unsigned long long*)nullptr)
#define PHG(g, ...) launch_phase(stream, [=] __device__ (LAS unsigned char* L, int bid, int nb) { __VA_ARGS__; })
    FORWARD_PROGRAM()
#undef PHG
#undef IN
}
#else
#ifndef TIMING_PROBE
#define TIMING_PROBE 0
#endif
#define GSTAMP_PTR ((unsigned long long*)(ws + MiB))
#ifndef XCCPROBE
#define XCCPROBE 0
#endif
#ifndef S2PROF
#define S2PROF 0
#endif
#define SP_A 4
#define SP_B 5
#define TP_A 4
#define TP_B 15
#define AS4 __attribute__((address_space(4)))
__device__ __forceinline__ const float* karg_ptr(unsigned off) { asm volatile("" : "+s"(off)); const unsigned char AS4* ka = (const unsigned char AS4*)__builtin_amdgcn_kernarg_segment_ptr(); return *(const float* const AS4*)(ka + off); }
__global__ void __launch_bounds__(NTHR, 2) hybrid_fwd(Prm p) {
    extern __shared__ __attribute__((aligned(16))) unsigned char lds_raw[];
    LAS unsigned char* L = (LAS unsigned char*)lds_raw;
    const int nb = gridDim.x;
    volatile LAS unsigned* st = (volatile LAS unsigned*)(L + LDS_BYTES - 16);
    if (threadIdx.x == 0) { st[0] = 0u; st[1] = 0u; st[2] = 0u; st[3] = 0u; *(volatile LAS unsigned*)(L + TID_TICKET_LDS) = 0u; *(volatile LAS unsigned*)(L + TID_TICKET_LDS + 4) = 0u; }
    __syncthreads();
    { XcdBarrier bar0 = xcd_barrier_post((unsigned*)((unsigned char*)karg_ptr(280) + WS_BAR), st); (void)bar0; }
#define IN(i) karg_ptr(8u * (i))
#define out ((float*)karg_ptr(272))
#define ws ((unsigned char*)karg_ptr(280))
#define mod ((float*)(ws + WS_MOD))
#define rope ((float*)(ws + WS_ROPE))
#define xctx ((float*)(ws + WS_XCTX))
#define H ((bf16_t*)(ws + WS_H))
#define W ((bf16_t*)(ws + WS_W))
#define S (ws + WS_S)
#if TIMING_PROBE
#define TSTAMP(g) { const int tq_ = tid_opq(); if (tq_ == 0 && blockIdx.x == 0) { unsigned long long* tsb = (unsigned long long*)(ws + WS_BAR + 14336); tsb[tsk] = (unsigned long long)wall_clock64(); ((unsigned*)(tsb + 64))[tsk] = (g); } ++tsk; }
#else
#define TSTAMP(g)
#endif
#if S2PROF
#define S2PROF_PTR ((unsigned long long*)(ws + WS_BAR + 15360))
#else
#define S2PROF_PTR ((unsigned long long*)nullptr)
#endif
#define PHG(g, ...) { const int bid = bid_opq(); __VA_ARGS__; XcdBarrier bar; bar.bar = (unsigned*)(ws + WS_BAR); bar.x = xb_xcc_id(); bar.st = (volatile LAS unsigned*)(L + LDS_BYTES - 16); xcd_barrier(bar, tid_opq()); TSTAMP(g) }
    int tsk = 0; TSTAMP(9)
#if XCCPROBE
    { unsigned* xc = (unsigned*)(ws + WS_BAR + 15872); const unsigned x = xb_xcc_id(); if (threadIdx.x == 0) { if (x == (blockIdx.x & 7u)) atomicAdd(xc, 1u); if (x == (blockIdx.x >> 5)) atomicAdd(xc + 1, 1u); } }
#endif
    FORWARD_PROGRAM()
#if GSTAMP
    { const int bid = bid_opq(); phase_gstamp(out, GSTAMP_PTR, bid, nb); }
#endif
#if HOTPROBE
    { const int bid = bid_opq(); phase_hotprobe(out, GSTAMP_PTR, bid, nb); }
#endif
#if XCCPROBE
    { const int bid = bid_opq(); phase_xccprobe(out, (unsigned*)(ws + WS_BAR + 15872), bid, nb); }
#endif
#if S2PROF
    { const int bid = bid_opq(); phase_prof6(out, (const unsigned long long*)(ws + WS_BAR + 15360), SP_A, SP_B, bid, nb); }
#endif
#if TIMING_PROBE
    { XcdBarrier bar; bar.bar = (unsigned*)(ws + WS_BAR); bar.x = xb_xcc_id(); bar.st = (volatile LAS unsigned*)(L + LDS_BYTES - 16); xcd_barrier(bar, tid_opq()); }
    { const int bid = bid_opq(); phase_timing(out, (const unsigned long long*)(ws + WS_BAR + 14336), tsk, bid, nb, TP_A, TP_B); }
#endif
#undef PHG
#undef IN
#undef out
#undef ws
#undef mod
#undef rope
#undef xctx
#undef H
#undef W
#undef S
    (void)p;
}
extern "C" void kernel_launch(void* const* d_in, const int* in_sizes, int n_in, void* d_out, int out_size, void* d_ws, size_t ws_size, hipStream_t stream) {
    static int ready = 0;
    if (!ready) {
        if (n_in != 34 || ws_size < WS_END) { fprintf(stderr, "kernel_launch: expected 34 inputs and >= %zu bytes of workspace (got %d, %zu)\n", (size_t)WS_END, n_in, ws_size); ready = -1; return; }
        if (hipFuncSetAttribute((const void*)hybrid_fwd, hipFuncAttributeMaxDynamicSharedMemorySize, LDS_BYTES) != hipSuccess) { fprintf(stderr, "kernel_launch: hipFuncSetAttribute failed\n"); ready = -1; return; }
        ready = 1;
    }
    if (ready < 0) return;
    (void)in_sizes; (void)out_size;
    (void)hipMemsetAsync((char*)d_ws + WS_BAR, 0, 16384, stream);
    Prm p{};
    for (int i = 0; i < 34; ++i) p.in[i] = (const float*)d_in[i];
    p.out = (float*)d_out; p.ws = (unsigned char*)d_ws;
    hipLaunchKernelGGL(hybrid_fwd, dim3(256), dim3(NTHR), LDS_BYTES, stream, p);
}
#endif
```

```cpp
#include <hip/hip_runtime.h>
#include <cstdio>
#include <cstdint>
#include <cmath>
#ifndef MK_MULTI
#define MK_MULTI 0
#endif
#ifndef PG8_KROT
#define PG8_KROT 0
#endif
#ifndef TP_SCALE
#define TP_SCALE 10.f
#endif
#ifndef GSTAMP
#define GSTAMP 0
#define HOTPROBE 0
#endif
#define TID_TICKET_LDS 163808
__device__ __forceinline__ int tid_opq() {
#if MK_MULTI
    int t = (int)threadIdx.x; asm volatile("" : "+v"(t)); return t;
#else
    const int lane = (int)__builtin_amdgcn_mbcnt_hi(~0u, __builtin_amdgcn_mbcnt_lo(~0u, 0u));
    unsigned id = 0u;
    if (lane == 0) id = __hip_atomic_fetch_add((__attribute__((address_space(3))) unsigned*)TID_TICKET_LDS, 1u, __ATOMIC_RELAXED, __HIP_MEMORY_SCOPE_WORKGROUP);
    id = (unsigned)__builtin_amdgcn_readfirstlane((int)id) & 7u;
    asm volatile("s_waitcnt lgkmcnt(0)" ::: "memory"); __builtin_amdgcn_s_barrier(); asm volatile("" ::: "memory");
    int t = (int)(id * 64u) + lane; asm volatile("" : "+v"(t)); return t;
#endif
}
__device__ __forceinline__ int bid_opq() { int b = (int)blockIdx.x; asm volatile("" : "+s"(b)); return b; }
#define XB_TMO      128
#define XB_XCNT(j)  (256  + 64 * (j))
#define XB_XSUB(j)  (1280 + 64 * (j))
#define XB_XGEN(j)  (2304 + 64 * (j))
#define XB_TOP      3328
#define XB_TOPGEN   3392
#define XCD_BAR_WORDS 3456
#define XB_SPIN_CAP (1u << 18)
#define LAS __attribute__((address_space(3)))

__device__ __forceinline__ unsigned xb_ld(unsigned* p)              { return __hip_atomic_load(p, __ATOMIC_RELAXED, __HIP_MEMORY_SCOPE_AGENT); }
__device__ __forceinline__ unsigned xb_add(unsigned* p, unsigned v) { return __hip_atomic_fetch_add(p, v, __ATOMIC_RELAXED, __HIP_MEMORY_SCOPE_AGENT); }
__device__ __forceinline__ unsigned xb_xcc_id() { return (unsigned)__builtin_amdgcn_s_getreg((3 << 11) | 20) & 0xFu; }
#define XB_SPIN(cond, bar) do { unsigned _sp = 0; while (cond) { __builtin_amdgcn_s_sleep(1); \
    if ((++_sp & 255u) == 0u) { if (xb_ld(&(bar)[XB_TMO])) break; if (_sp > XB_SPIN_CAP) { atomicAdd(&(bar)[XB_TMO], 1u); break; } } } } while (0)

struct XcdBarrier {
    unsigned* bar; unsigned x;
    volatile LAS unsigned* st;
};

__device__ __forceinline__ XcdBarrier xcd_barrier_post(unsigned* bar, volatile LAS unsigned* st) {
    XcdBarrier b; b.bar = bar; b.x = xb_xcc_id(); b.st = st;
    if (threadIdx.x == 0) (void)xb_add(&bar[XB_XCNT(b.x)], 1u);
    return b;
}
__device__ __forceinline__ void xcd_barrier_complete(unsigned* bar, unsigned x, unsigned& nloc, unsigned& nx) {
    const unsigned G = gridDim.x * gridDim.y * gridDim.z;
    unsigned sum, cnt, mine, sp = 0u;
    for (;;) {
        sum = 0u; cnt = 0u; mine = 0u;
#pragma unroll
        for (unsigned j = 0; j < 16; ++j) { const unsigned c = xb_ld(&bar[XB_XCNT(j)]); sum += c; cnt += (c > 0u) ? 1u : 0u; mine = (j == x) ? c : mine; }
        if (sum == G) break;
        __builtin_amdgcn_s_sleep(1);
        if ((++sp & 255u) == 0u) { if (xb_ld(&bar[XB_TMO])) break; if (sp > XB_SPIN_CAP) { atomicAdd(&bar[XB_TMO], 1u); break; } }
    }
    nloc = mine > 0u ? mine : 1u; nx = cnt > 0u ? cnt : 1u;
}

__device__ __forceinline__ void xcd_barrier(const XcdBarrier& b, const int tid0 = (int)threadIdx.x) {
    asm volatile("s_waitcnt vmcnt(0)" ::: "memory");
    __syncthreads();
    if (tid0 == 0) {
        unsigned* bar = b.bar;
        __builtin_amdgcn_s_waitcnt(0);
        unsigned nloc = b.st[0], nx = b.st[1];
        if (nloc == 0u) { xcd_barrier_complete(bar, b.x, nloc, nx); b.st[0] = nloc; b.st[1] = nx; }
        const unsigned old = xb_add(&bar[XB_XSUB(b.x)], 1u);
        const unsigned gen = old / nloc;
        if (old + 1u == (gen + 1u) * nloc) {
            __builtin_amdgcn_fence(__ATOMIC_RELEASE, "agent");
            asm volatile("s_waitcnt vmcnt(0)" ::: "memory");
            const unsigned og = xb_add(&bar[XB_TOP], 1u);
            const unsigned tg = og / nx;
            if (og + 1u == (tg + 1u) * nx) xb_add(&bar[XB_TOPGEN], 1u);
            else XB_SPIN(xb_ld(&bar[XB_TOPGEN]) == tg, bar);
            __builtin_amdgcn_fence(__ATOMIC_ACQUIRE, "agent");
            xb_add(&bar[XB_XGEN(b.x)], 1u);
            asm volatile("s_waitcnt vmcnt(0)" ::: "memory");
        } else {
            XB_SPIN(xb_ld(&bar[XB_XGEN(b.x)]) == gen, bar);
            __builtin_amdgcn_fence(__ATOMIC_ACQUIRE, "agent");
            asm volatile("s_waitcnt vmcnt(0)" ::: "memory");
        }
    }
    __syncthreads();
}
namespace pg8 {
#define PG8_LAS __attribute__((address_space(3)))
typedef unsigned short bf16_t;
typedef short bf16x8 __attribute__((ext_vector_type(8)));
typedef float f32x4 __attribute__((ext_vector_type(4)));
typedef unsigned u32x4 __attribute__((ext_vector_type(4)));
constexpr int BM = 256, BK = 64, HALF = 128, HTB = HALF * BK * 2  , STAGE_BYTES = 8 * HTB, NXCD = 8, WGM = 8;

__host__ __device__ __forceinline__ int lds_byte(int r, int c) { const int st = (r >> 4) * 2 + (c >> 5), rr = r & 15, cc = c & 31, ob = rr * 64 + cc * 2; return st * 1024 + (ob ^ (((ob >> 9) & 1) << 5)); }
__host__ __device__ __forceinline__ void stage_rc(int b, int& R, int& C) { const int st = b / 1024, sb = b % 1024, swz = sb ^ (((sb >> 9) & 1) << 5); R = (st >> 1) * 16 + swz / 64; C = (st & 1) * 32 + (swz % 64) / 2; }
__host__ __device__ __forceinline__ int perm32(int rho) { const int n = rho >> 4, i = rho & 15; return 8 * (i >> 2) + 4 * n + (i & 3); }

struct Unit { int pm, pn; };
struct Gemm { const bf16_t* A; const bf16_t* Bt; int M, N, K, ld; };

struct StaticOrder {
    int nM, nN, nwg, G, c;
    __host__ __device__ void init(int M, int N, int G_, int c_) { nM = M / BM; nN = N / BM; nwg = nM * nN; G = G_; c = c_; }
    __host__ __device__ bool unit_of(long L, Unit& u) const {
        if (L >= nwg) return false;
        int wgid = (int)L; { const int q = nwg / NXCD, r = nwg % NXCD, xcd = wgid % NXCD, off = wgid / NXCD; wgid = (xcd < r ? xcd * (q + 1) : r * (q + 1) + (xcd - r) * q) + off; }
        const int nig = WGM * nN, gid = wgid / nig, fm = gid * WGM, gsz = (nM - fm) < WGM ? (nM - fm) : WGM;
        u.pm = fm + ((wgid % nig) % gsz); u.pn = (wgid % nig) / gsz; return true;
    }
    __host__ __device__ bool next(int i, Unit& u) const { return unit_of((long)i * G + c, u); }
    __device__ __forceinline__ void a_ready(const Unit&) const {}
    __device__ __forceinline__ void done(const Unit&) const {}
};
__device__ __forceinline__ unsigned cvt_pk_bf16(float lo, float hi) { unsigned r; asm volatile("v_cvt_pk_bf16_f32 %0, %1, %2" : "=v"(r) : "v"(lo), "v"(hi)); return r; }
template <class Epi, class Sched, bool STAMP = false>
__device__ __forceinline__ void gemm_phase(PG8_LAS unsigned char* lds, const Gemm g, const Sched& S, const Epi& E, unsigned long long* stamps) {
    const int tid = tid_opq(), wid = __builtin_amdgcn_readfirstlane(tid >> 6), lane = tid & 63, wr = wid >> 2, wc = wid & 3, fr = lane & 15, fq = lane >> 4;
    const int nt = g.K / BK, K = g.ld ? g.ld : g.K;
    int ts_lo = 0, ts_hi = 0, nts = 0; const unsigned long long rt_entry = STAMP ? (unsigned long long)wall_clock64() : 0ull;
#define PG8_STAMP() do { if (STAMP && wid == 0 && nts < 64) { const unsigned long long _c = (unsigned long long)clock64(); \
        ts_lo = (lane == nts) ? (int)(unsigned)_c : ts_lo; ts_hi = (lane == nts) ? (int)(unsigned)(_c >> 32) : ts_hi; ++nts; } } while (0)
    PG8_STAMP();
    unsigned voffA[2], voffB[2];
#pragma unroll
    for (int i = 0; i < 2; ++i) { int R, C; stage_rc(tid * 16 + i * 8192, R, C); const int Rb = Epi::PERM ? ((R & ~31) + perm32(R & 31)) : R;
        voffA[i] = (unsigned)(R * K + C) * 2u; voffB[i] = (unsigned)(Rb * K + C) * 2u; }
    const size_t kstep = (size_t)(BK * 2);
    const size_t hstep = (size_t)HALF * K * 2;
    const size_t tstep = 2 * hstep;
    const unsigned ldsw = (unsigned)wid * 1024u;
    const int aoff = lds_byte(wr * 64 + fr, fq * 8), boff = lds_byte(wc * 32 + fr, fq * 8);
#define PG8_SA(b, h) (((b) * 2 + (h)) * HTB)
#define PG8_SB(b, h) ((4 + (b) * 2 + (h)) * HTB)
#define PG8_STAGE(bufoff, gbase, voff) do { _Pragma("unroll") for (int _i = 0; _i < 2; ++_i) \
        __builtin_amdgcn_global_load_lds((const unsigned*)((const char*)(gbase) + (voff)[_i]), (PG8_LAS unsigned*)(lds + (bufoff) + ldsw + _i * 8192), 16, 0, 0); } while (0)
#define PG8_LDA(dst, b, h) do { _Pragma("unroll") for (int m = 0; m < 4; ++m) _Pragma("unroll") for (int k = 0; k < 2; ++k) dst[m][k] = *(const PG8_LAS bf16x8*)(lds + PG8_SA(b, h) + aoff + m * 2048 + k * 1024); } while (0)
#define PG8_LDB(dst, b, h) do { _Pragma("unroll") for (int n = 0; n < 2; ++n) _Pragma("unroll") for (int k = 0; k < 2; ++k) dst[n][k] = *(const PG8_LAS bf16x8*)(lds + PG8_SB(b, h) + boff + n * 2048 + k * 1024); } while (0)
#define PG8_MMA(ai, bj, At, Bt) do { __builtin_amdgcn_s_setprio(1); _Pragma("unroll") for (int m = 0; m < 4; ++m) _Pragma("unroll") for (int n = 0; n < 2; ++n) _Pragma("unroll") for (int k = 0; k < 2; ++k) \
        acc[ai][bj][m][n] = __builtin_amdgcn_mfma_f32_16x16x32_bf16(Bt[n][k], At[m][k], acc[ai][bj][m][n], 0, 0, 0); __builtin_amdgcn_s_setprio(0); } while (0)
#define PG8_WAIT_V(n) asm volatile("s_waitcnt vmcnt(" #n ")" ::: "memory")
#define PG8_WAIT_L(n) asm volatile("s_waitcnt lgkmcnt(" #n ")" ::: "memory")
#define PG8_WAIT_VL(v, l) asm volatile("s_waitcnt vmcnt(" #v ") lgkmcnt(" #l ")" ::: "memory")
#define PG8_BAR __builtin_amdgcn_s_barrier()
#define PG8_SCHED __builtin_amdgcn_sched_barrier(0)
    Unit cur, nxt; int ui = 0;
    if (!S.next(0, cur)) return;
    const int ntm = nt - 1;
#define PG8_ROT(u) ((PG8_KROT) ? ((2 * ((u).pm & 7) + 4 * ((u).pn & 3)) & ntm) : 0)
#define PG8_KO(off, t) ((size_t)(((t) + (off)) & ntm) * kstep)
    int coff = PG8_ROT(cur);
    f32x4 acc[2][2][4][2];
#pragma unroll
    for (int a = 0; a < 2; ++a)
#pragma unroll
        for (int b = 0; b < 2; ++b)
#pragma unroll
            for (int m = 0; m < 4; ++m)
#pragma unroll
                for (int n = 0; n < 2; ++n) acc[a][b][m][n] = (f32x4){0.f, 0.f, 0.f, 0.f};
    bf16x8 At[4][2], B0[2][2], B1[2][2];
    const char* cA = (const char*)g.A + (size_t)cur.pm * tstep; const char* cB = (const char*)g.Bt + (size_t)cur.pn * tstep;
    S.a_ready(cur);
    { const size_t k0 = PG8_KO(coff, 0), k1 = PG8_KO(coff, 1);
    PG8_STAGE(PG8_SB(0, 0), cB + k0, voffB); PG8_STAGE(PG8_SA(0, 0), cA + k0, voffA); PG8_STAGE(PG8_SB(0, 1), cB + hstep + k0, voffB); PG8_STAGE(PG8_SA(0, 1), cA + hstep + k0, voffA);
    if (wr == 1) PG8_BAR;
    PG8_WAIT_V(4); PG8_BAR;
    PG8_STAGE(PG8_SB(1, 0), cB + k1, voffB); PG8_STAGE(PG8_SA(1, 0), cA + k1, voffA); PG8_STAGE(PG8_SB(1, 1), cB + hstep + k1, voffB); }
    PG8_WAIT_V(6); PG8_BAR;
    PG8_STAMP();
    for (;;) {
        const bool has_next = S.next(ui + 1, nxt);
        const char* nA = has_next ? (const char*)g.A + (size_t)nxt.pm * tstep : cA; const char* nB = has_next ? (const char*)g.Bt + (size_t)nxt.pn * tstep : cB;
        const int noff = has_next ? PG8_ROT(nxt) : coff;
        for (int t = 0; t < nt; t += 2) {
            const bool last = (t == nt - 2);
            const char* a1 = cA + PG8_KO(coff, t + 1);
            const size_t k2 = last ? PG8_KO(noff, 0) : PG8_KO(coff, t + 2), k3 = last ? PG8_KO(noff, 1) : PG8_KO(coff, t + 3);
            const char* a2 = (last ? nA : cA) + k2; const char* b2 = (last ? nB : cB) + k2;
            const char* a3 = (last ? nA : cA) + k3; const char* b3 = (last ? nB : cB) + k3;
            if (last && has_next) S.a_ready(nxt);
            PG8_LDB(B0, 0, 0); PG8_SCHED; PG8_LDA(At, 0, 0); PG8_STAGE(PG8_SA(1, 1), a1 + hstep, voffA);
            PG8_WAIT_VL(10, 8); PG8_BAR; PG8_WAIT_L(0); PG8_MMA(0, 0, At, B0); PG8_BAR; PG8_SCHED;
            PG8_LDB(B1, 0, 1); PG8_STAGE(PG8_SB(0, 0), b2, voffB);
            PG8_WAIT_V(10); PG8_BAR; PG8_WAIT_L(0); PG8_MMA(0, 1, At, B1); PG8_BAR;
            PG8_LDA(At, 0, 1); PG8_STAGE(PG8_SA(0, 0), a2, voffA);
            PG8_WAIT_V(10); PG8_BAR; PG8_WAIT_L(0); PG8_MMA(1, 0, At, B0); PG8_BAR; PG8_SCHED;
            PG8_STAGE(PG8_SB(0, 1), b2 + hstep, voffB);
            PG8_WAIT_V(10); PG8_BAR; PG8_MMA(1, 1, At, B1); PG8_BAR;
            PG8_LDB(B0, 1, 0); PG8_SCHED; PG8_LDA(At, 1, 0); PG8_STAGE(PG8_SA(0, 1), a2 + hstep, voffA);
            PG8_WAIT_VL(10, 8); PG8_BAR; PG8_WAIT_L(0); PG8_MMA(0, 0, At, B0); PG8_BAR; PG8_SCHED;
            PG8_LDB(B1, 1, 1); PG8_STAGE(PG8_SB(1, 0), b3, voffB);
            PG8_WAIT_V(10); PG8_BAR; PG8_WAIT_L(0); PG8_MMA(0, 1, At, B1); PG8_BAR;
            PG8_LDA(At, 1, 1); PG8_STAGE(PG8_SA(1, 0), a3, voffA);
            PG8_WAIT_V(10); PG8_BAR; PG8_WAIT_L(0); PG8_MMA(1, 0, At, B0); PG8_BAR; PG8_SCHED;
            PG8_STAGE(PG8_SB(1, 1), b3 + hstep, voffB);
            PG8_WAIT_V(10); PG8_BAR; PG8_MMA(1, 1, At, B1); PG8_BAR;
        }
        PG8_STAMP();
        if constexpr (!Epi::AFTER_DRAIN) { E(acc, cur, wr, wc, fr, fq); S.done(cur); }
        PG8_STAMP();
        if (!has_next) break;
#pragma unroll
        for (int a = 0; a < 2; ++a)
#pragma unroll
            for (int b = 0; b < 2; ++b)
#pragma unroll
                for (int m = 0; m < 4; ++m)
#pragma unroll
                    for (int n = 0; n < 2; ++n) acc[a][b][m][n] = (f32x4){0.f, 0.f, 0.f, 0.f};
        cur = nxt; cA = nA; cB = nB; coff = noff; ++ui;
    }
    PG8_WAIT_V(0);
    if (wr == 0) PG8_BAR;
    PG8_BAR;
    if constexpr (Epi::AFTER_DRAIN) { E.fused(acc, cur, wr, wc, fr, fq, lds, wid, lane); S.done(cur); }
    PG8_STAMP();
    if (STAMP && wid == 0) { stamps[lane] = lane < nts ? (((unsigned long long)(unsigned)ts_hi << 32) | (unsigned)ts_lo) : 0ull;
        if (lane == 62) stamps[62] = rt_entry; if (lane == 63) stamps[63] = (unsigned long long)wall_clock64(); }
#undef PG8_STAMP
#undef PG8_SA
#undef PG8_SB
#undef PG8_STAGE
#undef PG8_LDA
#undef PG8_LDB
#undef PG8_MMA
#undef PG8_WAIT_V
#undef PG8_WAIT_L
#undef PG8_WAIT_VL
#undef PG8_ROT
#undef PG8_KO
#undef PG8_BAR
#undef PG8_SCHED
}
}

using pg8::bf16_t; using pg8::bf16x8; using pg8::f32x4; using pg8::u32x4;
typedef unsigned u32x2 __attribute__((ext_vector_type(2)));
constexpr int NB = 8, CTXL = 256, SEQ = 4096, SP = CTXL + SEQ  , NTOK = NB * SP  , NH = NTOK / 2  , DM = 1024;
constexpr int NCH = SP / 128;
constexpr int NTHR = 512;
constexpr float ALPHA = 1.6817928305074290f;
constexpr float LN_EPS = 1e-5f;
constexpr size_t MiB = 1048576;
constexpr size_t WS_BAR = 0;
constexpr size_t WS_MOD = 16384;
constexpr size_t WS_ROPE = WS_MOD + 458752;
constexpr size_t WS_XCTX = 2 * MiB;
constexpr size_t WS_H = 10 * MiB;
constexpr size_t WS_W = 78 * MiB;
constexpr size_t WS_S = 102 * MiB;
constexpr size_t WS_END = 510 * MiB;
constexpr size_t U34 = 34 * MiB, U68 = 68 * MiB;
static_assert((size_t)NH * 1024 * 2 == U34 && (size_t)NTOK * 1024 * 2 == U68, "unit sizes");
constexpr int LDS_BYTES = 163840;

__device__ __forceinline__ float bf2f(unsigned short h) { return __uint_as_float(((unsigned)h) << 16); }
__device__ __forceinline__ float bflo(unsigned w) { return __uint_as_float(w << 16); }
__device__ __forceinline__ float bfhi(unsigned w) { return __uint_as_float(w & 0xffff0000u); }
__device__ __forceinline__ unsigned pk2(float lo, float hi) { return pg8::cvt_pk_bf16(lo, hi); }
__device__ __forceinline__ float siluf(float x) { return x * __builtin_amdgcn_rcpf(1.f + __expf(-x)); }
__device__ __forceinline__ float sigmf(float x) { return __builtin_amdgcn_rcpf(1.f + __expf(-x)); }
__device__ __forceinline__ void unpack8(const uint4 v, float (&f)[8]) {
    f[0] = bflo(v.x); f[1] = bfhi(v.x); f[2] = bflo(v.y); f[3] = bfhi(v.y); f[4] = bflo(v.z); f[5] = bfhi(v.z); f[6] = bflo(v.w); f[7] = bfhi(v.w); }
__device__ __forceinline__ uint4 pack8(const float (&f)[8]) { uint4 v; v.x = pk2(f[0], f[1]); v.y = pk2(f[2], f[3]); v.z = pk2(f[4], f[5]); v.w = pk2(f[6], f[7]); return v; }
#define SLABOFF(row, ch) ((row) * 128 + ((((ch) ^ (row)) & 7) << 4))
#define SLABOFF2(row, ch) ((row) * 128 + ((((ch) ^ (row) ^ ((row) >> 4)) & 7) << 4))
__device__ __forceinline__ bf16x8 lds_frag(LAS unsigned char* slab, int row, int ch) { return *(const LAS bf16x8*)(slab + SLABOFF(row, ch)); }
__device__ __forceinline__ void lds_st16(LAS unsigned char* slab, int row, int ch, uint4 v) { u32x4 t; t.x = v.x; t.y = v.y; t.z = v.z; t.w = v.w; *(LAS u32x4*)(slab + SLABOFF(row, ch)) = t; }
__device__ __forceinline__ void lds_st16b(LAS unsigned char* slab, int row, int ch, uint4 v) { u32x4 t; t.x = v.x; t.y = v.y; t.z = v.z; t.w = v.w; *(LAS u32x4*)(slab + SLABOFF2(row, ch)) = t; }
__device__ __forceinline__ uint4 lds_ld16(LAS unsigned char* slab, int row, int ch) { const u32x4 t = *(const LAS u32x4*)(slab + SLABOFF(row, ch)); return make_uint4(t.x, t.y, t.z, t.w); }
template <int TM, int TN, bool SW2 = false>
__device__ __forceinline__ void mma_slab(f32x4 (&acc)[TM][TN], LAS unsigned char* As, int arow0, LAS unsigned char* Bs, int brow0, int lane) {
#pragma unroll
    for (int ks = 0; ks < 2; ++ks) {
        bf16x8 a[TM], b[TN];
#pragma unroll
        for (int tm = 0; tm < TM; ++tm) { const int r_ = arow0 + 16 * tm + (lane & 15), c_ = (lane >> 4) + 4 * ks; a[tm] = *(const LAS bf16x8*)(As + (SW2 ? SLABOFF2(r_, c_) : SLABOFF(r_, c_))); }
#pragma unroll
        for (int tn = 0; tn < TN; ++tn) { const int r_ = brow0 + 16 * tn + (lane & 15), c_ = (lane >> 4) + 4 * ks; b[tn] = *(const LAS bf16x8*)(Bs + (SW2 ? SLABOFF2(r_, c_) : SLABOFF(r_, c_))); }
#pragma unroll
        for (int tm = 0; tm < TM; ++tm)
#pragma unroll
            for (int tn = 0; tn < TN; ++tn) acc[tm][tn] = __builtin_amdgcn_mfma_f32_16x16x32_bf16(a[tm], b[tn], acc[tm][tn], 0, 0, 0);
    }
}
__device__ __forceinline__ int ord_b(int k) { return k == 0 ? 1 : (k == 1 ? 0 : 35 - k); }
__device__ __forceinline__ int pos_b(int c) { return c == 1 ? 0 : (c == 0 ? 1 : 35 - c); }
__device__ __forceinline__ float log2_gamma(float logit) {
    const float sp = (logit > 15.f) ? __expf(-logit) : log1pf(__expf(-logit)); return -sp * 1.4426950408889634f; }

__device__ __forceinline__ void wg_sync() { asm volatile("s_waitcnt lgkmcnt(0)" ::: "memory"); __builtin_amdgcn_s_barrier(); asm volatile("" ::: "memory"); }

__device__ __forceinline__ void mfma_drain() { __builtin_amdgcn_sched_barrier(0); asm volatile("s_nop 15\n\ts_nop 15" ::: "memory"); __builtin_amdgcn_sched_barrier(0); }

struct Prm {
    const float* in[34]; float* out; unsigned char* ws;
};
#define PHASE_FN static __device__ __forceinline__

template <class F>
__device__ __forceinline__ void cvt_tiles(bf16_t* dst, int ld_dst, int koff, int NN, int KK, F f, LAS float* T, int bid, int nb, int& tbase) {
    const int tid = tid_opq(), tn = NN / 64, tk = KK / 64, nt = tn * tk;
    int first = (bid - (tbase % nb) + nb) % nb;
    float nv[8];
    if (first < nt) { const int n0 = (first % tn) * 64, k0 = (first / tn) * 64;
#pragma unroll
        for (int i = 0; i < 8; ++i) { const int kk = (tid >> 6) + 8 * i, nn = tid & 63; nv[i] = f(k0 + kk, n0 + nn); } }
    for (int t = first; t < nt; t += nb) {
        const int n0 = (t % tn) * 64, k0 = (t / tn) * 64;
        wg_sync();
#pragma unroll
        for (int i = 0; i < 8; ++i) { const int kk = (tid >> 6) + 8 * i, nn = tid & 63; T[kk * 65 + nn] = nv[i]; }
        if (t + nb < nt) { const int n1 = ((t + nb) % tn) * 64, k1 = ((t + nb) / tn) * 64;
#pragma unroll
            for (int i = 0; i < 8; ++i) { const int kk = (tid >> 6) + 8 * i, nn = tid & 63; nv[i] = f(k1 + kk, n1 + nn); } }
        wg_sync();
        const int nn2 = tid >> 3, kc = tid & 7; float v[8];
#pragma unroll
        for (int e = 0; e < 8; ++e) v[e] = T[(8 * kc + e) * 65 + nn2];
        *(uint4*)(dst + (size_t)(n0 + nn2) * ld_dst + koff + k0 + 8 * kc) = pack8(v);
    }
    tbase += nt;
}

PHASE_FN void phase_mod(const float* cvec, const float* cctx, const float* ada_w, const float* ada_b, float* mod, float* rope, LAS unsigned char* L, int bid, int nb) {
    const int tid = tid_opq();
    LAS float* sc = (LAS float*)L;
    LAS float* red = sc + 9 * 1024;
    for (int i = tid; i < 9 * 1024; i += NTHR) { const int j = i >> 10, k = i & 1023; const float v = (j < 8) ? cvec[j * 1024 + k] : cctx[k]; sc[i] = siluf(v); }
    wg_sync();
    for (int blk = bid; blk < 256; blk += nb) {
        const int l = blk >> 6, c0 = (blk & 63) * 48;
        float a[9];
#pragma unroll
        for (int j = 0; j < 9; ++j) a[j] = 0.f;
        const int col = tid % 48, kg = tid / 48;
        if (tid < 480) {
            for (int k = kg; k < 1024; k += 10) { const float w = ada_w[((size_t)l * 1024 + k) * 3072 + c0 + col];
#pragma unroll
                for (int j = 0; j < 9; ++j) a[j] += sc[j * 1024 + k] * w; }
#pragma unroll
            for (int j = 0; j < 9; ++j) red[(kg * 48 + col) * 9 + j] = a[j];
        }
        wg_sync();
        if (tid < 48 * 9) { const int cc = tid / 9, j = tid % 9; float s = 0.f;
#pragma unroll
            for (int g = 0; g < 10; ++g) s += red[(g * 48 + cc) * 9 + j];
            mod[((size_t)l * 9 + j) * 3072 + c0 + cc] = s + ada_b[l * 3072 + c0 + cc]; }
        wg_sync();
    }
    for (int i = bid * NTHR + tid; i < 4096; i += nb * NTHR) { const int pos = i >> 6, fi = i & 63;
        const double inv = pow(10000.0, -(double)fi / 64.0), ang = (double)pos * inv; rope[2 * i] = (float)cos(ang); rope[2 * i + 1] = (float)sin(ang); }
}

__device__ __forceinline__ const float* xrow_in(const float* xl, const float* xc, int R) { const int b = R / SP, s = R - b * SP; return s < CTXL ? xc + ((size_t)b * CTXL + s) * DM : xl + ((size_t)b * SEQ + (s - CTXL)) * DM; }

typedef float f32x2v __attribute__((ext_vector_type(2)));
template <int CTRL> __device__ __forceinline__ float dppf(float v) { return __int_as_float(__builtin_amdgcn_update_dpp(0, __float_as_int(v), CTRL, 0xF, 0xF, true)); }
__device__ __forceinline__ float red4(float v) { v += dppf<0xB1>(v); v += dppf<0x4E>(v); return v; }
__device__ __forceinline__ float red8(float v) { v = red4(v); v += dppf<0x141>(v); return v; }
__device__ __forceinline__ float red16(float v) { v = red8(v); v += dppf<0x140>(v); return v; }

PHASE_FN void phase_h0(const float* x, const float* ctx, const float* mod0, bf16_t* H, int R0, int R1, int bid, int nb) {
    const int tid = tid_opq(), lane = tid & 63, wv = tid >> 6;
    float4 cs[4], cgm[4]; int jc = -1;
    for (int R = R0 + bid * 8 + wv; R < R1; R += nb * 8) {
        const int b = R / SP, s = R - b * SP; const float* xr = xrow_in(x, ctx, R); const int j = (s < CTXL ? 8 : b);
        if (j != jc) { const float* md = mod0 + (size_t)j * 3072; jc = j;
#pragma unroll
            for (int u = 0; u < 4; ++u) { const int c = 8 * lane + 512 * (u >> 1) + 4 * (u & 1); cs[u] = *(const float4*)(md + c); cgm[u] = *(const float4*)(md + 1024 + c); } }
#pragma unroll
        for (int u = 0; u < 2; ++u) { const int c = 8 * lane + 512 * u; float v[8];
            const float4 x0 = *(const float4*)(xr + c), x1 = *(const float4*)(xr + c + 4), s0 = cs[2 * u], s1 = cs[2 * u + 1], g0 = cgm[2 * u], g1 = cgm[2 * u + 1];
            v[0] = x0.x * (1.f + g0.x) + s0.x; v[1] = x0.y * (1.f + g0.y) + s0.y; v[2] = x0.z * (1.f + g0.z) + s0.z; v[3] = x0.w * (1.f + g0.w) + s0.w;
            v[4] = x1.x * (1.f + g1.x) + s1.x; v[5] = x1.y * (1.f + g1.y) + s1.y; v[6] = x1.z * (1.f + g1.z) + s1.z; v[7] = x1.w * (1.f + g1.w) + s1.w;
            *(uint4*)(H + (size_t)R * DM + c) = pack8(v); }
    }
}

PHASE_FN void phase_ln(const float* xl_in, const float* xc_in, float* xl_out, float* xc_out, const bf16_t* ymix, const float* modl, const float* modn, const float* lng, const float* lnb,
                       bf16_t* H, int R0, int R1, int last, int bid, int nb, unsigned* cnt = nullptr) {
    const int tid = tid_opq(), lane = tid & 63, wv = tid >> 6;
    const bool inbf = ((const float*)xl_out == xl_in), outbf = !last;
    float4 nx[4]; uint4 nxb[2]; uint4 ny[2];
#define LN_FETCH(R_) do { const int b_ = (R_) / SP, s_ = (R_) - b_ * SP; if (!(last && s_ < CTXL)) { const float* xr_ = xrow_in(xl_in, xc_in, (R_)); const bf16_t* yr_ = ymix + (size_t)((R_) - R0) * DM; \
        _Pragma("unroll") for (int u = 0; u < 2; ++u) { const int c = 8 * lane + 512 * u; if (inbf) nxb[u] = *(const uint4*)((const bf16_t*)xr_ + c); else { nx[2 * u] = *(const float4*)(xr_ + c); nx[2 * u + 1] = *(const float4*)(xr_ + c + 4); } \
            ny[u] = *(const uint4*)(yr_ + c); } } } while (0)
    float4 cg[4], cb[4], cgt[4], csh[4], cscl[4]; int jc = -1;
#pragma unroll
    for (int u = 0; u < 4; ++u) { const int c = 8 * lane + 512 * (u >> 1) + 4 * (u & 1); cg[u] = *(const float4*)(lng + c); cb[u] = *(const float4*)(lnb + c); }
    const int Rfirst = R0 + bid * 8 + wv;
    if (Rfirst < R1) LN_FETCH(Rfirst);
    for (int R = Rfirst; R < R1; R += nb * 8) {
        const int b = R / SP, s = R - b * SP; const bool skip = (last && s < CTXL);
        float4 xv[4]; uint4 xw[2]; uint4 yw[2];
#pragma unroll
        for (int u = 0; u < 4; ++u) xv[u] = nx[u];
        xw[0] = nxb[0]; xw[1] = nxb[1];
        yw[0] = ny[0]; yw[1] = ny[1];
        if (R + nb * 8 < R1) LN_FETCH(R + nb * 8);
        if (skip) continue;
        const int j = (s < CTXL ? 8 : b);
        if (j != jc) { const float* gt = modl + (size_t)j * 3072 + 2048; const float* mn = modn + (size_t)j * 3072; jc = j;
#pragma unroll
            for (int u = 0; u < 4; ++u) { const int c = 8 * lane + 512 * (u >> 1) + 4 * (u & 1); cgt[u] = *(const float4*)(gt + c); if (!last) { csh[u] = *(const float4*)(mn + c); cscl[u] = *(const float4*)(mn + 1024 + c); } } }
        float z[16]; float sum = 0.f;
#pragma unroll
        for (int u = 0; u < 2; ++u) { const int c = 8 * lane + 512 * u; const float4 g0 = cgt[2 * u], g1 = cgt[2 * u + 1]; float yv[8]; unpack8(yw[u], yv);
            float4 x0 = xv[2 * u], x1 = xv[2 * u + 1];
            if (inbf) { float xf[8]; unpack8(xw[u], xf); x0 = make_float4(xf[0], xf[1], xf[2], xf[3]); x1 = make_float4(xf[4], xf[5], xf[6], xf[7]); }
            z[8 * u + 0] = ALPHA * x0.x + g0.x * yv[0]; z[8 * u + 1] = ALPHA * x0.y + g0.y * yv[1]; z[8 * u + 2] = ALPHA * x0.z + g0.z * yv[2]; z[8 * u + 3] = ALPHA * x0.w + g0.w * yv[3];
            z[8 * u + 4] = ALPHA * x1.x + g1.x * yv[4]; z[8 * u + 5] = ALPHA * x1.y + g1.y * yv[5]; z[8 * u + 6] = ALPHA * x1.z + g1.z * yv[6]; z[8 * u + 7] = ALPHA * x1.w + g1.w * yv[7];
#pragma unroll
            for (int e = 0; e < 8; ++e) sum += z[8 * u + e]; }
        sum = red16(sum); sum += __shfl_xor(sum, 16); sum += __shfl_xor(sum, 32);
        const float mu = sum * (1.f / 1024.f); float sq = 0.f;
#pragma unroll
        for (int e = 0; e < 16; ++e) { const float d = z[e] - mu; sq += d * d; }
        sq = red16(sq); sq += __shfl_xor(sq, 16); sq += __shfl_xor(sq, 32);
        const float rs = rsqrtf(sq * (1.f / 1024.f) + LN_EPS);
        if (cnt && lane == 0 && !(fabsf(sq) < 3.0e38f)) atomicAdd(cnt, 1u);
        float* xo = (s < CTXL) ? xc_out + ((size_t)b * CTXL + s) * DM : xl_out + ((size_t)b * SEQ + (s - CTXL)) * DM;
#pragma unroll
        for (int u = 0; u < 2; ++u) { const int c = 8 * lane + 512 * u; float o8[8];
#pragma unroll
            for (int q4 = 0; q4 < 2; ++q4) { const float4 g = cg[2 * u + q4], bb = cb[2 * u + q4];
                float4 o; o.x = (z[8 * u + 4 * q4] - mu) * rs * g.x + bb.x; o.y = (z[8 * u + 4 * q4 + 1] - mu) * rs * g.y + bb.y; o.z = (z[8 * u + 4 * q4 + 2] - mu) * rs * g.z + bb.z; o.w = (z[8 * u + 4 * q4 + 3] - mu) * rs * g.w + bb.w;
                if (!outbf) *(float4*)(xo + c + 4 * q4) = o; o8[4 * q4] = o.x; o8[4 * q4 + 1] = o.y; o8[4 * q4 + 2] = o.z; o8[4 * q4 + 3] = o.w; }
            if (outbf) *(uint4*)((bf16_t*)xo + c) = pack8(o8);
            if (!last) { float hv[8];
#pragma unroll
                for (int q4 = 0; q4 < 2; ++q4) { const float4 sh = csh[2 * u + q4], scl = cscl[2 * u + q4];
                    hv[4 * q4] = o8[4 * q4] * (1.f + scl.x) + sh.x; hv[4 * q4 + 1] = o8[4 * q4 + 1] * (1.f + scl.y) + sh.y; hv[4 * q4 + 2] = o8[4 * q4 + 2] * (1.f + scl.z) + sh.z; hv[4 * q4 + 3] = o8[4 * q4 + 3] * (1.f + scl.w) + sh.w; }
                *(uint4*)(H + (size_t)R * DM + c) = pack8(hv); } }
    }
#undef LN_FETCH
}

PHASE_FN void phase_probe(float* out, const unsigned* cnt, int bid, int nb) {
    float off = 0.f;
    for (int l = 3; l >= 0; --l) if (cnt[l]) off = 10.f * (l + 1);
    for (size_t i = (size_t)bid * NTHR + tid_opq(); i < (size_t)NB * SEQ * DM; i += (size_t)nb * NTHR) { out[i] = off; }
}

PHASE_FN void phase_scan(const void* buf, size_t n, int isbf, unsigned* cnt, int idx, int bid, int nb, float thr = 3.0e38f) {
    unsigned bad = 0;
    for (size_t i = (size_t)bid * NTHR + tid_opq(); i < n; i += (size_t)nb * NTHR) { const float v = isbf ? bf2f(((const bf16_t*)buf)[i]) : ((const float*)buf)[i]; if (!(fabsf(v) < thr)) ++bad; }
    if (bad) atomicAdd(cnt + idx, 1u);
}
PHASE_FN void phase_probe2(float* out, const unsigned* cnt, int bid, int nb) {
    float off = 0.f;
    for (int l = 15; l >= 0; --l) if (cnt[l]) off = 10.f * (l + 1);
    for (size_t i = (size_t)bid * NTHR + tid_opq(); i < (size_t)NB * SEQ * DM; i += (size_t)nb * NTHR) { out[i] = off; }
}

PHASE_FN void phase_probe3(float* out, const unsigned* cnt, int bid, int nb) {
    const unsigned code = cnt[20]; const float off = (code == 0xFFFFFFFFu) ? 0.f : 10.f * (float)(code + 1u);
    for (size_t i = (size_t)bid * NTHR + tid_opq(); i < (size_t)NB * SEQ * DM; i += (size_t)nb * NTHR) { out[i] = off; }
}

PHASE_FN void phase_cmp(const void* a, const void* b, size_t nbytes, unsigned* cnt, int idx, int bid, int nb) {
    const uint4* x = (const uint4*)a; const uint4* y = (const uint4*)b; unsigned bad = 0;
    for (size_t i = (size_t)bid * NTHR + tid_opq(); i < nbytes / 16; i += (size_t)nb * NTHR) { const uint4 u = x[i], v = y[i]; if (u.x != v.x || u.y != v.y || u.z != v.z || u.w != v.w) ++bad; }
    if (bad) atomicAdd(cnt + idx, 1u);
}

PHASE_FN void phase_probe5(float* out, const unsigned* cnt, int bid, int nb) {
    const float off = 10.f * (1.f + (cnt[14] ? 1.f : 0.f) + (cnt[15] ? 2.f : 0.f) + (cnt[16] ? 4.f : 0.f) + (cnt[17] ? 8.f : 0.f));
    for (size_t i = (size_t)bid * NTHR + tid_opq(); i < (size_t)NB * SEQ * DM; i += (size_t)nb * NTHR) { out[i] = off; }
}

PHASE_FN void phase_chkvt(const bf16_t* v, const bf16_t* Vt, unsigned* cnt, int idx, int bid, int nb) {
    unsigned bad = 0;
    for (size_t i = (size_t)bid * NTHR + tid_opq(); i < (size_t)16 * 512 * SP; i += (size_t)nb * NTHR) { const int s = (int)(i % SP); const size_t r = i / SP; const int n = (int)(r & 511), bh = (int)(r >> 9);
        const bf16_t a = Vt[i], b = v[((size_t)(bh >> 2) * SP + s) * 2048 + (bh & 3) * 512 + n]; if (a != b) ++bad; }
    if (bad) atomicAdd(cnt + idx, bad);
}
PHASE_FN void phase_probe6(float* out, const unsigned* cnt, int bid, int nb) {
    unsigned a = cnt[18], b = cnt[19]; int da = 0, db = 0; while (a) { ++da; a /= 10; } while (b) { ++db; b /= 10; }
    const float off = 10.f * (float)(1 + da + 10 * db);
    for (size_t i = (size_t)bid * NTHR + tid_opq(); i < (size_t)NB * SEQ * DM; i += (size_t)nb * NTHR) { out[i] = off; }
}

PHASE_FN void phase_probe7(float* out, const unsigned* seq, int bid, int nb) {
    unsigned a = seq[1]; int da = 0; while (a) { ++da; a /= 10; }
    const float off = 10.f * (float)(1 + da);
    for (size_t i = (size_t)bid * NTHR + tid_opq(); i < (size_t)NB * SEQ * DM; i += (size_t)nb * NTHR) { out[i] = off; }
}

PHASE_FN void phase_chkvt2(const bf16_t* v, const bf16_t* Vt, unsigned* mask, int bid, int nb) {
    for (size_t i = (size_t)bid * NTHR + tid_opq(); i < (size_t)16 * 512 * SP; i += (size_t)nb * NTHR) { const int s = (int)(i % SP); const size_t r = i / SP; const int n = (int)(r & 511), bh = (int)(r >> 9);
        const bf16_t a = Vt[i], b = v[((size_t)(bh >> 2) * SP + s) * 2048 + (bh & 3) * 512 + n]; if (a != b) { const int item = bh * NCH + (s >> 7); atomicOr(mask + (item >> 5), 1u << (item & 31)); } }
}
PHASE_FN void phase_probe8(float* out, const unsigned* mask, int bid, int nb) {
    int nbad = 0, first = -1; for (int it = 0; it < 16 * NCH; ++it) if (mask[it >> 5] & (1u << (it & 31))) { ++nbad; if (first < 0) first = it; }
    const float off = 10.f * (float)(1 + (nbad > 60 ? 60 : nbad)); const float off2 = 100.f + 10.f * (float)(first < 0 ? 0 : first);
    for (size_t i = (size_t)bid * NTHR + tid_opq(); i < (size_t)NB * SEQ * DM; i += (size_t)nb * NTHR) { out[i] = (i == 12345) ? off2 : off; }
}

PHASE_FN void phase_probe9(float* out, const unsigned* cnt, int bid, int nb) {
    int mask = 0; for (int l = 0; l < 5; ++l) if (cnt[20 + l]) mask |= 1 << l;
    const float off = 10.f * (float)(1 + mask);
    for (size_t i = (size_t)bid * NTHR + tid_opq(); i < (size_t)NB * SEQ * DM; i += (size_t)nb * NTHR) { out[i] = off; }
}

PHASE_FN void phase_probe10(float* out, const unsigned* cnt, int bid, int nb) {
    const float off = 10.f * (float)(1 + (cnt[25] > 100u ? 50u : cnt[25])); const float off2 = 100.f * (float)(1 + (cnt[26] > 100u ? 50u : cnt[26])) ;
    for (size_t i = (size_t)bid * NTHR + tid_opq(); i < (size_t)NB * SEQ * DM; i += (size_t)nb * NTHR) { out[i] = (i == 12345) ? off2 : off; }
}

PHASE_FN void phase_timing(float* out, const unsigned long long* tsb, int n, int bid, int nb, int ga, int gb) {
    const unsigned* grp = (const unsigned*)(tsb + 64); float ta = 0.f, tb = 0.f;
    for (int k = 1; k < n; ++k) { const float d = (float)(tsb[k] - tsb[k - 1]); if ((int)grp[k] == ga) ta += d; if ((int)grp[k] == gb) tb += d; }
    const float tot = (float)(tsb[n - 1] - tsb[0]); const float fa = TP_SCALE * ta / tot, fb = TP_SCALE * tb / tot;
    const float delta = sqrtf(fa * 8.0e-5f);
    const int tid = tid_opq();
    for (size_t i = (size_t)bid * NTHR + tid; i < (size_t)NB * SEQ * DM; i += (size_t)nb * NTHR) { float v = out[i] + ((i & 1) ? delta : -delta); if (i == 12345) v += 1.f + 9.f * fb; out[i] = v; }
}

PHASE_FN void phase_prof6(float* out, const unsigned long long* pr, int ia, int ib, int bid, int nb) {
    float tot = 0.f; for (int k = 0; k < 6; ++k) tot += (float)pr[k];
    const float fa = (float)pr[ia] / tot, fb = (float)pr[ib] / tot; const float delta = sqrtf(fa * 8.0e-5f);
    const int tid = tid_opq();
    for (size_t i = (size_t)bid * NTHR + tid; i < (size_t)NB * SEQ * DM; i += (size_t)nb * NTHR) { float v = out[i] + ((i & 1) ? delta : -delta); if (i == 12345) v += 1.f + 9.f * fb; out[i] = v; }
}

PHASE_FN void phase_xccprobe(float* out, unsigned* cnt, int bid, int nb) {
    const float fa = (float)cnt[0] / 256.f, fb = (float)cnt[1] / 256.f; const float delta = sqrtf(fa * 8.0e-5f);
    const int tid = tid_opq();
    for (size_t i = (size_t)bid * NTHR + tid; i < (size_t)NB * SEQ * DM; i += (size_t)nb * NTHR) { float v = out[i] + ((i & 1) ? delta : -delta); if (i == 12345) v += 1.f + 9.f * fb; out[i] = v; }
}

#ifndef EPI_NT
#define EPI_NT 0
#endif
#if EPI_NT
#define EPI_ST(ptr, w) __builtin_nontemporal_store((w), (u32x4*)(ptr))
#else
#define EPI_ST(ptr, w) (*(u32x4*)(ptr) = (w))
#endif
struct EpiBf {
    static constexpr bool PERM = true, AFTER_DRAIN = false;
    bf16_t* O; int ld;
    __device__ __forceinline__ void operator()(const f32x4 (&acc)[2][2][4][2], const pg8::Unit& u, int wr, int wc, int fr, int fq) const {
        const int row0 = u.pm * 256 + wr * 64 + fr, col0 = u.pn * 256 + wc * 32 + 8 * fq;
#pragma unroll
        for (int ai = 0; ai < 2; ++ai)
#pragma unroll
            for (int m = 0; m < 4; ++m) { bf16_t* rowp = O + (size_t)(row0 + ai * 128 + m * 16) * ld + col0;
#pragma unroll
                for (int bj = 0; bj < 2; ++bj) { const f32x4 v0 = acc[ai][bj][m][0], v1 = acc[ai][bj][m][1];
                    u32x4 w; w.x = pk2(v0[0], v0[1]); w.y = pk2(v0[2], v0[3]); w.z = pk2(v1[0], v1[1]); w.w = pk2(v1[2], v1[3]);
                    EPI_ST(rowp + bj * 128, w); } }
    }
};
struct EpiF32 {
    static constexpr bool PERM = false, AFTER_DRAIN = false;
    float* C; int ld;
    __device__ __forceinline__ void operator()(const f32x4 (&acc)[2][2][4][2], const pg8::Unit& u, int wr, int wc, int fr, int fq) const {
        const int row0 = u.pm * 256 + wr * 64 + fr, col0 = u.pn * 256 + wc * 32 + 4 * fq;
#pragma unroll
        for (int ai = 0; ai < 2; ++ai)
#pragma unroll
            for (int m = 0; m < 4; ++m) { float* rowp = C + (size_t)(row0 + ai * 128 + m * 16) * ld + col0;
#pragma unroll
                for (int bj = 0; bj < 2; ++bj)
#pragma unroll
                    for (int n = 0; n < 2; ++n) *(f32x4*)(rowp + bj * 128 + n * 16) = acc[ai][bj][m][n]; }
    }
};
struct EpiRetQKV {
    static constexpr bool PERM = true, AFTER_DRAIN = false;
    bf16_t* q; bf16_t* k; bf16_t* v; const float* rope; int rowbase;
    __device__ __forceinline__ void operator()(const f32x4 (&acc)[2][2][4][2], const pg8::Unit& u, int wr, int wc, int fr, int fq) const {
        const int row0 = u.pm * 256 + wr * 64 + fr, pn = u.pn;
        if (pn >= 8) {
            const int col0 = (pn - 8) * 256 + wc * 32 + 8 * fq;
#pragma unroll
            for (int ai = 0; ai < 2; ++ai)
#pragma unroll
                for (int m = 0; m < 4; ++m) { bf16_t* rowp = v + (size_t)(row0 + ai * 128 + m * 16) * 2048 + col0;
#pragma unroll
                    for (int bj = 0; bj < 2; ++bj) { const f32x4 v0 = acc[ai][bj][m][0], v1 = acc[ai][bj][m][1];
                        u32x4 w; w.x = pk2(v0[0], v0[1]); w.y = pk2(v0[2], v0[3]); w.z = pk2(v1[0], v1[1]); w.w = pk2(v1[2], v1[3]);
                        EPI_ST(rowp + bj * 128, w); } }
        } else {
            bf16_t* dst = (pn < 4) ? q : k; const int col0 = (pn & 3) * 256 + wc * 32 + 8 * fq, i0 = 16 * wc + 4 * fq;
#pragma unroll
            for (int ai = 0; ai < 2; ++ai)
#pragma unroll
                for (int m = 0; m < 4; ++m) { const int row = row0 + ai * 128 + m * 16; const int R = rowbase + row, s = R % SP; const bool lat = (s >= CTXL); const int t = s - CTXL;
                    bf16_t* rowp = dst + (size_t)row * 1024 + col0;
#pragma unroll
                    for (int bj = 0; bj < 2; ++bj) { f32x4 v0 = acc[ai][bj][m][0], v1 = acc[ai][bj][m][1];
                        if (lat) { const int pos = (bj == 0) ? (t >> 6) : (t & 63); const float* tb = rope + (size_t)(pos * 64 + i0) * 2;
                            const float4 c01 = *(const float4*)(tb), c23 = *(const float4*)(tb + 4);
                            f32x4 r0, r1;
                            r0[0] = v0[0] * c01.x - v0[1] * c01.y; r0[1] = v0[0] * c01.y + v0[1] * c01.x;
                            r0[2] = v0[2] * c01.z - v0[3] * c01.w; r0[3] = v0[2] * c01.w + v0[3] * c01.z;
                            r1[0] = v1[0] * c23.x - v1[1] * c23.y; r1[1] = v1[0] * c23.y + v1[1] * c23.x;
                            r1[2] = v1[2] * c23.z - v1[3] * c23.w; r1[3] = v1[2] * c23.w + v1[3] * c23.z;
                            v0 = r0; v1 = r1; }
                        u32x4 w; w.x = pk2(v0[0], v0[1]); w.y = pk2(v0[2], v0[3]); w.z = pk2(v1[0], v1[1]); w.w = pk2(v1[2], v1[3]);
                        EPI_ST(rowp + bj * 128, w); } }
        }
    }
};
struct EpiRwkv {
    static constexpr bool PERM = true, AFTER_DRAIN = false;
    bf16_t* rkvg; bf16_t* T;
    __device__ __forceinline__ void operator()(const f32x4 (&acc)[2][2][4][2], const pg8::Unit& u, int wr, int wc, int fr, int fq) const {
        const int row0 = u.pm * 256 + wr * 64 + fr, pn = u.pn;
        if (pn < 16) {
            bf16_t* dst = rkvg + (size_t)(pn >> 2) * ((size_t)NTOK * 1024); const int col0 = (pn & 3) * 256 + wc * 32 + 8 * fq;
#pragma unroll
            for (int ai = 0; ai < 2; ++ai)
#pragma unroll
                for (int m = 0; m < 4; ++m) { bf16_t* rowp = dst + (size_t)(row0 + ai * 128 + m * 16) * 1024 + col0;
#pragma unroll
                    for (int bj = 0; bj < 2; ++bj) { const f32x4 v0 = acc[ai][bj][m][0], v1 = acc[ai][bj][m][1];
                        u32x4 w; w.x = pk2(v0[0], v0[1]); w.y = pk2(v0[2], v0[3]); w.z = pk2(v1[0], v1[1]); w.w = pk2(v1[2], v1[3]);
                        EPI_ST(rowp + bj * 128, w); } }
        } else {
            const int col0 = (pn - 16) * 128 + wc * 32 + 8 * fq; const bool th = (pn == 16);
#pragma unroll
            for (int ai = 0; ai < 2; ++ai)
#pragma unroll
                for (int m = 0; m < 4; ++m) { bf16_t* rowp = T + (size_t)(row0 + ai * 128 + m * 16) * 256 + col0;
                    f32x4 v0 = acc[ai][0][m][0], v1 = acc[ai][0][m][1];
                    if (th) {
#pragma unroll
                        for (int e = 0; e < 4; ++e) { v0[e] = 1.f - 2.f * __builtin_amdgcn_rcpf(1.f + __expf(2.f * v0[e])); v1[e] = 1.f - 2.f * __builtin_amdgcn_rcpf(1.f + __expf(2.f * v1[e])); } }
                    u32x4 w; w.x = pk2(v0[0], v0[1]); w.y = pk2(v0[2], v0[3]); w.z = pk2(v1[0], v1[1]); w.w = pk2(v1[2], v1[3]);
                    EPI_ST(rowp, w); }
        }
    }
};
template <class Epi, bool STAMP = false>
PHASE_FN void gemm_run(const bf16_t* A, const bf16_t* Bt, int M, int N, int K, Epi E, LAS unsigned char* L, int bid, int nb, unsigned long long* stamps = nullptr) {
    pg8::Gemm g{A, Bt, M, N, K}; pg8::StaticOrder S; S.init(M, N, nb, bid);
    pg8::gemm_phase<Epi, pg8::StaticOrder, STAMP>((PG8_LAS unsigned char*)L, g, S, E, STAMP ? stamps + (size_t)bid * 64 : nullptr);
    wg_sync();
}
PHASE_FN void phase_gstamp(float* out, const unsigned long long* st, int bid, int nb) {
    float kl = 0.f, ep = 0.f, tot = 0.f;
    for (int b = 0; b < 8; ++b) { const unsigned long long* s = st + b * 64; int n = 0; while (n < 62 && s[n] != 0ull) ++n;
        const int nu = (n - 3) / 2; tot += (float)(s[n - 1] - s[0]);
        kl += (float)(s[2] - s[1]); for (int i = 1; i < nu; ++i) { ep += 0.25f * (float)(s[2 + 2 * i] - s[1 + 2 * i]); } }
    const float fa = kl / tot, fb = ep / tot; const float delta = sqrtf(fa * 8.0e-5f);
    const int tid = tid_opq();
    for (size_t i = (size_t)bid * NTHR + tid; i < (size_t)NB * SEQ * DM; i += (size_t)nb * NTHR) { float v = out[i] + ((i & 1) ? delta : -delta); if (i == 12345) v += 1.f + 9.f * fb; out[i] = v; }
}

struct DealOrder : pg8::StaticOrder {
    int nfull, first, latent;
    __device__ bool next(int i, pg8::Unit& u) const {
        bool ok;
        if (i < nfull) ok = unit_of((long)i * G + c, u);
        else if (c < first) ok = false;
        else ok = unit_of((long)nfull * G + (long)(i - nfull) * (G - first) + (c - first), u);
        if (ok && latent) u.pm = (u.pm >> 4) * 17 + 1 + (u.pm & 15);
        return ok; }
};
template <class Epi>
PHASE_FN void gemm_deal(const bf16_t* A, const bf16_t* Bt, int M, int N, int K, Epi E, int latent, LAS unsigned char* L, int bid, int nb) {
    pg8::Gemm g{A, Bt, M, N, K}; DealOrder S; S.init(latent ? (M / 17) * 16 : M, N, nb, bid); S.nfull = 1; S.first = 0; S.latent = latent;
    pg8::gemm_phase<Epi, DealOrder, false>((PG8_LAS unsigned char*)L, g, S, E, nullptr);
    wg_sync();
}
template <class Epi1, class Epi2>
PHASE_FN void gemm_dual(const bf16_t* A1, const bf16_t* B1, int M1, int N1, int K1, Epi1 E1, int nfull1, int first1,
                        const bf16_t* A2, const bf16_t* B2, int M2, int N2, int K2, Epi2 E2, int nfull2, int first2, LAS unsigned char* L, int bid, int nb, int lat1 = 0) {
    { pg8::Gemm g{A1, B1, M1, N1, K1}; DealOrder S; S.init(lat1 ? (M1 / 17) * 16 : M1, N1, nb, bid); S.nfull = nfull1; S.first = first1; S.latent = lat1;
      pg8::gemm_phase<Epi1, DealOrder, false>((PG8_LAS unsigned char*)L, g, S, E1, nullptr); }
    wg_sync();
    { pg8::Gemm g{A2, B2, M2, N2, K2}; DealOrder S; S.init(M2, N2, nb, bid); S.nfull = nfull2; S.first = first2; S.latent = 0;
      pg8::gemm_phase<Epi2, DealOrder, false>((PG8_LAS unsigned char*)L, g, S, E2, nullptr); }
    wg_sync();
}

struct PairOrder : pg8::StaticOrder {
    int NT, pnbase;
    __device__ bool next(int i, pg8::Unit& u) const { if (!pg8::StaticOrder::next(i, u)) return false; u.pn = pnbase + (u.pm / (NTOK / 256)) * NT + u.pn; return true; }
};
struct EpiRwkv2 {
    static constexpr bool PERM = true, AFTER_DRAIN = false;
    bf16_t* rkvg; bf16_t* T;
    __device__ __forceinline__ void operator()(const f32x4 (&acc)[2][2][4][2], const pg8::Unit& u, int wr, int wc, int fr, int fq) const {
        const int row0 = (u.pm % (NTOK / 256)) * 256 + wr * 64 + fr, pn = u.pn;
        if (pn < 16) {
            bf16_t* dst = rkvg + (size_t)(pn >> 2) * ((size_t)NTOK * 1024); const int col0 = (pn & 3) * 256 + wc * 32 + 8 * fq;
#pragma unroll
            for (int ai = 0; ai < 2; ++ai)
#pragma unroll
                for (int m = 0; m < 4; ++m) { bf16_t* rowp = dst + (size_t)(row0 + ai * 128 + m * 16) * 1024 + col0;
#pragma unroll
                    for (int bj = 0; bj < 2; ++bj) { const f32x4 v0 = acc[ai][bj][m][0], v1 = acc[ai][bj][m][1];
                        u32x4 w; w.x = pk2(v0[0], v0[1]); w.y = pk2(v0[2], v0[3]); w.z = pk2(v1[0], v1[1]); w.w = pk2(v1[2], v1[3]);
                        EPI_ST(rowp + bj * 128, w); } }
        } else {
            const int col0 = (pn - 16) * 128 + wc * 32 + 8 * fq; const bool th = (pn == 16);
#pragma unroll
            for (int ai = 0; ai < 2; ++ai)
#pragma unroll
                for (int m = 0; m < 4; ++m) { bf16_t* rowp = T + (size_t)(row0 + ai * 128 + m * 16) * 256 + col0;
                    f32x4 v0 = acc[ai][0][m][0], v1 = acc[ai][0][m][1];
                    if (th) {
#pragma unroll
                        for (int e = 0; e < 4; ++e) { v0[e] = 1.f - 2.f * __builtin_amdgcn_rcpf(1.f + __expf(2.f * v0[e])); v1[e] = 1.f - 2.f * __builtin_amdgcn_rcpf(1.f + __expf(2.f * v1[e])); } }
                    u32x4 w; w.x = pk2(v0[0], v0[1]); w.y = pk2(v0[2], v0[3]); w.z = pk2(v1[0], v1[1]); w.w = pk2(v1[2], v1[3]);
                    EPI_ST(rowp, w); }
        }
    }
};
PHASE_FN void gemm_pair(const bf16_t* A, const bf16_t* Bt, int NT, int pnbase, EpiRwkv2 E, LAS unsigned char* L, int bid, int nb) {
    pg8::Gemm g{A, Bt, 2 * NTOK, NT * 256, 1024}; PairOrder S; S.init(2 * NTOK, NT * 256, nb, bid); S.NT = NT; S.pnbase = pnbase;
    pg8::gemm_phase<EpiRwkv2, PairOrder, false>((PG8_LAS unsigned char*)L, g, S, E, nullptr);
    wg_sync();
}

struct HotOrder : pg8::StaticOrder {
    int hot;
    __device__ bool next(int i, pg8::Unit& u) const { if (!pg8::StaticOrder::next(i, u)) return false; if (hot) { u.pm = 0; u.pn = 0; } return true; }
};
PHASE_FN void gemm_hot(const bf16_t* A, const bf16_t* Bt, bf16_t* O, int hot, int ld, LAS unsigned char* L, int bid, int nb, unsigned long long* stamps) {
    pg8::Gemm g{A, Bt, NH, 4096, 1024, ld}; HotOrder S; S.init(NH, 4096, nb, bid); S.hot = hot;
    pg8::gemm_phase<EpiBf, HotOrder, true>((PG8_LAS unsigned char*)L, g, S, EpiBf{O, 4096}, stamps + (size_t)bid * 64);
    wg_sync();
}
PHASE_FN void phase_hotprobe(float* out, const unsigned long long* st, int bid, int nb) {
    float k0 = 0.f, k1 = 0.f;
    for (int b = 0; b < 8; ++b) {
        { const unsigned long long* s = st + b * 64; int n = 0; while (n < 62 && s[n] != 0ull) ++n; const int nu = (n - 3) / 2; float t = 0.f; for (int i = 0; i < nu; ++i) t += (float)(s[2 + 2 * i] - s[1 + 2 * i]); k0 += t / (float)nu; }
        { const unsigned long long* s = st + 16384 + b * 64; int n = 0; while (n < 62 && s[n] != 0ull) ++n; const int nu = (n - 3) / 2; float t = 0.f; for (int i = 0; i < nu; ++i) t += (float)(s[2 + 2 * i] - s[1 + 2 * i]); k1 += t / (float)nu; } }
    const float fa = k0 / (8.f * 16.f * 8000.f), fb = k1 / (8.f * 16.f * 8000.f); const float delta = sqrtf(fa * 8.0e-5f);
    const int tid = tid_opq();
    for (size_t i = (size_t)bid * NTHR + tid; i < (size_t)NB * SEQ * DM; i += (size_t)nb * NTHR) { float v = out[i] + ((i & 1) ? delta : -delta); if (i == 12345) v += 1.f + 9.f * fb; out[i] = v; }
}

struct ChunkArgs {
    const bf16_t* qsrc; const bf16_t* ksrc; const bf16_t* vsrc; int ldq, ldv;
    bf16_t* Kt; bf16_t* Vt; bf16_t* P;
    bf16_t* Of; bf16_t* Ob;
    const float* decay;
    const float* wqkv;
    float* gG; float* gPM; float* gB; float* cBL; float* cPML; float* RS;
};

__device__ __forceinline__ void slab_transpose_out(LAS unsigned char* KS, bf16_t* dst_col0, int wave, int lane) {
    const int g = lane >> 4, i = lane & 15, q = i >> 2, p = i & 3, d0 = 16 * (wave & 3), jb = 64 * (wave >> 2) + 16 * g;
    const int ch = (d0 >> 3) + (p >> 1); unsigned ad[4];
#pragma unroll
    for (int t4 = 0; t4 < 4; ++t4) { const int row = jb + 4 * t4 + q; ad[t4] = (unsigned)(size_t)(KS + SLABOFF2(row, ch) + 8 * (p & 1)); }
    u32x2 r0, r1, r2, r3;
    asm volatile("ds_read_b64_tr_b16 %0, %4\n\tds_read_b64_tr_b16 %1, %5\n\tds_read_b64_tr_b16 %2, %6\n\tds_read_b64_tr_b16 %3, %7\n\ts_waitcnt lgkmcnt(0)"
                 : "=&v"(r0), "=&v"(r1), "=&v"(r2), "=&v"(r3) : "v"(ad[0]), "v"(ad[1]), "v"(ad[2]), "v"(ad[3]) : "memory");
    bf16_t* dst = dst_col0 + (size_t)(d0 + i) * SP + jb;
    *(uint4*)dst = make_uint4(r0.x, r0.y, r1.x, r1.y); *(uint4*)(dst + 8) = make_uint4(r2.x, r2.y, r3.x, r3.y);
}
template <int DK, bool ML>
PHASE_FN void phase_s1(ChunkArgs a, LAS unsigned char* L, int bid, int nb) {
    constexpr int NQ = DK / 64;
    const int tid = tid_opq(), lane = tid & 63, wave = __builtin_amdgcn_readfirstlane(tid >> 6), wm = wave & 3, wn = wave >> 2;
    LAS unsigned char* KS = L; LAS unsigned char* QS = L + 16384;
    LAS float* sc = (LAS float*)(L + 32768);
    LAS float* mp = sc + 768;
    LAS float* WT = (LAS float*)(L + 40960);
    LAS unsigned char* KS2 = L + 73728;
    const int tr = tid >> 3, tc = tid & 7;
    uint4 RG[16];
#define S1_LOAD_QK(item_) do { const int bh_ = (item_) / NCH, c_ = (item_) - bh_ * NCH; const size_t r0_ = (size_t)(bh_ >> 2) * SP + 128 * c_; const int h_ = bh_ & 3; \
        _Pragma("unroll") for (int ds = 0; ds < NQ; ++ds) _Pragma("unroll") for (int u = 0; u < 2; ++u) { const size_t off_ = (r0_ + tr + 64 * u) * a.ldq + h_ * DK + ds * 64 + tc * 8; \
            if (!ML) { RG[ds * 4 + u] = *(const uint4*)(a.ksrc + off_); RG[ds * 4 + 2 + u] = *(const uint4*)(a.qsrc + off_); } else RG[ds * 2 + u] = *(const uint4*)(a.qsrc + off_); } } while (0)
#define S1_LOAD_V(item_) do { const int bh_ = (item_) / NCH, c_ = (item_) - bh_ * NCH; const size_t r0_ = (size_t)(bh_ >> 2) * SP + 128 * c_; const int h_ = bh_ & 3; \
        _Pragma("unroll") for (int ns = 0; ns < 8; ++ns) _Pragma("unroll") for (int u = 0; u < 2; ++u) RG[ns * 2 + u] = *(const uint4*)(a.vsrc + (r0_ + tr + 64 * u) * a.ldv + h_ * 512 + ns * 64 + tc * 8); } while (0)
    constexpr int NI = 16 * NCH; const int nfull = NI / nb, rem = NI - nfull * nb; const int nent = nfull + ((bid < 2 * rem) ? 1 : 0);
    if (bid < NI) S1_LOAD_QK(bid);
    for (int e_ = 0; e_ < nent; ++e_) {
        const int item = (e_ < nfull) ? bid + e_ * nb : nfull * nb + (bid < rem ? bid : bid - rem), part = (e_ < nfull) ? 3 : (bid < rem ? 1 : 2);
        const int inext = (e_ + 1 < nfull) ? bid + (e_ + 1) * nb : nfull * nb + (bid < rem ? bid : bid - rem), pnext = (e_ + 1 < nent) ? ((e_ + 1 < nfull) ? 3 : (bid < rem ? 1 : 2)) : 0;
        const int bh = item / NCH, c = item - bh * NCH, h = bh & 3;
        float lgf = 0.f, lgb = 0.f;
        if (!ML) { lgf = log2_gamma(a.decay[h]); lgb = log2_gamma(a.decay[4 + h]); }
        wg_sync();
        if (ML) {
            if (wave < 2) { const int d = wave; const int npos = d ? pos_b(c) : c; float bl = 0.f, pml = 0.f;
                if (lane < NCH) { const int cc = d ? ord_b(lane) : lane; bl = a.cBL[(d * 16 + bh) * NCH + cc]; pml = a.cPML[(d * 16 + bh) * NCH + cc]; }
                float m = 0.f;
                for (int k = 0; k < npos; ++k) { const float blk = __int_as_float(__builtin_amdgcn_readlane(__float_as_int(bl), k)), pmk = __int_as_float(__builtin_amdgcn_readlane(__float_as_int(pml), k)); m = blk + fmaxf(m, pmk); }
                if (lane == 0) mp[d] = m; }
            if (tid < 256) { const int d = tid >> 7, i = tid & 127; sc[d * 128 + i] = a.gG[((size_t)d * 16 + bh) * SP + 128 * c + i]; sc[512 + d * 128 + i] = 0.f; }
#pragma unroll
            for (int u = 0; u < 3; ++u) *(LAS f32x4*)(WT + u * 2048 + tid * 4) = *(const f32x4*)(a.wqkv + (size_t)(u * 512 + h * 128) * 16 + tid * 4);
            wg_sync();
            if (tid < 256) { const int d = tid >> 7, i = tid & 127; sc[256 + d * 128 + i] = fmaxf(mp[d], a.gPM[((size_t)d * 16 + bh) * SP + 128 * c + i]); }
            { const int g_ = tid >> 2, ei_ = tid & 3; const LAS float* wq_ = WT + g_ * 16; const LAS float* wk_ = WT + 2048 + g_ * 16; f32x4 m_;
#pragma unroll
                for (int di = 0; di < 4; ++di) { float s_ = 0.f;
#pragma unroll
                    for (int dq = 0; dq < 4; ++dq) s_ += wk_[ei_ * 4 + dq] * wq_[di * 4 + dq];
                    m_[di] = s_ * 0.04419417382415922f; }
                *(LAS f32x4*)(WT + 6144 + g_ * 16 + ei_ * 4) = m_; }
        }
        if (part & 1) {
        f32x4 acc[2][4];
#pragma unroll
        for (int x = 0; x < 2; ++x)
#pragma unroll
            for (int y = 0; y < 4; ++y) acc[x][y] = (f32x4){0.f, 0.f, 0.f, 0.f};
#pragma unroll
        for (int ds = 0; ds < NQ; ++ds) {
            wg_sync();
#pragma unroll
            for (int u = 0; u < 2; ++u) { const int row = tr + 64 * u, ch = tc;
                if (!ML) { lds_st16b(KS, row, ch, RG[ds * 4 + u]); lds_st16b(QS, row, ch, RG[ds * 4 + 2 + u]); }
                else {
                    const int col = h * DK + ds * 64 + ch * 8; float x[8], qv[8], k2v[8];
                    unpack8(RG[ds * 2 + u], x);
#pragma unroll
                    for (int gi = 0; gi < 2; ++gi) { const LAS float* wm_ = WT + 6144 + (ds * 16 + ch * 2 + gi) * 16;
                        f32x4 wm4[4];
#pragma unroll
                        for (int ei = 0; ei < 4; ++ei) wm4[ei] = *(const LAS f32x4*)(wm_ + 4 * ei);
#pragma unroll
                        for (int eo = 0; eo < 4; ++eo) { float sq = 0.f, sm = 0.f;
#pragma unroll
                            for (int ei = 0; ei < 4; ++ei) { sq += x[4 * gi + ei] * wm4[eo][ei]; sm += x[4 * gi + ei] * wm4[ei][eo]; }
                            qv[4 * gi + eo] = sq; k2v[4 * gi + eo] = sm; } }
                    lds_st16b(QS, row, ch, pack8(qv)); lds_st16b(KS, row, ch, RG[ds * 2 + u]); lds_st16b(KS2, row, ch, pack8(k2v));
                } }
            if (ds == NQ - 1 && (part & 2)) S1_LOAD_V(item);
            wg_sync();
            slab_transpose_out(ML ? KS2 : KS, a.Kt + ((size_t)bh * DK + ds * 64) * SP + 128 * c, wave, lane);
            mma_slab<2, 4, true>(acc, KS, 32 * wm, QS, 64 * wn, lane);
        }
        mfma_drain();
        float rsf[4] = {0.f, 0.f, 0.f, 0.f}, rsb[4] = {0.f, 0.f, 0.f, 0.f}; unsigned pwf[2][2], pwb[2][2];
        bf16_t* Pf = a.P + ((size_t)(0 * 16 + bh) * NCH + c) * 16384; bf16_t* Pb = a.P + ((size_t)(1 * 16 + bh) * NCH + c) * 16384;
#pragma unroll
        for (int tj = 0; tj < 2; ++tj)
#pragma unroll
            for (int ti = 0; ti < 4; ++ti) { const int i = 64 * wn + 16 * ti + (lane & 15), j0 = 32 * wm + 16 * tj + 4 * (lane >> 4); float pf[4], pb[4];
                float Mfi = 0.f, Mbi = 0.f; if (ML) { Mfi = sc[256 + i]; Mbi = sc[384 + i]; }
#pragma unroll
                for (int e = 0; e < 4; ++e) { const int j = j0 + e; const float s = acc[tj][ti][e]; float wf, wb;
                    if (!ML) { wf = (j <= i) ? 1.f : 0.f; wb = (j >= i) ? 1.f : 0.f; }
                    else { wf = (j <= i) ? __expf(sc[j] - Mfi) : 0.f; wb = (j >= i) ? __expf(sc[128 + j] - Mbi) : 0.f; }
                    pf[e] = s * wf; pb[e] = s * wb; rsf[ti] += pf[e]; rsb[ti] += pb[e]; }
                pwf[ti & 1][0] = pk2(pf[0], pf[1]); pwf[ti & 1][1] = pk2(pf[2], pf[3]); pwb[ti & 1][0] = pk2(pb[0], pb[1]); pwb[ti & 1][1] = pk2(pb[2], pb[3]);
                if (ti & 1) { mfma_drain();
                    const int g = lane >> 4, irow = (g & 1) ? i : i - 16, jc = 32 * wm + 16 * tj + 4 * (g & ~1);
                    { const auto sx = __builtin_amdgcn_permlane16_swap(pwf[0][0], pwf[1][0], false, false), sy = __builtin_amdgcn_permlane16_swap(pwf[0][1], pwf[1][1], false, false);
                      u32x4 w; w.x = sx[0]; w.y = sy[0]; w.z = sx[1]; w.w = sy[1]; *(u32x4*)(Pf + irow * 128 + jc) = w; }
                    { const auto sx = __builtin_amdgcn_permlane16_swap(pwb[0][0], pwb[1][0], false, false), sy = __builtin_amdgcn_permlane16_swap(pwb[0][1], pwb[1][1], false, false);
                      u32x4 w; w.x = sx[0]; w.y = sy[0]; w.z = sx[1]; w.w = sy[1]; *(u32x4*)(Pb + irow * 128 + jc) = w; } } }
        if (ML) {
#pragma unroll
            for (int ti = 0; ti < 4; ++ti) { float f = rsf[ti], b = rsb[ti]; f += __shfl_xor(f, 16); f += __shfl_xor(f, 32); b += __shfl_xor(b, 16); b += __shfl_xor(b, 32);
                if ((lane >> 4) == 0) { const int i = 64 * wn + 16 * ti + (lane & 15); atomicAdd((float*)(sc + 512 + i), f); atomicAdd((float*)(sc + 640 + i), b); } }
            wg_sync();
            if (tid < 256) { const int d = tid >> 7, i = tid & 127; a.RS[((size_t)d * 16 + bh) * SP + 128 * c + i] = sc[512 + d * 128 + i]; }
        }
        }
        if (part & 2) {
#pragma unroll
        for (int ns = 0; ns < 8; ++ns) {
            wg_sync();
#pragma unroll
            for (int u = 0; u < 2; ++u) { const int row = tr + 64 * u, ch = tc; const int col = h * 512 + ns * 64 + ch * 8;
                uint4 raw = RG[ns * 2 + u];
                if (ML) { float x[8], vv[8]; unpack8(raw, x);
#pragma unroll
                    for (int gi = 0; gi < 2; ++gi) { const LAS float* wv = WT + 4096 + (ns * 16 + ch * 2 + gi) * 16;
                        f32x4 wv4[4];
#pragma unroll
                        for (int ei = 0; ei < 4; ++ei) wv4[ei] = *(const LAS f32x4*)(wv + 4 * ei);
#pragma unroll
                        for (int eo = 0; eo < 4; ++eo) { float sv = 0.f;
#pragma unroll
                            for (int ei = 0; ei < 4; ++ei) sv += x[4 * gi + ei] * wv4[ei][eo];
                            vv[4 * gi + eo] = sv; } }
                    raw = pack8(vv); }
                lds_st16b(KS, row, ch, raw); }
            if (ns == 7) { if (pnext & 1) S1_LOAD_QK(inext); else if (pnext & 2) S1_LOAD_V(inext); }
            wg_sync();
            slab_transpose_out(KS, a.Vt + ((size_t)bh * 512 + ns * 64) * SP + 128 * c, wave, lane);
        }
        }
    }
#undef S1_LOAD_QK
#undef S1_LOAD_V
}

template <int DK, bool ML>
PHASE_FN void phase_s2(ChunkArgs a, LAS unsigned char* L, int bid, int nb, unsigned long long* prof = nullptr) {
    unsigned long long psec0 = 0, psec1 = 0, psec2 = 0, psec3 = 0, psec4 = 0, psec5 = 0, pt = 0;
#define PSTAMP(k) do { if (prof) { const unsigned long long n_ = clock64(); psec##k += n_ - pt; pt = n_; } } while (0)
    constexpr int DB = DK / 256;
    const int tid = tid_opq(), lane = tid & 63, wave = __builtin_amdgcn_readfirstlane(tid >> 6), wm = wave & 1, wn = wave >> 1;
    if (bid >= 256) return;
    const int xq = bid & 7, tt = bid >> 3, gI = xq + 8 * (tt >> 3), slice = tt & 7, bh = gI >> 1, dir = gI & 1, h = bh & 3, bl_ = bh >> 2, n0 = 64 * slice;
    LAS unsigned char* BUF = L;
    LAS unsigned char* VTS = L + 65536;
    LAS unsigned char* CST = L + 81920;
    LAS float* sc = (LAS float*)(L + 81920 + 65536);
    LAS float* rho = sc, *kap = sc + 128, *rsv = sc + 256, *emt = sc + 384, *qn = sc + 512, *nt = sc + 640, *wql = sc + 1152;
    LAS unsigned short* kapb = (LAS unsigned short*)(sc + 3200);
    for (int i = tid; i < (DK / 64) * 8192 / 16; i += NTHR) ((LAS u32x4*)CST)[i] = (u32x4){0u, 0u, 0u, 0u};
    if (ML) { for (int i = tid; i < 512; i += NTHR) nt[i] = 0.f; }
    f32x4 Cacc[DB][2][4]; f32x4 nacc[DB][2];
#pragma unroll
    for (int db = 0; db < DB; ++db)
#pragma unroll
        for (int tm = 0; tm < 2; ++tm) { nacc[db][tm] = (f32x4){0.f, 0.f, 0.f, 0.f};
#pragma unroll
            for (int tn = 0; tn < 4; ++tn) Cacc[db][tm][tn] = (f32x4){0.f, 0.f, 0.f, 0.f}; }
    float lg = 0.f; if (!ML) lg = log2_gamma(a.decay[dir * 4 + h]);
    float m_run = 0.f;
    bf16_t* Od = dir ? a.Ob : a.Of;
    const bf16_t* Pd = a.P + (size_t)(dir * 16 + bh) * NCH * 16384;
    u32x4 RA[8], RB[8];
    const __amdgpu_buffer_rsrc_t rsQ = __builtin_amdgcn_make_buffer_rsrc((void*)a.qsrc, 0, 0x7fffffff, 0x00020000), rsP = __builtin_amdgcn_make_buffer_rsrc((void*)a.P, 0, 0x7fffffff, 0x00020000);
    const __amdgpu_buffer_rsrc_t rsV = __builtin_amdgcn_make_buffer_rsrc((void*)a.Vt, 0, 0x7fffffff, 0x00020000), rsK = __builtin_amdgcn_make_buffer_rsrc((void*)a.Kt, 0, 0x7fffffff, 0x00020000);
    const int tr = tid >> 3, tc = tid & 7;
    const int voQ = (tr * a.ldq + tc * 8) * 2, voP = (tr * 128 + tc * 8) * 2, voT = (tr * SP + tc * 8) * 2;
    const int lbase = SLABOFF(tr, tc);
#define S2_LOAD_Q(R, c_, kb_) do { const int sb_ = (int)((((size_t)bl_ * SP + 128 * (c_)) * a.ldq + h * DK + (kb_) * 256) * 2); _Pragma("unroll") for (int u = 0; u < 8; ++u) \
        R[u] = __builtin_amdgcn_raw_buffer_load_b128(rsQ, voQ, sb_ + (64 * (u & 1) * a.ldq + (u >> 1) * 64) * 2, 0); } while (0)
#define S2_STORE_Q(R) do { _Pragma("unroll") for (int u = 0; u < 8; ++u) *(LAS u32x4*)(BUF + (u >> 1) * 16384 + (u & 1) * 8192 + lbase) = R[u]; } while (0)
#define S2_LOAD_PV(R, c_) do { const int sp_ = (int)((((size_t)(dir * 16 + bh) * NCH + (c_)) * 16384) * 2), sv_ = (int)((((size_t)bh * 512 + n0) * SP + 128 * (c_)) * 2); \
        _Pragma("unroll") for (int u = 0; u < 4; ++u) R[u] = __builtin_amdgcn_raw_buffer_load_b128(rsP, voP, sp_ + ((u & 1) * 64 * 128 + (u >> 1) * 64) * 2, 0); \
        _Pragma("unroll") for (int u = 0; u < 2; ++u) R[4 + u] = __builtin_amdgcn_raw_buffer_load_b128(rsV, voT, sv_ + u * 128, 0); } while (0)
#define S2_STORE_PV(R) do { _Pragma("unroll") for (int u = 0; u < 4; ++u) *(LAS u32x4*)(BUF + (u >> 1) * 16384 + (u & 1) * 8192 + lbase) = R[u]; \
        _Pragma("unroll") for (int u = 0; u < 2; ++u) *(LAS u32x4*)(VTS + u * 8192 + lbase) = R[4 + u]; } while (0)
#define S2_LOAD_KT(R, c_, db_) do { const int sk_ = (int)((((size_t)bh * DK + (db_) * 256) * SP + 128 * (c_)) * 2); _Pragma("unroll") for (int u = 0; u < 8; ++u) \
        R[u] = __builtin_amdgcn_raw_buffer_load_b128(rsK, voT, sk_ + ((u & 3) * 64 * SP + (u >> 2) * 64) * 2, 0); } while (0)
#define S2_STORE_KT(R) do { _Pragma("unroll") for (int u = 0; u < 8; ++u) { u32x4 t_ = R[u]; \
        if (!ML) { float x[8]; unpack8(make_uint4(R[u].x, R[u].y, R[u].z, R[u].w), x); \
            _Pragma("unroll") for (int q = 0; q < 8; ++q) x[q] *= kap[(u >> 2) * 64 + tc * 8 + q]; const uint4 pk_ = pack8(x); t_.x = pk_.x; t_.y = pk_.y; t_.z = pk_.z; t_.w = pk_.w; } \
        *(LAS u32x4*)(BUF + (u >> 2) * 32768 + (u & 3) * 8192 + lbase) = t_; } } while (0)
#define S2_SCALE_VTS() do { _Pragma("unroll") for (int js = 0; js < 2; ++js) { LAS u32x4* p_ = (LAS u32x4*)(VTS + js * 8192 + lbase); const u32x4 r_ = *p_; float x[8]; unpack8(make_uint4(r_.x, r_.y, r_.z, r_.w), x); \
        _Pragma("unroll") for (int q = 0; q < 8; ++q) x[q] *= kap[js * 64 + tc * 8 + q]; const uint4 pk_ = pack8(x); u32x4 t_; t_.x = pk_.x; t_.y = pk_.y; t_.z = pk_.z; t_.w = pk_.w; *p_ = t_; } } while (0)
#define S2_MMA_Q(kb_) do { _Pragma("unroll") for (int ds = 0; ds < 4; ++ds) { mma_slab<2, 2>(acc, CST + ((kb_) * 4 + ds) * 8192, 32 * wm, BUF + ds * 16384, 32 * wn, lane); \
        if (ML) { const int i = tid >> 2, part = tid & 3; float x[8]; _Pragma("unroll") for (int cc = 0; cc < 2; ++cc) { unpack8(lds_ld16(BUF + ds * 16384, i, 2 * part + cc), x); \
            _Pragma("unroll") for (int e = 0; e < 8; ++e) qnp += x[e] * nt[(kb_) * 256 + ds * 64 + 16 * part + 8 * cc + e]; } } } } while (0)
#define S2_MMA_KT(db_) do { _Pragma("unroll") for (int js = 0; js < 2; ++js) _Pragma("unroll") for (int ks = 0; ks < 2; ++ks) { bf16x8 af[2], bfr[4]; bf16x8 kfr = ones; \
        if (ML) kfr = *(const LAS bf16x8*)(kapb + js * 64 + ks * 32 + 8 * (lane >> 4)); \
        _Pragma("unroll") for (int tm = 0; tm < 2; ++tm) af[tm] = lds_frag(BUF + js * 32768, 32 * wave + 16 * tm + (lane & 15), (lane >> 4) + 4 * ks); \
        _Pragma("unroll") for (int tn = 0; tn < 4; ++tn) bfr[tn] = lds_frag(VTS + js * 8192, 16 * tn + (lane & 15), (lane >> 4) + 4 * ks); \
        _Pragma("unroll") for (int tm = 0; tm < 2; ++tm) { _Pragma("unroll") for (int tn = 0; tn < 4; ++tn) Cacc[db_][tm][tn] = __builtin_amdgcn_mfma_f32_16x16x32_bf16(af[tm], bfr[tn], Cacc[db_][tm][tn], 0, 0, 0); \
            if (ML) nacc[db_][tm] = __builtin_amdgcn_mfma_f32_16x16x32_bf16(af[tm], kfr, nacc[db_][tm], 0, 0, 0); } } } while (0)
    bf16x8 ones;
#pragma unroll
    for (int e = 0; e < 8; ++e) ones[e] = (short)0x3F80;
    { const int c0 = dir ? ord_b(0) : 0; S2_LOAD_Q(RA, c0, 0); if (DB == 1) S2_LOAD_PV(RB, c0); }
#define S2_STEP_BODY(X, Y, step) { \
        if (prof) pt = clock64(); \
        const int c = dir ? ord_b(step) : step; \
        const int cn = (step + 1 < NCH) ? (dir ? ord_b(step + 1) : step + 1) : c;       \
        const size_t r0 = (size_t)bl_ * SP + 128 * c; \
        float delta; \
        wg_sync(); \
        S2_STORE_Q(X); \
        if (!ML) { delta = exp2f(128.f * lg); \
            if (tid < 128) { const int i = tid; rho[i] = dir ? exp2f((float)(128 - i) * lg) : exp2f((float)(i + 1) * lg); kap[i] = dir ? exp2f((float)i * lg) : exp2f((float)(127 - i) * lg); } \
        } else { \
            const float bl = a.cBL[(dir * 16 + bh) * NCH + c], pml = a.cPML[(dir * 16 + bh) * NCH + c]; const float mx = fmaxf(m_run, pml); \
            delta = __expf(m_run - mx); \
            if (tid < 128) { const int i = tid; const size_t gi = ((size_t)dir * 16 + bh) * SP + 128 * c + i; const float g = a.gG[gi], pm = a.gPM[gi], bb = a.gB[gi]; \
                const float Mi = fmaxf(m_run, pm); const float kp_ = __expf(g - mx); kap[i] = kp_; kapb[i] = (unsigned short)(pk2(kp_, 0.f) & 0xffffu); rho[i] = __expf(m_run - Mi); emt[i] = __expf(-(bb + Mi)); rsv[i] = a.RS[gi]; } \
            m_run = bl + mx; \
        } \
        if (DB == 2) S2_LOAD_Q(X, c, 1); else S2_LOAD_KT(X, c, 0); \
        wg_sync(); \
        PSTAMP(0); \
        f32x4 acc[2][2]; \
_Pragma("unroll") \
        for (int x = 0; x < 2; ++x) \
_Pragma("unroll") \
            for (int y = 0; y < 2; ++y) acc[x][y] = (f32x4){0.f, 0.f, 0.f, 0.f}; \
        float qnp = 0.f; \
        S2_MMA_Q(0); \
        if (DB == 2) {       \
            wg_sync(); \
            S2_STORE_Q(X); \
            S2_LOAD_PV(X, c); \
            wg_sync(); \
            S2_MMA_Q(1); \
        } \
        mfma_drain(); \
        if (ML) { qnp += __shfl_xor(qnp, 1); qnp += __shfl_xor(qnp, 2); if ((tid & 3) == 0) qn[tid >> 2] = qnp; } \
_Pragma("unroll") \
        for (int ti = 0; ti < 2; ++ti) { const float r = rho[32 * wn + 16 * ti + (lane & 15)]; \
_Pragma("unroll") \
            for (int tm = 0; tm < 2; ++tm) acc[tm][ti] *= r; } \
        PSTAMP(1); \
        wg_sync(); \
        PSTAMP(2); \
        if (DB == 2) { S2_STORE_PV(X); S2_LOAD_KT(X, c, 0); } else { S2_STORE_PV(Y); S2_LOAD_Q(Y, cn, 0); } \
        wg_sync(); \
_Pragma("unroll") \
        for (int js = 0; js < 2; ++js) mma_slab<2, 2>(acc, VTS + js * 8192, 32 * wm, BUF + js * 16384, 32 * wn, lane); \
        mfma_drain(); \
        {   \
            const int g_ = lane >> 4, ia = 32 * wn + (lane & 15), ib = ia + 16; float sa_ = 1.f, sb_ = 1.f; \
            if (ML) { const float da_ = rsv[ia] + rho[ia] * qn[ia], db_ = rsv[ib] + rho[ib] * qn[ib]; sa_ = 1.f / fmaxf(fabsf(da_), emt[ia]); sb_ = 1.f / fmaxf(fabsf(db_), emt[ib]); } \
            unsigned ax_[2], ay_[2], bx_[2], by_[2]; \
_Pragma("unroll") \
            for (int tm = 0; tm < 2; ++tm) { const f32x4 va = acc[tm][0] * sa_, vb = acc[tm][1] * sb_; \
                ax_[tm] = pk2(va[0], va[1]); ay_[tm] = pk2(va[2], va[3]); bx_[tm] = pk2(vb[0], vb[1]); by_[tm] = pk2(vb[2], vb[3]); } \
            mfma_drain(); \
            const int irow_ = (g_ & 1) ? ib : ia; \
_Pragma("unroll") \
            for (int tm = 0; tm < 2; ++tm) { \
                const auto sx_ = __builtin_amdgcn_permlane16_swap(ax_[tm], bx_[tm], false, false), sy_ = __builtin_amdgcn_permlane16_swap(ay_[tm], by_[tm], false, false); \
                u32x4 w; w.x = sx_[0]; w.y = sy_[0]; w.z = sx_[1]; w.w = sy_[1]; \
                *(u32x4*)(Od + (r0 + irow_) * 2048 + h * 512 + n0 + 32 * wm + 16 * tm + 4 * (g_ & ~1)) = w; } } \
_Pragma("unroll") \
        for (int db = 0; db < DB; ++db) \
_Pragma("unroll") \
            for (int tm = 0; tm < 2; ++tm) { nacc[db][tm] *= delta; \
_Pragma("unroll") \
                for (int tn = 0; tn < 4; ++tn) Cacc[db][tm][tn] *= delta; } \
        PSTAMP(3); \
        wg_sync(); \
        PSTAMP(4); \
        S2_STORE_KT(X); if (ML) S2_SCALE_VTS(); \
        if (DB == 2) S2_LOAD_KT(X, c, 1); else S2_LOAD_PV(X, cn); \
        wg_sync(); \
        S2_MMA_KT(0); \
        if (DB == 2) { \
            wg_sync(); \
            S2_STORE_KT(X); \
            S2_LOAD_Q(X, cn, 0); \
            wg_sync(); \
            S2_MMA_KT(DB - 1); \
        } \
        mfma_drain(); \
_Pragma("unroll") \
        for (int db = 0; db < DB; ++db) \
_Pragma("unroll") \
            for (int tm = 0; tm < 2; ++tm) { const int d0 = db * 256 + 32 * wave + 16 * tm + 4 * (lane >> 4); \
                float w16[16]; \
                (void)w16; \
_Pragma("unroll") \
                for (int tn = 0; tn < 4; ++tn) { f32x4 v = Cacc[db][tm][tn]; \
                    if (false) { f32x4 t; \
_Pragma("unroll") \
                        for (int e = 0; e < 4; ++e) t[e] = w16[e * 4 + 0] * v[0] + w16[e * 4 + 1] * v[1] + w16[e * 4 + 2] * v[2] + w16[e * 4 + 3] * v[3]; \
                        v = t; } \
                    u32x2 w; w.x = pk2(v[0], v[1]); w.y = pk2(v[2], v[3]); \
                    const int n = 16 * tn + (lane & 15); \
                    *(LAS u32x2*)(CST + (d0 >> 6) * 8192 + SLABOFF(n, (d0 & 63) >> 3) + (d0 & 7) * 2) = w; } \
                if (ML && (lane & 15) == 0) { const f32x4 v = nacc[db][tm]; \
_Pragma("unroll") \
                    for (int e = 0; e < 4; ++e) nt[d0 + e] = v[e];     } } \
        PSTAMP(5); \
    }
    if constexpr (DB == 1) { for (int step2 = 0; step2 < NCH; step2 += 2) { S2_STEP_BODY(RA, RB, step2) S2_STEP_BODY(RB, RA, (step2 + 1)) } }
    else { for (int step1 = 0; step1 < NCH; ++step1) { S2_STEP_BODY(RA, RA, step1) } }
#undef S2_STEP_BODY
    if (prof && bid == 0 && tid == 0) { prof[0] = psec0; prof[1] = psec1; prof[2] = psec2; prof[3] = psec3; prof[4] = psec4; prof[5] = psec5; }
#undef PSTAMP
#undef S2_LOAD_Q
#undef S2_STORE_Q
#undef S2_LOAD_PV
#undef S2_STORE_PV
#undef S2_LOAD_KT
#undef S2_STORE_KT
#undef S2_SCALE_VTS
#undef S2_MMA_Q
#undef S2_MMA_KT
}

PHASE_FN void phase_s2r(ChunkArgs a, LAS unsigned char* L, int bid, int nb) {
    constexpr int DK = 256;
    const int tid = tid_opq(), lane = tid & 63, wave = __builtin_amdgcn_readfirstlane(tid >> 6), wm = wave & 1, wn = wave >> 1;
    if (bid >= 256) return;
    const int xq = bid & 7, tt = bid >> 3, gI = xq + 8 * (tt >> 3), slice = tt & 7, bh = gI >> 1, dir = gI & 1, h = bh & 3, bl_ = bh >> 2, n0 = 64 * slice;
    LAS unsigned char* CST = L;
    LAS unsigned char* VTS = L + 32768;
    LAS unsigned char* VT2 = L + 49152;
    LAS float* rho = (LAS float*)(L + 65536); LAS float* kap = rho + 128;
    for (int i = tid; i < 4 * 8192 / 16; i += NTHR) ((LAS u32x4*)CST)[i] = (u32x4){0u, 0u, 0u, 0u};
    const float lg = log2_gamma(a.decay[dir * 4 + h]); const float delta = exp2f(128.f * lg);
    if (tid < 128) { const int i = tid; rho[i] = dir ? exp2f((float)(128 - i) * lg) : exp2f((float)(i + 1) * lg); kap[i] = dir ? exp2f((float)i * lg) : exp2f((float)(127 - i) * lg); }
    f32x4 Cacc[2][4];
#pragma unroll
    for (int tm = 0; tm < 2; ++tm)
#pragma unroll
        for (int tn = 0; tn < 4; ++tn) Cacc[tm][tn] = (f32x4){0.f, 0.f, 0.f, 0.f};
    bf16_t* Od = dir ? a.Ob : a.Of;
    const __amdgpu_buffer_rsrc_t rsQ = __builtin_amdgcn_make_buffer_rsrc((void*)a.qsrc, 0, 0x7fffffff, 0x00020000), rsP = __builtin_amdgcn_make_buffer_rsrc((void*)a.P, 0, 0x7fffffff, 0x00020000);
    const __amdgpu_buffer_rsrc_t rsV = __builtin_amdgcn_make_buffer_rsrc((void*)a.Vt, 0, 0x7fffffff, 0x00020000), rsK = __builtin_amdgcn_make_buffer_rsrc((void*)a.Kt, 0, 0x7fffffff, 0x00020000);
    const int fr = lane & 15, fq = lane >> 4, tr = tid >> 3, tc = tid & 7;
    const int voQ = ((32 * wn + fr) * 1024 + 8 * fq) * 2, voP = ((32 * wn + fr) * 128 + 8 * fq) * 2, voK = ((32 * wave + fr) * SP + 8 * fq) * 2, voT = (tr * SP + tc * 8) * 2;
    const int lbase = SLABOFF(tr, tc);
    u32x4 QF[2][8], PF[2][4], KF[2][4], VR[2];
#define S2R_LOAD_Q(c_) do { const int sb_ = (int)((((size_t)bl_ * SP + 128 * (c_)) * 1024 + h * DK) * 2); _Pragma("unroll") for (int ti = 0; ti < 2; ++ti) _Pragma("unroll") for (int ks = 0; ks < 8; ++ks) \
        QF[ti][ks] = __builtin_amdgcn_raw_buffer_load_b128(rsQ, voQ, sb_ + (16 * ti * 1024 + 32 * ks) * 2, 0); } while (0)
#define S2R_LOAD_P(c_) do { const int sp_ = (int)((((size_t)(dir * 16 + bh) * NCH + (c_)) * 16384) * 2); _Pragma("unroll") for (int ti = 0; ti < 2; ++ti) _Pragma("unroll") for (int ks = 0; ks < 4; ++ks) \
        PF[ti][ks] = __builtin_amdgcn_raw_buffer_load_b128(rsP, voP, sp_ + (16 * ti * 128 + 32 * ks) * 2, 0); } while (0)
#define S2R_LOAD_K(c_) do { const int sk_ = (int)((((size_t)bh * DK) * SP + 128 * (c_)) * 2); _Pragma("unroll") for (int tm = 0; tm < 2; ++tm) _Pragma("unroll") for (int ks = 0; ks < 4; ++ks) \
        KF[tm][ks] = __builtin_amdgcn_raw_buffer_load_b128(rsK, voK, sk_ + (16 * tm * SP + 32 * ks) * 2, 0); } while (0)
#define S2R_LOAD_V(c_) do { const int sv_ = (int)((((size_t)bh * 512 + n0) * SP + 128 * (c_)) * 2); _Pragma("unroll") for (int u = 0; u < 2; ++u) VR[u] = __builtin_amdgcn_raw_buffer_load_b128(rsV, voT, sv_ + u * 128, 0); } while (0)
    { const int c0 = dir ? ord_b(0) : 0; S2R_LOAD_V(c0); S2R_LOAD_Q(c0); S2R_LOAD_P(c0); S2R_LOAD_K(c0); }
    for (int step = 0; step < NCH; ++step) {
        const int c = dir ? ord_b(step) : step;
        const int cn = (step + 1 < NCH) ? (dir ? ord_b(step + 1) : step + 1) : c;
        const size_t r0 = (size_t)bl_ * SP + 128 * c;
        wg_sync();
#pragma unroll
        for (int u = 0; u < 2; ++u) { *(LAS u32x4*)(VTS + u * 8192 + lbase) = VR[u]; float x[8]; unpack8(make_uint4(VR[u].x, VR[u].y, VR[u].z, VR[u].w), x);
#pragma unroll
            for (int q = 0; q < 8; ++q) x[q] *= kap[u * 64 + tc * 8 + q];
            const uint4 pk_ = pack8(x); u32x4 t_; t_.x = pk_.x; t_.y = pk_.y; t_.z = pk_.z; t_.w = pk_.w; *(LAS u32x4*)(VT2 + u * 8192 + lbase) = t_; }
        S2R_LOAD_V(cn);
        wg_sync();
        f32x4 acc[2][2];
#pragma unroll
        for (int x = 0; x < 2; ++x)
#pragma unroll
            for (int y = 0; y < 2; ++y) acc[x][y] = (f32x4){0.f, 0.f, 0.f, 0.f};
#pragma unroll
        for (int ks = 0; ks < 8; ++ks) { bf16x8 af[2];
#pragma unroll
            for (int tm = 0; tm < 2; ++tm) af[tm] = lds_frag(CST + (ks >> 1) * 8192, 32 * wm + 16 * tm + fr, fq + 4 * (ks & 1));
#pragma unroll
            for (int tm = 0; tm < 2; ++tm)
#pragma unroll
                for (int ti = 0; ti < 2; ++ti) acc[tm][ti] = __builtin_amdgcn_mfma_f32_16x16x32_bf16(af[tm], *(const bf16x8*)&QF[ti][ks], acc[tm][ti], 0, 0, 0); }
        S2R_LOAD_Q(cn);
        mfma_drain();
#pragma unroll
        for (int ti = 0; ti < 2; ++ti) { const float r = rho[32 * wn + 16 * ti + fr];
#pragma unroll
            for (int tm = 0; tm < 2; ++tm) acc[tm][ti] *= r; }
#pragma unroll
        for (int ks = 0; ks < 4; ++ks) { bf16x8 af[2];
#pragma unroll
            for (int tm = 0; tm < 2; ++tm) af[tm] = lds_frag(VTS + (ks >> 1) * 8192, 32 * wm + 16 * tm + fr, fq + 4 * (ks & 1));
#pragma unroll
            for (int tm = 0; tm < 2; ++tm)
#pragma unroll
                for (int ti = 0; ti < 2; ++ti) acc[tm][ti] = __builtin_amdgcn_mfma_f32_16x16x32_bf16(af[tm], *(const bf16x8*)&PF[ti][ks], acc[tm][ti], 0, 0, 0); }
        S2R_LOAD_P(cn);
        mfma_drain();
#pragma unroll
        for (int ti = 0; ti < 2; ++ti) { const int i = 32 * wn + 16 * ti + fr;
#pragma unroll
            for (int tm = 0; tm < 2; ++tm) { const f32x4 v = acc[tm][ti]; u32x2 w; w.x = pk2(v[0], v[1]); w.y = pk2(v[2], v[3]);
                *(u32x2*)(Od + (r0 + i) * 2048 + h * 512 + n0 + 32 * wm + 16 * tm + 4 * fq) = w; } }
#pragma unroll
        for (int tm = 0; tm < 2; ++tm)
#pragma unroll
            for (int tn = 0; tn < 4; ++tn) Cacc[tm][tn] *= delta;
#pragma unroll
        for (int ks = 0; ks < 4; ++ks) { bf16x8 bfr[4];
#pragma unroll
            for (int tn = 0; tn < 4; ++tn) bfr[tn] = lds_frag(VT2 + (ks >> 1) * 8192, 16 * tn + fr, fq + 4 * (ks & 1));
#pragma unroll
            for (int tm = 0; tm < 2; ++tm)
#pragma unroll
                for (int tn = 0; tn < 4; ++tn) Cacc[tm][tn] = __builtin_amdgcn_mfma_f32_16x16x32_bf16(*(const bf16x8*)&KF[tm][ks], bfr[tn], Cacc[tm][tn], 0, 0, 0); }
        S2R_LOAD_K(cn);
        wg_sync();
        mfma_drain();
#pragma unroll
        for (int tm = 0; tm < 2; ++tm) { const int d0 = 32 * wave + 16 * tm + 4 * fq;
#pragma unroll
            for (int tn = 0; tn < 4; ++tn) { const f32x4 v = Cacc[tm][tn]; u32x2 w; w.x = pk2(v[0], v[1]); w.y = pk2(v[2], v[3]); const int n = 16 * tn + fr;
                *(LAS u32x2*)(CST + (d0 >> 6) * 8192 + SLABOFF(n, (d0 & 63) >> 3) + (d0 & 7) * 2) = w; } }
    }
#undef S2R_LOAD_Q
#undef S2R_LOAD_P
#undef S2R_LOAD_K
#undef S2R_LOAD_V
}

PHASE_FN void phase_s2p(ChunkArgs a, LAS unsigned char* L, int bid, int nb) {
    constexpr int DK = 256;
    const int tid = tid_opq(), lane = tid & 63, wave = __builtin_amdgcn_readfirstlane(tid >> 6), wm = wave & 1, wn = wave >> 1;
    if (bid >= 256) return;
    const int xq = bid & 7, tt = bid >> 3, gI = xq + 8 * (tt >> 3), slice = tt & 7, bh = gI >> 1, dir = gI & 1, h = bh & 3, bl_ = bh >> 2, n0 = 64 * slice;
    LAS unsigned char* BUFA = L; LAS unsigned char* BUFB = L + 32768;
    LAS unsigned char* VTS = L + 65536;
    LAS unsigned char* CST = L + 81920;
    LAS float* rho = (LAS float*)(L + 114688); LAS float* kap = rho + 128;
    for (int i = tid; i < 4 * 8192 / 16; i += NTHR) ((LAS u32x4*)CST)[i] = (u32x4){0u, 0u, 0u, 0u};
    const float lg = log2_gamma(a.decay[dir * 4 + h]); const float delta = exp2f(128.f * lg);
    if (tid < 128) { const int i = tid; rho[i] = dir ? exp2f((float)(128 - i) * lg) : exp2f((float)(i + 1) * lg); kap[i] = dir ? exp2f((float)i * lg) : exp2f((float)(127 - i) * lg); }
    f32x4 Cacc[2][4];
#pragma unroll
    for (int tm = 0; tm < 2; ++tm)
#pragma unroll
        for (int tn = 0; tn < 4; ++tn) Cacc[tm][tn] = (f32x4){0.f, 0.f, 0.f, 0.f};
    bf16_t* Od = dir ? a.Ob : a.Of;
    const __amdgpu_buffer_rsrc_t rsQ = __builtin_amdgcn_make_buffer_rsrc((void*)a.qsrc, 0, 0x7fffffff, 0x00020000), rsP = __builtin_amdgcn_make_buffer_rsrc((void*)a.P, 0, 0x7fffffff, 0x00020000);
    const __amdgpu_buffer_rsrc_t rsV = __builtin_amdgcn_make_buffer_rsrc((void*)a.Vt, 0, 0x7fffffff, 0x00020000), rsK = __builtin_amdgcn_make_buffer_rsrc((void*)a.Kt, 0, 0x7fffffff, 0x00020000);
    const int tr = tid >> 3, tc = tid & 7;
    const int voQ = (tr * 1024 + tc * 8) * 2, voP = (tr * 128 + tc * 8) * 2, voT = (tr * SP + tc * 8) * 2;
    const int lbase = SLABOFF(tr, tc);
    u32x4 RQa[4], RQb[4], RP[6], RK0[4], RK1[4];
#define P_LOAD_Q(R, c_, kbh_) do { const int sb_ = (int)((((size_t)bl_ * SP + 128 * (c_)) * 1024 + h * DK + (kbh_) * 128) * 2); _Pragma("unroll") for (int u = 0; u < 4; ++u) \
        R[u] = __builtin_amdgcn_raw_buffer_load_b128(rsQ, voQ, sb_ + (64 * (u & 1) * 1024 + (u >> 1) * 64) * 2, 0); } while (0)
#define P_LOAD_PV(R, c_) do { const int sp_ = (int)((((size_t)(dir * 16 + bh) * NCH + (c_)) * 16384) * 2), sv_ = (int)((((size_t)bh * 512 + n0) * SP + 128 * (c_)) * 2); \
        _Pragma("unroll") for (int u = 0; u < 4; ++u) R[u] = __builtin_amdgcn_raw_buffer_load_b128(rsP, voP, sp_ + ((u & 1) * 64 * 128 + (u >> 1) * 64) * 2, 0); \
        _Pragma("unroll") for (int u = 0; u < 2; ++u) R[4 + u] = __builtin_amdgcn_raw_buffer_load_b128(rsV, voT, sv_ + u * 128, 0); } while (0)
#define P_LOAD_KT(R, c_, js_) do { const int sk_ = (int)((((size_t)bh * DK) * SP + 128 * (c_) + (js_) * 64) * 2); _Pragma("unroll") for (int u = 0; u < 4; ++u) \
        R[u] = __builtin_amdgcn_raw_buffer_load_b128(rsK, voT, sk_ + (u * 64 * SP) * 2, 0); } while (0)
#define P_STORE_QP(R, BUF) do { _Pragma("unroll") for (int u = 0; u < 4; ++u) *(LAS u32x4*)((BUF) + (u >> 1) * 16384 + (u & 1) * 8192 + lbase) = R[u]; } while (0)
#define P_STORE_V(R) do { _Pragma("unroll") for (int u = 0; u < 2; ++u) *(LAS u32x4*)(VTS + u * 8192 + lbase) = R[4 + u]; } while (0)
#define P_STORE_KT(R, BUF, js_) do { _Pragma("unroll") for (int u = 0; u < 4; ++u) { float x[8]; unpack8(make_uint4(R[u].x, R[u].y, R[u].z, R[u].w), x); \
        _Pragma("unroll") for (int q = 0; q < 8; ++q) x[q] *= kap[(js_) * 64 + tc * 8 + q]; const uint4 pk_ = pack8(x); u32x4 t_; t_.x = pk_.x; t_.y = pk_.y; t_.z = pk_.z; t_.w = pk_.w; \
        *(LAS u32x4*)((BUF) + u * 8192 + lbase) = t_; } } while (0)
#define P_MMA_Q(BUF, kbh_) do { _Pragma("unroll") for (int sl = 0; sl < 2; ++sl) mma_slab<2, 2>(acc, CST + ((kbh_) * 2 + sl) * 8192, 32 * wm, (BUF) + sl * 16384, 32 * wn, lane); } while (0)
#define P_MMA_P(BUF) do { _Pragma("unroll") for (int js = 0; js < 2; ++js) mma_slab<2, 2>(acc, VTS + js * 8192, 32 * wm, (BUF) + js * 16384, 32 * wn, lane); } while (0)
#define P_MMA_KT(BUF, js_) do { _Pragma("unroll") for (int ks = 0; ks < 2; ++ks) { bf16x8 af[2], bfr[4]; \
        _Pragma("unroll") for (int tm = 0; tm < 2; ++tm) af[tm] = lds_frag((BUF), 32 * wave + 16 * tm + (lane & 15), (lane >> 4) + 4 * ks); \
        _Pragma("unroll") for (int tn = 0; tn < 4; ++tn) bfr[tn] = lds_frag(VTS + (js_) * 8192, 16 * tn + (lane & 15), (lane >> 4) + 4 * ks); \
        _Pragma("unroll") for (int tm = 0; tm < 2; ++tm) _Pragma("unroll") for (int tn = 0; tn < 4; ++tn) Cacc[tm][tn] = __builtin_amdgcn_mfma_f32_16x16x32_bf16(af[tm], bfr[tn], Cacc[tm][tn], 0, 0, 0); } } while (0)
#define P_STEP(BX, BY, step) { \
        const int c = dir ? ord_b(step) : step; \
        const int cn = (step + 1 < NCH) ? (dir ? ord_b(step + 1) : step + 1) : c; \
        const int cnn = (step + 2 < NCH) ? (dir ? ord_b(step + 2) : step + 2) : cn; \
        const size_t r0 = (size_t)bl_ * SP + 128 * c; \
        f32x4 acc[2][2]; \
        _Pragma("unroll") for (int x = 0; x < 2; ++x) _Pragma("unroll") for (int y = 0; y < 2; ++y) acc[x][y] = (f32x4){0.f, 0.f, 0.f, 0.f}; \
        wg_sync(); P_STORE_QP(RQb, BY); P_LOAD_Q(RQb, cn, 1); P_MMA_Q(BX, 0); \
        wg_sync(); P_STORE_QP(RP, BX); P_STORE_V(RP); P_LOAD_PV(RP, cn); P_MMA_Q(BY, 1); \
        mfma_drain(); \
        _Pragma("unroll") for (int ti = 0; ti < 2; ++ti) { const float r = rho[32 * wn + 16 * ti + (lane & 15)]; _Pragma("unroll") for (int tm = 0; tm < 2; ++tm) acc[tm][ti] *= r; } \
        wg_sync(); P_STORE_KT(RK0, BY, 0); P_LOAD_KT(RK0, cn, 0); P_MMA_P(BX); \
        mfma_drain(); \
        _Pragma("unroll") for (int ti = 0; ti < 2; ++ti) { const int i = 32 * wn + 16 * ti + (lane & 15); \
            _Pragma("unroll") for (int tm = 0; tm < 2; ++tm) { const f32x4 v = acc[tm][ti]; u32x2 w; w.x = pk2(v[0], v[1]); w.y = pk2(v[2], v[3]); \
                *(u32x2*)(Od + (r0 + i) * 2048 + h * 512 + n0 + 32 * wm + 16 * tm + 4 * (lane >> 4)) = w; } } \
        _Pragma("unroll") for (int tm = 0; tm < 2; ++tm) _Pragma("unroll") for (int tn = 0; tn < 4; ++tn) Cacc[tm][tn] *= delta; \
        wg_sync(); P_STORE_KT(RK1, BX, 1); P_LOAD_KT(RK1, cn, 1); P_MMA_KT(BY, 0); \
        wg_sync(); P_STORE_QP(RQa, BY); P_LOAD_Q(RQa, cnn, 0); P_MMA_KT(BX, 1); \
        mfma_drain(); \
        _Pragma("unroll") for (int tm = 0; tm < 2; ++tm) { const int d0 = 32 * wave + 16 * tm + 4 * (lane >> 4); \
            _Pragma("unroll") for (int tn = 0; tn < 4; ++tn) { const f32x4 v = Cacc[tm][tn]; u32x2 w; w.x = pk2(v[0], v[1]); w.y = pk2(v[2], v[3]); const int n = 16 * tn + (lane & 15); \
                *(LAS u32x2*)(CST + (d0 >> 6) * 8192 + SLABOFF(n, (d0 & 63) >> 3) + (d0 & 7) * 2) = w; } } \
    }
    { const int c0 = dir ? ord_b(0) : 0, c1 = dir ? ord_b(1) : 1; P_LOAD_Q(RQa, c0, 0); P_LOAD_Q(RQb, c0, 1); P_LOAD_PV(RP, c0); P_LOAD_KT(RK0, c0, 0); P_LOAD_KT(RK1, c0, 1); wg_sync(); P_STORE_QP(RQa, BUFA); P_LOAD_Q(RQa, c1, 0); }
    for (int step2 = 0; step2 < NCH; step2 += 2) { P_STEP(BUFA, BUFB, step2) P_STEP(BUFB, BUFA, (step2 + 1)) }
#undef P_STEP
#undef P_LOAD_Q
#undef P_LOAD_PV
#undef P_LOAD_KT
#undef P_STORE_QP
#undef P_STORE_V
#undef P_STORE_KT
#undef P_MMA_Q
#undef P_MMA_P
#undef P_MMA_KT
}

PHASE_FN void phase_s2w(ChunkArgs a, LAS unsigned char* L, int bid, int nb) {
    constexpr int DK = 256;
    const int tid = tid_opq(), lane = tid & 63, wave = __builtin_amdgcn_readfirstlane(tid >> 6), wm = wave & 3, wn = wave >> 2;
    if (bid >= 128) return;
    const int xq = bid & 7, tt = bid >> 3, gI = xq + 8 * (tt >> 2), slice = tt & 3, bh = gI >> 1, dir = gI & 1, h = bh & 3, bl_ = bh >> 2, n0 = 128 * slice;
    LAS unsigned char* BUF = L;
    LAS unsigned char* VTS = L + 32768;
    LAS unsigned char* CST = L + 65536;
    LAS float* rho = (LAS float*)(L + 131072); LAS float* kap = rho + 128;
    for (int i = tid; i < 4 * 16384 / 16; i += NTHR) ((LAS u32x4*)CST)[i] = (u32x4){0u, 0u, 0u, 0u};
    const float lg = log2_gamma(a.decay[dir * 4 + h]); const float delta = exp2f(128.f * lg);
    if (tid < 128) { const int i = tid; rho[i] = dir ? exp2f(-(float)i * lg) : exp2f((float)(i - 127) * lg); kap[i] = dir ? exp2f((float)i * lg) : exp2f((float)(127 - i) * lg); }
    f32x4 Cacc[2][8];
#pragma unroll
    for (int tm = 0; tm < 2; ++tm)
#pragma unroll
        for (int tn = 0; tn < 8; ++tn) Cacc[tm][tn] = (f32x4){0.f, 0.f, 0.f, 0.f};
    bf16_t* Od = dir ? a.Ob : a.Of;
    const __amdgpu_buffer_rsrc_t rsQ = __builtin_amdgcn_make_buffer_rsrc((void*)a.qsrc, 0, 0x7fffffff, 0x00020000), rsP = __builtin_amdgcn_make_buffer_rsrc((void*)a.P, 0, 0x7fffffff, 0x00020000);
    const __amdgpu_buffer_rsrc_t rsV = __builtin_amdgcn_make_buffer_rsrc((void*)a.Vt, 0, 0x7fffffff, 0x00020000), rsK = __builtin_amdgcn_make_buffer_rsrc((void*)a.Kt, 0, 0x7fffffff, 0x00020000);
    const int tr = tid >> 3, tc = tid & 7;
    const int voQ = (tr * 1024 + tc * 8) * 2, voP = (tr * 128 + tc * 8) * 2, voT = (tr * SP + tc * 8) * 2;
    const int lbase = SLABOFF(tr, tc);
    u32x4 RA[4], RB[4], RC[4];
#define W_LOAD_Q(R, c_, kbh_) do { const int sb_ = (int)((((size_t)bl_ * SP + 128 * (c_)) * 1024 + h * DK + (kbh_) * 128) * 2); _Pragma("unroll") for (int u = 0; u < 4; ++u) \
        R[u] = __builtin_amdgcn_raw_buffer_load_b128(rsQ, voQ, sb_ + (64 * (u & 1) * 1024 + (u >> 1) * 64) * 2, 0); } while (0)
#define W_LOAD_P(R, c_) do { const int sp_ = (int)((((size_t)(dir * 16 + bh) * NCH + (c_)) * 16384) * 2); \
        _Pragma("unroll") for (int u = 0; u < 4; ++u) R[u] = __builtin_amdgcn_raw_buffer_load_b128(rsP, voP, sp_ + ((u & 1) * 64 * 128 + (u >> 1) * 64) * 2, 0); } while (0)
#define W_LOAD_V(R, c_) do { const int sv_ = (int)((((size_t)bh * 512 + n0) * SP + 128 * (c_)) * 2); \
        _Pragma("unroll") for (int u = 0; u < 4; ++u) R[u] = __builtin_amdgcn_raw_buffer_load_b128(rsV, voT, sv_ + ((u & 1) * 64 * SP + (u >> 1) * 64) * 2, 0); } while (0)
#define W_LOAD_KT(R, c_, js_) do { const int sk_ = (int)((((size_t)bh * DK) * SP + 128 * (c_) + (js_) * 64) * 2); _Pragma("unroll") for (int u = 0; u < 4; ++u) \
        R[u] = __builtin_amdgcn_raw_buffer_load_b128(rsK, voT, sk_ + (u * 64 * SP) * 2, 0); } while (0)
#define W_STORE_2S(R, DST) do { _Pragma("unroll") for (int u = 0; u < 4; ++u) *(LAS u32x4*)((DST) + (u >> 1) * 16384 + (u & 1) * 8192 + lbase) = R[u]; } while (0)
#define W_STORE_KT(R, js_) do { _Pragma("unroll") for (int u = 0; u < 4; ++u) *(LAS u32x4*)(BUF + u * 8192 + lbase) = R[u]; } while (0)
#define W_STORE_VS(R) do { _Pragma("unroll") for (int u = 0; u < 4; ++u) { float x[8]; unpack8(make_uint4(R[u].x, R[u].y, R[u].z, R[u].w), x); \
        _Pragma("unroll") for (int q = 0; q < 8; ++q) x[q] *= kap[(u >> 1) * 64 + tc * 8 + q]; const uint4 pk_ = pack8(x); u32x4 t_; t_.x = pk_.x; t_.y = pk_.y; t_.z = pk_.z; t_.w = pk_.w; \
        *(LAS u32x4*)(VTS + (u >> 1) * 16384 + (u & 1) * 8192 + lbase) = t_; } } while (0)
#define W_MMA_Q(kbh_) do { _Pragma("unroll") for (int sl = 0; sl < 2; ++sl) mma_slab<2, 4>(acc, CST + ((kbh_) * 2 + sl) * 16384, 32 * wm, BUF + sl * 16384, 64 * wn, lane); } while (0)
#define W_MMA_P() do { _Pragma("unroll") for (int js = 0; js < 2; ++js) mma_slab<2, 4>(acc, VTS + js * 16384, 32 * wm, BUF + js * 16384, 64 * wn, lane); } while (0)
#define W_MMA_KT(js_) do { _Pragma("unroll") for (int ks = 0; ks < 2; ++ks) { bf16x8 af[2]; \
        _Pragma("unroll") for (int tm = 0; tm < 2; ++tm) af[tm] = lds_frag(BUF, 32 * wave + 16 * tm + (lane & 15), (lane >> 4) + 4 * ks); \
        _Pragma("unroll") for (int tn = 0; tn < 8; ++tn) { const bf16x8 bfr = lds_frag(VTS + (js_) * 16384, 16 * tn + (lane & 15), (lane >> 4) + 4 * ks); \
            _Pragma("unroll") for (int tm = 0; tm < 2; ++tm) Cacc[tm][tn] = __builtin_amdgcn_mfma_f32_16x16x32_bf16(af[tm], bfr, Cacc[tm][tn], 0, 0, 0); } } } while (0)
    { const int c0 = dir ? ord_b(0) : 0; W_LOAD_Q(RA, c0, 0); W_LOAD_Q(RB, c0, 1); W_LOAD_P(RC, c0); }
    for (int step = 0; step < NCH; ++step) {
        const int c = dir ? ord_b(step) : step;
        const int cn = (step + 1 < NCH) ? (dir ? ord_b(step + 1) : step + 1) : c;
        const size_t r0 = (size_t)bl_ * SP + 128 * c;
        f32x4 acc[2][4];
#pragma unroll
        for (int x = 0; x < 2; ++x)
#pragma unroll
            for (int y = 0; y < 4; ++y) acc[x][y] = (f32x4){0.f, 0.f, 0.f, 0.f};
        wg_sync(); W_STORE_2S(RA, BUF); W_LOAD_V(RA, c); wg_sync(); W_MMA_Q(0);
        wg_sync(); W_STORE_2S(RB, BUF); W_LOAD_KT(RB, c, 0); wg_sync(); W_MMA_Q(1);
        mfma_drain();
#pragma unroll
        for (int ti = 0; ti < 4; ++ti) {
#pragma unroll
            for (int tm = 0; tm < 2; ++tm) acc[tm][ti] *= delta; }
        wg_sync(); W_STORE_2S(RC, BUF); W_STORE_VS(RA); W_LOAD_KT(RC, c, 1); W_LOAD_Q(RA, cn, 0); wg_sync(); W_MMA_P();
        mfma_drain();
#pragma unroll
        for (int tp = 0; tp < 2; ++tp) { const int g = lane >> 4; const int ia = 64 * wn + 32 * tp + (lane & 15), ib = ia + 16; const float rsa = rho[ia], rsb = rho[ib]; const int irow = (g & 1) ? ib : ia;
            unsigned ax[2], ay[2], bx[2], by[2];
#pragma unroll
            for (int tm = 0; tm < 2; ++tm) { const f32x4 va = acc[tm][2 * tp] * rsa, vb = acc[tm][2 * tp + 1] * rsb;
                ax[tm] = pk2(va[0], va[1]); ay[tm] = pk2(va[2], va[3]); bx[tm] = pk2(vb[0], vb[1]); by[tm] = pk2(vb[2], vb[3]); }
            mfma_drain();
#pragma unroll
            for (int tm = 0; tm < 2; ++tm) {
                const auto sx = __builtin_amdgcn_permlane16_swap(ax[tm], bx[tm], false, false), sy = __builtin_amdgcn_permlane16_swap(ay[tm], by[tm], false, false);
                u32x4 w; w.x = sx[0]; w.y = sy[0]; w.z = sx[1]; w.w = sy[1];
                *(u32x4*)(Od + (r0 + irow) * 2048 + h * 512 + n0 + 32 * wm + 16 * tm + 4 * (g & ~1)) = w; } }
#pragma unroll
        for (int tm = 0; tm < 2; ++tm)
#pragma unroll
            for (int tn = 0; tn < 8; ++tn) Cacc[tm][tn] *= delta;
        wg_sync(); W_STORE_KT(RB, 0); W_LOAD_Q(RB, cn, 1); wg_sync(); W_MMA_KT(0);
        wg_sync(); W_STORE_KT(RC, 1); W_LOAD_P(RC, cn); wg_sync(); W_MMA_KT(1);
        mfma_drain();
#pragma unroll
        for (int tm = 0; tm < 2; ++tm) { const int d0 = 32 * wave + 16 * tm + 4 * (lane >> 4);
#pragma unroll
            for (int tn = 0; tn < 8; ++tn) { const f32x4 v = Cacc[tm][tn]; u32x2 w; w.x = pk2(v[0], v[1]); w.y = pk2(v[2], v[3]); const int n = 16 * tn + (lane & 15);
                *(LAS u32x2*)(CST + (d0 >> 6) * 16384 + SLABOFF(n, (d0 & 63) >> 3) + (d0 & 7) * 2) = w; } }
    }
#undef W_LOAD_Q
#undef W_LOAD_P
#undef W_LOAD_V
#undef W_LOAD_KT
#undef W_STORE_2S
#undef W_STORE_KT
#undef W_STORE_VS
#undef W_MMA_Q
#undef W_MMA_P
#undef W_MMA_KT
}

PHASE_FN void phase_fin_ret(const bf16_t* Of, const bf16_t* Ob, const bf16_t* G, bf16_t* Dst, int last, int bid, int nb) {
    const int tid = tid_opq(), lane = tid & 63, wv = tid >> 6;
    for (int r = bid * 8 + wv; r < NH; r += nb * 8) {
        if (last && (r % SP) < CTXL) continue;
        const size_t base = (size_t)r * 2048 + (lane >> 4) * 512 + (lane & 15) * 8;
        float o[32]; float ss = 0.f;
#pragma unroll
        for (int u = 0; u < 4; ++u) { float a[8], b[8]; unpack8(*(const uint4*)(Of + base + u * 128), a); unpack8(*(const uint4*)(Ob + base + u * 128), b);
#pragma unroll
            for (int e = 0; e < 8; ++e) { o[8 * u + e] = a[e] + b[e]; ss += o[8 * u + e] * o[8 * u + e]; } }
        ss = red16(ss);
        const float rn = rsqrtf(ss * (1.f / 512.f) + 1e-6f);
#pragma unroll
        for (int u = 0; u < 4; ++u) { float g[8], w[8]; unpack8(*(const uint4*)(G + base + u * 128), g);
#pragma unroll
            for (int e = 0; e < 8; ++e) w[e] = siluf(g[e]) * o[8 * u + e] * rn;
            *(uint4*)(Dst + base + u * 128) = pack8(w); }
    }
}
PHASE_FN void phase_fin_ml(const bf16_t* Of, const bf16_t* Ob, const bf16_t* XC, bf16_t* Z, const float* gng, const float* skip, int bid, int nb) {
    const int tid = tid_opq(), lane = tid & 63, wv = tid >> 6;
    const int cb = (lane >> 4) * 512 + (lane & 15) * 8;
    float4 gq[8], kq[8];
#pragma unroll
    for (int u = 0; u < 4; ++u) { gq[2 * u] = *(const float4*)(gng + cb + u * 128); gq[2 * u + 1] = *(const float4*)(gng + cb + u * 128 + 4); kq[2 * u] = *(const float4*)(skip + cb + u * 128); kq[2 * u + 1] = *(const float4*)(skip + cb + u * 128 + 4); }
    for (int r = bid * 8 + wv; r < NH; r += nb * 8) {
        const size_t base = (size_t)r * 2048 + cb;
        float o[32]; float s1 = 0.f;
#pragma unroll
        for (int u = 0; u < 4; ++u) { float a[8], b[8]; unpack8(*(const uint4*)(Of + base + u * 128), a); unpack8(*(const uint4*)(Ob + base + u * 128), b);
#pragma unroll
            for (int e = 0; e < 8; ++e) { o[8 * u + e] = a[e] + b[e]; s1 += o[8 * u + e]; } }
#pragma unroll
        for (int m = 8; m >= 1; m >>= 1) s1 += __shfl_xor(s1, m);
        const float mu = s1 * (1.f / 512.f); float s2 = 0.f;
#pragma unroll
        for (int e = 0; e < 32; ++e) { const float d = o[e] - mu; s2 += d * d; }
#pragma unroll
        for (int m = 8; m >= 1; m >>= 1) s2 += __shfl_xor(s2, m);
        const float rn = rsqrtf(s2 * (1.f / 512.f) + LN_EPS);
#pragma unroll
        for (int u = 0; u < 4; ++u) { float z[8], xc[8], w[8]; unpack8(*(const uint4*)(Z + base + u * 128), z); unpack8(*(const uint4*)(XC + base + u * 128), xc);
            const float4 g0 = gq[2 * u], g1 = gq[2 * u + 1], k0 = kq[2 * u], k1 = kq[2 * u + 1];
            const float gg[8] = {g0.x, g0.y, g0.z, g0.w, g1.x, g1.y, g1.z, g1.w}, kk[8] = {k0.x, k0.y, k0.z, k0.w, k1.x, k1.y, k1.z, k1.w};
#pragma unroll
            for (int e = 0; e < 8; ++e) w[e] = ((o[8 * u + e] - mu) * rn * gg[e] + kk[e] * xc[e]) * siluf(z[e]);
            *(uint4*)(Z + base + u * 128) = pack8(w); }
    }
}

PHASE_FN void phase_mlprep(const bf16_t* XM, bf16_t* XCONV, const bf16_t* Gt, const float* convw, const float* convb, const float* gateb,
                           float* gG, float* gPM, float* gB, float* cBL, float* cPML, LAS unsigned char* L, int bid, int nb) {
    const int tid = tid_opq(), lane = tid & 63, wave = __builtin_amdgcn_readfirstlane(tid >> 6);
    LAS unsigned char* XMS = L; LAS unsigned char* XCS = L + 16896; LAS unsigned char* GT1 = L + 33280; LAS unsigned char* GT2 = L + 35328; LAS float* GOUT = (LAS float*)(L + 37376);
    LAS float* CW = (LAS float*)(L + 45568);
    for (int i = tid; i < 2048; i += NTHR) { *(LAS f32x4*)(CW + 4 * i) = (i < 1536) ? *(const f32x4*)(convw + 4 * i) : *(const f32x4*)(convb + 4 * (i - 1536)); }
    const int tr = tid >> 3, tc = tid & 7;
    for (int item = bid; item < 4 * NCH; item += nb) {
        const int bl_ = item / NCH, c = item - bl_ * NCH; const size_t r0 = (size_t)bl_ * SP + 128 * c;
        const bool has_prev = (c != 0 && c != 2), has_next = (c != 1 && c != NCH - 1);
        f32x4 acc[1][1]; acc[0][0] = (f32x4){0.f, 0.f, 0.f, 0.f};
        uint4 RX[3], RGt[2];
#define MLP_LOAD(cs_) do { _Pragma("unroll") for (int u = 0; u < 3; ++u) { const int e = tid + 512 * u; RX[u] = make_uint4(0u, 0u, 0u, 0u); if (e < 1040) { const int tr_ = (e >> 3) - 1; \
            const bool ok = (tr_ >= 0 && tr_ < 128) || (tr_ < 0 && has_prev) || (tr_ >= 128 && has_next); if (ok) RX[u] = *(const uint4*)(XM + (size_t)((long)r0 + tr_) * 2048 + (cs_) * 64 + (e & 7) * 8); } } \
            if (tid < 128) { RGt[0] = *(const uint4*)(Gt + (size_t)tr * 4096 + (cs_) * 64 + tc * 8); RGt[1] = *(const uint4*)(Gt + (size_t)tr * 4096 + 2048 + (cs_) * 64 + tc * 8); } } while (0)
        MLP_LOAD(0);
        for (int cs = 0; cs < 32; ++cs) {
            LAS unsigned char* XMSp = XMS + (cs & 1) * 78336; LAS unsigned char* XCSp = XCS + (cs & 1) * 78336; LAS unsigned char* GT1p = GT1 + (cs & 1) * 78336; LAS unsigned char* GT2p = GT2 + (cs & 1) * 78336;
#pragma unroll
            for (int u = 0; u < 3; ++u) { const int e = tid + 512 * u; if (e < 1040) lds_st16(XMSp, e >> 3, e & 7, RX[u]); }
            if (tid < 128) { lds_st16(GT1p, tr, tc, RGt[0]); lds_st16(GT2p, tr, tc, RGt[1]); }
            { const int cn = (cs + 1 < 32) ? cs + 1 : cs; MLP_LOAD(cn); }
            wg_sync();
#pragma unroll
            for (int u = 0; u < 2; ++u) { const int e = tid + 512 * u, row = e >> 3, ch = e & 7, cg = cs * 64 + ch * 8; float xa[8], xb[8], xc[8], o[8];
                unpack8(lds_ld16(XMSp, row, ch), xa); unpack8(lds_ld16(XMSp, row + 1, ch), xb); unpack8(lds_ld16(XMSp, row + 2, ch), xc);
#pragma unroll
                for (int q4 = 0; q4 < 2; ++q4) { const f32x4 wb_ = *(const LAS f32x4*)(CW + 6144 + cg + 4 * q4), w0_ = *(const LAS f32x4*)(CW + cg + 4 * q4), w1_ = *(const LAS f32x4*)(CW + 2048 + cg + 4 * q4), w2_ = *(const LAS f32x4*)(CW + 4096 + cg + 4 * q4);
#pragma unroll
                    for (int qq = 0; qq < 4; ++qq) { const int q = 4 * q4 + qq; const float pre = wb_[qq] + w0_[qq] * xa[q] + w1_[qq] * xb[q] + w2_[qq] * xc[q]; o[q] = siluf(pre); } }
                const uint4 pk = pack8(o); lds_st16(XCSp, row, ch, pk); *(uint4*)(XCONV + (r0 + row) * 2048 + cg) = pk; }
            wg_sync();
            mma_slab<1, 1>(acc, XCSp, 16 * wave, GT1p, 0, lane);
            mma_slab<1, 1>(acc, XMSp, 16 * wave + 1, GT2p, 0, lane);
        }
#undef MLP_LOAD
        mfma_drain();
        { const int o = lane & 15;
#pragma unroll
            for (int e = 0; e < 4; ++e) GOUT[(16 * wave + 4 * (lane >> 4) + e) * 16 + o] = acc[0][0][e] + gateb[o]; }
        wg_sync();
        { const int d = wave >> 2, hh = wave & 3, bh = bl_ * 4 + hh;
            const int u0 = 2 * lane, u1 = u0 + 1, t0 = d ? 127 - u0 : u0, t1 = d ? 127 - u1 : u1;
            const float i0 = GOUT[t0 * 16 + d * 8 + hh], i1 = GOUT[t1 * 16 + d * 8 + hh], f0 = GOUT[t0 * 16 + d * 8 + 4 + hh], f1 = GOUT[t1 * 16 + d * 8 + 4 + hh];
            const float l0 = fminf(f0, 0.f) - log1pf(__expf(-fabsf(f0))), l1 = fminf(f1, 0.f) - log1pf(__expf(-fabsf(f1)));
            float tot = l0 + l1, inc = tot;
#pragma unroll
            for (int s = 1; s < 64; s <<= 1) { const float v = __shfl_up(inc, s); if (lane >= s) inc += v; }
            const float off = inc - tot, b0 = off + l0, b1 = off + l0 + l1, g0 = i0 - b0, g1 = i1 - b1;
            float pmx = fmaxf(g0, g1), pinc = pmx;
#pragma unroll
            for (int s = 1; s < 64; s <<= 1) { const float v = __shfl_up(pinc, s); if (lane >= s) pinc = fmaxf(pinc, v); }
            float pexc = __shfl_up(pinc, 1); if (lane == 0) pexc = -3.0e38f;
            const float pm0 = fmaxf(pexc, g0), pm1 = fmaxf(pexc, pmx);
            const size_t gb = ((size_t)d * 16 + bh) * SP + 128 * c;
            gG[gb + t0] = g0; gG[gb + t1] = g1; gPM[gb + t0] = pm0; gPM[gb + t1] = pm1; gB[gb + t0] = b0; gB[gb + t1] = b1;
            if (lane == 63) { cBL[(d * 16 + bh) * NCH + c] = b1; cPML[(d * 16 + bh) * NCH + c] = pm1; } }
    }
}

PHASE_FN void phase_rkmix(const bf16_t* H, bf16_t* A2, int bid, int nb) {
    const int tid = tid_opq(), lane = tid & 63, wv = tid >> 6;
    for (int R = bid * 8 + wv; R < NTOK; R += nb * 8) {
        const int b = R / SP, s = R - b * SP;
#pragma unroll
        for (int u = 0; u < 2; ++u) { const int c = 8 * lane + 512 * u; int src = -1;
            if (s < CTXL) { if (u == 0) { if (s > 0) src = R - 1; } else { if (s < CTXL - 1) src = R + 1; } }
            else { const int t = s - CTXL, row = t >> 6, col = t & 63, qd = c >> 8;
                if (qd == 0) { if (col > 0) src = R - 1; } else if (qd == 1) { if (col < 63) src = R + 1; } else if (qd == 2) { if (row > 0) src = R - 64; } else { if (row < 63) src = R + 64; } }
            const uint4 hv = *(const uint4*)(H + (size_t)R * DM + c); uint4 sv = make_uint4(0u, 0u, 0u, 0u); if (src >= 0) sv = *(const uint4*)(H + (size_t)src * DM + c);
            *(uint4*)(A2 + (size_t)R * 2048 + c) = hv; *(uint4*)(A2 + (size_t)R * 2048 + 1024 + c) = sv; }
    }
}

PHASE_FN void phase_rkmix2(const bf16_t* H, bf16_t* X2, const float* mix, int j1, int j2, int bid, int nb) {
    const int tid = tid_opq(), lane = tid & 63, wv = tid >> 6;
    float4 mq[2][4];
#pragma unroll
    for (int u = 0; u < 2; ++u) { const int c = 8 * lane + 512 * u; mq[u][0] = *(const float4*)(mix + j1 * 1024 + c); mq[u][1] = *(const float4*)(mix + j1 * 1024 + c + 4); mq[u][2] = *(const float4*)(mix + j2 * 1024 + c); mq[u][3] = *(const float4*)(mix + j2 * 1024 + c + 4); }
    for (int R = bid * 8 + wv; R < NTOK; R += nb * 8) {
        const int b = R / SP, s = R - b * SP;
#pragma unroll
        for (int u = 0; u < 2; ++u) { const int c = 8 * lane + 512 * u; int src = -1;
            if (s < CTXL) { if (u == 0) { if (s > 0) src = R - 1; } else { if (s < CTXL - 1) src = R + 1; } }
            else { const int t = s - CTXL, row = t >> 6, col = t & 63, qd = c >> 8;
                if (qd == 0) { if (col > 0) src = R - 1; } else if (qd == 1) { if (col < 63) src = R + 1; } else if (qd == 2) { if (row > 0) src = R - 64; } else { if (row < 63) src = R + 64; } }
            float hv[8], sv[8], o1[8], o2[8]; unpack8(*(const uint4*)(H + (size_t)R * DM + c), hv);
            if (src >= 0) unpack8(*(const uint4*)(H + (size_t)src * DM + c), sv); else {
#pragma unroll
                for (int e = 0; e < 8; ++e) sv[e] = 0.f; }
            const float4 m1a = mq[u][0], m1b = mq[u][1], m2a = mq[u][2], m2b = mq[u][3];
            const float m1[8] = {m1a.x, m1a.y, m1a.z, m1a.w, m1b.x, m1b.y, m1b.z, m1b.w}, m2[8] = {m2a.x, m2a.y, m2a.z, m2a.w, m2b.x, m2b.y, m2b.z, m2b.w};
#pragma unroll
            for (int e = 0; e < 8; ++e) { const float xx = sv[e] - hv[e]; o1[e] = hv[e] + xx * m1[e]; o2[e] = hv[e] + xx * m2[e]; }
            *(uint4*)(X2 + (size_t)R * DM + c) = pack8(o1); *(uint4*)(X2 + ((size_t)NTOK + R) * DM + c) = pack8(o2); }
    }
}

PHASE_FN void phase_rkscan(const bf16_t* Rr, const bf16_t* Kk, const bf16_t* Vv, const bf16_t* T, const float* w0, const float* w2, const float* a0, const float* a2,
                           const float* k_k, const float* k_a, const float* r_k, bf16_t* Yf, bf16_t* Yb, float* bon, LAS unsigned char* L, int bid, int nb) {
    if (bid >= 256) return;
    const int tid = tid_opq(), lane = tid & 63, wave = __builtin_amdgcn_readfirstlane(tid >> 6);
    const int b = bid >> 5, h = (bid >> 1) & 15, d = bid & 1;
    LAS float* WB = (LAS float*)L; LAS float* AD = WB + 2048; LAS float* RB = AD + 2048; LAS float* KD = RB + 2048; LAS float* VB = KD + 2048; LAS float* AB = VB + 2048; LAS float* BB = AB + 2048; LAS float* YB = BB + 2048;
    bf16_t* Y = d ? Yb : Yf;
    const int tt = wave >> 2, ct = wave & 3;
    bf16x8 bw[2], ba[2];
#pragma unroll
    for (int ks = 0; ks < 2; ++ks) { float fw[8], fa[8];
#pragma unroll
        for (int j = 0; j < 8; ++j) { const int m = 8 * (lane >> 4) + j + 32 * ks, cc = 64 * h + 16 * ct + (lane & 15); fw[j] = w2[((size_t)d * 64 + m) * 1024 + cc]; fa[j] = a2[((size_t)d * 64 + m) * 1024 + cc]; }
        const uint4 pw = pack8(fw), pa = pack8(fa); bw[ks] = *(const bf16x8*)&pw; ba[ks] = *(const bf16x8*)&pa; }
    const int cch = 64 * h + 16 * ct + (lane & 15);
    const float w0c = w0[d * 1024 + cch], a0c = a0[d * 1024 + cch];
    const int etok = tid >> 4, ecg = tid & 15, ec = 64 * h + 4 * ecg;
    const float4 kk4 = *(const float4*)(k_k + ec), ka4 = *(const float4*)(k_a + ec), rk4 = *(const float4*)(r_k + ec);
    const int pr = tid >> 4, rq = tid & 15;
    float S[2][4];
#pragma unroll
    for (int r = 0; r < 2; ++r)
#pragma unroll
        for (int e = 0; e < 4; ++e) S[r][e] = 0.f;
#define RK_SLO(kb_) (d ? ((kb_) < 8 ? CTXL - 32 * ((kb_) + 1) : SP - 32 * ((kb_) - 8 + 1)) : 32 * (kb_))
    uint4 tw[2], ta[2]; u32x2 rw, kw, vw;
#define RK_GLOAD(kb_) do { const size_t Rn_ = (size_t)b * SP + RK_SLO(kb_); const bf16_t* trow_ = T + (Rn_ + 16 * tt + (lane & 15)) * 256 + 8 * (lane >> 4); \
        _Pragma("unroll") for (int ks = 0; ks < 2; ++ks) { tw[ks] = *(const uint4*)(trow_ + 64 * d + 32 * ks); ta[ks] = *(const uint4*)(trow_ + 128 + 64 * d + 32 * ks); } \
        const size_t g_ = (Rn_ + etok) * 1024 + ec; rw = *(const u32x2*)(Rr + g_); kw = *(const u32x2*)(Kk + g_); vw = *(const u32x2*)(Vv + g_); } while (0)
    RK_GLOAD(0);
    for (int kb = 0; kb < SP / 32; ++kb) {
        const int slo = RK_SLO(kb);
        const size_t Rb = (size_t)b * SP + slo;
        wg_sync();
        { f32x4 dw = (f32x4){0.f, 0.f, 0.f, 0.f}, da = (f32x4){0.f, 0.f, 0.f, 0.f};
#pragma unroll
            for (int ks = 0; ks < 2; ++ks) {
                dw = __builtin_amdgcn_mfma_f32_16x16x32_bf16(*(const bf16x8*)&tw[ks], bw[ks], dw, 0, 0, 0);
                da = __builtin_amdgcn_mfma_f32_16x16x32_bf16(*(const bf16x8*)&ta[ks], ba[ks], da, 0, 0, 0); }
            mfma_drain();
#pragma unroll
            for (int e = 0; e < 4; ++e) { const int tok = 16 * tt + 4 * (lane >> 4) + e, cc = 16 * ct + (lane & 15);
                const float x = -(w0c + dw[e]);
                const float sp = fmaxf(x, 0.f) + log1pf(__expf(-fabsf(x)));
                WB[tok * 64 + cc] = __expf(-__expf(-sp - 0.5f));
                AD[tok * 64 + cc] = sigmf(a0c + da[e]); } }
        const float r[4] = {bflo(rw.x), bfhi(rw.x), bflo(rw.y), bfhi(rw.y)}, k[4] = {bflo(kw.x), bfhi(kw.x), bflo(kw.y), bfhi(kw.y)}, v[4] = {bflo(vw.x), bfhi(vw.x), bflo(vw.y), bfhi(vw.y)};
        { const int kn = (kb + 1 < SP / 32) ? kb + 1 : kb; RK_GLOAD(kn); }
        wg_sync();
        {   const float kkc[4] = {kk4.x, kk4.y, kk4.z, kk4.w}, kac[4] = {ka4.x, ka4.y, ka4.z, ka4.w}, rkc[4] = {rk4.x, rk4.y, rk4.z, rk4.w};
            float kr[4], ss = 0.f;
#pragma unroll
            for (int e = 0; e < 4; ++e) { kr[e] = k[e] * kkc[e]; ss += kr[e] * kr[e]; }
            ss = red16(ss); const float inv = 1.f / fmaxf(sqrtf(ss), 1e-12f); float bs = 0.f;
#pragma unroll
            for (int e = 0; e < 4; ++e) { const int o = etok * 64 + 4 * ecg + e; const float ad = AD[o], kkn = kr[e] * inv, kd = k[e] * (1.f + (ad - 1.f) * kac[e]);
                RB[o] = r[e]; KD[o] = kd; VB[o] = v[e]; AB[o] = -kkn; BB[o] = kkn * ad; bs += r[e] * kd * rkc[e]; }
            bs = red16(bs); if (ecg == 0) bon[((size_t)d * NTOK + Rb + etok) * 16 + h] = bs; }
        wg_sync();
#define RK_LOAD(SET, u_) do { const int o_ = (u_) * 64 + 4 * rq; SET##a = *(const LAS f32x4*)(AB + o_); SET##w = *(const LAS f32x4*)(WB + o_); SET##k = *(const LAS f32x4*)(KD + o_); SET##b = *(const LAS f32x4*)(BB + o_); \
            SET##r = *(const LAS f32x4*)(RB + o_); SET##v = *(const LAS f32x2v*)(VB + (u_) * 64 + 2 * pr); } while (0)
#define RK_STEP(SET, u_) do { \
            const float sa0 = red16((S[0][0] * SET##a[0] + S[0][1] * SET##a[1]) + (S[0][2] * SET##a[2] + S[0][3] * SET##a[3])); \
            const float sa1 = red16((S[1][0] * SET##a[0] + S[1][1] * SET##a[1]) + (S[1][2] * SET##a[2] + S[1][3] * SET##a[3])); \
            _Pragma("unroll") for (int e = 0; e < 4; ++e) { S[0][e] = S[0][e] * SET##w[e] + sa0 * SET##b[e] + SET##v[0] * SET##k[e]; S[1][e] = S[1][e] * SET##w[e] + sa1 * SET##b[e] + SET##v[1] * SET##k[e]; } \
            const float y0 = red16((S[0][0] * SET##r[0] + S[0][1] * SET##r[1]) + (S[0][2] * SET##r[2] + S[0][3] * SET##r[3])); \
            const float y1 = red16((S[1][0] * SET##r[0] + S[1][1] * SET##r[1]) + (S[1][2] * SET##r[2] + S[1][3] * SET##r[3])); \
            if (rq == 0) { f32x2v yy; yy[0] = y0; yy[1] = y1; *(LAS f32x2v*)(YB + (u_) * 64 + 2 * pr) = yy; } } while (0)
        { f32x4 Aa, Aw, Ak, Ab, Ar, Ba, Bw, Bk, Bb, Br; f32x2v Av, Bv;
            RK_LOAD(A, d ? 31 : 0);
            for (int t2 = 0; t2 < 32; t2 += 2) { const int u0 = d ? 31 - t2 : t2, u1 = d ? 30 - t2 : t2 + 1, u2 = d ? (t2 + 2 < 32 ? 29 - t2 : 0) : (t2 + 2 < 32 ? t2 + 2 : 31);
                RK_LOAD(B, u1); RK_STEP(A, u0);
                RK_LOAD(A, u2); RK_STEP(B, u1); } }
#undef RK_LOAD
#undef RK_STEP
        wg_sync();
        { const int o = etok * 64 + 4 * ecg; u32x2 w; w.x = pk2(YB[o], YB[o + 1]); w.y = pk2(YB[o + 2], YB[o + 3]); *(u32x2*)(Y + (Rb + etok) * 1024 + ec) = w; }
    }
#undef RK_GLOAD
#undef RK_SLO
}

template <int CTRL> __device__ __forceinline__ float dppz(float v) { return __int_as_float(__builtin_amdgcn_update_dpp(0, __float_as_int(v), CTRL, 0xF, 0xF, true)); }
__device__ __forceinline__ unsigned short f2bf(float x) { return (unsigned short)(pk2(x, 0.f) & 0xffffu); }
PHASE_FN void phase_rkscan2(const bf16_t* Rr, const bf16_t* Kk, const bf16_t* Vv, const bf16_t* T, const float* w0, const float* w2, const float* a0, const float* a2,
                            const float* k_k, const float* k_a, const float* r_k, bf16_t* Yf, bf16_t* Yb, float* bon, LAS unsigned char* L, int bid, int nb, unsigned long long* prof = nullptr) {
    unsigned long long psec0 = 0, psec1 = 0, psec2 = 0, psec3 = 0, psec4 = 0, psec5 = 0, pt = 0;
#define PSTAMP(k) do { if (prof) { const unsigned long long n_ = clock64(); psec##k += n_ - pt; pt = n_; } } while (0)
    if (bid >= 256) return;
    const int tid = tid_opq(), lane = tid & 63, wave = __builtin_amdgcn_readfirstlane(tid >> 6);
    const int b = bid >> 5, h = (bid >> 1) & 15, d = bid & 1;
    LAS float* WB = (LAS float*)L; LAS float* AD = WB + 2112; LAS float* RB = AD + 2112; LAS float* KD = RB + 2112; LAS float* VB = KD + 2112; LAS float* AB = VB + 2112; LAS float* BB = AB + 2112;
    LAS float* YB = (LAS float*)(L + 121856);
    LAS unsigned char* AT = L + 65536; LAS unsigned char* RT = L + 70144; LAS unsigned char* BT = L + 74752; LAS unsigned char* KT = L + 79360;
    LAS unsigned char* BKt = L + 83968; LAS unsigned char* UVt = L + 94208;
    LAS unsigned char* SB = L + 104448;
    LAS unsigned char* ARK = L + 113664; LAS unsigned char* AK0 = L + 114944;
    LAS float* AAB = (LAS float*)(L + 116224); LAS float* XF = (LAS float*)(L + 117248); LAS float* GL = (LAS float*)(L + 121344);
    bf16_t* Y = d ? Yb : Yf;
    const int tt = wave >> 2, ct = wave & 3;
    bf16x8 bw[2], ba[2];
#pragma unroll
    for (int ks = 0; ks < 2; ++ks) { float fw[8], fa[8];
#pragma unroll
        for (int j = 0; j < 8; ++j) { const int m = 8 * (lane >> 4) + j + 32 * ks, cc = 64 * h + 16 * ct + (lane & 15); fw[j] = w2[((size_t)d * 64 + m) * 1024 + cc]; fa[j] = a2[((size_t)d * 64 + m) * 1024 + cc]; }
        const uint4 pw = pack8(fw), pa = pack8(fa); bw[ks] = *(const bf16x8*)&pw; ba[ks] = *(const bf16x8*)&pa; }
    const int cch = 64 * h + 16 * ct + (lane & 15);
    const float w0c = w0[d * 1024 + cch], a0c = a0[d * 1024 + cch];
    const int etok = tid >> 4, ecg = tid & 15, ec = 64 * h + 4 * ecg;
    const float4 kk4 = *(const float4*)(k_k + ec), ka4 = *(const float4*)(k_a + ec), rk4 = *(const float4*)(r_k + ec);
    for (int i = tid; i < (121856 - 83968) / 4; i += NTHR) ((LAS unsigned*)(L + 83968))[i] = 0u;
    f32x4 Sacc[2];
    Sacc[0] = (f32x4){0.f, 0.f, 0.f, 0.f}; Sacc[1] = (f32x4){0.f, 0.f, 0.f, 0.f};
#define RK_SLO(kb_) (d ? ((kb_) < 8 ? CTXL - 32 * ((kb_) + 1) : SP - 32 * ((kb_) - 8 + 1)) : 32 * (kb_))
    uint4 tw[2], ta[2]; u32x2 rw, kw, vw;
#define RK_GLOAD(kb_) do { const size_t Rn_ = (size_t)b * SP + RK_SLO(kb_); const bf16_t* trow_ = T + (Rn_ + 16 * tt + (lane & 15)) * 256 + 8 * (lane >> 4); \
        _Pragma("unroll") for (int ks = 0; ks < 2; ++ks) { tw[ks] = *(const uint4*)(trow_ + 64 * d + 32 * ks); ta[ks] = *(const uint4*)(trow_ + 128 + 64 * d + 32 * ks); } \
        const size_t g_ = (Rn_ + etok) * 1024 + ec; rw = *(const u32x2*)(Rr + g_); kw = *(const u32x2*)(Kk + g_); vw = *(const u32x2*)(Vv + g_); } while (0)
#define FRAG(base, row, pitchB, koffB) (*(const LAS bf16x8*)((base) + (row) * (pitchB) + (koffB) + (lane >> 4) * 16))
    RK_GLOAD(0);
    for (int kb = 0; kb < SP / 32; ++kb) {
        const int slo = RK_SLO(kb);
        const size_t Rb = (size_t)b * SP + slo;
        if (prof) pt = clock64();
        wg_sync();
        { f32x4 dw = (f32x4){0.f, 0.f, 0.f, 0.f}, da = (f32x4){0.f, 0.f, 0.f, 0.f};
#pragma unroll
            for (int ks = 0; ks < 2; ++ks) {
                dw = __builtin_amdgcn_mfma_f32_16x16x32_bf16(*(const bf16x8*)&tw[ks], bw[ks], dw, 0, 0, 0);
                da = __builtin_amdgcn_mfma_f32_16x16x32_bf16(*(const bf16x8*)&ta[ks], ba[ks], da, 0, 0, 0); }
            mfma_drain();
#pragma unroll
            for (int e = 0; e < 4; ++e) { const int tok = 16 * tt + 4 * (lane >> 4) + e, cc = 16 * ct + (lane & 15);
                const float x = -(w0c + dw[e]);
                const float sp = fmaxf(x, 0.f) + log1pf(__expf(-fabsf(x)));
                WB[tok * 65 + cc] = -__expf(-sp - 0.5f) * 1.4426950408889634f;
                AD[tok * 65 + cc] = sigmf(a0c + da[e]); } }
        const float r[4] = {bflo(rw.x), bfhi(rw.x), bflo(rw.y), bfhi(rw.y)}, k[4] = {bflo(kw.x), bfhi(kw.x), bflo(kw.y), bfhi(kw.y)}, v[4] = {bflo(vw.x), bfhi(vw.x), bflo(vw.y), bfhi(vw.y)};
        { const int kn = (kb + 1 < SP / 32) ? kb + 1 : kb; RK_GLOAD(kn); }
        wg_sync();
        {   const float kkc[4] = {kk4.x, kk4.y, kk4.z, kk4.w}, kac[4] = {ka4.x, ka4.y, ka4.z, ka4.w}, rkc[4] = {rk4.x, rk4.y, rk4.z, rk4.w};
            float kr[4], ss = 0.f;
#pragma unroll
            for (int e = 0; e < 4; ++e) { kr[e] = k[e] * kkc[e]; ss += kr[e] * kr[e]; }
            ss = red16(ss); const float inv = 1.f / fmaxf(sqrtf(ss), 1e-12f); float bs = 0.f;
#pragma unroll
            for (int e = 0; e < 4; ++e) { const int o = etok * 65 + 4 * ecg + e; const float ad = AD[o], kkn = kr[e] * inv, kd = k[e] * (1.f + (ad - 1.f) * kac[e]);
                RB[o] = r[e]; KD[o] = kd; VB[o] = v[e]; AB[o] = -kkn; BB[o] = kkn * ad; bs += r[e] * kd * rkc[e]; }
            bs = red16(bs); if (ecg == 0) bon[((size_t)d * NTOK + Rb + etok) * 16 + h] = bs; }
        wg_sync();
        PSTAMP(0);
        { const int kq = tid >> 4, t = tid & 15;
#pragma unroll
            for (int c = 0; c < 2; ++c) { const int u = d ? 31 - 16 * c - t : 16 * c + t;
#pragma unroll
                for (int hh = 0; hh < 2; ++hh) { const int kk = kq + 32 * hh, o = u * 65 + kk;
                    const float lw = WB[o]; float cs = lw;
                    cs += dppz<0x111>(cs); cs += dppz<0x112>(cs); cs += dppz<0x114>(cs); cs += dppz<0x118>(cs);
                    const float g = exp2f(cs), gp = exp2f(cs - lw), ig = exp2f(-cs);
                    const float av = AB[o] * gp, rv = RB[o] * g, bv = BB[o] * ig, kv = KD[o] * ig;
                    const int ro = c * 2304 + t * 144 + kk * 2;
                    *(LAS unsigned short*)(AT + ro) = f2bf(av); *(LAS unsigned short*)(RT + ro) = f2bf(rv); *(LAS unsigned short*)(BT + ro) = f2bf(bv); *(LAS unsigned short*)(KT + ro) = f2bf(kv);
                    *(LAS unsigned short*)(BKt + c * 5120 + kk * 80 + t * 2) = f2bf(bv); *(LAS unsigned short*)(BKt + c * 5120 + kk * 80 + 32 + t * 2) = f2bf(kv);
                    *(LAS unsigned short*)(UVt + c * 5120 + kk * 80 + 32 + t * 2) = f2bf(VB[o]);
                    if (t == 15) GL[c * 64 + kk] = g; } } }
        wg_sync();
        PSTAMP(1);
#pragma unroll
        for (int c = 0; c < 2; ++c) {
            f32x4 accx = (f32x4){0.f, 0.f, 0.f, 0.f}, acca = (f32x4){0.f, 0.f, 0.f, 0.f};
            if (wave < 4) {
                LAS unsigned char* Aa = (wave < 2) ? AT : RT; LAS unsigned char* Bb = (wave & 1) ? KT : BT;
#pragma unroll
                for (int ks = 0; ks < 2; ++ks) { const bf16x8 fa = FRAG(AT + c * 2304, lane & 15, 144, ks * 64), fs = FRAG(SB, 16 * wave + (lane & 15), 144, ks * 64);
                    accx = __builtin_amdgcn_mfma_f32_16x16x32_bf16(fa, fs, accx, 0, 0, 0);
                    const bf16x8 f1 = FRAG(Aa + c * 2304, lane & 15, 144, ks * 64), f2 = FRAG(Bb + c * 2304, lane & 15, 144, ks * 64);
                    acca = __builtin_amdgcn_mfma_f32_16x16x32_bf16(f1, f2, acca, 0, 0, 0); }
                mfma_drain();
#pragma unroll
                for (int e = 0; e < 4; ++e) { const int t = 4 * (lane >> 4) + e, ta_ = lane & 15; const bool strict = ta_ < t, incl = ta_ <= t; const float val = acca[e];
                    if (wave == 0) AAB[ta_ * 16 + t] = strict ? val : 0.f;
                    else if (wave == 1) *(LAS unsigned short*)(AK0 + t * 80 + 32 + ta_ * 2) = f2bf(strict ? val : 0.f);
                    else if (wave == 2) *(LAS unsigned short*)(ARK + t * 80 + ta_ * 2) = f2bf(incl ? val : 0.f);
                    else *(LAS unsigned short*)(ARK + t * 80 + 32 + ta_ * 2) = f2bf(incl ? val : 0.f); }
            } else {
#pragma unroll
                for (int ks = 0; ks < 2; ++ks) { const bf16x8 fr = FRAG(RT + c * 2304, lane & 15, 144, ks * 64), fs = FRAG(SB, 16 * (wave - 4) + (lane & 15), 144, ks * 64);
                    accx = __builtin_amdgcn_mfma_f32_16x16x32_bf16(fr, fs, accx, 0, 0, 0); }
            }
            wg_sync();
            PSTAMP(2);
            if (wave < 4) { const bf16x8 fk = FRAG(AK0, lane & 15, 80, 0), fv = FRAG(UVt + c * 5120, 16 * wave + (lane & 15), 80, 0);
                accx = __builtin_amdgcn_mfma_f32_16x16x32_bf16(fk, fv, accx, 0, 0, 0);
                mfma_drain();
#pragma unroll
                for (int e = 0; e < 4; ++e) XF[(4 * (lane >> 4) + e) * 64 + 16 * wave + (lane & 15)] = accx[e]; }
            wg_sync();
            PSTAMP(3);
            if (wave == 0) { float uu[16];
#pragma unroll
                for (int t = 0; t < 16; ++t) uu[t] = XF[t * 64 + lane];
#pragma unroll
                for (int q = 0; q < 15; ++q) { const f32x4 c0 = *(const LAS f32x4*)(AAB + q * 16), c1 = *(const LAS f32x4*)(AAB + q * 16 + 4), c2 = *(const LAS f32x4*)(AAB + q * 16 + 8), c3 = *(const LAS f32x4*)(AAB + q * 16 + 12);
                    const float col[16] = {c0[0], c0[1], c0[2], c0[3], c1[0], c1[1], c1[2], c1[3], c2[0], c2[1], c2[2], c2[3], c3[0], c3[1], c3[2], c3[3]};
#pragma unroll
                    for (int t = q + 1; t < 16; ++t) uu[t] += col[t] * uu[q];
                    if (q & 1) asm volatile("" ::: "memory"); }
                uint4 p0, p1; p0.x = pk2(uu[0], uu[1]); p0.y = pk2(uu[2], uu[3]); p0.z = pk2(uu[4], uu[5]); p0.w = pk2(uu[6], uu[7]); p1.x = pk2(uu[8], uu[9]); p1.y = pk2(uu[10], uu[11]); p1.z = pk2(uu[12], uu[13]); p1.w = pk2(uu[14], uu[15]);
                u32x4 q0, q1; q0.x = p0.x; q0.y = p0.y; q0.z = p0.z; q0.w = p0.w; q1.x = p1.x; q1.y = p1.y; q1.z = p1.z; q1.w = p1.w;
                *(LAS u32x4*)(UVt + c * 5120 + lane * 80) = q0; *(LAS u32x4*)(UVt + c * 5120 + lane * 80 + 16) = q1; }
            wg_sync();
            PSTAMP(4);
            if (wave >= 4) { const bf16x8 fr = FRAG(ARK, lane & 15, 80, 0), fu = FRAG(UVt + c * 5120, 16 * (wave - 4) + (lane & 15), 80, 0);
                accx = __builtin_amdgcn_mfma_f32_16x16x32_bf16(fr, fu, accx, 0, 0, 0);
                mfma_drain();
#pragma unroll
                for (int e = 0; e < 4; ++e) { const int t = 4 * (lane >> 4) + e, u = d ? 31 - 16 * c - t : 16 * c + t; YB[u * 64 + 16 * (wave - 4) + (lane & 15)] = accx[e]; } }
            { const int kt = wave & 3; const bf16x8 fb = FRAG(BKt + c * 5120, 16 * kt + (lane & 15), 80, 0);
#pragma unroll
                for (int x = 0; x < 2; ++x) { const int it = 2 * (wave >> 2) + x; const bf16x8 fu = FRAG(UVt + c * 5120, 16 * it + (lane & 15), 80, 0);
                    Sacc[x] = __builtin_amdgcn_mfma_f32_16x16x32_bf16(fb, fu, Sacc[x], 0, 0, 0); }
                mfma_drain();
                const f32x4 gl = *(const LAS f32x4*)(GL + c * 64 + 16 * kt + 4 * (lane >> 4));
#pragma unroll
                for (int x = 0; x < 2; ++x) { const int it = 2 * (wave >> 2) + x; Sacc[x] *= gl;
                    u32x2 w_; w_.x = pk2(Sacc[x][0], Sacc[x][1]); w_.y = pk2(Sacc[x][2], Sacc[x][3]);
                    *(LAS u32x2*)(SB + (16 * it + (lane & 15)) * 144 + (16 * kt + 4 * (lane >> 4)) * 2) = w_; } }
            wg_sync();
            PSTAMP(5);
        }
        { const int o = etok * 64 + 4 * ecg; u32x2 w; w.x = pk2(YB[o], YB[o + 1]); w.y = pk2(YB[o + 2], YB[o + 3]); *(u32x2*)(Y + (Rb + etok) * 1024 + ec) = w; }
    }
    if (prof && bid == 0 && tid == 0) { prof[0] = psec0; prof[1] = psec1; prof[2] = psec2; prof[3] = psec3; prof[4] = psec4; prof[5] = psec5; }
#undef PSTAMP
#undef FRAG
#undef RK_GLOAD
#undef RK_SLO
}

PHASE_FN void phase_rkscan3(const bf16_t* Rr, const bf16_t* Kk, const bf16_t* Vv, const bf16_t* T, const float* w0, const float* w2, const float* a0, const float* a2,
                            const float* k_k, const float* k_a, const float* r_k, bf16_t* Yf, bf16_t* Yb, float* bon, LAS unsigned char* L, int bid, int nb) {
    if (bid >= 256) return;
    const int tid = tid_opq(), lane = tid & 63, wave = __builtin_amdgcn_readfirstlane(tid >> 6);
    const int b = bid >> 5, h = (bid >> 1) & 15, d = bid & 1;
    LAS float* WB = (LAS float*)L; LAS float* AD = WB + 2112; LAS float* RB = AD + 2112; LAS float* KD = RB + 2112; LAS float* VB = KD + 2112; LAS float* AB = VB + 2112; LAS float* BB = AB + 2112;
    LAS float* YB = (LAS float*)(L + 121856);
    LAS unsigned char* AT = L + 65536; LAS unsigned char* RT = L + 70144; LAS unsigned char* BT = L + 74752; LAS unsigned char* KT = L + 79360;
    LAS unsigned char* BKt = L + 83968; LAS unsigned char* UVt = L + 94208;
    LAS unsigned char* SB = L + 104448;
    LAS unsigned char* ARK = L + 113664; LAS unsigned char* AK0 = L + 114944;
    LAS float* AAB = (LAS float*)(L + 116224); LAS float* XF = (LAS float*)(L + 117248); LAS float* GL = (LAS float*)(L + 121344);
    bf16_t* Y = d ? Yb : Yf;
    const int tt = wave >> 2, ct = wave & 3;
    bf16x8 bw[2], ba[2];
#pragma unroll
    for (int ks = 0; ks < 2; ++ks) { float fw[8], fa[8];
#pragma unroll
        for (int j = 0; j < 8; ++j) { const int m = 8 * (lane >> 4) + j + 32 * ks, cc = 64 * h + 16 * ct + (lane & 15); fw[j] = w2[((size_t)d * 64 + m) * 1024 + cc]; fa[j] = a2[((size_t)d * 64 + m) * 1024 + cc]; }
        const uint4 pw = pack8(fw), pa = pack8(fa); bw[ks] = *(const bf16x8*)&pw; ba[ks] = *(const bf16x8*)&pa; }
    const int cch = 64 * h + 16 * ct + (lane & 15);
    const float w0c = w0[d * 1024 + cch], a0c = a0[d * 1024 + cch];
    const int etok = tid >> 4, ecg = tid & 15, ec = 64 * h + 4 * ecg;
    const float4 kk4 = *(const float4*)(k_k + ec), ka4 = *(const float4*)(k_a + ec), rk4 = *(const float4*)(r_k + ec);
    for (int i = tid; i < (121856 - 83968) / 4; i += NTHR) ((LAS unsigned*)(L + 83968))[i] = 0u;
    f32x4 Sacc[2];
    Sacc[0] = (f32x4){0.f, 0.f, 0.f, 0.f}; Sacc[1] = (f32x4){0.f, 0.f, 0.f, 0.f};
#define RK_SLO(kb_) (d ? ((kb_) < 8 ? CTXL - 32 * ((kb_) + 1) : SP - 32 * ((kb_) - 8 + 1)) : 32 * (kb_))
    uint4 tw[2], ta[2]; u32x2 rw, kw, vw;
#define RK_GLOAD(kb_) do { const size_t Rn_ = (size_t)b * SP + RK_SLO(kb_); const bf16_t* trow_ = T + (Rn_ + 16 * tt + (lane & 15)) * 256 + 8 * (lane >> 4); \
        _Pragma("unroll") for (int ks = 0; ks < 2; ++ks) { tw[ks] = *(const uint4*)(trow_ + 64 * d + 32 * ks); ta[ks] = *(const uint4*)(trow_ + 128 + 64 * d + 32 * ks); } \
        const size_t g_ = (Rn_ + etok) * 1024 + ec; rw = *(const u32x2*)(Rr + g_); kw = *(const u32x2*)(Kk + g_); vw = *(const u32x2*)(Vv + g_); } while (0)
#define FRAG(base, row, pitchB, koffB) (*(const LAS bf16x8*)((base) + (row) * (pitchB) + (koffB) + (lane >> 4) * 16))
#define RK_PREP_A() do { f32x4 dw = (f32x4){0.f, 0.f, 0.f, 0.f}, da = (f32x4){0.f, 0.f, 0.f, 0.f}; \
        _Pragma("unroll") for (int ks = 0; ks < 2; ++ks) { \
            dw = __builtin_amdgcn_mfma_f32_16x16x32_bf16(*(const bf16x8*)&tw[ks], bw[ks], dw, 0, 0, 0); \
            da = __builtin_amdgcn_mfma_f32_16x16x32_bf16(*(const bf16x8*)&ta[ks], ba[ks], da, 0, 0, 0); } \
        mfma_drain(); \
        _Pragma("unroll") for (int e = 0; e < 4; ++e) { const int tok = 16 * tt + 4 * (lane >> 4) + e, cc = 16 * ct + (lane & 15); \
            WB[tok * 65 + cc] = -0.8750388f * sigmf(w0c + dw[e]);     \
            AD[tok * 65 + cc] = sigmf(a0c + da[e]); } } while (0)
#define RK_PREP_B1(Rb_, kl_) do { \
        const float r[4] = {bflo(rw.x), bfhi(rw.x), bflo(rw.y), bfhi(rw.y)}, k[4] = {bflo(kw.x), bfhi(kw.x), bflo(kw.y), bfhi(kw.y)}, v[4] = {bflo(vw.x), bfhi(vw.x), bflo(vw.y), bfhi(vw.y)}; \
        if ((kl_) >= 0) RK_GLOAD(kl_); \
        const float kkc[4] = {kk4.x, kk4.y, kk4.z, kk4.w}, kac[4] = {ka4.x, ka4.y, ka4.z, ka4.w}, rkc[4] = {rk4.x, rk4.y, rk4.z, rk4.w}; \
        float kr[4], ss = 0.f; \
        _Pragma("unroll") for (int e = 0; e < 4; ++e) { kr[e] = k[e] * kkc[e]; ss += kr[e] * kr[e]; } \
        ss = red16(ss); const float inv = 1.f / fmaxf(sqrtf(ss), 1e-12f); float bs = 0.f; \
        _Pragma("unroll") for (int e = 0; e < 4; ++e) { const int o = etok * 65 + 4 * ecg + e; const float ad = AD[o], kkn = kr[e] * inv, kd = k[e] * (1.f + (ad - 1.f) * kac[e]); \
            RB[o] = r[e]; KD[o] = kd; VB[o] = v[e]; AB[o] = -kkn; BB[o] = kkn * ad; bs += r[e] * kd * rkc[e]; } \
        bs = red16(bs); if (ecg == 0) bon[((size_t)d * NTOK + (Rb_) + etok) * 16 + h] = bs; } while (0)
#define RK_PREP_B2(c_) do { const int kq = tid >> 4, t = tid & 15; const int u = d ? 31 - 16 * (c_) - t : 16 * (c_) + t; \
        _Pragma("unroll") for (int hh = 0; hh < 2; ++hh) { const int kk = kq + 32 * hh, o = u * 65 + kk; \
            const float lw = WB[o]; float cs = lw; \
            cs += dppz<0x111>(cs); cs += dppz<0x112>(cs); cs += dppz<0x114>(cs); cs += dppz<0x118>(cs); \
            const float g = __builtin_amdgcn_exp2f(cs), gp = __builtin_amdgcn_exp2f(cs - lw), ig = __builtin_amdgcn_exp2f(-cs); \
            const float av = AB[o] * gp, rv = RB[o] * g, bv = BB[o] * ig, kv = KD[o] * ig; \
            const int ro = (c_) * 2304 + t * 144 + kk * 2; \
            *(LAS unsigned short*)(AT + ro) = f2bf(av); *(LAS unsigned short*)(RT + ro) = f2bf(rv); *(LAS unsigned short*)(BT + ro) = f2bf(bv); *(LAS unsigned short*)(KT + ro) = f2bf(kv); \
            *(LAS unsigned short*)(BKt + (c_) * 5120 + kk * 80 + t * 2) = f2bf(bv); *(LAS unsigned short*)(BKt + (c_) * 5120 + kk * 80 + 32 + t * 2) = f2bf(kv); \
            *(LAS unsigned short*)(UVt + (c_) * 5120 + kk * 80 + 32 + t * 2) = f2bf(VB[o]); \
            if (t == 15) GL[(c_) * 64 + kk] = g; } } while (0)
    RK_GLOAD(0);
    wg_sync();
    RK_PREP_A();
    wg_sync();
    { const size_t Rb0 = (size_t)b * SP + RK_SLO(0); RK_PREP_B1(Rb0, 1); }
    wg_sync();
    RK_PREP_B2(0);
    wg_sync();
    constexpr int NBLK = SP / 32;
    for (int kb = 0; kb < NBLK; ++kb) {
        const int slo = RK_SLO(kb);
        const size_t Rb = (size_t)b * SP + slo;
        const bool more = (kb + 1 < NBLK);
#pragma unroll
        for (int c = 0; c < 2; ++c) {
            f32x4 accx = (f32x4){0.f, 0.f, 0.f, 0.f}, acca = (f32x4){0.f, 0.f, 0.f, 0.f};
            if (wave < 4) {
                LAS unsigned char* Aa = (wave < 2) ? AT : RT; LAS unsigned char* Bb = (wave & 1) ? KT : BT;
#pragma unroll
                for (int ks = 0; ks < 2; ++ks) { const bf16x8 fa = FRAG(AT + c * 2304, lane & 15, 144, ks * 64), fs = FRAG(SB, 16 * wave + (lane & 15), 144, ks * 64);
                    accx = __builtin_amdgcn_mfma_f32_16x16x32_bf16(fa, fs, accx, 0, 0, 0);
                    const bf16x8 f1 = FRAG(Aa + c * 2304, lane & 15, 144, ks * 64), f2 = FRAG(Bb + c * 2304, lane & 15, 144, ks * 64);
                    acca = __builtin_amdgcn_mfma_f32_16x16x32_bf16(f1, f2, acca, 0, 0, 0); }
                mfma_drain();
#pragma unroll
                for (int e = 0; e < 4; ++e) { const int t = 4 * (lane >> 4) + e, ta_ = lane & 15; const bool strict = ta_ < t, incl = ta_ <= t; const float val = acca[e];
                    if (wave == 0) AAB[ta_ * 16 + t] = strict ? val : 0.f;
                    else if (wave == 1) *(LAS unsigned short*)(AK0 + t * 80 + 32 + ta_ * 2) = f2bf(strict ? val : 0.f);
                    else if (wave == 2) *(LAS unsigned short*)(ARK + t * 80 + ta_ * 2) = f2bf(incl ? val : 0.f);
                    else *(LAS unsigned short*)(ARK + t * 80 + 32 + ta_ * 2) = f2bf(incl ? val : 0.f); }
            } else {
#pragma unroll
                for (int ks = 0; ks < 2; ++ks) { const bf16x8 fr = FRAG(RT + c * 2304, lane & 15, 144, ks * 64), fs = FRAG(SB, 16 * (wave - 4) + (lane & 15), 144, ks * 64);
                    accx = __builtin_amdgcn_mfma_f32_16x16x32_bf16(fr, fs, accx, 0, 0, 0); }
            }
            if (c == 0) { RK_PREP_B2(1); }
            else if (more) { RK_PREP_B2(0); }
            wg_sync();
            if (wave < 4) { const bf16x8 fk = FRAG(AK0, lane & 15, 80, 0), fv = FRAG(UVt + c * 5120, 16 * wave + (lane & 15), 80, 0);
                accx = __builtin_amdgcn_mfma_f32_16x16x32_bf16(fk, fv, accx, 0, 0, 0);
                mfma_drain();
#pragma unroll
                for (int e = 0; e < 4; ++e) XF[(4 * (lane >> 4) + e) * 64 + 16 * wave + (lane & 15)] = accx[e]; }
            if (c == 0 && more) { RK_PREP_A(); }
            wg_sync();
            if (wave == 0) { float uu[16];
#pragma unroll
                for (int t = 0; t < 16; ++t) uu[t] = XF[t * 64 + lane];
#pragma unroll
                for (int q = 0; q < 15; ++q) { const f32x4 c0 = *(const LAS f32x4*)(AAB + q * 16), c1 = *(const LAS f32x4*)(AAB + q * 16 + 4), c2 = *(const LAS f32x4*)(AAB + q * 16 + 8), c3 = *(const LAS f32x4*)(AAB + q * 16 + 12);
                    const float col[16] = {c0[0], c0[1], c0[2], c0[3], c1[0], c1[1], c1[2], c1[3], c2[0], c2[1], c2[2], c2[3], c3[0], c3[1], c3[2], c3[3]};
#pragma unroll
                    for (int t = q + 1; t < 16; ++t) uu[t] += col[t] * uu[q];
                    if (q & 1) asm volatile("" ::: "memory"); }
                uint4 p0, p1; p0.x = pk2(uu[0], uu[1]); p0.y = pk2(uu[2], uu[3]); p0.z = pk2(uu[4], uu[5]); p0.w = pk2(uu[6], uu[7]); p1.x = pk2(uu[8], uu[9]); p1.y = pk2(uu[10], uu[11]); p1.z = pk2(uu[12], uu[13]); p1.w = pk2(uu[14], uu[15]);
                u32x4 q0, q1; q0.x = p0.x; q0.y = p0.y; q0.z = p0.z; q0.w = p0.w; q1.x = p1.x; q1.y = p1.y; q1.z = p1.z; q1.w = p1.w;
                *(LAS u32x4*)(UVt + c * 5120 + lane * 80) = q0; *(LAS u32x4*)(UVt + c * 5120 + lane * 80 + 16) = q1; }
            wg_sync();
            if (wave >= 4) { const bf16x8 fr = FRAG(ARK, lane & 15, 80, 0), fu = FRAG(UVt + c * 5120, 16 * (wave - 4) + (lane & 15), 80, 0);
                accx = __builtin_amdgcn_mfma_f32_16x16x32_bf16(fr, fu, accx, 0, 0, 0);
                mfma_drain();
#pragma unroll
                for (int e = 0; e < 4; ++e) { const int t = 4 * (lane >> 4) + e, u = d ? 31 - 16 * c - t : 16 * c + t; YB[u * 64 + 16 * (wave - 4) + (lane & 15)] = accx[e]; } }
            { const int kt = wave & 3; const bf16x8 fb = FRAG(BKt + c * 5120, 16 * kt + (lane & 15), 80, 0);
#pragma unroll
                for (int x = 0; x < 2; ++x) { const int it = 2 * (wave >> 2) + x; const bf16x8 fu = FRAG(UVt + c * 5120, 16 * it + (lane & 15), 80, 0);
                    Sacc[x] = __builtin_amdgcn_mfma_f32_16x16x32_bf16(fb, fu, Sacc[x], 0, 0, 0); }
                mfma_drain();
                const f32x4 gl = *(const LAS f32x4*)(GL + c * 64 + 16 * kt + 4 * (lane >> 4));
#pragma unroll
                for (int x = 0; x < 2; ++x) { const int it = 2 * (wave >> 2) + x; Sacc[x] *= gl;
                    u32x2 w_; w_.x = pk2(Sacc[x][0], Sacc[x][1]); w_.y = pk2(Sacc[x][2], Sacc[x][3]);
                    *(LAS u32x2*)(SB + (16 * it + (lane & 15)) * 144 + (16 * kt + 4 * (lane >> 4)) * 2) = w_; } }
            if (c == 0 && more) { const size_t Rb1 = (size_t)b * SP + RK_SLO(kb + 1); const int kl = (kb + 2 < NBLK) ? kb + 2 : -1; RK_PREP_B1(Rb1, kl); }
            wg_sync();
        }
        { const int o = etok * 64 + 4 * ecg; u32x2 w; w.x = pk2(YB[o], YB[o + 1]); w.y = pk2(YB[o + 2], YB[o + 3]); *(u32x2*)(Y + (Rb + etok) * 1024 + ec) = w; }
    }
#undef RK_PREP_A
#undef RK_PREP_B1
#undef RK_PREP_B2
#undef FRAG
#undef RK_GLOAD
#undef RK_SLO
}

#define RK_CENSUS_LDS 163812
PHASE_FN void phase_rkscan4(const bf16_t* Rr, const bf16_t* Kk, const bf16_t* Vv, const bf16_t* T, const float* w0, const float* w2, const float* a0, const float* a2,
                            const float* k_k, const float* k_a, const float* r_k, bf16_t* Yf, bf16_t* Yb, float* bon, LAS unsigned char* L, int bid, int nb, unsigned long long* prof = nullptr) {
    if (bid >= 256) return;
    unsigned long long ps0 = 0, ps1 = 0, ps2 = 0, ps3 = 0, ps4 = 0, ps5 = 0, pt = 0;
#define RKP(k) do { if (prof) { const unsigned long long n_ = clock64(); ps##k += n_ - pt; pt = n_; } } while (0)
    const int tid0 = tid_opq(), lane = tid0 & 63, lane0 = lane;
    int role, widx;
    {   const unsigned simd = ((unsigned)__builtin_amdgcn_s_getreg((1 << 11) | (4 << 6) | 4)) & 3u;
        unsigned old = 0u;
        if (lane == 0) old = __hip_atomic_fetch_add((LAS unsigned*)RK_CENSUS_LDS, 1u << (8u * simd), __ATOMIC_RELAXED, __HIP_MEMORY_SCOPE_WORKGROUP);
        old = (unsigned)__builtin_amdgcn_readfirstlane((int)old);
        wg_sync();
        const unsigned all = *(volatile LAS unsigned*)RK_CENSUS_LDS;
        const unsigned mine = (old >> (8u * simd)) & 0xffu;
        if (all == 0x02020202u) { role = (int)mine; widx = (int)simd; } else { role = (tid0 >> 6) >> 2; widx = (tid0 >> 6) & 3; }
        role = __builtin_amdgcn_readfirstlane(role); widx = __builtin_amdgcn_readfirstlane(widx); }
    const int gtid = role * 256 + widx * 64 + lane;
    const int b = bid >> 5, h = (bid >> 1) & 15, d = bid & 1;
    LAS float* WB = (LAS float*)L; LAS float* AD = WB + 2176; LAS float* RB = AD + 2176; LAS float* KD = RB + 2176; LAS float* VB = KD + 2176; LAS float* AB = VB + 2176; LAS float* BB = AB + 2176;
    LAS float* WB2 = (LAS float*)(L + 130048);
    LAS float* YB = (LAS float*)(L + 121856);
    LAS unsigned char* AT = L + 65536; LAS unsigned char* RT = L + 70144; LAS unsigned char* BT = L + 74752; LAS unsigned char* KT = L + 79360;
    LAS unsigned char* BKt = L + 83968; LAS unsigned char* UVt = L + 94208;
    LAS unsigned char* SB = L + 104448;
    LAS unsigned char* ARK = L + 113664; LAS unsigned char* AK0 = L + 114944;
    LAS float* AAB = (LAS float*)(L + 116224); LAS float* XF = (LAS float*)(L + 117248); LAS float* GL = (LAS float*)(L + 121344);
    bf16_t* Y = d ? Yb : Yf;
    const int ptid = widx * 64 + lane, ct = widx;
    bf16x8 bw[2], ba[2];
    float w0c = 0.f, a0c = 0.f;
    const int ecg = ptid & 15, ec = 64 * h + 4 * ecg, etok0 = ptid >> 4;
    float4 kk4 = make_float4(0.f, 0.f, 0.f, 0.f), ka4 = kk4, rk4 = kk4;
    if (role == 1) {
#pragma unroll
        for (int ks = 0; ks < 2; ++ks) { float fw[8], fa[8];
#pragma unroll
            for (int j = 0; j < 8; ++j) { const int m = 8 * (lane >> 4) + j + 32 * ks, cc = 64 * h + 16 * ct + (lane & 15); fw[j] = w2[((size_t)d * 64 + m) * 1024 + cc]; fa[j] = a2[((size_t)d * 64 + m) * 1024 + cc]; }
            const uint4 pw = pack8(fw), pa = pack8(fa); bw[ks] = *(const bf16x8*)&pw; ba[ks] = *(const bf16x8*)&pa; }
        const int cch = 64 * h + 16 * ct + (lane & 15);
        w0c = w0[d * 1024 + cch]; a0c = a0[d * 1024 + cch];
        kk4 = *(const float4*)(k_k + ec); ka4 = *(const float4*)(k_a + ec); rk4 = *(const float4*)(r_k + ec);
    } else { const uint4 z = make_uint4(0u, 0u, 0u, 0u); bw[0] = *(const bf16x8*)&z; bw[1] = bw[0]; ba[0] = bw[0]; ba[1] = bw[0]; }
    for (int i = gtid; i < (121856 - 83968) / 4; i += NTHR) ((LAS unsigned*)(L + 83968))[i] = 0u;
    f32x4 Sacc[4];
#pragma unroll
    for (int x = 0; x < 4; ++x) Sacc[x] = (f32x4){0.f, 0.f, 0.f, 0.f};
#define RK_SLO(kb_) (d ? ((kb_) < 8 ? CTXL - 32 * ((kb_) + 1) : SP - 32 * ((kb_) - 8 + 1)) : 32 * (kb_))
    uint4 tw[2][2], ta[2][2]; u32x2 rw[2], kw[2], vw[2];
#define RK_GLOAD_T(kb_) do { const size_t Rn_ = (size_t)b * SP + RK_SLO(kb_); \
        _Pragma("unroll") for (int tt = 0; tt < 2; ++tt) { const bf16_t* trow_ = T + (Rn_ + 16 * tt + (lane & 15)) * 256 + 8 * (lane >> 4); \
            _Pragma("unroll") for (int ks = 0; ks < 2; ++ks) { tw[tt][ks] = *(const uint4*)(trow_ + 64 * d + 32 * ks); ta[tt][ks] = *(const uint4*)(trow_ + 128 + 64 * d + 32 * ks); } } } while (0)
#define RK_GLOAD_RKV(kb_) do { const size_t Rn_ = (size_t)b * SP + RK_SLO(kb_); \
        _Pragma("unroll") for (int j = 0; j < 2; ++j) { const size_t g_ = (Rn_ + etok0 + 16 * j) * 1024 + ec; rw[j] = *(const u32x2*)(Rr + g_); kw[j] = *(const u32x2*)(Kk + g_); vw[j] = *(const u32x2*)(Vv + g_); } } while (0)
#define FRAG(base, row, pitchB, koffB) (*(const LAS bf16x8*)((base) + (row) * (pitchB) + (koffB) + (lane >> 4) * 16))
#define RK_SHADOW int lane = lane0; asm volatile("" : "+v"(lane)); const int ptid = widx * 64 + lane, ecg = ptid & 15, ec = 64 * h + 4 * ecg, etok0 = ptid >> 4; (void)ec; (void)etok0; (void)ecg
#define RK_PREP_A(WBD) do { _Pragma("unroll") for (int tt = 0; tt < 2; ++tt) { f32x4 dw = (f32x4){0.f, 0.f, 0.f, 0.f}, da = (f32x4){0.f, 0.f, 0.f, 0.f}; \
        _Pragma("unroll") for (int ks = 0; ks < 2; ++ks) { \
            dw = __builtin_amdgcn_mfma_f32_16x16x32_bf16(*(const bf16x8*)&tw[tt][ks], bw[ks], dw, 0, 0, 0); \
            da = __builtin_amdgcn_mfma_f32_16x16x32_bf16(*(const bf16x8*)&ta[tt][ks], ba[ks], da, 0, 0, 0); } \
        mfma_drain(); \
        _Pragma("unroll") for (int e = 0; e < 4; ++e) { const int tok = 16 * tt + 4 * (lane >> 4) + e, cc = 16 * ct + (lane & 15); \
            (WBD)[tok * 68 + cc] = -0.8750388f * __builtin_amdgcn_rcpf(1.f + __expf(-(w0c + dw[e])));     \
            AD[tok * 68 + cc] = __builtin_amdgcn_rcpf(1.f + __expf(-(a0c + da[e]))); } } } while (0)
#define RK_PREP_B1(Rb_, kl_) do { \
        float r[2][4], k[2][4], v[2][4]; \
        _Pragma("unroll") for (int j = 0; j < 2; ++j) { r[j][0] = bflo(rw[j].x); r[j][1] = bfhi(rw[j].x); r[j][2] = bflo(rw[j].y); r[j][3] = bfhi(rw[j].y); k[j][0] = bflo(kw[j].x); k[j][1] = bfhi(kw[j].x); k[j][2] = bflo(kw[j].y); k[j][3] = bfhi(kw[j].y); \
            v[j][0] = bflo(vw[j].x); v[j][1] = bfhi(vw[j].x); v[j][2] = bflo(vw[j].y); v[j][3] = bfhi(vw[j].y); } \
        if ((kl_) >= 0) RK_GLOAD_RKV(kl_); \
        const float kkc[4] = {kk4.x, kk4.y, kk4.z, kk4.w}, kac[4] = {ka4.x, ka4.y, ka4.z, ka4.w}, rkc[4] = {rk4.x, rk4.y, rk4.z, rk4.w}; \
        _Pragma("unroll") for (int j = 0; j < 2; ++j) { const int etok = etok0 + 16 * j; float kr[4], ss = 0.f; \
            _Pragma("unroll") for (int e = 0; e < 4; ++e) { kr[e] = k[j][e] * kkc[e]; ss += kr[e] * kr[e]; } \
            ss = red16(ss); const float inv = __builtin_amdgcn_rsqf(fmaxf(ss, 1e-24f)); float bs = 0.f; \
            const int o4 = etok * 68 + 4 * ecg; const f32x4 ad4 = *(const LAS f32x4*)(AD + o4); f32x4 r4, kd4, v4, a4, b4; \
            _Pragma("unroll") for (int e = 0; e < 4; ++e) { const float ad = ad4[e], kkn = kr[e] * inv, kd = k[j][e] * (1.f + (ad - 1.f) * kac[e]); \
                r4[e] = r[j][e]; kd4[e] = kd; v4[e] = v[j][e]; a4[e] = -kkn; b4[e] = kkn * ad; bs += r[j][e] * kd * rkc[e]; } \
            *(LAS f32x4*)(RB + o4) = r4; *(LAS f32x4*)(KD + o4) = kd4; *(LAS f32x4*)(VB + o4) = v4; *(LAS f32x4*)(AB + o4) = a4; *(LAS f32x4*)(BB + o4) = b4; \
            bs = red16(bs); if (ecg == 0) bon[((size_t)d * NTOK + (Rb_) + etok) * 16 + h] = bs; } } while (0)
    typedef float f32x2w __attribute__((ext_vector_type(2)));
#define RK_PREP_B2(c_, half_, WBS) do { const int t = ptid & 15, kk0 = 2 * ((ptid >> 4) + 16 * (half_)); const int u = d ? 31 - 16 * (c_) - t : 16 * (c_) + t; const int o = u * 68 + kk0; \
        const f32x2w lw = *(const LAS f32x2w*)((WBS) + o), a2_ = *(const LAS f32x2w*)(AB + o), r2_ = *(const LAS f32x2w*)(RB + o), b2_ = *(const LAS f32x2w*)(BB + o), k2_ = *(const LAS f32x2w*)(KD + o), v2_ = *(const LAS f32x2w*)(VB + o); \
        float cs0 = lw[0], cs1 = lw[1]; \
        cs0 += dppz<0x111>(cs0); cs1 += dppz<0x111>(cs1); cs0 += dppz<0x112>(cs0); cs1 += dppz<0x112>(cs1); cs0 += dppz<0x114>(cs0); cs1 += dppz<0x114>(cs1); cs0 += dppz<0x118>(cs0); cs1 += dppz<0x118>(cs1); \
        const float g0 = __builtin_amdgcn_exp2f(cs0), gp0 = __builtin_amdgcn_exp2f(cs0 - lw[0]), ig0 = __builtin_amdgcn_exp2f(-cs0), g1 = __builtin_amdgcn_exp2f(cs1), gp1 = __builtin_amdgcn_exp2f(cs1 - lw[1]), ig1 = __builtin_amdgcn_exp2f(-cs1); \
        const unsigned avp = pk2(a2_[0] * gp0, a2_[1] * gp1), rvp = pk2(r2_[0] * g0, r2_[1] * g1), bvp = pk2(b2_[0] * ig0, b2_[1] * ig1), kvp = pk2(k2_[0] * ig0, k2_[1] * ig1), vvp = pk2(v2_[0], v2_[1]); \
        const int ro = (c_) * 2304 + t * 144 + kk0 * 2; \
        *(LAS unsigned*)(AT + ro) = avp; *(LAS unsigned*)(RT + ro) = rvp; *(LAS unsigned*)(BT + ro) = bvp; *(LAS unsigned*)(KT + ro) = kvp; \
        LAS unsigned char* bk_ = BKt + (c_) * 5120 + kk0 * 80 + t * 2; LAS unsigned char* uv_ = UVt + (c_) * 5120 + kk0 * 80 + 32 + t * 2; \
        *(LAS unsigned short*)(bk_) = (unsigned short)(bvp & 0xffffu); *(LAS unsigned short*)(bk_ + 80) = (unsigned short)(bvp >> 16); \
        *(LAS unsigned short*)(bk_ + 32) = (unsigned short)(kvp & 0xffffu); *(LAS unsigned short*)(bk_ + 112) = (unsigned short)(kvp >> 16); \
        *(LAS unsigned short*)(uv_) = (unsigned short)(vvp & 0xffffu); *(LAS unsigned short*)(uv_ + 80) = (unsigned short)(vvp >> 16); \
        if (t == 15) { f32x2w gg; gg[0] = g0; gg[1] = g1; *(LAS f32x2w*)(GL + (c_) * 64 + kk0) = gg; } } while (0)
    if (role == 1) { RK_SHADOW; RK_GLOAD_T(0); RK_GLOAD_RKV(0); }
    wg_sync();
    if (role == 1) { RK_SHADOW; RK_PREP_A(WB); RK_GLOAD_T(1); }
    wg_sync();
    if (role == 1) { RK_SHADOW; const size_t Rb0 = (size_t)b * SP + RK_SLO(0); RK_PREP_B1(Rb0, 1); }
    wg_sync();
    if (role == 1) { { RK_SHADOW; RK_PREP_A(WB2); RK_GLOAD_T(2); } { RK_SHADOW; RK_PREP_B2(0, 0, WB); } { RK_SHADOW; RK_PREP_B2(0, 1, WB); } }
    wg_sync();
    constexpr int NBLK = SP / 32;
    for (int kb = 0; kb < NBLK; ++kb) {
        const int slo = RK_SLO(kb);
        const size_t Rb = (size_t)b * SP + slo;
        const bool more = (kb + 1 < NBLK);
        LAS float* WBc = (kb & 1) ? WB2 : WB; LAS float* WBn = (kb & 1) ? WB : WB2;
        if (prof) { if (kb == 0) pt = clock64(); else RKP(5); }
#pragma unroll
        for (int c = 0; c < 2; ++c) {
            f32x4 accx = (f32x4){0.f, 0.f, 0.f, 0.f}, acca = (f32x4){0.f, 0.f, 0.f, 0.f}, accy = (f32x4){0.f, 0.f, 0.f, 0.f};
            if (role == 0) { RK_SHADOW;
                LAS unsigned char* Aa = (widx < 2) ? AT : RT; LAS unsigned char* Bb = (widx & 1) ? KT : BT;
#pragma unroll
                for (int ks = 0; ks < 2; ++ks) { const bf16x8 fa = FRAG(AT + c * 2304, lane & 15, 144, ks * 64), fs = FRAG(SB, 16 * widx + (lane & 15), 144, ks * 64), fr = FRAG(RT + c * 2304, lane & 15, 144, ks * 64);
                    accx = __builtin_amdgcn_mfma_f32_16x16x32_bf16(fa, fs, accx, 0, 0, 0);
                    accy = __builtin_amdgcn_mfma_f32_16x16x32_bf16(fr, fs, accy, 0, 0, 0);
                    const bf16x8 f1 = FRAG(Aa + c * 2304, lane & 15, 144, ks * 64), f2 = FRAG(Bb + c * 2304, lane & 15, 144, ks * 64);
                    acca = __builtin_amdgcn_mfma_f32_16x16x32_bf16(f1, f2, acca, 0, 0, 0); }
                mfma_drain();
#pragma unroll
                for (int e = 0; e < 4; ++e) { const int t = 4 * (lane >> 4) + e, ta_ = lane & 15; const bool strict = ta_ < t, incl = ta_ <= t; const float val = acca[e];
                    if (widx == 0) { }
                    else if (widx == 1) *(LAS unsigned short*)(AK0 + t * 80 + 32 + ta_ * 2) = f2bf(strict ? val : 0.f);
                    else if (widx == 2) *(LAS unsigned short*)(ARK + t * 80 + ta_ * 2) = f2bf(incl ? val : 0.f);
                    else *(LAS unsigned short*)(ARK + t * 80 + 32 + ta_ * 2) = f2bf(incl ? val : 0.f); }
            } else { RK_SHADOW;
                if (c == 0) { RK_PREP_B2(1, 0, WBc); }
                else if (more) { RK_PREP_B2(0, 0, WBn); }
            }
            wg_sync(); RKP(0);
            if (role == 0) { RK_SHADOW; const bf16x8 fk = FRAG(AK0, lane & 15, 80, 0), fv = FRAG(UVt + c * 5120, 16 * widx + (lane & 15), 80, 0);
                accx = __builtin_amdgcn_mfma_f32_16x16x32_bf16(fk, fv, accx, 0, 0, 0);
                mfma_drain();
#pragma unroll
                for (int e = 0; e < 4; ++e) XF[(4 * (lane >> 4) + e) * 64 + 16 * widx + (lane & 15)] = accx[e];
            } else { RK_SHADOW;
                if (c == 0) { RK_PREP_B2(1, 1, WBc); }
                else if (more) { RK_PREP_B2(0, 1, WBn); }
            }
            wg_sync(); RKP(1);
            if (role == 0) { RK_SHADOW;
                if (widx == 0) { float uu[16];
#pragma unroll
                    for (int t = 0; t < 16; ++t) uu[t] = XF[t * 64 + lane];
#pragma unroll
                    for (int q = 0; q < 15; ++q) {
#pragma unroll
                        for (int t = q + 1; t < 16; ++t) { const float aq = __int_as_float(__builtin_amdgcn_readlane(__float_as_int(acca[t & 3]), q + 16 * (t >> 2))); uu[t] += aq * uu[q]; } }
                    uint4 p0, p1; p0.x = pk2(uu[0], uu[1]); p0.y = pk2(uu[2], uu[3]); p0.z = pk2(uu[4], uu[5]); p0.w = pk2(uu[6], uu[7]); p1.x = pk2(uu[8], uu[9]); p1.y = pk2(uu[10], uu[11]); p1.z = pk2(uu[12], uu[13]); p1.w = pk2(uu[14], uu[15]);
                    u32x4 q0, q1; q0.x = p0.x; q0.y = p0.y; q0.z = p0.z; q0.w = p0.w; q1.x = p1.x; q1.y = p1.y; q1.z = p1.z; q1.w = p1.w;
                    *(LAS u32x4*)(UVt + c * 5120 + lane * 80) = q0; *(LAS u32x4*)(UVt + c * 5120 + lane * 80 + 16) = q1; }
            } else { RK_SHADOW;
                if (c == 0) { if (more) { const size_t Rb1 = (size_t)b * SP + RK_SLO(kb + 1); const int kl = (kb + 2 < NBLK) ? kb + 2 : -1; RK_PREP_B1(Rb1, kl); } }
                else if (kb + 2 < NBLK) { RK_PREP_A(WBc); if (kb + 3 < NBLK) RK_GLOAD_T(kb + 3); }
            }
            wg_sync(); RKP(2);
            if (role == 0) { RK_SHADOW;
                { const bf16x8 fr = FRAG(ARK, lane & 15, 80, 0), fu = FRAG(UVt + c * 5120, 16 * widx + (lane & 15), 80, 0);
                    accy = __builtin_amdgcn_mfma_f32_16x16x32_bf16(fr, fu, accy, 0, 0, 0); }
                const int kt = widx; const bf16x8 fb = FRAG(BKt + c * 5120, 16 * kt + (lane & 15), 80, 0);
#pragma unroll
                for (int x = 0; x < 4; ++x) { const bf16x8 fu = FRAG(UVt + c * 5120, 16 * x + (lane & 15), 80, 0);
                    Sacc[x] = __builtin_amdgcn_mfma_f32_16x16x32_bf16(fb, fu, Sacc[x], 0, 0, 0); }
                mfma_drain();
#pragma unroll
                for (int e = 0; e < 4; ++e) { const int t = 4 * (lane >> 4) + e, u = d ? 31 - 16 * c - t : 16 * c + t; YB[u * 64 + 16 * widx + (lane & 15)] = accy[e]; }
                const f32x4 gl = *(const LAS f32x4*)(GL + c * 64 + 16 * kt + 4 * (lane >> 4));
#pragma unroll
                for (int x = 0; x < 4; ++x) { Sacc[x] *= gl;
                    u32x2 w_; w_.x = pk2(Sacc[x][0], Sacc[x][1]); w_.y = pk2(Sacc[x][2], Sacc[x][3]);
                    *(LAS u32x2*)(SB + (16 * x + (lane & 15)) * 144 + (16 * kt + 4 * (lane >> 4)) * 2) = w_; }
            } else { RK_SHADOW;
            }
            wg_sync(); if (c == 0) RKP(3); else RKP(4);
        }
        { const int etok = gtid >> 4, eg = gtid & 15; const int o = etok * 64 + 4 * eg; u32x2 w; w.x = pk2(YB[o], YB[o + 1]); w.y = pk2(YB[o + 2], YB[o + 3]); *(u32x2*)(Y + (Rb + etok) * 1024 + 64 * h + 4 * eg) = w; }
    }
#undef RK_PREP_A
#undef RK_PREP_B1
#undef RK_PREP_B2
#undef FRAG
#undef RK_SHADOW
#undef RK_GLOAD_T
#undef RK_GLOAD_RKV
    if (prof && bid == 0 && gtid == 0) { prof[0] = ps0; prof[1] = ps1; prof[2] = ps2; prof[3] = ps3; prof[4] = ps4; prof[5] = ps5; }
#undef RKP
#undef RK_SLO
}


PHASE_FN void phase_fin_rk(const bf16_t* Yf, const bf16_t* Yb, const bf16_t* Vv, bf16_t* G, const float* bon, const float* gng, const float* gnb, int bid, int nb) {
    const int tid = tid_opq(), lane = tid & 63, wv = tid >> 6;
    const int hd = lane >> 2, c0 = 64 * hd + 16 * (lane & 3);
    float gqv[16], bqv[16];
#pragma unroll
    for (int u = 0; u < 4; ++u) { const float4 g_ = *(const float4*)(gng + c0 + 4 * u), b_ = *(const float4*)(gnb + c0 + 4 * u);
        gqv[4 * u] = g_.x; gqv[4 * u + 1] = g_.y; gqv[4 * u + 2] = g_.z; gqv[4 * u + 3] = g_.w; bqv[4 * u] = b_.x; bqv[4 * u + 1] = b_.y; bqv[4 * u + 2] = b_.z; bqv[4 * u + 3] = b_.w; }
    for (int R = bid * 8 + wv; R < NTOK; R += nb * 8) {
        const size_t base = (size_t)R * 1024 + c0;
        float y[16]; float s1 = 0.f;
#pragma unroll
        for (int u = 0; u < 2; ++u) { float a[8], b[8]; unpack8(*(const uint4*)(Yf + base + 8 * u), a); unpack8(*(const uint4*)(Yb + base + 8 * u), b);
#pragma unroll
            for (int e = 0; e < 8; ++e) { y[8 * u + e] = a[e] + b[e]; s1 += y[8 * u + e]; } }
        s1 = red4(s1); const float mu = s1 * (1.f / 64.f); float s2 = 0.f;
#pragma unroll
        for (int e = 0; e < 16; ++e) { const float dd = y[e] - mu; s2 += dd * dd; }
        s2 = red4(s2); const float rn = rsqrtf(s2 * (1.f / 64.f) + 64e-5f);
        const float bsum = bon[(size_t)R * 16 + hd] + bon[((size_t)NTOK + R) * 16 + hd];
#pragma unroll
        for (int u = 0; u < 2; ++u) { float v[8], g[8], w[8]; unpack8(*(const uint4*)(Vv + base + 8 * u), v); unpack8(*(const uint4*)(G + base + 8 * u), g);
#pragma unroll
            for (int e = 0; e < 8; ++e) { w[e] = ((y[8 * u + e] - mu) * rn * gqv[8 * u + e] + bqv[8 * u + e] + bsum * v[e]) * siluf(g[e]); }
            *(uint4*)(G + base + 8 * u) = pack8(w); }
    }
}

PHASE_FN void wcvt_ret(const float* w_in, const float* w_out, bf16_t* W, LAS unsigned char* L, int bid, int nb) {
    LAS float* T = (LAS float*)L; int tb = 0;
    cvt_tiles(W, 1024, 0, 6144, 1024, [=](int k, int n) -> float {
        int col = n; float sc = 1.f;
        if (n < 2048) { const int sec = n >> 10, hn = n & 1023, hh = hn >> 8, pp = hn & 255, hb = pp & 128, i2 = pp & 127, i = i2 >> 1; col = sec * 1024 + hh * 256 + hb + ((i2 & 1) ? 64 + i : i); if (sec == 1) sc = 0.0625f; }
        return w_in[(size_t)k * 6144 + col] * sc; }, T, bid, nb, tb);
    cvt_tiles(W + (size_t)6144 * 1024, 2048, 0, 1024, 2048, [=](int k, int n) -> float { return w_out[(size_t)k * 1024 + n]; }, T, bid, nb, tb);
}
PHASE_FN void wcvt_ml_in(const float* w_in, bf16_t* Wdst, LAS unsigned char* L, int bid, int nb) {
    LAS float* T = (LAS float*)L; int tb = 0;
    cvt_tiles(Wdst, 1024, 0, 4096, 1024, [=](int k, int n) -> float { return w_in[(size_t)k * 4096 + n]; }, T, bid, nb, tb);
}
PHASE_FN void wcvt_ml(const float* w_out, const float* wqkv, const float* gw, bf16_t* W, LAS unsigned char* L, int bid, int nb) {
    LAS float* T = (LAS float*)L; int tb = 0;
    cvt_tiles(W + (size_t)4096 * 1024, 2048, 0, 1024, 2048, [=](int k, int n) -> float { return w_out[(size_t)k * 1024 + n]; }, T, bid, nb, tb);
    bf16_t* Gt = W + (size_t)6144 * 1024;
    for (int idx = bid * NTHR + tid_opq(); idx < 65536; idx += nb * NTHR) { const int o = idx >> 12, c = idx & 4095, d = o >> 3, gi = o & 7; float val = 0.f;
        if (c < 2048) { const int grp = c >> 2, ci = c & 3;
#pragma unroll
            for (int eo = 0; eo < 4; ++eo) val += wqkv[(size_t)(grp) * 16 + ci * 4 + eo] * gw[((size_t)d * 6144 + 4 * grp + eo) * 8 + gi] + wqkv[(size_t)(512 + grp) * 16 + ci * 4 + eo] * gw[((size_t)d * 6144 + 2048 + 4 * grp + eo) * 8 + gi];
        } else { const int c2 = c - 2048, grp = c2 >> 2, ci = c2 & 3;
#pragma unroll
            for (int eo = 0; eo < 4; ++eo) val += wqkv[(size_t)(1024 + grp) * 16 + ci * 4 + eo] * gw[((size_t)d * 6144 + 4096 + 4 * grp + eo) * 8 + gi]; }
        Gt[idx] = (bf16_t)(pk2(val, 0.f) & 0xffffu); }
}
PHASE_FN void wcvt_rk(const float* mix, const float* wrkvg, const float* w1, const float* a1, const float* w_out, bf16_t* W, LAS unsigned char* L, int bid, int nb) {
    LAS float* T = (LAS float*)L; int tb = 0;
    cvt_tiles(W, 2048, 0, 4608, 2048, [=](int k, int n) -> float {
        const int kk = k & 1023; float w, mx;
        if (n < 4096) { const int j = n >> 10, cc = n & 1023; const int mj = (j == 0) ? 0 : (j == 1 ? 2 : (j == 2 ? 3 : 5)); w = wrkvg[((size_t)j * 1024 + kk) * 1024 + cc]; mx = mix[mj * 1024 + kk]; }
        else { const int n2 = n - 4096, blk = n2 >> 8, cc = n2 & 255; if (cc >= 128) return 0.f; const int d = cc >> 6, m = cc & 63;
            w = (blk == 0 ? w1 : a1)[((size_t)d * 1024 + kk) * 64 + m]; mx = mix[(blk == 0 ? 1 : 4) * 1024 + kk]; }
        return w * (k < 1024 ? 1.f - mx : mx); }, T, bid, nb, tb);
    cvt_tiles(W + (size_t)4608 * 2048, 1024, 0, 1024, 1024, [=](int k, int n) -> float { return w_out[(size_t)k * 1024 + n]; }, T, bid, nb, tb);
}

PHASE_FN void wcvt_rk2(const float* wrkvg, const float* w1, const float* a1, const float* w_out, bf16_t* W, LAS unsigned char* L, int bid, int nb) {
    LAS float* T = (LAS float*)L; int tb = 0;
    cvt_tiles(W, 1024, 0, 4608, 1024, [=](int k, int n) -> float {
        if (n < 4096) { const int j = n >> 10, cc = n & 1023; return wrkvg[((size_t)j * 1024 + k) * 1024 + cc]; }
        const int n2 = n - 4096, blk = n2 >> 8, cc = n2 & 255; if (cc >= 128) return 0.f; const int d = cc >> 6, mm = cc & 63;
        return (blk == 0 ? w1 : a1)[((size_t)d * 1024 + k) * 64 + mm]; }, T, bid, nb, tb);
    cvt_tiles(W + (size_t)4608 * 1024, 1024, 0, 1024, 1024, [=](int k, int n) -> float { return w_out[(size_t)k * 1024 + n]; }, T, bid, nb, tb);
}
PHASE_FN void wcvt_rk2a(const float* wrkvg, bf16_t* W, int nlo, LAS unsigned char* L, int bid, int nb) {
    LAS float* T = (LAS float*)L; int tb = 0;
    cvt_tiles(W + (size_t)nlo * 1024, 1024, 0, 2048, 1024, [=](int k, int n) -> float { const int n2 = n + nlo, j = n2 >> 10, cc = n2 & 1023; return wrkvg[((size_t)j * 1024 + k) * 1024 + cc]; }, T, bid, nb, tb);
}
PHASE_FN void wcvt_rk2b(const float* w1, const float* a1, const float* w_out, bf16_t* W, LAS unsigned char* L, int bid, int nb) {
    LAS float* T = (LAS float*)L; int tb = 0;
    cvt_tiles(W + (size_t)4096 * 1024, 1024, 0, 512, 1024, [=](int k, int n2) -> float {
        const int blk = n2 >> 8, cc = n2 & 255; if (cc >= 128) return 0.f; const int d = cc >> 6, mm = cc & 63;
        return (blk == 0 ? w1 : a1)[((size_t)d * 1024 + k) * 64 + mm]; }, T, bid, nb, tb);
    cvt_tiles(W + (size_t)4608 * 1024, 1024, 0, 1024, 1024, [=](int k, int n) -> float { return w_out[(size_t)k * 1024 + n]; }, T, bid, nb, tb);
}

#define R_Q ((bf16_t*)(S))
#define R_K ((bf16_t*)(S + U34))
#define R_V ((bf16_t*)(S + U68))
#define R_P ((bf16_t*)(S + 2 * U68))
#define R_KT ((bf16_t*)(S + 2 * U68 + U34))
#define R_VT ((bf16_t*)(S + 3 * U68))
#define R_OF ((bf16_t*)(S + 4 * U68))
#define R_OB ((bf16_t*)(S + 5 * U68))
#define R_CA(JJ) ChunkArgs ca{}; ca.qsrc = R_Q; ca.ksrc = R_K; ca.vsrc = R_V; ca.ldq = 1024; ca.ldv = 2048; ca.Kt = R_KT; ca.Vt = R_VT; ca.P = R_P; ca.Of = R_OF; ca.Ob = R_OB; ca.decay = IN(9) + (JJ) * 8
#define AH(half) (H + (size_t)(half) * NH * DM)
#define HB(half) ((half) * NH)
#define RET_QKV_ARGS(half) AH(half), W, NH, 4096, 1024, EpiRetQKV{R_Q, R_K, R_V, rope, HB(half)}
#define RET_OUT_ARGS(YM) R_VT, W + (size_t)6144 * 1024, NH, 1024, 2048, EpiBf{YM, 1024}
#define RET_MID(half, JJ, EXTRA, LASTF) \
        PHG(1, R_CA(JJ); (phase_s1<256, false>(ca, L, bid, nb))); \
        PHG(2, R_CA(JJ); if (bid < 128) phase_s2w(ca, L, bid, 128); else { gemm_run<EpiBf>(AH(half), W + (size_t)4096 * 1024, NH, 2048, 1024, EpiBf{R_V, 2048}, L, bid - 128, 128); EXTRA; }); \
        PHG(5, phase_fin_ret(R_OF, R_OB, R_V, R_VT, LASTF, bid, nb));
#define RET_LN_ROWS(half, YM, LI, XL_IN, XC_IN, RA, RB_, BID, NBL) \
        phase_ln(XL_IN, XC_IN, out, xctx, (const bf16_t*)(YM) + (size_t)(RA) * DM, mod + (size_t)(LI) * 9 * 3072, mod + (size_t)((LI) + 1) * 9 * 3072, IN(6) + (LI) * 1024, IN(7) + (LI) * 1024, H, HB(half) + (RA), HB(half) + (RB_), 0, BID, NBL)
#define RET_LN_CALL(half, YM, LI, XL_IN, XC_IN, LAST, BID, NBL) \
        phase_ln(XL_IN, XC_IN, out, xctx, (const bf16_t*)(YM), mod + (size_t)(LI) * 9 * 3072, mod + (size_t)((LI) + 1 < 4 ? (LI) + 1 : 3) * 9 * 3072, IN(6) + (LI) * 1024, IN(7) + (LI) * 1024, H, HB(half), HB(half) + NH, LAST, BID, NBL)
#define RET_LAYER(LI, JJ, XL_IN, XC_IN, LAST, NEXT_WCVT, PRE_EXTRA, FINAL_LN, OUT1) \
    { \
        PHG(10, gemm_run<EpiRetQKV, GSTAMP != 0>(RET_QKV_ARGS(0), L, bid, nb, GSTAMP_PTR)); \
        RET_MID(0, JJ, PRE_EXTRA, LAST) \
        PHG(12, gemm_dual(RET_OUT_ARGS(AH(0)), 1, 0, RET_QKV_ARGS(1), 3, 16, L, bid, nb, LAST)); \
        RET_MID(1, JJ, RET_LN_CALL(0, AH(0), LI, XL_IN, XC_IN, LAST, bid - 128, 128), LAST) \
        PHG(12, OUT1); \
        PHG(6, FINAL_LN; NEXT_WCVT); \
    }
#define M_XM ((bf16_t*)(S))
#define M_XC ((bf16_t*)(S + U68))
#define M_KT ((bf16_t*)(S + 2 * U68))
#define M_VT ((bf16_t*)(S + 3 * U68))
#define M_P ((bf16_t*)(S + 4 * U68))
#define M_OB ((bf16_t*)(S + 4 * U68 + U34))
#define M_GAR ((float*)(S + 5 * U68 + U34))
#define M_GG (M_GAR)
#define M_GPM (M_GAR + 2 * 16 * SP)
#define M_GB (M_GAR + 4 * 16 * SP)
#define M_RS (M_GAR + 6 * 16 * SP)
#define M_CBL (M_GAR + 8 * 16 * SP)
#define M_CPML (M_GAR + 8 * 16 * SP + 2 * 16 * NCH)
#define M_CA ChunkArgs ca{}; ca.qsrc = M_XC; ca.ksrc = M_XC; ca.vsrc = M_XM; ca.ldq = 2048; ca.ldv = 2048; ca.Kt = M_KT; ca.Vt = M_VT; ca.P = M_P; ca.Of = M_XM; ca.Ob = M_OB; ca.wqkv = IN(14); \
        ca.gG = M_GG; ca.gPM = M_GPM; ca.gB = M_GB; ca.cBL = M_CBL; ca.cPML = M_CPML; ca.RS = M_RS
#define K_A2 ((bf16_t*)(S))
#define K_RKVG ((bf16_t*)(S + 2 * U68))
#define K_T (H)
#define K_BON ((float*)((unsigned char*)H + 17 * MiB))
#define K_R (K_RKVG)
#define K_K (K_RKVG + (size_t)NTOK * 1024)
#define K_V (K_RKVG + (size_t)2 * NTOK * 1024)
#define K_G (K_RKVG + (size_t)3 * NTOK * 1024)
#define K_YF ((bf16_t*)(S))
#define K_YB ((bf16_t*)(S + U68))

#define ML_MID(half, PREP) \
        PHG(4, PREP); \
        PHG(17, M_CA; (phase_s1<512, true>(ca, L, bid, nb))); \
        PHG(18, M_CA; (phase_s2<512, true>(ca, L, bid, nb))); \
        PHG(16, gemm_run<EpiBf>(AH(half), W_MLIN + (size_t)2048 * 1024, NH, 2048, 1024, EpiBf{M_KT, 2048}, L, bid, nb)); \
        PHG(5, phase_fin_ml(M_XM, M_OB, M_XC, M_KT, IN(18), IN(17), bid, nb));
#define ML_PREP(BID, NBL) phase_mlprep(M_XM, M_XC, W + (size_t)6144 * 1024, IN(12), IN(13), IN(16), M_GG, M_GPM, M_GB, M_CBL, M_CPML, L, BID, NBL)
#define W_MLIN (W + (size_t)8192 * 1024)
#define ML_XM_ARGS(half) AH(half), W_MLIN, NH, 2048, 1024, EpiBf{M_XM, 2048}
#define ML_OUT_ARGS(YM) M_KT, W + (size_t)4096 * 1024, NH, 1024, 2048, EpiBf{YM, 1024}
#define ML_LN_CALL(half, YM, BID, NBL) \
        phase_ln(out, xctx, out, xctx, (const bf16_t*)(YM), mod + (size_t)1 * 9 * 3072, mod + (size_t)2 * 9 * 3072, IN(6) + 1024, IN(7) + 1024, H, HB(half), HB(half) + NH, 0, BID, NBL)
#define LN_SPLIT 17408
#define ML_LN_ROWS(half, YM, RA, RB_, BID, NBL) \
        phase_ln(out, xctx, out, xctx, (const bf16_t*)(YM) + (size_t)(RA) * DM, mod + (size_t)1 * 9 * 3072, mod + (size_t)2 * 9 * 3072, IN(6) + 1024, IN(7) + 1024, H, HB(half) + (RA), HB(half) + (RB_), 0, BID, NBL)
#define ML_LAYER(NEXT_WCVT, PREV_LN, PREV_LN_TAIL) \
    { \
        ML_MID(0, if (bid < 136) { ML_PREP(bid, 136); PREV_LN_TAIL; } else { PREV_LN; }) \
        PHG(15, gemm_dual(ML_OUT_ARGS(AH(0)), 1, 0, ML_XM_ARGS(1), 1, 16, L, bid, nb)); \
        ML_MID(1, if (bid < 136) { ML_PREP(bid, 136); ML_LN_ROWS(0, AH(0), LN_SPLIT, NH, bid, 136); } else { ML_LN_ROWS(0, AH(0), 0, LN_SPLIT, bid - 136, 120); wcvt_rk2a(IN(21), W, 2048, L, bid - 136, 120); }) \
        PHG(15, gemm_run<EpiBf>(ML_OUT_ARGS(M_VT), L, bid, nb)); \
        PHG(6, ML_LN_CALL(1, M_VT, bid, nb); NEXT_WCVT); \
    }

#ifndef HOTPROBE
#define HOTPROBE 0
#endif
#if HOTPROBE
#define HOTPHASE PHG(7, gemm_hot(H, W, (bf16_t*)(S + 64 * MiB), 0, 1024, L, bid, nb, GSTAMP_PTR)); \
    PHG(7, gemm_hot((const bf16_t*)S, (const bf16_t*)(S + 40 * MiB), (bf16_t*)(S + 64 * MiB), 0, 1024, L, bid, nb, GSTAMP_PTR + 16384));
#else
#define HOTPHASE
#endif
#define FORWARD_PROGRAM() \
    PHG(7, phase_mod(IN(1), IN(3), IN(4), IN(5), mod, rope, L, bid, nb); wcvt_ret(IN(8), IN(10), W, L, bid, nb)); \
    PHG(7, phase_h0(IN(0), IN(2), mod, H, 0, NH, bid, nb)); \
    HOTPHASE \
    RET_LAYER(0, 0, IN(0), IN(2), 0, wcvt_ml(IN(19), IN(14), IN(15), W, L, bid, nb), phase_h0(IN(0), IN(2), mod, H, NH, NTOK, bid - 128, 128); wcvt_ml_in(IN(11), W_MLIN, L, bid - 128, 128), (void)0, \
              gemm_dual(RET_OUT_ARGS(R_P), 1, 0, ML_XM_ARGS(0), 1, 16, L, bid, nb)) \
    ML_LAYER(wcvt_rk2b(IN(23), IN(26), IN(33), W, L, bid, nb), RET_LN_ROWS(1, R_P, 0, IN(0), IN(2), 0, LN_SPLIT, bid - 136, 120); wcvt_rk2a(IN(21), W, 0, L, bid - 136, 120), RET_LN_ROWS(1, R_P, 0, IN(0), IN(2), LN_SPLIT, NH, bid, 136)) \
    PHG(7, phase_rkmix2(H, K_A2, IN(20), 0, 2, bid, nb)); \
    PHG(13, gemm_pair(K_A2, W, 4, 0, EpiRwkv2{K_RKVG, K_T}, L, bid, nb)); \
    PHG(7, phase_rkmix2(H, K_A2, IN(20), 3, 5, bid, nb)); \
    PHG(13, gemm_pair(K_A2, W, 4, 8, EpiRwkv2{K_RKVG, K_T}, L, bid, nb)); \
    PHG(7, phase_rkmix2(H, K_A2, IN(20), 1, 4, bid, nb)); \
    PHG(13, gemm_pair(K_A2, W, 1, 16, EpiRwkv2{K_RKVG, K_T}, L, bid, nb)); \
    PHG(3, phase_rkscan4(K_R, K_K, K_V, K_T, IN(22), IN(24), IN(25), IN(27), IN(28), IN(29), IN(30), K_YF, K_YB, K_BON, L, bid, nb, S2PROF_PTR)); \
    PHG(5, phase_fin_rk(K_YF, K_YB, K_V, K_G, K_BON, IN(31), IN(32), bid, nb)); \
    PHG(14, gemm_run<EpiBf>(K_G, W + (size_t)4608 * 1024, NTOK, 1024, 1024, EpiBf{H, 1024}, L, bid, nb)); \
    PHG(6, phase_ln(out, xctx, out, xctx, (const bf16_t*)H, mod + (size_t)2 * 9 * 3072, mod + (size_t)3 * 9 * 3072, IN(6) + 2048, IN(7) + 2048, H, 0, NH, 0, bid, nb); \
       wcvt_ret(IN(8) + (size_t)1024 * 6144, IN(10) + (size_t)2048 * 1024, W, L, bid, nb)); \
    RET_LAYER(3, 1, out, xctx, 1, (void)0, phase_ln(out, xctx, out, xctx, (const bf16_t*)(H + (size_t)NH * DM), mod + (size_t)2 * 9 * 3072, mod + (size_t)3 * 9 * 3072, IN(6) + 2048, IN(7) + 2048, H, NH, NTOK, 0, bid - 128, 128), RET_LN_CALL(1, R_P, 3, out, xctx, 1, bid, nb), gemm_deal<EpiBf>(RET_OUT_ARGS(R_P), 1, L, bid, nb))


#if MK_MULTI
template <class F> __global__ void __launch_bounds__(NTHR, 2) kphase(F f) {
    extern __shared__ __attribute__((aligned(16))) unsigned char lds_raw[];
    f((LAS unsigned char*)lds_raw, (int)blockIdx.x, (int)gridDim.x);
}
template <class F> static void launch_phase(hipStream_t st, F f) {
    static int attr_done = 0;
    if (!attr_done) { (void)hipFuncSetAttribute((const void*)kphase<F>, hipFuncAttributeMaxDynamicSharedMemorySize, LDS_BYTES); attr_done = 1; }
    hipLaunchKernelGGL(kphase<F>, dim3(256), dim3(NTHR), LDS_BYTES, st, f);
}
extern "C" void kernel_launch(void* const* d_in, const int* in_sizes, int n_in, void* d_out, int out_size, void* d_ws, size_t ws_size, hipStream_t stream) {
    if (n_in != 34 || ws_size < WS_END) { fprintf(stderr, "kernel_launch: expected 34 inputs and >= %zu bytes of workspace (got %d, %zu)\n", (size_t)WS_END, n_in, ws_size); return; }
    (void)in_sizes; (void)out_size;
    const float* in[34]; for (int i = 0; i < 34; ++i) in[i] = (const float*)d_in[i];
    float* out = (float*)d_out; unsigned char* ws = (unsigned char*)d_ws;
    float* mod = (float*)(ws + WS_MOD); float* rope = (float*)(ws + WS_ROPE); float* xctx = (float*)(ws + WS_XCTX);
    bf16_t* H = (bf16_t*)(ws + WS_H); bf16_t* W = (bf16_t*)(ws + WS_W); unsigned char* S = ws + WS_S; unsigned* dbgcnt = (unsigned*)(ws + WS_ROPE + 32768);
#define IN(i) in[i]
#define S2PROF_PTR ((unsigned long long*)nullptr)
#define GSTAMP_PTR ((unsigned long long*)nullptr)
#define PHG(g, ...) launch_phase(stream, [=] __device__ (LAS unsigned char* L, int bid, int nb) { __VA_ARGS__; })
    FORWARD_PROGRAM()
#undef PHG
#undef IN
}
#else
#ifndef TIMING_PROBE
#define TIMING_PROBE 0
#endif
#define GSTAMP_PTR ((unsigned long long*)(ws + MiB))
#ifndef XCCPROBE
#define XCCPROBE 0
#endif
#ifndef S2PROF
#define S2PROF 0
#endif
#define SP_A 4
#define SP_B 5
#define TP_A 4
#define TP_B 15
#define AS4 __attribute__((address_space(4)))
__device__ __forceinline__ const float* karg_ptr(unsigned off) { asm volatile("" : "+s"(off)); const unsigned char AS4* ka = (const unsigned char AS4*)__builtin_amdgcn_kernarg_segment_ptr(); return *(const float* const AS4*)(ka + off); }
__global__ void __launch_bounds__(NTHR, 2) hybrid_fwd(Prm p) {
    extern __shared__ __attribute__((aligned(16))) unsigned char lds_raw[];
    LAS unsigned char* L = (LAS unsigned char*)lds_raw;
    const int nb = gridDim.x;
    volatile LAS unsigned* st = (volatile LAS unsigned*)(L + LDS_BYTES - 16);
    if (threadIdx.x == 0) { st[0] = 0u; st[1] = 0u; st[2] = 0u; st[3] = 0u; *(volatile LAS unsigned*)(L + TID_TICKET_LDS) = 0u; *(volatile LAS unsigned*)(L + TID_TICKET_LDS + 4) = 0u; }
    __syncthreads();
    { XcdBarrier bar0 = xcd_barrier_post((unsigned*)((unsigned char*)karg_ptr(280) + WS_BAR), st); (void)bar0; }
#define IN(i) karg_ptr(8u * (i))
#define out ((float*)karg_ptr(272))
#define ws ((unsigned char*)karg_ptr(280))
#define mod ((float*)(ws + WS_MOD))
#define rope ((float*)(ws + WS_ROPE))
#define xctx ((float*)(ws + WS_XCTX))
#define H ((bf16_t*)(ws + WS_H))
#define W ((bf16_t*)(ws + WS_W))
#define S (ws + WS_S)
#if TIMING_PROBE
#define TSTAMP(g) { const int tq_ = tid_opq(); if (tq_ == 0 && blockIdx.x == 0) { unsigned long long* tsb = (unsigned long long*)(ws + WS_BAR + 14336); tsb[tsk] = (unsigned long long)wall_clock64(); ((unsigned*)(tsb + 64))[tsk] = (g); } ++tsk; }
#else
#define TSTAMP(g)
#endif
#if S2PROF
#define S2PROF_PTR ((unsigned long long*)(ws + WS_BAR + 15360))
#else
#define S2PROF_PTR ((unsigned long long*)nullptr)
#endif
#define PHG(g, ...) { const int bid = bid_opq(); __VA_ARGS__; XcdBarrier bar; bar.bar = (unsigned*)(ws + WS_BAR); bar.x = xb_xcc_id(); bar.st = (volatile LAS unsigned*)(L + LDS_BYTES - 16); xcd_barrier(bar, tid_opq()); TSTAMP(g) }
    int tsk = 0; TSTAMP(9)
#if XCCPROBE
    { unsigned* xc = (unsigned*)(ws + WS_BAR + 15872); const unsigned x = xb_xcc_id(); if (threadIdx.x == 0) { if (x == (blockIdx.x & 7u)) atomicAdd(xc, 1u); if (x == (blockIdx.x >> 5)) atomicAdd(xc + 1, 1u); } }
#endif
    FORWARD_PROGRAM()
#if GSTAMP
    { const int bid = bid_opq(); phase_gstamp(out, GSTAMP_PTR, bid, nb); }
#endif
#if HOTPROBE
    { const int bid = bid_opq(); phase_hotprobe(out, GSTAMP_PTR, bid, nb); }
#endif
#if XCCPROBE
    { const int bid = bid_opq(); phase_xccprobe(out, (unsigned*)(ws + WS_BAR + 15872), bid, nb); }
#endif
#if S2PROF
    { const int bid = bid_opq(); phase_prof6(out, (const unsigned long long*)(ws + WS_BAR + 15360), SP_A, SP_B, bid, nb); }
#endif
#if TIMING_PROBE
    { XcdBarrier bar; bar.bar = (unsigned*)(ws + WS_BAR); bar.x = xb_xcc_id(); bar.st = (volatile LAS unsigned*)(L + LDS_BYTES - 16); xcd_barrier(bar, tid_opq()); }
    { const int bid = bid_opq(); phase_timing(out, (const unsigned long long*)(ws + WS_BAR + 14336), tsk, bid, nb, TP_A, TP_B); }
#endif
#undef PHG
#undef IN
#undef out
#undef ws
#undef mod
#undef rope
#undef xctx
#undef H
#undef W
#undef S
    (void)p;
}
extern "C" void kernel_launch(void* const* d_in, const int* in_sizes, int n_in, void* d_out, int out_size, void* d_ws, size_t ws_size, hipStream_t stream) {
    static int ready = 0;
    if (!ready) {
        if (n_in != 34 || ws_size < WS_END) { fprintf(stderr, "kernel_launch: expected 34 inputs and >= %zu bytes of workspace (got %d, %zu)\n", (size_t)WS_END, n_in, ws_size); ready = -1; return; }
        if (hipFuncSetAttribute((const void*)hybrid_fwd, hipFuncAttributeMaxDynamicSharedMemorySize, LDS_BYTES) != hipSuccess) { fprintf(stderr, "kernel_launch: hipFuncSetAttribute failed\n"); ready = -1; return; }
        ready = 1;
    }
    if (ready < 0) return;
    (void)in_sizes; (void)out_size;
    (void)hipMemsetAsync((char*)d_ws + WS_BAR, 0, 16384, stream);
    Prm p{};
    for (int i = 0; i < 34; ++i) p.in[i] = (const float*)d_in[i];
    p.out = (float*)d_out; p.ws = (unsigned char*)d_ws;
    hipLaunchKernelGGL(hybrid_fwd, dim3(256), dim3(NTHR), LDS_BYTES, stream, p);
}
#endif
```

```cpp
#include <hip/hip_runtime.h>
#include <cstdio>
#include <cstdint>
#include <cmath>
#ifndef MK_MULTI
#define MK_MULTI 0
#endif
#ifndef PG8_KROT
#define PG8_KROT 0
#endif
#ifndef TP_SCALE
#define TP_SCALE 10.f
#endif
#ifndef GSTAMP
#define GSTAMP 0
#define HOTPROBE 0
#endif
#define TID_TICKET_LDS 163808
__device__ __forceinline__ int tid_opq() {
#if MK_MULTI
    int t = (int)threadIdx.x; asm volatile("" : "+v"(t)); return t;
#else
    const int lane = (int)__builtin_amdgcn_mbcnt_hi(~0u, __builtin_amdgcn_mbcnt_lo(~0u, 0u));
    unsigned id = 0u;
    if (lane == 0) id = __hip_atomic_fetch_add((__attribute__((address_space(3))) unsigned*)TID_TICKET_LDS, 1u, __ATOMIC_RELAXED, __HIP_MEMORY_SCOPE_WORKGROUP);
    id = (unsigned)__builtin_amdgcn_readfirstlane((int)id) & 7u;
    asm volatile("s_waitcnt lgkmcnt(0)" ::: "memory"); __builtin_amdgcn_s_barrier(); asm volatile("" ::: "memory");
    int t = (int)(id * 64u) + lane; asm volatile("" : "+v"(t)); return t;
#endif
}
__device__ __forceinline__ int bid_opq() { int b = (int)blockIdx.x; asm volatile("" : "+s"(b)); return b; }
#define XB_TMO      128
#define XB_XCNT(j)  (256  + 64 * (j))
#define XB_XSUB(j)  (1280 + 64 * (j))
#define XB_XGEN(j)  (2304 + 64 * (j))
#define XB_TOP      3328
#define XB_TOPGEN   3392
#define XCD_BAR_WORDS 3456
#define XB_SPIN_CAP (1u << 18)
#define LAS __attribute__((address_space(3)))

__device__ __forceinline__ unsigned xb_ld(unsigned* p)              { return __hip_atomic_load(p, __ATOMIC_RELAXED, __HIP_MEMORY_SCOPE_AGENT); }
__device__ __forceinline__ unsigned xb_add(unsigned* p, unsigned v) { return __hip_atomic_fetch_add(p, v, __ATOMIC_RELAXED, __HIP_MEMORY_SCOPE_AGENT); }
__device__ __forceinline__ unsigned xb_xcc_id() { return (unsigned)__builtin_amdgcn_s_getreg((3 << 11) | 20) & 0xFu; }
#define XB_SPIN(cond, bar) do { unsigned _sp = 0; while (cond) { __builtin_amdgcn_s_sleep(1); \
    if ((++_sp & 255u) == 0u) { if (xb_ld(&(bar)[XB_TMO])) break; if (_sp > XB_SPIN_CAP) { atomicAdd(&(bar)[XB_TMO], 1u); break; } } } } while (0)

struct XcdBarrier {
    unsigned* bar; unsigned x;
    volatile LAS unsigned* st;
};

__device__ __forceinline__ XcdBarrier xcd_barrier_post(unsigned* bar, volatile LAS unsigned* st) {
    XcdBarrier b; b.bar = bar; b.x = xb_xcc_id(); b.st = st;
    if (threadIdx.x == 0) (void)xb_add(&bar[XB_XCNT(b.x)], 1u);
    return b;
}
__device__ __forceinline__ void xcd_barrier_complete(unsigned* bar, unsigned x, unsigned& nloc, unsigned& nx) {
    const unsigned G = gridDim.x * gridDim.y * gridDim.z;
    unsigned sum, cnt, mine, sp = 0u;
    for (;;) {
        sum = 0u; cnt = 0u; mine = 0u;
#pragma unroll
        for (unsigned j = 0; j < 16; ++j) { const unsigned c = xb_ld(&bar[XB_XCNT(j)]); sum += c; cnt += (c > 0u) ? 1u : 0u; mine = (j == x) ? c : mine; }
        if (sum == G) break;
        __builtin_amdgcn_s_sleep(1);
        if ((++sp & 255u) == 0u) { if (xb_ld(&bar[XB_TMO])) break; if (sp > XB_SPIN_CAP) { atomicAdd(&bar[XB_TMO], 1u); break; } }
    }
    nloc = mine > 0u ? mine : 1u; nx = cnt > 0u ? cnt : 1u;
}

__device__ __forceinline__ void xcd_barrier(const XcdBarrier& b, const int tid0 = (int)threadIdx.x) {
    asm volatile("s_waitcnt vmcnt(0)" ::: "memory");
    __syncthreads();
    if (tid0 == 0) {
        unsigned* bar = b.bar;
        __builtin_amdgcn_s_waitcnt(0);
        unsigned nloc = b.st[0], nx = b.st[1];
        if (nloc == 0u) { xcd_barrier_complete(bar, b.x, nloc, nx); b.st[0] = nloc; b.st[1] = nx; }
        const unsigned old = xb_add(&bar[XB_XSUB(b.x)], 1u);
        const unsigned gen = old / nloc;
        if (old + 1u == (gen + 1u) * nloc) {
            __builtin_amdgcn_fence(__ATOMIC_RELEASE, "agent");
            asm volatile("s_waitcnt vmcnt(0)" ::: "memory");
            const unsigned og = xb_add(&bar[XB_TOP], 1u);
            const unsigned tg = og / nx;
            if (og + 1u == (tg + 1u) * nx) xb_add(&bar[XB_TOPGEN], 1u);
            else XB_SPIN(xb_ld(&bar[XB_TOPGEN]) == tg, bar);
            __builtin_amdgcn_fence(__ATOMIC_ACQUIRE, "agent");
            xb_add(&bar[XB_XGEN(b.x)], 1u);
            asm volatile("s_waitcnt vmcnt(0)" ::: "memory");
        } else {
            XB_SPIN(xb_ld(&bar[XB_XGEN(b.x)]) == gen, bar);
            __builtin_amdgcn_fence(__ATOMIC_ACQUIRE, "agent");
            asm volatile("s_waitcnt vmcnt(0)" ::: "memory");
        }
    }
    __syncthreads();
}
namespace pg8 {
#define PG8_LAS __attribute__((address_space(3)))
typedef unsigned short bf16_t;
typedef short bf16x8 __attribute__((ext_vector_type(8)));
typedef float f32x4 __attribute__((ext_vector_type(4)));
typedef unsigned u32x4 __attribute__((ext_vector_type(4)));
constexpr int BM = 256, BK = 64, HALF = 128, HTB = HALF * BK * 2  , STAGE_BYTES = 8 * HTB, NXCD = 8, WGM = 8;

__host__ __device__ __forceinline__ int lds_byte(int r, int c) { const int st = (r >> 4) * 2 + (c >> 5), rr = r & 15, cc = c & 31, ob = rr * 64 + cc * 2; return st * 1024 + (ob ^ (((ob >> 9) & 1) << 5)); }
__host__ __device__ __forceinline__ void stage_rc(int b, int& R, int& C) { const int st = b / 1024, sb = b % 1024, swz = sb ^ (((sb >> 9) & 1) << 5); R = (st >> 1) * 16 + swz / 64; C = (st & 1) * 32 + (swz % 64) / 2; }
__host__ __device__ __forceinline__ int perm32(int rho) { const int n = rho >> 4, i = rho & 15; return 8 * (i >> 2) + 4 * n + (i & 3); }

struct Unit { int pm, pn; };
struct Gemm { const bf16_t* A; const bf16_t* Bt; int M, N, K, ld; };

struct StaticOrder {
    int nM, nN, nwg, G, c;
    __host__ __device__ void init(int M, int N, int G_, int c_) { nM = M / BM; nN = N / BM; nwg = nM * nN; G = G_; c = c_; }
    __host__ __device__ bool unit_of(long L, Unit& u) const {
        if (L >= nwg) return false;
        int wgid = (int)L; { const int q = nwg / NXCD, r = nwg % NXCD, xcd = wgid % NXCD, off = wgid / NXCD; wgid = (xcd < r ? xcd * (q + 1) : r * (q + 1) + (xcd - r) * q) + off; }
        const int nig = WGM * nN, gid = wgid / nig, fm = gid * WGM, gsz = (nM - fm) < WGM ? (nM - fm) : WGM;
        u.pm = fm + ((wgid % nig) % gsz); u.pn = (wgid % nig) / gsz; return true;
    }
    __host__ __device__ bool next(int i, Unit& u) const { return unit_of((long)i * G + c, u); }
    __device__ __forceinline__ void a_ready(const Unit&) const {}
    __device__ __forceinline__ void done(const Unit&) const {}
};
__device__ __forceinline__ unsigned cvt_pk_bf16(float lo, float hi) { unsigned r; asm volatile("v_cvt_pk_bf16_f32 %0, %1, %2" : "=v"(r) : "v"(lo), "v"(hi)); return r; }
template <class Epi, class Sched, bool STAMP = false>
__device__ __forceinline__ void gemm_phase(PG8_LAS unsigned char* lds, const Gemm g, const Sched& S, const Epi& E, unsigned long long* stamps) {
    const int tid = tid_opq(), wid = __builtin_amdgcn_readfirstlane(tid >> 6), lane = tid & 63, wr = wid >> 2, wc = wid & 3, fr = lane & 15, fq = lane >> 4;
    const int nt = g.K / BK, K = g.ld ? g.ld : g.K;
    int ts_lo = 0, ts_hi = 0, nts = 0; const unsigned long long rt_entry = STAMP ? (unsigned long long)wall_clock64() : 0ull;
#define PG8_STAMP() do { if (STAMP && wid == 0 && nts < 64) { const unsigned long long _c = (unsigned long long)clock64(); \
        ts_lo = (lane == nts) ? (int)(unsigned)_c : ts_lo; ts_hi = (lane == nts) ? (int)(unsigned)(_c >> 32) : ts_hi; ++nts; } } while (0)
    PG8_STAMP();
    unsigned voffA[2], voffB[2];
#pragma unroll
    for (int i = 0; i < 2; ++i) { int R, C; stage_rc(tid * 16 + i * 8192, R, C); const int Rb = Epi::PERM ? ((R & ~31) + perm32(R & 31)) : R;
        voffA[i] = (unsigned)(R * K + C) * 2u; voffB[i] = (unsigned)(Rb * K + C) * 2u; }
    const size_t kstep = (size_t)(BK * 2);
    const size_t hstep = (size_t)HALF * K * 2;
    const size_t tstep = 2 * hstep;
    const unsigned ldsw = (unsigned)wid * 1024u;
    const int aoff = lds_byte(wr * 64 + fr, fq * 8), boff = lds_byte(wc * 32 + fr, fq * 8);
#define PG8_SA(b, h) (((b) * 2 + (h)) * HTB)
#define PG8_SB(b, h) ((4 + (b) * 2 + (h)) * HTB)
#define PG8_STAGE(bufoff, gbase, voff) do { _Pragma("unroll") for (int _i = 0; _i < 2; ++_i) \
        __builtin_amdgcn_global_load_lds((const unsigned*)((const char*)(gbase) + (voff)[_i]), (PG8_LAS unsigned*)(lds + (bufoff) + ldsw + _i * 8192), 16, 0, 0); } while (0)
#define PG8_LDA(dst, b, h) do { _Pragma("unroll") for (int m = 0; m < 4; ++m) _Pragma("unroll") for (int k = 0; k < 2; ++k) dst[m][k] = *(const PG8_LAS bf16x8*)(lds + PG8_SA(b, h) + aoff + m * 2048 + k * 1024); } while (0)
#define PG8_LDB(dst, b, h) do { _Pragma("unroll") for (int n = 0; n < 2; ++n) _Pragma("unroll") for (int k = 0; k < 2; ++k) dst[n][k] = *(const PG8_LAS bf16x8*)(lds + PG8_SB(b, h) + boff + n * 2048 + k * 1024); } while (0)
#define PG8_MMA(ai, bj, At, Bt) do { __builtin_amdgcn_s_setprio(1); _Pragma("unroll") for (int m = 0; m < 4; ++m) _Pragma("unroll") for (int n = 0; n < 2; ++n) _Pragma("unroll") for (int k = 0; k < 2; ++k) \
        acc[ai][bj][m][n] = __builtin_amdgcn_mfma_f32_16x16x32_bf16(Bt[n][k], At[m][k], acc[ai][bj][m][n], 0, 0, 0); __builtin_amdgcn_s_setprio(0); } while (0)
#define PG8_WAIT_V(n) asm volatile("s_waitcnt vmcnt(" #n ")" ::: "memory")
#define PG8_WAIT_L(n) asm volatile("s_waitcnt lgkmcnt(" #n ")" ::: "memory")
#define PG8_WAIT_VL(v, l) asm volatile("s_waitcnt vmcnt(" #v ") lgkmcnt(" #l ")" ::: "memory")
#define PG8_BAR __builtin_amdgcn_s_barrier()
#define PG8_SCHED __builtin_amdgcn_sched_barrier(0)
    Unit cur, nxt; int ui = 0;
    if (!S.next(0, cur)) return;
    const int ntm = nt - 1;
#define PG8_ROT(u) ((PG8_KROT) ? ((2 * ((u).pm & 7) + 4 * ((u).pn & 3)) & ntm) : 0)
#define PG8_KO(off, t) ((size_t)(((t) + (off)) & ntm) * kstep)
    int coff = PG8_ROT(cur);
    f32x4 acc[2][2][4][2];
#pragma unroll
    for (int a = 0; a < 2; ++a)
#pragma unroll
        for (int b = 0; b < 2; ++b)
#pragma unroll
            for (int m = 0; m < 4; ++m)
#pragma unroll
                for (int n = 0; n < 2; ++n) acc[a][b][m][n] = (f32x4){0.f, 0.f, 0.f, 0.f};
    bf16x8 At[4][2], B0[2][2], B1[2][2];
    const char* cA = (const char*)g.A + (size_t)cur.pm * tstep; const char* cB = (const char*)g.Bt + (size_t)cur.pn * tstep;
    S.a_ready(cur);
    { const size_t k0 = PG8_KO(coff, 0), k1 = PG8_KO(coff, 1);
    PG8_STAGE(PG8_SB(0, 0), cB + k0, voffB); PG8_STAGE(PG8_SA(0, 0), cA + k0, voffA); PG8_STAGE(PG8_SB(0, 1), cB + hstep + k0, voffB); PG8_STAGE(PG8_SA(0, 1), cA + hstep + k0, voffA);
    if (wr == 1) PG8_BAR;
    PG8_WAIT_V(4); PG8_BAR;
    PG8_STAGE(PG8_SB(1, 0), cB + k1, voffB); PG8_STAGE(PG8_SA(1, 0), cA + k1, voffA); PG8_STAGE(PG8_SB(1, 1), cB + hstep + k1, voffB); }
    PG8_WAIT_V(6); PG8_BAR;
    PG8_STAMP();
    for (;;) {
        const bool has_next = S.next(ui + 1, nxt);
        const char* nA = has_next ? (const char*)g.A + (size_t)nxt.pm * tstep : cA; const char* nB = has_next ? (const char*)g.Bt + (size_t)nxt.pn * tstep : cB;
        const int noff = has_next ? PG8_ROT(nxt) : coff;
        for (int t = 0; t < nt; t += 2) {
            const bool last = (t == nt - 2);
            const char* a1 = cA + PG8_KO(coff, t + 1);
            const size_t k2 = last ? PG8_KO(noff, 0) : PG8_KO(coff, t + 2), k3 = last ? PG8_KO(noff, 1) : PG8_KO(coff, t + 3);
            const char* a2 = (last ? nA : cA) + k2; const char* b2 = (last ? nB : cB) + k2;
            const char* a3 = (last ? nA : cA) + k3; const char* b3 = (last ? nB : cB) + k3;
            if (last && has_next) S.a_ready(nxt);
            PG8_LDB(B0, 0, 0); PG8_SCHED; PG8_LDA(At, 0, 0); PG8_STAGE(PG8_SA(1, 1), a1 + hstep, voffA);
            PG8_WAIT_VL(10, 8); PG8_BAR; PG8_WAIT_L(0); PG8_MMA(0, 0, At, B0); PG8_BAR; PG8_SCHED;
            PG8_LDB(B1, 0, 1); PG8_STAGE(PG8_SB(0, 0), b2, voffB);
            PG8_WAIT_V(10); PG8_BAR; PG8_WAIT_L(0); PG8_MMA(0, 1, At, B1); PG8_BAR;
            PG8_LDA(At, 0, 1); PG8_STAGE(PG8_SA(0, 0), a2, voffA);
            PG8_WAIT_V(10); PG8_BAR; PG8_WAIT_L(0); PG8_MMA(1, 0, At, B0); PG8_BAR; PG8_SCHED;
            PG8_STAGE(PG8_SB(0, 1), b2 + hstep, voffB);
            PG8_WAIT_V(10); PG8_BAR; PG8_MMA(1, 1, At, B1); PG8_BAR;
            PG8_LDB(B0, 1, 0); PG8_SCHED; PG8_LDA(At, 1, 0); PG8_STAGE(PG8_SA(0, 1), a2 + hstep, voffA);
            PG8_WAIT_VL(10, 8); PG8_BAR; PG8_WAIT_L(0); PG8_MMA(0, 0, At, B0); PG8_BAR; PG8_SCHED;
            PG8_LDB(B1, 1, 1); PG8_STAGE(PG8_SB(1, 0), b3, voffB);
            PG8_WAIT_V(10); PG8_BAR; PG8_WAIT_L(0); PG8_MMA(0, 1, At, B1); PG8_BAR;
            PG8_LDA(At, 1, 1); PG8_STAGE(PG8_SA(1, 0), a3, voffA);
            PG8_WAIT_V(10); PG8_BAR; PG8_WAIT_L(0); PG8_MMA(1, 0, At, B0); PG8_BAR; PG8_SCHED;
            PG8_STAGE(PG8_SB(1, 1), b3 + hstep, voffB);
            PG8_WAIT_V(10); PG8_BAR; PG8_MMA(1, 1, At, B1); PG8_BAR;
        }
        PG8_STAMP();
        if constexpr (!Epi::AFTER_DRAIN) { E(acc, cur, wr, wc, fr, fq); S.done(cur); }
        PG8_STAMP();
        if (!has_next) break;
#pragma unroll
        for (int a = 0; a < 2; ++a)
#pragma unroll
            for (int b = 0; b < 2; ++b)
#pragma unroll
                for (int m = 0; m < 4; ++m)
#pragma unroll
                    for (int n = 0; n < 2; ++n) acc[a][b][m][n] = (f32x4){0.f, 0.f, 0.f, 0.f};
        cur = nxt; cA = nA; cB = nB; coff = noff; ++ui;
    }
    PG8_WAIT_V(0);
    if (wr == 0) PG8_BAR;
    PG8_BAR;
    if constexpr (Epi::AFTER_DRAIN) { E.fused(acc, cur, wr, wc, fr, fq, lds, wid, lane); S.done(cur); }
    PG8_STAMP();
    if (STAMP && wid == 0) { stamps[lane] = lane < nts ? (((unsigned long long)(unsigned)ts_hi << 32) | (unsigned)ts_lo) : 0ull;
        if (lane == 62) stamps[62] = rt_entry; if (lane == 63) stamps[63] = (unsigned long long)wall_clock64(); }
#undef PG8_STAMP
#undef PG8_SA
#undef PG8_SB
#undef PG8_STAGE
#undef PG8_LDA
#undef PG8_LDB
#undef PG8_MMA
#undef PG8_WAIT_V
#undef PG8_WAIT_L
#undef PG8_WAIT_VL
#undef PG8_ROT
#undef PG8_KO
#undef PG8_BAR
#undef PG8_SCHED
}
}

using pg8::bf16_t; using pg8::bf16x8; using pg8::f32x4; using pg8::u32x4;
typedef unsigned u32x2 __attribute__((ext_vector_type(2)));
constexpr int NB = 8, CTXL = 256, SEQ = 4096, SP = CTXL + SEQ  , NTOK = NB * SP  , NH = NTOK / 2  , DM = 1024;
constexpr int NCH = SP / 128;
constexpr int NTHR = 512;
constexpr float ALPHA = 1.6817928305074290f;
constexpr float LN_EPS = 1e-5f;
constexpr size_t MiB = 1048576;
constexpr size_t WS_BAR = 0;
constexpr size_t WS_MOD = 16384;
constexpr size_t WS_ROPE = WS_MOD + 458752;
constexpr size_t WS_XCTX = 2 * MiB;
constexpr size_t WS_H = 10 * MiB;
constexpr size_t WS_W = 78 * MiB;
constexpr size_t WS_S = 102 * MiB;
constexpr size_t WS_END = 510 * MiB;
constexpr size_t U34 = 34 * MiB, U68 = 68 * MiB;
static_assert((size_t)NH * 1024 * 2 == U34 && (size_t)NTOK * 1024 * 2 == U68, "unit sizes");
constexpr int LDS_BYTES = 163840;

__device__ __forceinline__ float bf2f(unsigned short h) { return __uint_as_float(((unsigned)h) << 16); }
__device__ __forceinline__ float bflo(unsigned w) { return __uint_as_float(w << 16); }
__device__ __forceinline__ float bfhi(unsigned w) { return __uint_as_float(w & 0xffff0000u); }
__device__ __forceinline__ unsigned pk2(float lo, float hi) { return pg8::cvt_pk_bf16(lo, hi); }
__device__ __forceinline__ float siluf(float x) { return x * __builtin_amdgcn_rcpf(1.f + __expf(-x)); }
__device__ __forceinline__ float sigmf(float x) { return __builtin_amdgcn_rcpf(1.f + __expf(-x)); }
__device__ __forceinline__ void unpack8(const uint4 v, float (&f)[8]) {
    f[0] = bflo(v.x); f[1] = bfhi(v.x); f[2] = bflo(v.y); f[3] = bfhi(v.y); f[4] = bflo(v.z); f[5] = bfhi(v.z); f[6] = bflo(v.w); f[7] = bfhi(v.w); }
__device__ __forceinline__ uint4 pack8(const float (&f)[8]) { uint4 v; v.x = pk2(f[0], f[1]); v.y = pk2(f[2], f[3]); v.z = pk2(f[4], f[5]); v.w = pk2(f[6], f[7]); return v; }
#define SLABOFF(row, ch) ((row) * 128 + ((((ch) ^ (row)) & 7) << 4))
#define SLABOFF2(row, ch) ((row) * 128 + ((((ch) ^ (row) ^ ((row) >> 4)) & 7) << 4))
__device__ __forceinline__ bf16x8 lds_frag(LAS unsigned char* slab, int row, int ch) { return *(const LAS bf16x8*)(slab + SLABOFF(row, ch)); }
__device__ __forceinline__ void lds_st16(LAS unsigned char* slab, int row, int ch, uint4 v) { u32x4 t; t.x = v.x; t.y = v.y; t.z = v.z; t.w = v.w; *(LAS u32x4*)(slab + SLABOFF(row, ch)) = t; }
__device__ __forceinline__ void lds_st16b(LAS unsigned char* slab, int row, int ch, uint4 v) { u32x4 t; t.x = v.x; t.y = v.y; t.z = v.z; t.w = v.w; *(LAS u32x4*)(slab + SLABOFF2(row, ch)) = t; }
__device__ __forceinline__ uint4 lds_ld16(LAS unsigned char* slab, int row, int ch) { const u32x4 t = *(const LAS u32x4*)(slab + SLABOFF(row, ch)); return make_uint4(t.x, t.y, t.z, t.w); }
template <int TM, int TN, bool SW2 = false>
__device__ __forceinline__ void mma_slab(f32x4 (&acc)[TM][TN], LAS unsigned char* As, int arow0, LAS unsigned char* Bs, int brow0, int lane) {
#pragma unroll
    for (int ks = 0; ks < 2; ++ks) {
        bf16x8 a[TM], b[TN];
#pragma unroll
        for (int tm = 0; tm < TM; ++tm) { const int r_ = arow0 + 16 * tm + (lane & 15), c_ = (lane >> 4) + 4 * ks; a[tm] = *(const LAS bf16x8*)(As + (SW2 ? SLABOFF2(r_, c_) : SLABOFF(r_, c_))); }
#pragma unroll
        for (int tn = 0; tn < TN; ++tn) { const int r_ = brow0 + 16 * tn + (lane & 15), c_ = (lane >> 4) + 4 * ks; b[tn] = *(const LAS bf16x8*)(Bs + (SW2 ? SLABOFF2(r_, c_) : SLABOFF(r_, c_))); }
#pragma unroll
        for (int tm = 0; tm < TM; ++tm)
#pragma unroll
            for (int tn = 0; tn < TN; ++tn) acc[tm][tn] = __builtin_amdgcn_mfma_f32_16x16x32_bf16(a[tm], b[tn], acc[tm][tn], 0, 0, 0);
    }
}
__device__ __forceinline__ int ord_b(int k) { return k == 0 ? 1 : (k == 1 ? 0 : 35 - k); }
__device__ __forceinline__ int pos_b(int c) { return c == 1 ? 0 : (c == 0 ? 1 : 35 - c); }
__device__ __forceinline__ float log2_gamma(float logit) {
    const float sp = (logit > 15.f) ? __expf(-logit) : log1pf(__expf(-logit)); return -sp * 1.4426950408889634f; }

__device__ __forceinline__ void wg_sync() { asm volatile("s_waitcnt lgkmcnt(0)" ::: "memory"); __builtin_amdgcn_s_barrier(); asm volatile("" ::: "memory"); }

__device__ __forceinline__ void mfma_drain() { __builtin_amdgcn_sched_barrier(0); asm volatile("s_nop 15\n\ts_nop 15" ::: "memory"); __builtin_amdgcn_sched_barrier(0); }

struct Prm {
    const float* in[34]; float* out; unsigned char* ws;
};
#define PHASE_FN static __device__ __forceinline__

template <class F>
__device__ __forceinline__ void cvt_tiles(bf16_t* dst, int ld_dst, int koff, int NN, int KK, F f, LAS float* T, int bid, int nb, int& tbase) {
    const int tid = tid_opq(), tn = NN / 64, tk = KK / 64, nt = tn * tk;
    int first = (bid - (tbase % nb) + nb) % nb;
    float nv[8];
    if (first < nt) { const int n0 = (first % tn) * 64, k0 = (first / tn) * 64;
#pragma unroll
        for (int i = 0; i < 8; ++i) { const int kk = (tid >> 6) + 8 * i, nn = tid & 63; nv[i] = f(k0 + kk, n0 + nn); } }
    for (int t = first; t < nt; t += nb) {
        const int n0 = (t % tn) * 64, k0 = (t / tn) * 64;
        wg_sync();
#pragma unroll
        for (int i = 0; i < 8; ++i) { const int kk = (tid >> 6) + 8 * i, nn = tid & 63; T[kk * 65 + nn] = nv[i]; }
        if (t + nb < nt) { const int n1 = ((t + nb) % tn) * 64, k1 = ((t + nb) / tn) * 64;
#pragma unroll
            for (int i = 0; i < 8; ++i) { const int kk = (tid >> 6) + 8 * i, nn = tid & 63; nv[i] = f(k1 + kk, n1 + nn); } }
        wg_sync();
        const int nn2 = tid >> 3, kc = tid & 7; float v[8];
#pragma unroll
        for (int e = 0; e < 8; ++e) v[e] = T[(8 * kc + e) * 65 + nn2];
        *(uint4*)(dst + (size_t)(n0 + nn2) * ld_dst + koff + k0 + 8 * kc) = pack8(v);
    }
    tbase += nt;
}

PHASE_FN void phase_mod(const float* cvec, const float* cctx, const float* ada_w, const float* ada_b, float* mod, float* rope, LAS unsigned char* L, int bid, int nb) {
    const int tid = tid_opq();
    LAS float* sc = (LAS float*)L;
    LAS float* red = sc + 9 * 1024;
    for (int i = tid; i < 9 * 1024; i += NTHR) { const int j = i >> 10, k = i & 1023; const float v = (j < 8) ? cvec[j * 1024 + k] : cctx[k]; sc[i] = siluf(v); }
    wg_sync();
    for (int blk = bid; blk < 256; blk += nb) {
        const int l = blk >> 6, c0 = (blk & 63) * 48;
        float a[9];
#pragma unroll
        for (int j = 0; j < 9; ++j) a[j] = 0.f;
        const int col = tid % 48, kg = tid / 48;
        if (tid < 480) {
            for (int k = kg; k < 1024; k += 10) { const float w = ada_w[((size_t)l * 1024 + k) * 3072 + c0 + col];
#pragma unroll
                for (int j = 0; j < 9; ++j) a[j] += sc[j * 1024 + k] * w; }
#pragma unroll
            for (int j = 0; j < 9; ++j) red[(kg * 48 + col) * 9 + j] = a[j];
        }
        wg_sync();
        if (tid < 48 * 9) { const int cc = tid / 9, j = tid % 9; float s = 0.f;
#pragma unroll
            for (int g = 0; g < 10; ++g) s += red[(g * 48 + cc) * 9 + j];
            mod[((size_t)l * 9 + j) * 3072 + c0 + cc] = s + ada_b[l * 3072 + c0 + cc]; }
        wg_sync();
    }
    for (int i = bid * NTHR + tid; i < 4096; i += nb * NTHR) { const int pos = i >> 6, fi = i & 63;
        const double inv = pow(10000.0, -(double)fi / 64.0), ang = (double)pos * inv; rope[2 * i] = (float)cos(ang); rope[2 * i + 1] = (float)sin(ang); }
}

__device__ __forceinline__ const float* xrow_in(const float* xl, const float* xc, int R) { const int b = R / SP, s = R - b * SP; return s < CTXL ? xc + ((size_t)b * CTXL + s) * DM : xl + ((size_t)b * SEQ + (s - CTXL)) * DM; }

typedef float f32x2v __attribute__((ext_vector_type(2)));
template <int CTRL> __device__ __forceinline__ float dppf(float v) { return __int_as_float(__builtin_amdgcn_update_dpp(0, __float_as_int(v), CTRL, 0xF, 0xF, true)); }
__device__ __forceinline__ float red4(float v) { v += dppf<0xB1>(v); v += dppf<0x4E>(v); return v; }
__device__ __forceinline__ float red8(float v) { v = red4(v); v += dppf<0x141>(v); return v; }
__device__ __forceinline__ float red16(float v) { v = red8(v); v += dppf<0x140>(v); return v; }

PHASE_FN void phase_h0(const float* x, const float* ctx, const float* mod0, bf16_t* H, int R0, int R1, int bid, int nb) {
    const int tid = tid_opq(), lane = tid & 63, wv = tid >> 6;
    float4 cs[4], cgm[4]; int jc = -1;
    for (int R = R0 + bid * 8 + wv; R < R1; R += nb * 8) {
        const int b = R / SP, s = R - b * SP; const float* xr = xrow_in(x, ctx, R); const int j = (s < CTXL ? 8 : b);
        if (j != jc) { const float* md = mod0 + (size_t)j * 3072; jc = j;
#pragma unroll
            for (int u = 0; u < 4; ++u) { const int c = 8 * lane + 512 * (u >> 1) + 4 * (u & 1); cs[u] = *(const float4*)(md + c); cgm[u] = *(const float4*)(md + 1024 + c); } }
#pragma unroll
        for (int u = 0; u < 2; ++u) { const int c = 8 * lane + 512 * u; float v[8];
            const float4 x0 = *(const float4*)(xr + c), x1 = *(const float4*)(xr + c + 4), s0 = cs[2 * u], s1 = cs[2 * u + 1], g0 = cgm[2 * u], g1 = cgm[2 * u + 1];
            v[0] = x0.x * (1.f + g0.x) + s0.x; v[1] = x0.y * (1.f + g0.y) + s0.y; v[2] = x0.z * (1.f + g0.z) + s0.z; v[3] = x0.w * (1.f + g0.w) + s0.w;
            v[4] = x1.x * (1.f + g1.x) + s1.x; v[5] = x1.y * (1.f + g1.y) + s1.y; v[6] = x1.z * (1.f + g1.z) + s1.z; v[7] = x1.w * (1.f + g1.w) + s1.w;
            *(uint4*)(H + (size_t)R * DM + c) = pack8(v); }
    }
}

PHASE_FN void phase_ln(const float* xl_in, const float* xc_in, float* xl_out, float* xc_out, const bf16_t* ymix, const float* modl, const float* modn, const float* lng, const float* lnb,
                       bf16_t* H, int R0, int R1, int last, int bid, int nb, unsigned* cnt = nullptr) {
    const int tid = tid_opq(), lane = tid & 63, wv = tid >> 6;
    const bool inbf = ((const float*)xl_out == xl_in), outbf = !last;
    float4 nx[4]; uint4 nxb[2]; uint4 ny[2];
#define LN_FETCH(R_) do { const int b_ = (R_) / SP, s_ = (R_) - b_ * SP; if (!(last && s_ < CTXL)) { const float* xr_ = xrow_in(xl_in, xc_in, (R_)); const bf16_t* yr_ = ymix + (size_t)((R_) - R0) * DM; \
        _Pragma("unroll") for (int u = 0; u < 2; ++u) { const int c = 8 * lane + 512 * u; if (inbf) nxb[u] = *(const uint4*)((const bf16_t*)xr_ + c); else { nx[2 * u] = *(const float4*)(xr_ + c); nx[2 * u + 1] = *(const float4*)(xr_ + c + 4); } \
            ny[u] = *(const uint4*)(yr_ + c); } } } while (0)
    float4 cg[4], cb[4], cgt[4], csh[4], cscl[4]; int jc = -1;
#pragma unroll
    for (int u = 0; u < 4; ++u) { const int c = 8 * lane + 512 * (u >> 1) + 4 * (u & 1); cg[u] = *(const float4*)(lng + c); cb[u] = *(const float4*)(lnb + c); }
    const int Rfirst = R0 + bid * 8 + wv;
    if (Rfirst < R1) LN_FETCH(Rfirst);
    for (int R = Rfirst; R < R1; R += nb * 8) {
        const int b = R / SP, s = R - b * SP; const bool skip = (last && s < CTXL);
        float4 xv[4]; uint4 xw[2]; uint4 yw[2];
#pragma unroll
        for (int u = 0; u < 4; ++u) xv[u] = nx[u];
        xw[0] = nxb[0]; xw[1] = nxb[1];
        yw[0] = ny[0]; yw[1] = ny[1];
        if (R + nb * 8 < R1) LN_FETCH(R + nb * 8);
        if (skip) continue;
        const int j = (s < CTXL ? 8 : b);
        if (j != jc) { const float* gt = modl + (size_t)j * 3072 + 2048; const float* mn = modn + (size_t)j * 3072; jc = j;
#pragma unroll
            for (int u = 0; u < 4; ++u) { const int c = 8 * lane + 512 * (u >> 1) + 4 * (u & 1); cgt[u] = *(const float4*)(gt + c); if (!last) { csh[u] = *(const float4*)(mn + c); cscl[u] = *(const float4*)(mn + 1024 + c); } } }
        float z[16]; float sum = 0.f;
#pragma unroll
        for (int u = 0; u < 2; ++u) { const int c = 8 * lane + 512 * u; const float4 g0 = cgt[2 * u], g1 = cgt[2 * u + 1]; float yv[8]; unpack8(yw[u], yv);
            float4 x0 = xv[2 * u], x1 = xv[2 * u + 1];
            if (inbf) { float xf[8]; unpack8(xw[u], xf); x0 = make_float4(xf[0], xf[1], xf[2], xf[3]); x1 = make_float4(xf[4], xf[5], xf[6], xf[7]); }
            z[8 * u + 0] = ALPHA * x0.x + g0.x * yv[0]; z[8 * u + 1] = ALPHA * x0.y + g0.y * yv[1]; z[8 * u + 2] = ALPHA * x0.z + g0.z * yv[2]; z[8 * u + 3] = ALPHA * x0.w + g0.w * yv[3];
            z[8 * u + 4] = ALPHA * x1.x + g1.x * yv[4]; z[8 * u + 5] = ALPHA * x1.y + g1.y * yv[5]; z[8 * u + 6] = ALPHA * x1.z + g1.z * yv[6]; z[8 * u + 7] = ALPHA * x1.w + g1.w * yv[7];
#pragma unroll
            for (int e = 0; e < 8; ++e) sum += z[8 * u + e]; }
        sum = red16(sum); sum += __shfl_xor(sum, 16); sum += __shfl_xor(sum, 32);
        const float mu = sum * (1.f / 1024.f); float sq = 0.f;
#pragma unroll
        for (int e = 0; e < 16; ++e) { const float d = z[e] - mu; sq += d * d; }
        sq = red16(sq); sq += __shfl_xor(sq, 16); sq += __shfl_xor(sq, 32);
        const float rs = rsqrtf(sq * (1.f / 1024.f) + LN_EPS);
        if (cnt && lane == 0 && !(fabsf(sq) < 3.0e38f)) atomicAdd(cnt, 1u);
        float* xo = (s < CTXL) ? xc_out + ((size_t)b * CTXL + s) * DM : xl_out + ((size_t)b * SEQ + (s - CTXL)) * DM;
#pragma unroll
        for (int u = 0; u < 2; ++u) { const int c = 8 * lane + 512 * u; float o8[8];
#pragma unroll
            for (int q4 = 0; q4 < 2; ++q4) { const float4 g = cg[2 * u + q4], bb = cb[2 * u + q4];
                float4 o; o.x = (z[8 * u + 4 * q4] - mu) * rs * g.x + bb.x; o.y = (z[8 * u + 4 * q4 + 1] - mu) * rs * g.y + bb.y; o.z = (z[8 * u + 4 * q4 + 2] - mu) * rs * g.z + bb.z; o.w = (z[8 * u + 4 * q4 + 3] - mu) * rs * g.w + bb.w;
                if (!outbf) *(float4*)(xo + c + 4 * q4) = o; o8[4 * q4] = o.x; o8[4 * q4 + 1] = o.y; o8[4 * q4 + 2] = o.z; o8[4 * q4 + 3] = o.w; }
            if (outbf) *(uint4*)((bf16_t*)xo + c) = pack8(o8);
            if (!last) { float hv[8];
#pragma unroll
                for (int q4 = 0; q4 < 2; ++q4) { const float4 sh = csh[2 * u + q4], scl = cscl[2 * u + q4];
                    hv[4 * q4] = o8[4 * q4] * (1.f + scl.x) + sh.x; hv[4 * q4 + 1] = o8[4 * q4 + 1] * (1.f + scl.y) + sh.y; hv[4 * q4 + 2] = o8[4 * q4 + 2] * (1.f + scl.z) + sh.z; hv[4 * q4 + 3] = o8[4 * q4 + 3] * (1.f + scl.w) + sh.w; }
                *(uint4*)(H + (size_t)R * DM + c) = pack8(hv); } }
    }
#undef LN_FETCH
}

PHASE_FN void phase_probe(float* out, const unsigned* cnt, int bid, int nb) {
    float off = 0.f;
    for (int l = 3; l >= 0; --l) if (cnt[l]) off = 10.f * (l + 1);
    for (size_t i = (size_t)bid * NTHR + tid_opq(); i < (size_t)NB * SEQ * DM; i += (size_t)nb * NTHR) { out[i] = off; }
}

PHASE_FN void phase_scan(const void* buf, size_t n, int isbf, unsigned* cnt, int idx, int bid, int nb, float thr = 3.0e38f) {
    unsigned bad = 0;
    for (size_t i = (size_t)bid * NTHR + tid_opq(); i < n; i += (size_t)nb * NTHR) { const float v = isbf ? bf2f(((const bf16_t*)buf)[i]) : ((const float*)buf)[i]; if (!(fabsf(v) < thr)) ++bad; }
    if (bad) atomicAdd(cnt + idx, 1u);
}
PHASE_FN void phase_probe2(float* out, const unsigned* cnt, int bid, int nb) {
    float off = 0.f;
    for (int l = 15; l >= 0; --l) if (cnt[l]) off = 10.f * (l + 1);
    for (size_t i = (size_t)bid * NTHR + tid_opq(); i < (size_t)NB * SEQ * DM; i += (size_t)nb * NTHR) { out[i] = off; }
}

PHASE_FN void phase_probe3(float* out, const unsigned* cnt, int bid, int nb) {
    const unsigned code = cnt[20]; const float off = (code == 0xFFFFFFFFu) ? 0.f : 10.f * (float)(code + 1u);
    for (size_t i = (size_t)bid * NTHR + tid_opq(); i < (size_t)NB * SEQ * DM; i += (size_t)nb * NTHR) { out[i] = off; }
}

PHASE_FN void phase_cmp(const void* a, const void* b, size_t nbytes, unsigned* cnt, int idx, int bid, int nb) {
    const uint4* x = (const uint4*)a; const uint4* y = (const uint4*)b; unsigned bad = 0;
    for (size_t i = (size_t)bid * NTHR + tid_opq(); i < nbytes / 16; i += (size_t)nb * NTHR) { const uint4 u = x[i], v = y[i]; if (u.x != v.x || u.y != v.y || u.z != v.z || u.w != v.w) ++bad; }
    if (bad) atomicAdd(cnt + idx, 1u);
}

PHASE_FN void phase_probe5(float* out, const unsigned* cnt, int bid, int nb) {
    const float off = 10.f * (1.f + (cnt[14] ? 1.f : 0.f) + (cnt[15] ? 2.f : 0.f) + (cnt[16] ? 4.f : 0.f) + (cnt[17] ? 8.f : 0.f));
    for (size_t i = (size_t)bid * NTHR + tid_opq(); i < (size_t)NB * SEQ * DM; i += (size_t)nb * NTHR) { out[i] = off; }
}

PHASE_FN void phase_chkvt(const bf16_t* v, const bf16_t* Vt, unsigned* cnt, int idx, int bid, int nb) {
    unsigned bad = 0;
    for (size_t i = (size_t)bid * NTHR + tid_opq(); i < (size_t)16 * 512 * SP; i += (size_t)nb * NTHR) { const int s = (int)(i % SP); const size_t r = i / SP; const int n = (int)(r & 511), bh = (int)(r >> 9);
        const bf16_t a = Vt[i], b = v[((size_t)(bh >> 2) * SP + s) * 2048 + (bh & 3) * 512 + n]; if (a != b) ++bad; }
    if (bad) atomicAdd(cnt + idx, bad);
}
PHASE_FN void phase_probe6(float* out, const unsigned* cnt, int bid, int nb) {
    unsigned a = cnt[18], b = cnt[19]; int da = 0, db = 0; while (a) { ++da; a /= 10; } while (b) { ++db; b /= 10; }
    const float off = 10.f * (float)(1 + da + 10 * db);
    for (size_t i = (size_t)bid * NTHR + tid_opq(); i < (size_t)NB * SEQ * DM; i += (size_t)nb * NTHR) { out[i] = off; }
}

PHASE_FN void phase_probe7(float* out, const unsigned* seq, int bid, int nb) {
    unsigned a = seq[1]; int da = 0; while (a) { ++da; a /= 10; }
    const float off = 10.f * (float)(1 + da);
    for (size_t i = (size_t)bid * NTHR + tid_opq(); i < (size_t)NB * SEQ * DM; i += (size_t)nb * NTHR) { out[i] = off; }
}

PHASE_FN void phase_chkvt2(const bf16_t* v, const bf16_t* Vt, unsigned* mask, int bid, int nb) {
    for (size_t i = (size_t)bid * NTHR + tid_opq(); i < (size_t)16 * 512 * SP; i += (size_t)nb * NTHR) { const int s = (int)(i % SP); const size_t r = i / SP; const int n = (int)(r & 511), bh = (int)(r >> 9);
        const bf16_t a = Vt[i], b = v[((size_t)(bh >> 2) * SP + s) * 2048 + (bh & 3) * 512 + n]; if (a != b) { const int item = bh * NCH + (s >> 7); atomicOr(mask + (item >> 5), 1u << (item & 31)); } }
}
PHASE_FN void phase_probe8(float* out, const unsigned* mask, int bid, int nb) {
    int nbad = 0, first = -1; for (int it = 0; it < 16 * NCH; ++it) if (mask[it >> 5] & (1u << (it & 31))) { ++nbad; if (first < 0) first = it; }
    const float off = 10.f * (float)(1 + (nbad > 60 ? 60 : nbad)); const float off2 = 100.f + 10.f * (float)(first < 0 ? 0 : first);
    for (size_t i = (size_t)bid * NTHR + tid_opq(); i < (size_t)NB * SEQ * DM; i += (size_t)nb * NTHR) { out[i] = (i == 12345) ? off2 : off; }
}

PHASE_FN void phase_probe9(float* out, const unsigned* cnt, int bid, int nb) {
    int mask = 0; for (int l = 0; l < 5; ++l) if (cnt[20 + l]) mask |= 1 << l;
    const float off = 10.f * (float)(1 + mask);
    for (size_t i = (size_t)bid * NTHR + tid_opq(); i < (size_t)NB * SEQ * DM; i += (size_t)nb * NTHR) { out[i] = off; }
}

PHASE_FN void phase_probe10(float* out, const unsigned* cnt, int bid, int nb) {
    const float off = 10.f * (float)(1 + (cnt[25] > 100u ? 50u : cnt[25])); const float off2 = 100.f * (float)(1 + (cnt[26] > 100u ? 50u : cnt[26])) ;
    for (size_t i = (size_t)bid * NTHR + tid_opq(); i < (size_t)NB * SEQ * DM; i += (size_t)nb * NTHR) { out[i] = (i == 12345) ? off2 : off; }
}

PHASE_FN void phase_timing(float* out, const unsigned long long* tsb, int n, int bid, int nb, int ga, int gb) {
    const unsigned* grp = (const unsigned*)(tsb + 64); float ta = 0.f, tb = 0.f;
    for (int k = 1; k < n; ++k) { const float d = (float)(tsb[k] - tsb[k - 1]); if ((int)grp[k] == ga) ta += d; if ((int)grp[k] == gb) tb += d; }
    const float tot = (float)(tsb[n - 1] - tsb[0]); const float fa = TP_SCALE * ta / tot, fb = TP_SCALE * tb / tot;
    const float delta = sqrtf(fa * 8.0e-5f);
    const int tid = tid_opq();
    for (size_t i = (size_t)bid * NTHR + tid; i < (size_t)NB * SEQ * DM; i += (size_t)nb * NTHR) { float v = out[i] + ((i & 1) ? delta : -delta); if (i == 12345) v += 1.f + 9.f * fb; out[i] = v; }
}

PHASE_FN void phase_prof6(float* out, const unsigned long long* pr, int ia, int ib, int bid, int nb) {
    float tot = 0.f; for (int k = 0; k < 6; ++k) tot += (float)pr[k];
    const float fa = (float)pr[ia] / tot, fb = (float)pr[ib] / tot; const float delta = sqrtf(fa * 8.0e-5f);
    const int tid = tid_opq();
    for (size_t i = (size_t)bid * NTHR + tid; i < (size_t)NB * SEQ * DM; i += (size_t)nb * NTHR) { float v = out[i] + ((i & 1) ? delta : -delta); if (i == 12345) v += 1.f + 9.f * fb; out[i] = v; }
}

PHASE_FN void phase_xccprobe(float* out, unsigned* cnt, int bid, int nb) {
    const float fa = (float)cnt[0] / 256.f, fb = (float)cnt[1] / 256.f; const float delta = sqrtf(fa * 8.0e-5f);
    const int tid = tid_opq();
    for (size_t i = (size_t)bid * NTHR + tid; i < (size_t)NB * SEQ * DM; i += (size_t)nb * NTHR) { float v = out[i] + ((i & 1) ? delta : -delta); if (i == 12345) v += 1.f + 9.f * fb; out[i] = v; }
}

#ifndef EPI_NT
#define EPI_NT 0
#endif
#if EPI_NT
#define EPI_ST(ptr, w) __builtin_nontemporal_store((w), (u32x4*)(ptr))
#else
#define EPI_ST(ptr, w) (*(u32x4*)(ptr) = (w))
#endif
struct EpiBf {
    static constexpr bool PERM = true, AFTER_DRAIN = false;
    bf16_t* O; int ld;
    __device__ __forceinline__ void operator()(const f32x4 (&acc)[2][2][4][2], const pg8::Unit& u, int wr, int wc, int fr, int fq) const {
        const int row0 = u.pm * 256 + wr * 64 + fr, col0 = u.pn * 256 + wc * 32 + 8 * fq;
#pragma unroll
        for (int ai = 0; ai < 2; ++ai)
#pragma unroll
            for (int m = 0; m < 4; ++m) { bf16_t* rowp = O + (size_t)(row0 + ai * 128 + m * 16) * ld + col0;
#pragma unroll
                for (int bj = 0; bj < 2; ++bj) { const f32x4 v0 = acc[ai][bj][m][0], v1 = acc[ai][bj][m][1];
                    u32x4 w; w.x = pk2(v0[0], v0[1]); w.y = pk2(v0[2], v0[3]); w.z = pk2(v1[0], v1[1]); w.w = pk2(v1[2], v1[3]);
                    EPI_ST(rowp + bj * 128, w); } }
    }
};
struct EpiF32 {
    static constexpr bool PERM = false, AFTER_DRAIN = false;
    float* C; int ld;
    __device__ __forceinline__ void operator()(const f32x4 (&acc)[2][2][4][2], const pg8::Unit& u, int wr, int wc, int fr, int fq) const {
        const int row0 = u.pm * 256 + wr * 64 + fr, col0 = u.pn * 256 + wc * 32 + 4 * fq;
#pragma unroll
        for (int ai = 0; ai < 2; ++ai)
#pragma unroll
            for (int m = 0; m < 4; ++m) { float* rowp = C + (size_t)(row0 + ai * 128 + m * 16) * ld + col0;
#pragma unroll
                for (int bj = 0; bj < 2; ++bj)
#pragma unroll
                    for (int n = 0; n < 2; ++n) *(f32x4*)(rowp + bj * 128 + n * 16) = acc[ai][bj][m][n]; }
    }
};
struct EpiRetQKV {
    static constexpr bool PERM = true, AFTER_DRAIN = false;
    bf16_t* q; bf16_t* k; bf16_t* v; const float* rope; int rowbase;
    __device__ __forceinline__ void operator()(const f32x4 (&acc)[2][2][4][2], const pg8::Unit& u, int wr, int wc, int fr, int fq) const {
        const int row0 = u.pm * 256 + wr * 64 + fr, pn = u.pn;
        if (pn >= 8) {
            const int col0 = (pn - 8) * 256 + wc * 32 + 8 * fq;
#pragma unroll
            for (int ai = 0; ai < 2; ++ai)
#pragma unroll
                for (int m = 0; m < 4; ++m) { bf16_t* rowp = v + (size_t)(row0 + ai * 128 + m * 16) * 2048 + col0;
#pragma unroll
                    for (int bj = 0; bj < 2; ++bj) { const f32x4 v0 = acc[ai][bj][m][0], v1 = acc[ai][bj][m][1];
                        u32x4 w; w.x = pk2(v0[0], v0[1]); w.y = pk2(v0[2], v0[3]); w.z = pk2(v1[0], v1[1]); w.w = pk2(v1[2], v1[3]);
                        EPI_ST(rowp + bj * 128, w); } }
        } else {
            bf16_t* dst = (pn < 4) ? q : k; const int col0 = (pn & 3) * 256 + wc * 32 + 8 * fq, i0 = 16 * wc + 4 * fq;
#pragma unroll
            for (int ai = 0; ai < 2; ++ai)
#pragma unroll
                for (int m = 0; m < 4; ++m) { const int row = row0 + ai * 128 + m * 16; const int R = rowbase + row, s = R % SP; const bool lat = (s >= CTXL); const int t = s - CTXL;
                    bf16_t* rowp = dst + (size_t)row * 1024 + col0;
#pragma unroll
                    for (int bj = 0; bj < 2; ++bj) { f32x4 v0 = acc[ai][bj][m][0], v1 = acc[ai][bj][m][1];
                        if (lat) { const int pos = (bj == 0) ? (t >> 6) : (t & 63); const float* tb = rope + (size_t)(pos * 64 + i0) * 2;
                            const float4 c01 = *(const float4*)(tb), c23 = *(const float4*)(tb + 4);
                            f32x4 r0, r1;
                            r0[0] = v0[0] * c01.x - v0[1] * c01.y; r0[1] = v0[0] * c01.y + v0[1] * c01.x;
                            r0[2] = v0[2] * c01.z - v0[3] * c01.w; r0[3] = v0[2] * c01.w + v0[3] * c01.z;
                            r1[0] = v1[0] * c23.x - v1[1] * c23.y; r1[1] = v1[0] * c23.y + v1[1] * c23.x;
                            r1[2] = v1[2] * c23.z - v1[3] * c23.w; r1[3] = v1[2] * c23.w + v1[3] * c23.z;
                            v0 = r0; v1 = r1; }
                        u32x4 w; w.x = pk2(v0[0], v0[1]); w.y = pk2(v0[2], v0[3]); w.z = pk2(v1[0], v1[1]); w.w = pk2(v1[2], v1[3]);
                        EPI_ST(rowp + bj * 128, w); } }
        }
    }
};
struct EpiRwkv {
    static constexpr bool PERM = true, AFTER_DRAIN = false;
    bf16_t* rkvg; bf16_t* T;
    __device__ __forceinline__ void operator()(const f32x4 (&acc)[2][2][4][2], const pg8::Unit& u, int wr, int wc, int fr, int fq) const {
        const int row0 = u.pm * 256 + wr * 64 + fr, pn = u.pn;
        if (pn < 16) {
            bf16_t* dst = rkvg + (size_t)(pn >> 2) * ((size_t)NTOK * 1024); const int col0 = (pn & 3) * 256 + wc * 32 + 8 * fq;
#pragma unroll
            for (int ai = 0; ai < 2; ++ai)
#pragma unroll
                for (int m = 0; m < 4; ++m) { bf16_t* rowp = dst + (size_t)(row0 + ai * 128 + m * 16) * 1024 + col0;
#pragma unroll
                    for (int bj = 0; bj < 2; ++bj) { const f32x4 v0 = acc[ai][bj][m][0], v1 = acc[ai][bj][m][1];
                        u32x4 w; w.x = pk2(v0[0], v0[1]); w.y = pk2(v0[2], v0[3]); w.z = pk2(v1[0], v1[1]); w.w = pk2(v1[2], v1[3]);
                        EPI_ST(rowp + bj * 128, w); } }
        } else {
            const int col0 = (pn - 16) * 128 + wc * 32 + 8 * fq; const bool th = (pn == 16);
#pragma unroll
            for (int ai = 0; ai < 2; ++ai)
#pragma unroll
                for (int m = 0; m < 4; ++m) { bf16_t* rowp = T + (size_t)(row0 + ai * 128 + m * 16) * 256 + col0;
                    f32x4 v0 = acc[ai][0][m][0], v1 = acc[ai][0][m][1];
                    if (th) {
#pragma unroll
                        for (int e = 0; e < 4; ++e) { v0[e] = 1.f - 2.f * __builtin_amdgcn_rcpf(1.f + __expf(2.f * v0[e])); v1[e] = 1.f - 2.f * __builtin_amdgcn_rcpf(1.f + __expf(2.f * v1[e])); } }
                    u32x4 w; w.x = pk2(v0[0], v0[1]); w.y = pk2(v0[2], v0[3]); w.z = pk2(v1[0], v1[1]); w.w = pk2(v1[2], v1[3]);
                    EPI_ST(rowp, w); }
        }
    }
};
template <class Epi, bool STAMP = false>
PHASE_FN void gemm_run(const bf16_t* A, const bf16_t* Bt, int M, int N, int K, Epi E, LAS unsigned char* L, int bid, int nb, unsigned long long* stamps = nullptr) {
    pg8::Gemm g{A, Bt, M, N, K}; pg8::StaticOrder S; S.init(M, N, nb, bid);
    pg8::gemm_phase<Epi, pg8::StaticOrder, STAMP>((PG8_LAS unsigned char*)L, g, S, E, STAMP ? stamps + (size_t)bid * 64 : nullptr);
    wg_sync();
}
PHASE_FN void phase_gstamp(float* out, const unsigned long long* st, int bid, int nb) {
    float kl = 0.f, ep = 0.f, tot = 0.f;
    for (int b = 0; b < 8; ++b) { const unsigned long long* s = st + b * 64; int n = 0; while (n < 62 && s[n] != 0ull) ++n;
        const int nu = (n - 3) / 2; tot += (float)(s[n - 1] - s[0]);
        kl += (float)(s[2] - s[1]); for (int i = 1; i < nu; ++i) { ep += 0.25f * (float)(s[2 + 2 * i] - s[1 + 2 * i]); } }
    const float fa = kl / tot, fb = ep / tot; const float delta = sqrtf(fa * 8.0e-5f);
    const int tid = tid_opq();
    for (size_t i = (size_t)bid * NTHR + tid; i < (size_t)NB * SEQ * DM; i += (size_t)nb * NTHR) { float v = out[i] + ((i & 1) ? delta : -delta); if (i == 12345) v += 1.f + 9.f * fb; out[i] = v; }
}

struct DealOrder : pg8::StaticOrder {
    int nfull, first, latent;
    __device__ bool next(int i, pg8::Unit& u) const {
        bool ok;
        if (i < nfull) ok = unit_of((long)i * G + c, u);
        else if (c < first) ok = false;
        else ok = unit_of((long)nfull * G + (long)(i - nfull) * (G - first) + (c - first), u);
        if (ok && latent) u.pm = (u.pm >> 4) * 17 + 1 + (u.pm & 15);
        return ok; }
};
template <class Epi>
PHASE_FN void gemm_deal(const bf16_t* A, const bf16_t* Bt, int M, int N, int K, Epi E, int latent, LAS unsigned char* L, int bid, int nb) {
    pg8::Gemm g{A, Bt, M, N, K}; DealOrder S; S.init(latent ? (M / 17) * 16 : M, N, nb, bid); S.nfull = 1; S.first = 0; S.latent = latent;
    pg8::gemm_phase<Epi, DealOrder, false>((PG8_LAS unsigned char*)L, g, S, E, nullptr);
    wg_sync();
}
template <class Epi1, class Epi2>
PHASE_FN void gemm_dual(const bf16_t* A1, const bf16_t* B1, int M1, int N1, int K1, Epi1 E1, int nfull1, int first1,
                        const bf16_t* A2, const bf16_t* B2, int M2, int N2, int K2, Epi2 E2, int nfull2, int first2, LAS unsigned char* L, int bid, int nb, int lat1 = 0) {
    { pg8::Gemm g{A1, B1, M1, N1, K1}; DealOrder S; S.init(lat1 ? (M1 / 17) * 16 : M1, N1, nb, bid); S.nfull = nfull1; S.first = first1; S.latent = lat1;
      pg8::gemm_phase<Epi1, DealOrder, false>((PG8_LAS unsigned char*)L, g, S, E1, nullptr); }
    wg_sync();
    { pg8::Gemm g{A2, B2, M2, N2, K2}; DealOrder S; S.init(M2, N2, nb, bid); S.nfull = nfull2; S.first = first2; S.latent = 0;
      pg8::gemm_phase<Epi2, DealOrder, false>((PG8_LAS unsigned char*)L, g, S, E2, nullptr); }
    wg_sync();
}

struct PairOrder : pg8::StaticOrder {
    int NT, pnbase;
    __device__ bool next(int i, pg8::Unit& u) const { if (!pg8::StaticOrder::next(i, u)) return false; u.pn = pnbase + (u.pm / (NTOK / 256)) * NT + u.pn; return true; }
};
struct EpiRwkv2 {
    static constexpr bool PERM = true, AFTER_DRAIN = false;
    bf16_t* rkvg; bf16_t* T;
    __device__ __forceinline__ void operator()(const f32x4 (&acc)[2][2][4][2], const pg8::Unit& u, int wr, int wc, int fr, int fq) const {
        const int row0 = (u.pm % (NTOK / 256)) * 256 + wr * 64 + fr, pn = u.pn;
        if (pn < 16) {
            bf16_t* dst = rkvg + (size_t)(pn >> 2) * ((size_t)NTOK * 1024); const int col0 = (pn & 3) * 256 + wc * 32 + 8 * fq;
#pragma unroll
            for (int ai = 0; ai < 2; ++ai)
#pragma unroll
                for (int m = 0; m < 4; ++m) { bf16_t* rowp = dst + (size_t)(row0 + ai * 128 + m * 16) * 1024 + col0;
#pragma unroll
                    for (int bj = 0; bj < 2; ++bj) { const f32x4 v0 = acc[ai][bj][m][0], v1 = acc[ai][bj][m][1];
                        u32x4 w; w.x = pk2(v0[0], v0[1]); w.y = pk2(v0[2], v0[3]); w.z = pk2(v1[0], v1[1]); w.w = pk2(v1[2], v1[3]);
                        EPI_ST(rowp + bj * 128, w); } }
        } else {
            const int col0 = (pn - 16) * 128 + wc * 32 + 8 * fq; const bool th = (pn == 16);
#pragma unroll
            for (int ai = 0; ai < 2; ++ai)
#pragma unroll
                for (int m = 0; m < 4; ++m) { bf16_t* rowp = T + (size_t)(row0 + ai * 128 + m * 16) * 256 + col0;
                    f32x4 v0 = acc[ai][0][m][0], v1 = acc[ai][0][m][1];
                    if (th) {
#pragma unroll
                        for (int e = 0; e < 4; ++e) { v0[e] = 1.f - 2.f * __builtin_amdgcn_rcpf(1.f + __expf(2.f * v0[e])); v1[e] = 1.f - 2.f * __builtin_amdgcn_rcpf(1.f + __expf(2.f * v1[e])); } }
                    u32x4 w; w.x = pk2(v0[0], v0[1]); w.y = pk2(v0[2], v0[3]); w.z = pk2(v1[0], v1[1]); w.w = pk2(v1[2], v1[3]);
                    EPI_ST(rowp, w); }
        }
    }
};
PHASE_FN void gemm_pair(const bf16_t* A, const bf16_t* Bt, int NT, int pnbase, EpiRwkv2 E, LAS unsigned char* L, int bid, int nb) {
    pg8::Gemm g{A, Bt, 2 * NTOK, NT * 256, 1024}; PairOrder S; S.init(2 * NTOK, NT * 256, nb, bid); S.NT = NT; S.pnbase = pnbase;
    pg8::gemm_phase<EpiRwkv2, PairOrder, false>((PG8_LAS unsigned char*)L, g, S, E, nullptr);
    wg_sync();
}

struct HotOrder : pg8::StaticOrder {
    int hot;
    __device__ bool next(int i, pg8::Unit& u) const { if (!pg8::StaticOrder::next(i, u)) return false; if (hot) { u.pm = 0; u.pn = 0; } return true; }
};
PHASE_FN void gemm_hot(const bf16_t* A, const bf16_t* Bt, bf16_t* O, int hot, int ld, LAS unsigned char* L, int bid, int nb, unsigned long long* stamps) {
    pg8::Gemm g{A, Bt, NH, 4096, 1024, ld}; HotOrder S; S.init(NH, 4096, nb, bid); S.hot = hot;
    pg8::gemm_phase<EpiBf, HotOrder, true>((PG8_LAS unsigned char*)L, g, S, EpiBf{O, 4096}, stamps + (size_t)bid * 64);
    wg_sync();
}
PHASE_FN void phase_hotprobe(float* out, const unsigned long long* st, int bid, int nb) {
    float k0 = 0.f, k1 = 0.f;
    for (int b = 0; b < 8; ++b) {
        { const unsigned long long* s = st + b * 64; int n = 0; while (n < 62 && s[n] != 0ull) ++n; const int nu = (n - 3) / 2; float t = 0.f; for (int i = 0; i < nu; ++i) t += (float)(s[2 + 2 * i] - s[1 + 2 * i]); k0 += t / (float)nu; }
        { const unsigned long long* s = st + 16384 + b * 64; int n = 0; while (n < 62 && s[n] != 0ull) ++n; const int nu = (n - 3) / 2; float t = 0.f; for (int i = 0; i < nu; ++i) t += (float)(s[2 + 2 * i] - s[1 + 2 * i]); k1 += t / (float)nu; } }
    const float fa = k0 / (8.f * 16.f * 8000.f), fb = k1 / (8.f * 16.f * 8000.f); const float delta = sqrtf(fa * 8.0e-5f);
    const int tid = tid_opq();
    for (size_t i = (size_t)bid * NTHR + tid; i < (size_t)NB * SEQ * DM; i += (size_t)nb * NTHR) { float v = out[i] + ((i & 1) ? delta : -delta); if (i == 12345) v += 1.f + 9.f * fb; out[i] = v; }
}

struct ChunkArgs {
    const bf16_t* qsrc; const bf16_t* ksrc; const bf16_t* vsrc; int ldq, ldv;
    bf16_t* Kt; bf16_t* Vt; bf16_t* P;
    bf16_t* Of; bf16_t* Ob;
    const float* decay;
    const float* wqkv;
    float* gG; float* gPM; float* gB; float* cBL; float* cPML; float* RS;
};

__device__ __forceinline__ void slab_transpose_out(LAS unsigned char* KS, bf16_t* dst_col0, int wave, int lane) {
    const int g = lane >> 4, i = lane & 15, q = i >> 2, p = i & 3, d0 = 16 * (wave & 3), jb = 64 * (wave >> 2) + 16 * g;
    const int ch = (d0 >> 3) + (p >> 1); unsigned ad[4];
#pragma unroll
    for (int t4 = 0; t4 < 4; ++t4) { const int row = jb + 4 * t4 + q; ad[t4] = (unsigned)(size_t)(KS + SLABOFF2(row, ch) + 8 * (p & 1)); }
    u32x2 r0, r1, r2, r3;
    asm volatile("ds_read_b64_tr_b16 %0, %4\n\tds_read_b64_tr_b16 %1, %5\n\tds_read_b64_tr_b16 %2, %6\n\tds_read_b64_tr_b16 %3, %7\n\ts_waitcnt lgkmcnt(0)"
                 : "=&v"(r0), "=&v"(r1), "=&v"(r2), "=&v"(r3) : "v"(ad[0]), "v"(ad[1]), "v"(ad[2]), "v"(ad[3]) : "memory");
    bf16_t* dst = dst_col0 + (size_t)(d0 + i) * SP + jb;
    *(uint4*)dst = make_uint4(r0.x, r0.y, r1.x, r1.y); *(uint4*)(dst + 8) = make_uint4(r2.x, r2.y, r3.x, r3.y);
}
template <int DK, bool ML>
PHASE_FN void phase_s1(ChunkArgs a, LAS unsigned char* L, int bid, int nb) {
    constexpr int NQ = DK / 64;
    const int tid = tid_opq(), lane = tid & 63, wave = __builtin_amdgcn_readfirstlane(tid >> 6), wm = wave & 3, wn = wave >> 2;
    LAS unsigned char* KS = L; LAS unsigned char* QS = L + 16384;
    LAS float* sc = (LAS float*)(L + 32768);
    LAS float* mp = sc + 768;
    LAS float* WT = (LAS float*)(L + 40960);
    LAS unsigned char* KS2 = L + 73728;
    const int tr = tid >> 3, tc = tid & 7;
    uint4 RG[16];
#define S1_LOAD_QK(item_) do { const int bh_ = (item_) / NCH, c_ = (item_) - bh_ * NCH; const size_t r0_ = (size_t)(bh_ >> 2) * SP + 128 * c_; const int h_ = bh_ & 3; \
        _Pragma("unroll") for (int ds = 0; ds < NQ; ++ds) _Pragma("unroll") for (int u = 0; u < 2; ++u) { const size_t off_ = (r0_ + tr + 64 * u) * a.ldq + h_ * DK + ds * 64 + tc * 8; \
            if (!ML) { RG[ds * 4 + u] = *(const uint4*)(a.ksrc + off_); RG[ds * 4 + 2 + u] = *(const uint4*)(a.qsrc + off_); } else RG[ds * 2 + u] = *(const uint4*)(a.qsrc + off_); } } while (0)
#define S1_LOAD_V(item_) do { const int bh_ = (item_) / NCH, c_ = (item_) - bh_ * NCH; const size_t r0_ = (size_t)(bh_ >> 2) * SP + 128 * c_; const int h_ = bh_ & 3; \
        _Pragma("unroll") for (int ns = 0; ns < 8; ++ns) _Pragma("unroll") for (int u = 0; u < 2; ++u) RG[ns * 2 + u] = *(const uint4*)(a.vsrc + (r0_ + tr + 64 * u) * a.ldv + h_ * 512 + ns * 64 + tc * 8); } while (0)
    constexpr int NI = 16 * NCH; const int nfull = NI / nb, rem = NI - nfull * nb; const int nent = nfull + ((bid < 2 * rem) ? 1 : 0);
    if (bid < NI) S1_LOAD_QK(bid);
    for (int e_ = 0; e_ < nent; ++e_) {
        const int item = (e_ < nfull) ? bid + e_ * nb : nfull * nb + (bid < rem ? bid : bid - rem), part = (e_ < nfull) ? 3 : (bid < rem ? 1 : 2);
        const int inext = (e_ + 1 < nfull) ? bid + (e_ + 1) * nb : nfull * nb + (bid < rem ? bid : bid - rem), pnext = (e_ + 1 < nent) ? ((e_ + 1 < nfull) ? 3 : (bid < rem ? 1 : 2)) : 0;
        const int bh = item / NCH, c = item - bh * NCH, h = bh & 3;
        float lgf = 0.f, lgb = 0.f;
        if (!ML) { lgf = log2_gamma(a.decay[h]); lgb = log2_gamma(a.decay[4 + h]); }
        wg_sync();
        if (ML) {
            if (wave < 2) { const int d = wave; const int npos = d ? pos_b(c) : c; float bl = 0.f, pml = 0.f;
                if (lane < NCH) { const int cc = d ? ord_b(lane) : lane; bl = a.cBL[(d * 16 + bh) * NCH + cc]; pml = a.cPML[(d * 16 + bh) * NCH + cc]; }
                float m = 0.f;
                for (int k = 0; k < npos; ++k) { const float blk = __int_as_float(__builtin_amdgcn_readlane(__float_as_int(bl), k)), pmk = __int_as_float(__builtin_amdgcn_readlane(__float_as_int(pml), k)); m = blk + fmaxf(m, pmk); }
                if (lane == 0) mp[d] = m; }
            if (tid < 256) { const int d = tid >> 7, i = tid & 127; sc[d * 128 + i] = a.gG[((size_t)d * 16 + bh) * SP + 128 * c + i]; sc[512 + d * 128 + i] = 0.f; }
#pragma unroll
            for (int u = 0; u < 3; ++u) *(LAS f32x4*)(WT + u * 2048 + tid * 4) = *(const f32x4*)(a.wqkv + (size_t)(u * 512 + h * 128) * 16 + tid * 4);
            wg_sync();
            if (tid < 256) { const int d = tid >> 7, i = tid & 127; sc[256 + d * 128 + i] = fmaxf(mp[d], a.gPM[((size_t)d * 16 + bh) * SP + 128 * c + i]); }
            { const int g_ = tid >> 2, ei_ = tid & 3; const LAS float* wq_ = WT + g_ * 16; const LAS float* wk_ = WT + 2048 + g_ * 16; f32x4 m_;
#pragma unroll
                for (int di = 0; di < 4; ++di) { float s_ = 0.f;
#pragma unroll
                    for (int dq = 0; dq < 4; ++dq) s_ += wk_[ei_ * 4 + dq] * wq_[di * 4 + dq];
                    m_[di] = s_ * 0.04419417382415922f; }
                *(LAS f32x4*)(WT + 6144 + g_ * 16 + ei_ * 4) = m_; }
        }
        if (part & 1) {
        f32x4 acc[2][4];
#pragma unroll
        for (int x = 0; x < 2; ++x)
#pragma unroll
            for (int y = 0; y < 4; ++y) acc[x][y] = (f32x4){0.f, 0.f, 0.f, 0.f};
#pragma unroll
        for (int ds = 0; ds < NQ; ++ds) {
            wg_sync();
#pragma unroll
            for (int u = 0; u < 2; ++u) { const int row = tr + 64 * u, ch = tc;
                if (!ML) { lds_st16b(KS, row, ch, RG[ds * 4 + u]); lds_st16b(QS, row, ch, RG[ds * 4 + 2 + u]); }
                else {
                    const int col = h * DK + ds * 64 + ch * 8; float x[8], qv[8], k2v[8];
                    unpack8(RG[ds * 2 + u], x);
#pragma unroll
                    for (int gi = 0; gi < 2; ++gi) { const LAS float* wm_ = WT + 6144 + (ds * 16 + ch * 2 + gi) * 16;
                        f32x4 wm4[4];
#pragma unroll
                        for (int ei = 0; ei < 4; ++ei) wm4[ei] = *(const LAS f32x4*)(wm_ + 4 * ei);
#pragma unroll
                        for (int eo = 0; eo < 4; ++eo) { float sq = 0.f, sm = 0.f;
#pragma unroll
                            for (int ei = 0; ei < 4; ++ei) { sq += x[4 * gi + ei] * wm4[eo][ei]; sm += x[4 * gi + ei] * wm4[ei][eo]; }
                            qv[4 * gi + eo] = sq; k2v[4 * gi + eo] = sm; } }
                    lds_st16b(QS, row, ch, pack8(qv)); lds_st16b(KS, row, ch, RG[ds * 2 + u]); lds_st16b(KS2, row, ch, pack8(k2v));
                } }
            if (ds == NQ - 1 && (part & 2)) S1_LOAD_V(item);
            wg_sync();
            slab_transpose_out(ML ? KS2 : KS, a.Kt + ((size_t)bh * DK + ds * 64) * SP + 128 * c, wave, lane);
            mma_slab<2, 4, true>(acc, KS, 32 * wm, QS, 64 * wn, lane);
        }
        mfma_drain();
        float rsf[4] = {0.f, 0.f, 0.f, 0.f}, rsb[4] = {0.f, 0.f, 0.f, 0.f}; unsigned pwf[2][2], pwb[2][2];
        bf16_t* Pf = a.P + ((size_t)(0 * 16 + bh) * NCH + c) * 16384; bf16_t* Pb = a.P + ((size_t)(1 * 16 + bh) * NCH + c) * 16384;
#pragma unroll
        for (int tj = 0; tj < 2; ++tj)
#pragma unroll
            for (int ti = 0; ti < 4; ++ti) { const int i = 64 * wn + 16 * ti + (lane & 15), j0 = 32 * wm + 16 * tj + 4 * (lane >> 4); float pf[4], pb[4];
                float Mfi = 0.f, Mbi = 0.f; if (ML) { Mfi = sc[256 + i]; Mbi = sc[384 + i]; }
#pragma unroll
                for (int e = 0; e < 4; ++e) { const int j = j0 + e; const float s = acc[tj][ti][e]; float wf, wb;
                    if (!ML) { wf = (j <= i) ? 1.f : 0.f; wb = (j >= i) ? 1.f : 0.f; }
                    else { wf = (j <= i) ? __expf(sc[j] - Mfi) : 0.f; wb = (j >= i) ? __expf(sc[128 + j] - Mbi) : 0.f; }
                    pf[e] = s * wf; pb[e] = s * wb; rsf[ti] += pf[e]; rsb[ti] += pb[e]; }
                pwf[ti & 1][0] = pk2(pf[0], pf[1]); pwf[ti & 1][1] = pk2(pf[2], pf[3]); pwb[ti & 1][0] = pk2(pb[0], pb[1]); pwb[ti & 1][1] = pk2(pb[2], pb[3]);
                if (ti & 1) { mfma_drain();
                    const int g = lane >> 4, irow = (g & 1) ? i : i - 16, jc = 32 * wm + 16 * tj + 4 * (g & ~1);
                    { const auto sx = __builtin_amdgcn_permlane16_swap(pwf[0][0], pwf[1][0], false, false), sy = __builtin_amdgcn_permlane16_swap(pwf[0][1], pwf[1][1], false, false);
                      u32x4 w; w.x = sx[0]; w.y = sy[0]; w.z = sx[1]; w.w = sy[1]; *(u32x4*)(Pf + irow * 128 + jc) = w; }
                    { const auto sx = __builtin_amdgcn_permlane16_swap(pwb[0][0], pwb[1][0], false, false), sy = __builtin_amdgcn_permlane16_swap(pwb[0][1], pwb[1][1], false, false);
                      u32x4 w; w.x = sx[0]; w.y = sy[0]; w.z = sx[1]; w.w = sy[1]; *(u32x4*)(Pb + irow * 128 + jc) = w; } } }
        if (ML) {
#pragma unroll
            for (int ti = 0; ti < 4; ++ti) { float f = rsf[ti], b = rsb[ti]; f += __shfl_xor(f, 16); f += __shfl_xor(f, 32); b += __shfl_xor(b, 16); b += __shfl_xor(b, 32);
                if ((lane >> 4) == 0) { const int i = 64 * wn + 16 * ti + (lane & 15); atomicAdd((float*)(sc + 512 + i), f); atomicAdd((float*)(sc + 640 + i), b); } }
            wg_sync();
            if (tid < 256) { const int d = tid >> 7, i = tid & 127; a.RS[((size_t)d * 16 + bh) * SP + 128 * c + i] = sc[512 + d * 128 + i]; }
        }
        }
        if (part & 2) {
#pragma unroll
        for (int ns = 0; ns < 8; ++ns) {
            wg_sync();
#pragma unroll
            for (int u = 0; u < 2; ++u) { const int row = tr + 64 * u, ch = tc; const int col = h * 512 + ns * 64 + ch * 8;
                uint4 raw = RG[ns * 2 + u];
                if (ML) { float x[8], vv[8]; unpack8(raw, x);
#pragma unroll
                    for (int gi = 0; gi < 2; ++gi) { const LAS float* wv = WT + 4096 + (ns * 16 + ch * 2 + gi) * 16;
                        f32x4 wv4[4];
#pragma unroll
                        for (int ei = 0; ei < 4; ++ei) wv4[ei] = *(const LAS f32x4*)(wv + 4 * ei);
#pragma unroll
                        for (int eo = 0; eo < 4; ++eo) { float sv = 0.f;
#pragma unroll
                            for (int ei = 0; ei < 4; ++ei) sv += x[4 * gi + ei] * wv4[ei][eo];
                            vv[4 * gi + eo] = sv; } }
                    raw = pack8(vv); }
                lds_st16b(KS, row, ch, raw); }
            if (ns == 7) { if (pnext & 1) S1_LOAD_QK(inext); else if (pnext & 2) S1_LOAD_V(inext); }
            wg_sync();
            slab_transpose_out(KS, a.Vt + ((size_t)bh * 512 + ns * 64) * SP + 128 * c, wave, lane);
        }
        }
    }
#undef S1_LOAD_QK
#undef S1_LOAD_V
}

template <int DK, bool ML>
PHASE_FN void phase_s2(ChunkArgs a, LAS unsigned char* L, int bid, int nb, unsigned long long* prof = nullptr) {
    unsigned long long psec0 = 0, psec1 = 0, psec2 = 0, psec3 = 0, psec4 = 0, psec5 = 0, pt = 0;
#define PSTAMP(k) do { if (prof) { const unsigned long long n_ = clock64(); psec##k += n_ - pt; pt = n_; } } while (0)
    constexpr int DB = DK / 256;
    const int tid = tid_opq(), lane = tid & 63, wave = __builtin_amdgcn_readfirstlane(tid >> 6), wm = wave & 1, wn = wave >> 1;
    if (bid >= 256) return;
    const int xq = bid & 7, tt = bid >> 3, gI = xq + 8 * (tt >> 3), slice = tt & 7, bh = gI >> 1, dir = gI & 1, h = bh & 3, bl_ = bh >> 2, n0 = 64 * slice;
    LAS unsigned char* BUF = L;
    LAS unsigned char* VTS = L + 65536;
    LAS unsigned char* CST = L + 81920;
    LAS float* sc = (LAS float*)(L + 81920 + 65536);
    LAS float* rho = sc, *kap = sc + 128, *rsv = sc + 256, *emt = sc + 384, *qn = sc + 512, *nt = sc + 640, *wql = sc + 1152;
    LAS unsigned short* kapb = (LAS unsigned short*)(sc + 3200);
    for (int i = tid; i < (DK / 64) * 8192 / 16; i += NTHR) ((LAS u32x4*)CST)[i] = (u32x4){0u, 0u, 0u, 0u};
    if (ML) { for (int i = tid; i < 512; i += NTHR) nt[i] = 0.f; for (int i = tid; i < 2048; i += NTHR) wql[i] = a.wqkv[(size_t)(h * 128) * 16 + i]; }
    f32x4 Cacc[DB][2][4]; f32x4 nacc[DB][2];
#pragma unroll
    for (int db = 0; db < DB; ++db)
#pragma unroll
        for (int tm = 0; tm < 2; ++tm) { nacc[db][tm] = (f32x4){0.f, 0.f, 0.f, 0.f};
#pragma unroll
            for (int tn = 0; tn < 4; ++tn) Cacc[db][tm][tn] = (f32x4){0.f, 0.f, 0.f, 0.f}; }
    float lg = 0.f; if (!ML) lg = log2_gamma(a.decay[dir * 4 + h]);
    float m_run = 0.f;
    bf16_t* Od = dir ? a.Ob : a.Of;
    const bf16_t* Pd = a.P + (size_t)(dir * 16 + bh) * NCH * 16384;
    u32x4 RA[8], RB[8];
    const __amdgpu_buffer_rsrc_t rsQ = __builtin_amdgcn_make_buffer_rsrc((void*)a.qsrc, 0, 0x7fffffff, 0x00020000), rsP = __builtin_amdgcn_make_buffer_rsrc((void*)a.P, 0, 0x7fffffff, 0x00020000);
    const __amdgpu_buffer_rsrc_t rsV = __builtin_amdgcn_make_buffer_rsrc((void*)a.Vt, 0, 0x7fffffff, 0x00020000), rsK = __builtin_amdgcn_make_buffer_rsrc((void*)a.Kt, 0, 0x7fffffff, 0x00020000);
    const int tr = tid >> 3, tc = tid & 7;
    const int voQ = (tr * a.ldq + tc * 8) * 2, voP = (tr * 128 + tc * 8) * 2, voT = (tr * SP + tc * 8) * 2;
    const int lbase = SLABOFF(tr, tc);
#define S2_LOAD_Q(R, c_, kb_) do { const int sb_ = (int)((((size_t)bl_ * SP + 128 * (c_)) * a.ldq + h * DK + (kb_) * 256) * 2); _Pragma("unroll") for (int u = 0; u < 8; ++u) \
        R[u] = __builtin_amdgcn_raw_buffer_load_b128(rsQ, voQ, sb_ + (64 * (u & 1) * a.ldq + (u >> 1) * 64) * 2, 0); } while (0)
#define S2_STORE_Q(R) do { _Pragma("unroll") for (int u = 0; u < 8; ++u) *(LAS u32x4*)(BUF + (u >> 1) * 16384 + (u & 1) * 8192 + lbase) = R[u]; } while (0)
#define S2_LOAD_PV(R, c_) do { const int sp_ = (int)((((size_t)(dir * 16 + bh) * NCH + (c_)) * 16384) * 2), sv_ = (int)((((size_t)bh * 512 + n0) * SP + 128 * (c_)) * 2); \
        _Pragma("unroll") for (int u = 0; u < 4; ++u) R[u] = __builtin_amdgcn_raw_buffer_load_b128(rsP, voP, sp_ + ((u & 1) * 64 * 128 + (u >> 1) * 64) * 2, 0); \
        _Pragma("unroll") for (int u = 0; u < 2; ++u) R[4 + u] = __builtin_amdgcn_raw_buffer_load_b128(rsV, voT, sv_ + u * 128, 0); } while (0)
#define S2_STORE_PV(R) do { _Pragma("unroll") for (int u = 0; u < 4; ++u) *(LAS u32x4*)(BUF + (u >> 1) * 16384 + (u & 1) * 8192 + lbase) = R[u]; \
        _Pragma("unroll") for (int u = 0; u < 2; ++u) *(LAS u32x4*)(VTS + u * 8192 + lbase) = R[4 + u]; } while (0)
#define S2_LOAD_KT(R, c_, db_) do { const int sk_ = (int)((((size_t)bh * DK + (db_) * 256) * SP + 128 * (c_)) * 2); _Pragma("unroll") for (int u = 0; u < 8; ++u) \
        R[u] = __builtin_amdgcn_raw_buffer_load_b128(rsK, voT, sk_ + ((u & 3) * 64 * SP + (u >> 2) * 64) * 2, 0); } while (0)
#define S2_STORE_KT(R) do { _Pragma("unroll") for (int u = 0; u < 8; ++u) { u32x4 t_ = R[u]; \
        if (!ML) { float x[8]; unpack8(make_uint4(R[u].x, R[u].y, R[u].z, R[u].w), x); \
            _Pragma("unroll") for (int q = 0; q < 8; ++q) x[q] *= kap[(u >> 2) * 64 + tc * 8 + q]; const uint4 pk_ = pack8(x); t_.x = pk_.x; t_.y = pk_.y; t_.z = pk_.z; t_.w = pk_.w; } \
        *(LAS u32x4*)(BUF + (u >> 2) * 32768 + (u & 3) * 8192 + lbase) = t_; } } while (0)
#define S2_SCALE_VTS() do { _Pragma("unroll") for (int js = 0; js < 2; ++js) { LAS u32x4* p_ = (LAS u32x4*)(VTS + js * 8192 + lbase); const u32x4 r_ = *p_; float x[8]; unpack8(make_uint4(r_.x, r_.y, r_.z, r_.w), x); \
        _Pragma("unroll") for (int q = 0; q < 8; ++q) x[q] *= kap[js * 64 + tc * 8 + q]; const uint4 pk_ = pack8(x); u32x4 t_; t_.x = pk_.x; t_.y = pk_.y; t_.z = pk_.z; t_.w = pk_.w; *p_ = t_; } } while (0)
#define S2_MMA_Q(kb_) do { _Pragma("unroll") for (int ds = 0; ds < 4; ++ds) { mma_slab<2, 2>(acc, CST + ((kb_) * 4 + ds) * 8192, 32 * wm, BUF + ds * 16384, 32 * wn, lane); \
        if (ML) { const int i = tid >> 2, part = tid & 3; float x[8]; _Pragma("unroll") for (int cc = 0; cc < 2; ++cc) { unpack8(lds_ld16(BUF + ds * 16384, i, 2 * part + cc), x); \
            _Pragma("unroll") for (int e = 0; e < 8; ++e) qnp += x[e] * nt[(kb_) * 256 + ds * 64 + 16 * part + 8 * cc + e]; } } } } while (0)
#define S2_MMA_KT(db_) do { _Pragma("unroll") for (int js = 0; js < 2; ++js) _Pragma("unroll") for (int ks = 0; ks < 2; ++ks) { bf16x8 af[2], bfr[4]; bf16x8 kfr = ones; \
        if (ML) kfr = *(const LAS bf16x8*)(kapb + js * 64 + ks * 32 + 8 * (lane >> 4)); \
        _Pragma("unroll") for (int tm = 0; tm < 2; ++tm) af[tm] = lds_frag(BUF + js * 32768, 32 * wave + 16 * tm + (lane & 15), (lane >> 4) + 4 * ks); \
        _Pragma("unroll") for (int tn = 0; tn < 4; ++tn) bfr[tn] = lds_frag(VTS + js * 8192, 16 * tn + (lane & 15), (lane >> 4) + 4 * ks); \
        _Pragma("unroll") for (int tm = 0; tm < 2; ++tm) { _Pragma("unroll") for (int tn = 0; tn < 4; ++tn) Cacc[db_][tm][tn] = __builtin_amdgcn_mfma_f32_16x16x32_bf16(af[tm], bfr[tn], Cacc[db_][tm][tn], 0, 0, 0); \
            if (ML) nacc[db_][tm] = __builtin_amdgcn_mfma_f32_16x16x32_bf16(af[tm], kfr, nacc[db_][tm], 0, 0, 0); } } } while (0)
    bf16x8 ones;
#pragma unroll
    for (int e = 0; e < 8; ++e) ones[e] = (short)0x3F80;
    { const int c0 = dir ? ord_b(0) : 0; S2_LOAD_Q(RA, c0, 0); if (DB == 1) S2_LOAD_PV(RB, c0); }
#define S2_STEP_BODY(X, Y, step) { \
        if (prof) pt = clock64(); \
        const int c = dir ? ord_b(step) : step; \
        const int cn = (step + 1 < NCH) ? (dir ? ord_b(step + 1) : step + 1) : c;       \
        const size_t r0 = (size_t)bl_ * SP + 128 * c; \
        float delta; \
        wg_sync(); \
        S2_STORE_Q(X); \
        if (!ML) { delta = exp2f(128.f * lg); \
            if (tid < 128) { const int i = tid; rho[i] = dir ? exp2f((float)(128 - i) * lg) : exp2f((float)(i + 1) * lg); kap[i] = dir ? exp2f((float)i * lg) : exp2f((float)(127 - i) * lg); } \
        } else { \
            const float bl = a.cBL[(dir * 16 + bh) * NCH + c], pml = a.cPML[(dir * 16 + bh) * NCH + c]; const float mx = fmaxf(m_run, pml); \
            delta = __expf(m_run - mx); \
            if (tid < 128) { const int i = tid; const size_t gi = ((size_t)dir * 16 + bh) * SP + 128 * c + i; const float g = a.gG[gi], pm = a.gPM[gi], bb = a.gB[gi]; \
                const float Mi = fmaxf(m_run, pm); const float kp_ = __expf(g - mx); kap[i] = kp_; kapb[i] = (unsigned short)(pk2(kp_, 0.f) & 0xffffu); rho[i] = __expf(m_run - Mi); emt[i] = __expf(-(bb + Mi)); rsv[i] = a.RS[gi]; } \
            m_run = bl + mx; \
        } \
        if (DB == 2) S2_LOAD_Q(X, c, 1); else S2_LOAD_KT(X, c, 0); \
        wg_sync(); \
        PSTAMP(0); \
        f32x4 acc[2][2]; \
_Pragma("unroll") \
        for (int x = 0; x < 2; ++x) \
_Pragma("unroll") \
            for (int y = 0; y < 2; ++y) acc[x][y] = (f32x4){0.f, 0.f, 0.f, 0.f}; \
        float qnp = 0.f; \
        S2_MMA_Q(0); \
        if (DB == 2) {       \
            wg_sync(); \
            S2_STORE_Q(X); \
            S2_LOAD_PV(X, c); \
            wg_sync(); \
            S2_MMA_Q(1); \
        } \
        mfma_drain(); \
        if (ML) { qnp += __shfl_xor(qnp, 1); qnp += __shfl_xor(qnp, 2); if ((tid & 3) == 0) qn[tid >> 2] = qnp; } \
_Pragma("unroll") \
        for (int ti = 0; ti < 2; ++ti) { const float r = rho[32 * wn + 16 * ti + (lane & 15)]; \
_Pragma("unroll") \
            for (int tm = 0; tm < 2; ++tm) acc[tm][ti] *= r; } \
        PSTAMP(1); \
        wg_sync(); \
        PSTAMP(2); \
        if (DB == 2) { S2_STORE_PV(X); S2_LOAD_KT(X, c, 0); } else { S2_STORE_PV(Y); S2_LOAD_Q(Y, cn, 0); } \
        wg_sync(); \
_Pragma("unroll") \
        for (int js = 0; js < 2; ++js) mma_slab<2, 2>(acc, VTS + js * 8192, 32 * wm, BUF + js * 16384, 32 * wn, lane); \
        mfma_drain(); \
        {   \
            const int g_ = lane >> 4, ia = 32 * wn + (lane & 15), ib = ia + 16; float sa_ = 1.f, sb_ = 1.f; \
            if (ML) { const float da_ = rsv[ia] + rho[ia] * qn[ia], db_ = rsv[ib] + rho[ib] * qn[ib]; sa_ = 1.f / fmaxf(fabsf(da_), emt[ia]); sb_ = 1.f / fmaxf(fabsf(db_), emt[ib]); } \
            unsigned ax_[2], ay_[2], bx_[2], by_[2]; \
_Pragma("unroll") \
            for (int tm = 0; tm < 2; ++tm) { const f32x4 va = acc[tm][0] * sa_, vb = acc[tm][1] * sb_; \
                ax_[tm] = pk2(va[0], va[1]); ay_[tm] = pk2(va[2], va[3]); bx_[tm] = pk2(vb[0], vb[1]); by_[tm] = pk2(vb[2], vb[3]); } \
            mfma_drain(); \
            const int irow_ = (g_ & 1) ? ib : ia; \
_Pragma("unroll") \
            for (int tm = 0; tm < 2; ++tm) { \
                const auto sx_ = __builtin_amdgcn_permlane16_swap(ax_[tm], bx_[tm], false, false), sy_ = __builtin_amdgcn_permlane16_swap(ay_[tm], by_[tm], false, false); \
                u32x4 w; w.x = sx_[0]; w.y = sy_[0]; w.z = sx_[1]; w.w = sy_[1]; \
                *(u32x4*)(Od + (r0 + irow_) * 2048 + h * 512 + n0 + 32 * wm + 16 * tm + 4 * (g_ & ~1)) = w; } } \
_Pragma("unroll") \
        for (int db = 0; db < DB; ++db) \
_Pragma("unroll") \
            for (int tm = 0; tm < 2; ++tm) { nacc[db][tm] *= delta; \
_Pragma("unroll") \
                for (int tn = 0; tn < 4; ++tn) Cacc[db][tm][tn] *= delta; } \
        PSTAMP(3); \
        wg_sync(); \
        PSTAMP(4); \
        S2_STORE_KT(X); if (ML) S2_SCALE_VTS(); \
        if (DB == 2) S2_LOAD_KT(X, c, 1); else S2_LOAD_PV(X, cn); \
        wg_sync(); \
        S2_MMA_KT(0); \
        if (DB == 2) { \
            wg_sync(); \
            S2_STORE_KT(X); \
            S2_LOAD_Q(X, cn, 0); \
            wg_sync(); \
            S2_MMA_KT(DB - 1); \
        } \
        mfma_drain(); \
_Pragma("unroll") \
        for (int db = 0; db < DB; ++db) \
_Pragma("unroll") \
            for (int tm = 0; tm < 2; ++tm) { const int d0 = db * 256 + 32 * wave + 16 * tm + 4 * (lane >> 4); \
                float w16[16]; \
                (void)w16; \
_Pragma("unroll") \
                for (int tn = 0; tn < 4; ++tn) { f32x4 v = Cacc[db][tm][tn]; \
                    if (false) { f32x4 t; \
_Pragma("unroll") \
                        for (int e = 0; e < 4; ++e) t[e] = w16[e * 4 + 0] * v[0] + w16[e * 4 + 1] * v[1] + w16[e * 4 + 2] * v[2] + w16[e * 4 + 3] * v[3]; \
                        v = t; } \
                    u32x2 w; w.x = pk2(v[0], v[1]); w.y = pk2(v[2], v[3]); \
                    const int n = 16 * tn + (lane & 15); \
                    *(LAS u32x2*)(CST + (d0 >> 6) * 8192 + SLABOFF(n, (d0 & 63) >> 3) + (d0 & 7) * 2) = w; } \
                if (ML && (lane & 15) == 0) { const f32x4 v = nacc[db][tm]; \
_Pragma("unroll") \
                    for (int e = 0; e < 4; ++e) nt[d0 + e] = v[e];     } } \
        PSTAMP(5); \
    }
    if constexpr (DB == 1) { for (int step2 = 0; step2 < NCH; step2 += 2) { S2_STEP_BODY(RA, RB, step2) S2_STEP_BODY(RB, RA, (step2 + 1)) } }
    else { for (int step1 = 0; step1 < NCH; ++step1) { S2_STEP_BODY(RA, RA, step1) } }
#undef S2_STEP_BODY
    if (prof && bid == 0 && tid == 0) { prof[0] = psec0; prof[1] = psec1; prof[2] = psec2; prof[3] = psec3; prof[4] = psec4; prof[5] = psec5; }
#undef PSTAMP
#undef S2_LOAD_Q
#undef S2_STORE_Q
#undef S2_LOAD_PV
#undef S2_STORE_PV
#undef S2_LOAD_KT
#undef S2_STORE_KT
#undef S2_SCALE_VTS
#undef S2_MMA_Q
#undef S2_MMA_KT
}

PHASE_FN void phase_s2r(ChunkArgs a, LAS unsigned char* L, int bid, int nb) {
    constexpr int DK = 256;
    const int tid = tid_opq(), lane = tid & 63, wave = __builtin_amdgcn_readfirstlane(tid >> 6), wm = wave & 1, wn = wave >> 1;
    if (bid >= 256) return;
    const int xq = bid & 7, tt = bid >> 3, gI = xq + 8 * (tt >> 3), slice = tt & 7, bh = gI >> 1, dir = gI & 1, h = bh & 3, bl_ = bh >> 2, n0 = 64 * slice;
    LAS unsigned char* CST = L;
    LAS unsigned char* VTS = L + 32768;
    LAS unsigned char* VT2 = L + 49152;
    LAS float* rho = (LAS float*)(L + 65536); LAS float* kap = rho + 128;
    for (int i = tid; i < 4 * 8192 / 16; i += NTHR) ((LAS u32x4*)CST)[i] = (u32x4){0u, 0u, 0u, 0u};
    const float lg = log2_gamma(a.decay[dir * 4 + h]); const float delta = exp2f(128.f * lg);
    if (tid < 128) { const int i = tid; rho[i] = dir ? exp2f((float)(128 - i) * lg) : exp2f((float)(i + 1) * lg); kap[i] = dir ? exp2f((float)i * lg) : exp2f((float)(127 - i) * lg); }
    f32x4 Cacc[2][4];
#pragma unroll
    for (int tm = 0; tm < 2; ++tm)
#pragma unroll
        for (int tn = 0; tn < 4; ++tn) Cacc[tm][tn] = (f32x4){0.f, 0.f, 0.f, 0.f};
    bf16_t* Od = dir ? a.Ob : a.Of;
    const __amdgpu_buffer_rsrc_t rsQ = __builtin_amdgcn_make_buffer_rsrc((void*)a.qsrc, 0, 0x7fffffff, 0x00020000), rsP = __builtin_amdgcn_make_buffer_rsrc((void*)a.P, 0, 0x7fffffff, 0x00020000);
    const __amdgpu_buffer_rsrc_t rsV = __builtin_amdgcn_make_buffer_rsrc((void*)a.Vt, 0, 0x7fffffff, 0x00020000), rsK = __builtin_amdgcn_make_buffer_rsrc((void*)a.Kt, 0, 0x7fffffff, 0x00020000);
    const int fr = lane & 15, fq = lane >> 4, tr = tid >> 3, tc = tid & 7;
    const int voQ = ((32 * wn + fr) * 1024 + 8 * fq) * 2, voP = ((32 * wn + fr) * 128 + 8 * fq) * 2, voK = ((32 * wave + fr) * SP + 8 * fq) * 2, voT = (tr * SP + tc * 8) * 2;
    const int lbase = SLABOFF(tr, tc);
    u32x4 QF[2][8], PF[2][4], KF[2][4], VR[2];
#define S2R_LOAD_Q(c_) do { const int sb_ = (int)((((size_t)bl_ * SP + 128 * (c_)) * 1024 + h * DK) * 2); _Pragma("unroll") for (int ti = 0; ti < 2; ++ti) _Pragma("unroll") for (int ks = 0; ks < 8; ++ks) \
        QF[ti][ks] = __builtin_amdgcn_raw_buffer_load_b128(rsQ, voQ, sb_ + (16 * ti * 1024 + 32 * ks) * 2, 0); } while (0)
#define S2R_LOAD_P(c_) do { const int sp_ = (int)((((size_t)(dir * 16 + bh) * NCH + (c_)) * 16384) * 2); _Pragma("unroll") for (int ti = 0; ti < 2; ++ti) _Pragma("unroll") for (int ks = 0; ks < 4; ++ks) \
        PF[ti][ks] = __builtin_amdgcn_raw_buffer_load_b128(rsP, voP, sp_ + (16 * ti * 128 + 32 * ks) * 2, 0); } while (0)
#define S2R_LOAD_K(c_) do { const int sk_ = (int)((((size_t)bh * DK) * SP + 128 * (c_)) * 2); _Pragma("unroll") for (int tm = 0; tm < 2; ++tm) _Pragma("unroll") for (int ks = 0; ks < 4; ++ks) \
        KF[tm][ks] = __builtin_amdgcn_raw_buffer_load_b128(rsK, voK, sk_ + (16 * tm * SP + 32 * ks) * 2, 0); } while (0)
#define S2R_LOAD_V(c_) do { const int sv_ = (int)((((size_t)bh * 512 + n0) * SP + 128 * (c_)) * 2); _Pragma("unroll") for (int u = 0; u < 2; ++u) VR[u] = __builtin_amdgcn_raw_buffer_load_b128(rsV, voT, sv_ + u * 128, 0); } while (0)
    { const int c0 = dir ? ord_b(0) : 0; S2R_LOAD_V(c0); S2R_LOAD_Q(c0); S2R_LOAD_P(c0); S2R_LOAD_K(c0); }
    for (int step = 0; step < NCH; ++step) {
        const int c = dir ? ord_b(step) : step;
        const int cn = (step + 1 < NCH) ? (dir ? ord_b(step + 1) : step + 1) : c;
        const size_t r0 = (size_t)bl_ * SP + 128 * c;
        wg_sync();
#pragma unroll
        for (int u = 0; u < 2; ++u) { *(LAS u32x4*)(VTS + u * 8192 + lbase) = VR[u]; float x[8]; unpack8(make_uint4(VR[u].x, VR[u].y, VR[u].z, VR[u].w), x);
#pragma unroll
            for (int q = 0; q < 8; ++q) x[q] *= kap[u * 64 + tc * 8 + q];
            const uint4 pk_ = pack8(x); u32x4 t_; t_.x = pk_.x; t_.y = pk_.y; t_.z = pk_.z; t_.w = pk_.w; *(LAS u32x4*)(VT2 + u * 8192 + lbase) = t_; }
        S2R_LOAD_V(cn);
        wg_sync();
        f32x4 acc[2][2];
#pragma unroll
        for (int x = 0; x < 2; ++x)
#pragma unroll
            for (int y = 0; y < 2; ++y) acc[x][y] = (f32x4){0.f, 0.f, 0.f, 0.f};
#pragma unroll
        for (int ks = 0; ks < 8; ++ks) { bf16x8 af[2];
#pragma unroll
            for (int tm = 0; tm < 2; ++tm) af[tm] = lds_frag(CST + (ks >> 1) * 8192, 32 * wm + 16 * tm + fr, fq + 4 * (ks & 1));
#pragma unroll
            for (int tm = 0; tm < 2; ++tm)
#pragma unroll
                for (int ti = 0; ti < 2; ++ti) acc[tm][ti] = __builtin_amdgcn_mfma_f32_16x16x32_bf16(af[tm], *(const bf16x8*)&QF[ti][ks], acc[tm][ti], 0, 0, 0); }
        S2R_LOAD_Q(cn);
        mfma_drain();
#pragma unroll
        for (int ti = 0; ti < 2; ++ti) { const float r = rho[32 * wn + 16 * ti + fr];
#pragma unroll
            for (int tm = 0; tm < 2; ++tm) acc[tm][ti] *= r; }
#pragma unroll
        for (int ks = 0; ks < 4; ++ks) { bf16x8 af[2];
#pragma unroll
            for (int tm = 0; tm < 2; ++tm) af[tm] = lds_frag(VTS + (ks >> 1) * 8192, 32 * wm + 16 * tm + fr, fq + 4 * (ks & 1));
#pragma unroll
            for (int tm = 0; tm < 2; ++tm)
#pragma unroll
                for (int ti = 0; ti < 2; ++ti) acc[tm][ti] = __builtin_amdgcn_mfma_f32_16x16x32_bf16(af[tm], *(const bf16x8*)&PF[ti][ks], acc[tm][ti], 0, 0, 0); }
        S2R_LOAD_P(cn);
        mfma_drain();
#pragma unroll
        for (int ti = 0; ti < 2; ++ti) { const int i = 32 * wn + 16 * ti + fr;
#pragma unroll
            for (int tm = 0; tm < 2; ++tm) { const f32x4 v = acc[tm][ti]; u32x2 w; w.x = pk2(v[0], v[1]); w.y = pk2(v[2], v[3]);
                *(u32x2*)(Od + (r0 + i) * 2048 + h * 512 + n0 + 32 * wm + 16 * tm + 4 * fq) = w; } }
#pragma unroll
        for (int tm = 0; tm < 2; ++tm)
#pragma unroll
            for (int tn = 0; tn < 4; ++tn) Cacc[tm][tn] *= delta;
#pragma unroll
        for (int ks = 0; ks < 4; ++ks) { bf16x8 bfr[4];
#pragma unroll
            for (int tn = 0; tn < 4; ++tn) bfr[tn] = lds_frag(VT2 + (ks >> 1) * 8192, 16 * tn + fr, fq + 4 * (ks & 1));
#pragma unroll
            for (int tm = 0; tm < 2; ++tm)
#pragma unroll
                for (int tn = 0; tn < 4; ++tn) Cacc[tm][tn] = __builtin_amdgcn_mfma_f32_16x16x32_bf16(*(const bf16x8*)&KF[tm][ks], bfr[tn], Cacc[tm][tn], 0, 0, 0); }
        S2R_LOAD_K(cn);
        wg_sync();
        mfma_drain();
#pragma unroll
        for (int tm = 0; tm < 2; ++tm) { const int d0 = 32 * wave + 16 * tm + 4 * fq;
#pragma unroll
            for (int tn = 0; tn < 4; ++tn) { const f32x4 v = Cacc[tm][tn]; u32x2 w; w.x = pk2(v[0], v[1]); w.y = pk2(v[2], v[3]); const int n = 16 * tn + fr;
                *(LAS u32x2*)(CST + (d0 >> 6) * 8192 + SLABOFF(n, (d0 & 63) >> 3) + (d0 & 7) * 2) = w; } }
    }
#undef S2R_LOAD_Q
#undef S2R_LOAD_P
#undef S2R_LOAD_K
#undef S2R_LOAD_V
}

PHASE_FN void phase_s2p(ChunkArgs a, LAS unsigned char* L, int bid, int nb) {
    constexpr int DK = 256;
    const int tid = tid_opq(), lane = tid & 63, wave = __builtin_amdgcn_readfirstlane(tid >> 6), wm = wave & 1, wn = wave >> 1;
    if (bid >= 256) return;
    const int xq = bid & 7, tt = bid >> 3, gI = xq + 8 * (tt >> 3), slice = tt & 7, bh = gI >> 1, dir = gI & 1, h = bh & 3, bl_ = bh >> 2, n0 = 64 * slice;
    LAS unsigned char* BUFA = L; LAS unsigned char* BUFB = L + 32768;
    LAS unsigned char* VTS = L + 65536;
    LAS unsigned char* CST = L + 81920;
    LAS float* rho = (LAS float*)(L + 114688); LAS float* kap = rho + 128;
    for (int i = tid; i < 4 * 8192 / 16; i += NTHR) ((LAS u32x4*)CST)[i] = (u32x4){0u, 0u, 0u, 0u};
    const float lg = log2_gamma(a.decay[dir * 4 + h]); const float delta = exp2f(128.f * lg);
    if (tid < 128) { const int i = tid; rho[i] = dir ? exp2f((float)(128 - i) * lg) : exp2f((float)(i + 1) * lg); kap[i] = dir ? exp2f((float)i * lg) : exp2f((float)(127 - i) * lg); }
    f32x4 Cacc[2][4];
#pragma unroll
    for (int tm = 0; tm < 2; ++tm)
#pragma unroll
        for (int tn = 0; tn < 4; ++tn) Cacc[tm][tn] = (f32x4){0.f, 0.f, 0.f, 0.f};
    bf16_t* Od = dir ? a.Ob : a.Of;
    const __amdgpu_buffer_rsrc_t rsQ = __builtin_amdgcn_make_buffer_rsrc((void*)a.qsrc, 0, 0x7fffffff, 0x00020000), rsP = __builtin_amdgcn_make_buffer_rsrc((void*)a.P, 0, 0x7fffffff, 0x00020000);
    const __amdgpu_buffer_rsrc_t rsV = __builtin_amdgcn_make_buffer_rsrc((void*)a.Vt, 0, 0x7fffffff, 0x00020000), rsK = __builtin_amdgcn_make_buffer_rsrc((void*)a.Kt, 0, 0x7fffffff, 0x00020000);
    const int tr = tid >> 3, tc = tid & 7;
    const int voQ = (tr * 1024 + tc * 8) * 2, voP = (tr * 128 + tc * 8) * 2, voT = (tr * SP + tc * 8) * 2;
    const int lbase = SLABOFF(tr, tc);
    u32x4 RQa[4], RQb[4], RP[6], RK0[4], RK1[4];
#define P_LOAD_Q(R, c_, kbh_) do { const int sb_ = (int)((((size_t)bl_ * SP + 128 * (c_)) * 1024 + h * DK + (kbh_) * 128) * 2); _Pragma("unroll") for (int u = 0; u < 4; ++u) \
        R[u] = __builtin_amdgcn_raw_buffer_load_b128(rsQ, voQ, sb_ + (64 * (u & 1) * 1024 + (u >> 1) * 64) * 2, 0); } while (0)
#define P_LOAD_PV(R, c_) do { const int sp_ = (int)((((size_t)(dir * 16 + bh) * NCH + (c_)) * 16384) * 2), sv_ = (int)((((size_t)bh * 512 + n0) * SP + 128 * (c_)) * 2); \
        _Pragma("unroll") for (int u = 0; u < 4; ++u) R[u] = __builtin_amdgcn_raw_buffer_load_b128(rsP, voP, sp_ + ((u & 1) * 64 * 128 + (u >> 1) * 64) * 2, 0); \
        _Pragma("unroll") for (int u = 0; u < 2; ++u) R[4 + u] = __builtin_amdgcn_raw_buffer_load_b128(rsV, voT, sv_ + u * 128, 0); } while (0)
#define P_LOAD_KT(R, c_, js_) do { const int sk_ = (int)((((size_t)bh * DK) * SP + 128 * (c_) + (js_) * 64) * 2); _Pragma("unroll") for (int u = 0; u < 4; ++u) \
        R[u] = __builtin_amdgcn_raw_buffer_load_b128(rsK, voT, sk_ + (u * 64 * SP) * 2, 0); } while (0)
#define P_STORE_QP(R, BUF) do { _Pragma("unroll") for (int u = 0; u < 4; ++u) *(LAS u32x4*)((BUF) + (u >> 1) * 16384 + (u & 1) * 8192 + lbase) = R[u]; } while (0)
#define P_STORE_V(R) do { _Pragma("unroll") for (int u = 0; u < 2; ++u) *(LAS u32x4*)(VTS + u * 8192 + lbase) = R[4 + u]; } while (0)
#define P_STORE_KT(R, BUF, js_) do { _Pragma("unroll") for (int u = 0; u < 4; ++u) { float x[8]; unpack8(make_uint4(R[u].x, R[u].y, R[u].z, R[u].w), x); \
        _Pragma("unroll") for (int q = 0; q < 8; ++q) x[q] *= kap[(js_) * 64 + tc * 8 + q]; const uint4 pk_ = pack8(x); u32x4 t_; t_.x = pk_.x; t_.y = pk_.y; t_.z = pk_.z; t_.w = pk_.w; \
        *(LAS u32x4*)((BUF) + u * 8192 + lbase) = t_; } } while (0)
#define P_MMA_Q(BUF, kbh_) do { _Pragma("unroll") for (int sl = 0; sl < 2; ++sl) mma_slab<2, 2>(acc, CST + ((kbh_) * 2 + sl) * 8192, 32 * wm, (BUF) + sl * 16384, 32 * wn, lane); } while (0)
#define P_MMA_P(BUF) do { _Pragma("unroll") for (int js = 0; js < 2; ++js) mma_slab<2, 2>(acc, VTS + js * 8192, 32 * wm, (BUF) + js * 16384, 32 * wn, lane); } while (0)
#define P_MMA_KT(BUF, js_) do { _Pragma("unroll") for (int ks = 0; ks < 2; ++ks) { bf16x8 af[2], bfr[4]; \
        _Pragma("unroll") for (int tm = 0; tm < 2; ++tm) af[tm] = lds_frag((BUF), 32 * wave + 16 * tm + (lane & 15), (lane >> 4) + 4 * ks); \
        _Pragma("unroll") for (int tn = 0; tn < 4; ++tn) bfr[tn] = lds_frag(VTS + (js_) * 8192, 16 * tn + (lane & 15), (lane >> 4) + 4 * ks); \
        _Pragma("unroll") for (int tm = 0; tm < 2; ++tm) _Pragma("unroll") for (int tn = 0; tn < 4; ++tn) Cacc[tm][tn] = __builtin_amdgcn_mfma_f32_16x16x32_bf16(af[tm], bfr[tn], Cacc[tm][tn], 0, 0, 0); } } while (0)
#define P_STEP(BX, BY, step) { \
        const int c = dir ? ord_b(step) : step; \
        const int cn = (step + 1 < NCH) ? (dir ? ord_b(step + 1) : step + 1) : c; \
        const int cnn = (step + 2 < NCH) ? (dir ? ord_b(step + 2) : step + 2) : cn; \
        const size_t r0 = (size_t)bl_ * SP + 128 * c; \
        f32x4 acc[2][2]; \
        _Pragma("unroll") for (int x = 0; x < 2; ++x) _Pragma("unroll") for (int y = 0; y < 2; ++y) acc[x][y] = (f32x4){0.f, 0.f, 0.f, 0.f}; \
        wg_sync(); P_STORE_QP(RQb, BY); P_LOAD_Q(RQb, cn, 1); P_MMA_Q(BX, 0); \
        wg_sync(); P_STORE_QP(RP, BX); P_STORE_V(RP); P_LOAD_PV(RP, cn); P_MMA_Q(BY, 1); \
        mfma_drain(); \
        _Pragma("unroll") for (int ti = 0; ti < 2; ++ti) { const float r = rho[32 * wn + 16 * ti + (lane & 15)]; _Pragma("unroll") for (int tm = 0; tm < 2; ++tm) acc[tm][ti] *= r; } \
        wg_sync(); P_STORE_KT(RK0, BY, 0); P_LOAD_KT(RK0, cn, 0); P_MMA_P(BX); \
        mfma_drain(); \
        _Pragma("unroll") for (int ti = 0; ti < 2; ++ti) { const int i = 32 * wn + 16 * ti + (lane & 15); \
            _Pragma("unroll") for (int tm = 0; tm < 2; ++tm) { const f32x4 v = acc[tm][ti]; u32x2 w; w.x = pk2(v[0], v[1]); w.y = pk2(v[2], v[3]); \
                *(u32x2*)(Od + (r0 + i) * 2048 + h * 512 + n0 + 32 * wm + 16 * tm + 4 * (lane >> 4)) = w; } } \
        _Pragma("unroll") for (int tm = 0; tm < 2; ++tm) _Pragma("unroll") for (int tn = 0; tn < 4; ++tn) Cacc[tm][tn] *= delta; \
        wg_sync(); P_STORE_KT(RK1, BX, 1); P_LOAD_KT(RK1, cn, 1); P_MMA_KT(BY, 0); \
        wg_sync(); P_STORE_QP(RQa, BY); P_LOAD_Q(RQa, cnn, 0); P_MMA_KT(BX, 1); \
        mfma_drain(); \
        _Pragma("unroll") for (int tm = 0; tm < 2; ++tm) { const int d0 = 32 * wave + 16 * tm + 4 * (lane >> 4); \
            _Pragma("unroll") for (int tn = 0; tn < 4; ++tn) { const f32x4 v = Cacc[tm][tn]; u32x2 w; w.x = pk2(v[0], v[1]); w.y = pk2(v[2], v[3]); const int n = 16 * tn + (lane & 15); \
                *(LAS u32x2*)(CST + (d0 >> 6) * 8192 + SLABOFF(n, (d0 & 63) >> 3) + (d0 & 7) * 2) = w; } } \
    }
    { const int c0 = dir ? ord_b(0) : 0, c1 = dir ? ord_b(1) : 1; P_LOAD_Q(RQa, c0, 0); P_LOAD_Q(RQb, c0, 1); P_LOAD_PV(RP, c0); P_LOAD_KT(RK0, c0, 0); P_LOAD_KT(RK1, c0, 1); wg_sync(); P_STORE_QP(RQa, BUFA); P_LOAD_Q(RQa, c1, 0); }
    for (int step2 = 0; step2 < NCH; step2 += 2) { P_STEP(BUFA, BUFB, step2) P_STEP(BUFB, BUFA, (step2 + 1)) }
#undef P_STEP
#undef P_LOAD_Q
#undef P_LOAD_PV
#undef P_LOAD_KT
#undef P_STORE_QP
#undef P_STORE_V
#undef P_STORE_KT
#undef P_MMA_Q
#undef P_MMA_P
#undef P_MMA_KT
}

PHASE_FN void phase_s2w(ChunkArgs a, LAS unsigned char* L, int bid, int nb) {
    constexpr int DK = 256;
    const int tid = tid_opq(), lane = tid & 63, wave = __builtin_amdgcn_readfirstlane(tid >> 6), wm = wave & 3, wn = wave >> 2;
    if (bid >= 128) return;
    const int xq = bid & 7, tt = bid >> 3, gI = xq + 8 * (tt >> 2), slice = tt & 3, bh = gI >> 1, dir = gI & 1, h = bh & 3, bl_ = bh >> 2, n0 = 128 * slice;
    LAS unsigned char* BUF = L;
    LAS unsigned char* VTS = L + 32768;
    LAS unsigned char* CST = L + 65536;
    LAS float* rho = (LAS float*)(L + 131072); LAS float* kap = rho + 128;
    for (int i = tid; i < 4 * 16384 / 16; i += NTHR) ((LAS u32x4*)CST)[i] = (u32x4){0u, 0u, 0u, 0u};
    const float lg = log2_gamma(a.decay[dir * 4 + h]); const float delta = exp2f(128.f * lg);
    if (tid < 128) { const int i = tid; rho[i] = dir ? exp2f(-(float)i * lg) : exp2f((float)(i - 127) * lg); kap[i] = dir ? exp2f((float)i * lg) : exp2f((float)(127 - i) * lg); }
    f32x4 Cacc[2][8];
#pragma unroll
    for (int tm = 0; tm < 2; ++tm)
#pragma unroll
        for (int tn = 0; tn < 8; ++tn) Cacc[tm][tn] = (f32x4){0.f, 0.f, 0.f, 0.f};
    bf16_t* Od = dir ? a.Ob : a.Of;
    const __amdgpu_buffer_rsrc_t rsQ = __builtin_amdgcn_make_buffer_rsrc((void*)a.qsrc, 0, 0x7fffffff, 0x00020000), rsP = __builtin_amdgcn_make_buffer_rsrc((void*)a.P, 0, 0x7fffffff, 0x00020000);
    const __amdgpu_buffer_rsrc_t rsV = __builtin_amdgcn_make_buffer_rsrc((void*)a.Vt, 0, 0x7fffffff, 0x00020000), rsK = __builtin_amdgcn_make_buffer_rsrc((void*)a.Kt, 0, 0x7fffffff, 0x00020000);
    const int tr = tid >> 3, tc = tid & 7;
    const int voQ = (tr * 1024 + tc * 8) * 2, voP = (tr * 128 + tc * 8) * 2, voT = (tr * SP + tc * 8) * 2;
    const int lbase = SLABOFF(tr, tc);
    u32x4 RA[4], RB[4], RC[4];
#define W_LOAD_Q(R, c_, kbh_) do { const int sb_ = (int)((((size_t)bl_ * SP + 128 * (c_)) * 1024 + h * DK + (kbh_) * 128) * 2); _Pragma("unroll") for (int u = 0; u < 4; ++u) \
        R[u] = __builtin_amdgcn_raw_buffer_load_b128(rsQ, voQ, sb_ + (64 * (u & 1) * 1024 + (u >> 1) * 64) * 2, 0); } while (0)
#define W_LOAD_P(R, c_) do { const int sp_ = (int)((((size_t)(dir * 16 + bh) * NCH + (c_)) * 16384) * 2); \
        _Pragma("unroll") for (int u = 0; u < 4; ++u) R[u] = __builtin_amdgcn_raw_buffer_load_b128(rsP, voP, sp_ + ((u & 1) * 64 * 128 + (u >> 1) * 64) * 2, 0); } while (0)
#define W_LOAD_V(R, c_) do { const int sv_ = (int)((((size_t)bh * 512 + n0) * SP + 128 * (c_)) * 2); \
        _Pragma("unroll") for (int u = 0; u < 4; ++u) R[u] = __builtin_amdgcn_raw_buffer_load_b128(rsV, voT, sv_ + ((u & 1) * 64 * SP + (u >> 1) * 64) * 2, 0); } while (0)
#define W_LOAD_KT(R, c_, js_) do { const int sk_ = (int)((((size_t)bh * DK) * SP + 128 * (c_) + (js_) * 64) * 2); _Pragma("unroll") for (int u = 0; u < 4; ++u) \
        R[u] = __builtin_amdgcn_raw_buffer_load_b128(rsK, voT, sk_ + (u * 64 * SP) * 2, 0); } while (0)
#define W_STORE_2S(R, DST) do { _Pragma("unroll") for (int u = 0; u < 4; ++u) *(LAS u32x4*)((DST) + (u >> 1) * 16384 + (u & 1) * 8192 + lbase) = R[u]; } while (0)
#define W_STORE_KT(R, js_) do { _Pragma("unroll") for (int u = 0; u < 4; ++u) *(LAS u32x4*)(BUF + u * 8192 + lbase) = R[u]; } while (0)
#define W_STORE_VS(R) do { _Pragma("unroll") for (int u = 0; u < 4; ++u) { float x[8]; unpack8(make_uint4(R[u].x, R[u].y, R[u].z, R[u].w), x); \
        _Pragma("unroll") for (int q = 0; q < 8; ++q) x[q] *= kap[(u >> 1) * 64 + tc * 8 + q]; const uint4 pk_ = pack8(x); u32x4 t_; t_.x = pk_.x; t_.y = pk_.y; t_.z = pk_.z; t_.w = pk_.w; \
        *(LAS u32x4*)(VTS + (u >> 1) * 16384 + (u & 1) * 8192 + lbase) = t_; } } while (0)
#define W_MMA_Q(kbh_) do { _Pragma("unroll") for (int sl = 0; sl < 2; ++sl) mma_slab<2, 4>(acc, CST + ((kbh_) * 2 + sl) * 16384, 32 * wm, BUF + sl * 16384, 64 * wn, lane); } while (0)
#define W_MMA_P() do { _Pragma("unroll") for (int js = 0; js < 2; ++js) mma_slab<2, 4>(acc, VTS + js * 16384, 32 * wm, BUF + js * 16384, 64 * wn, lane); } while (0)
#define W_MMA_KT(js_) do { _Pragma("unroll") for (int ks = 0; ks < 2; ++ks) { bf16x8 af[2]; \
        _Pragma("unroll") for (int tm = 0; tm < 2; ++tm) af[tm] = lds_frag(BUF, 32 * wave + 16 * tm + (lane & 15), (lane >> 4) + 4 * ks); \
        _Pragma("unroll") for (int tn = 0; tn < 8; ++tn) { const bf16x8 bfr = lds_frag(VTS + (js_) * 16384, 16 * tn + (lane & 15), (lane >> 4) + 4 * ks); \
            _Pragma("unroll") for (int tm = 0; tm < 2; ++tm) Cacc[tm][tn] = __builtin_amdgcn_mfma_f32_16x16x32_bf16(af[tm], bfr, Cacc[tm][tn], 0, 0, 0); } } } while (0)
    { const int c0 = dir ? ord_b(0) : 0; W_LOAD_Q(RA, c0, 0); W_LOAD_Q(RB, c0, 1); W_LOAD_P(RC, c0); }
    for (int step = 0; step < NCH; ++step) {
        const int c = dir ? ord_b(step) : step;
        const int cn = (step + 1 < NCH) ? (dir ? ord_b(step + 1) : step + 1) : c;
        const size_t r0 = (size_t)bl_ * SP + 128 * c;
        f32x4 acc[2][4];
#pragma unroll
        for (int x = 0; x < 2; ++x)
#pragma unroll
            for (int y = 0; y < 4; ++y) acc[x][y] = (f32x4){0.f, 0.f, 0.f, 0.f};
        wg_sync(); W_STORE_2S(RA, BUF); W_LOAD_V(RA, c); wg_sync(); W_MMA_Q(0);
        wg_sync(); W_STORE_2S(RB, BUF); W_LOAD_KT(RB, c, 0); wg_sync(); W_MMA_Q(1);
        mfma_drain();
#pragma unroll
        for (int ti = 0; ti < 4; ++ti) {
#pragma unroll
            for (int tm = 0; tm < 2; ++tm) acc[tm][ti] *= delta; }
        wg_sync(); W_STORE_2S(RC, BUF); W_STORE_VS(RA); W_LOAD_KT(RC, c, 1); W_LOAD_Q(RA, cn, 0); wg_sync(); W_MMA_P();
        mfma_drain();
#pragma unroll
        for (int tp = 0; tp < 2; ++tp) { const int g = lane >> 4; const int ia = 64 * wn + 32 * tp + (lane & 15), ib = ia + 16; const float rsa = rho[ia], rsb = rho[ib]; const int irow = (g & 1) ? ib : ia;
            unsigned ax[2], ay[2], bx[2], by[2];
#pragma unroll
            for (int tm = 0; tm < 2; ++tm) { const f32x4 va = acc[tm][2 * tp] * rsa, vb = acc[tm][2 * tp + 1] * rsb;
                ax[tm] = pk2(va[0], va[1]); ay[tm] = pk2(va[2], va[3]); bx[tm] = pk2(vb[0], vb[1]); by[tm] = pk2(vb[2], vb[3]); }
            mfma_drain();
#pragma unroll
            for (int tm = 0; tm < 2; ++tm) {
                const auto sx = __builtin_amdgcn_permlane16_swap(ax[tm], bx[tm], false, false), sy = __builtin_amdgcn_permlane16_swap(ay[tm], by[tm], false, false);
                u32x4 w; w.x = sx[0]; w.y = sy[0]; w.z = sx[1]; w.w = sy[1];
                *(u32x4*)(Od + (r0 + irow) * 2048 + h * 512 + n0 + 32 * wm + 16 * tm + 4 * (g & ~1)) = w; } }
#pragma unroll
        for (int tm = 0; tm < 2; ++tm)
#pragma unroll
            for (int tn = 0; tn < 8; ++tn) Cacc[tm][tn] *= delta;
        wg_sync(); W_STORE_KT(RB, 0); W_LOAD_Q(RB, cn, 1); wg_sync(); W_MMA_KT(0);
        wg_sync(); W_STORE_KT(RC, 1); W_LOAD_P(RC, cn); wg_sync(); W_MMA_KT(1);
        mfma_drain();
#pragma unroll
        for (int tm = 0; tm < 2; ++tm) { const int d0 = 32 * wave + 16 * tm + 4 * (lane >> 4);
#pragma unroll
            for (int tn = 0; tn < 8; ++tn) { const f32x4 v = Cacc[tm][tn]; u32x2 w; w.x = pk2(v[0], v[1]); w.y = pk2(v[2], v[3]); const int n = 16 * tn + (lane & 15);
                *(LAS u32x2*)(CST + (d0 >> 6) * 16384 + SLABOFF(n, (d0 & 63) >> 3) + (d0 & 7) * 2) = w; } }
    }
#undef W_LOAD_Q
#undef W_LOAD_P
#undef W_LOAD_V
#undef W_LOAD_KT
#undef W_STORE_2S
#undef W_STORE_KT
#undef W_STORE_VS
#undef W_MMA_Q
#undef W_MMA_P
#undef W_MMA_KT
}

PHASE_FN void phase_fin_ret(const bf16_t* Of, const bf16_t* Ob, const bf16_t* G, bf16_t* Dst, int last, int bid, int nb) {
    const int tid = tid_opq(), lane = tid & 63, wv = tid >> 6;
    for (int r = bid * 8 + wv; r < NH; r += nb * 8) {
        if (last && (r % SP) < CTXL) continue;
        const size_t base = (size_t)r * 2048 + (lane >> 4) * 512 + (lane & 15) * 8;
        float o[32]; float ss = 0.f;
#pragma unroll
        for (int u = 0; u < 4; ++u) { float a[8], b[8]; unpack8(*(const uint4*)(Of + base + u * 128), a); unpack8(*(const uint4*)(Ob + base + u * 128), b);
#pragma unroll
            for (int e = 0; e < 8; ++e) { o[8 * u + e] = a[e] + b[e]; ss += o[8 * u + e] * o[8 * u + e]; } }
        ss = red16(ss);
        const float rn = rsqrtf(ss * (1.f / 512.f) + 1e-6f);
#pragma unroll
        for (int u = 0; u < 4; ++u) { float g[8], w[8]; unpack8(*(const uint4*)(G + base + u * 128), g);
#pragma unroll
            for (int e = 0; e < 8; ++e) w[e] = siluf(g[e]) * o[8 * u + e] * rn;
            *(uint4*)(Dst + base + u * 128) = pack8(w); }
    }
}
PHASE_FN void phase_fin_ml(const bf16_t* Of, const bf16_t* Ob, const bf16_t* XC, bf16_t* Z, const float* gng, const float* skip, int bid, int nb) {
    const int tid = tid_opq(), lane = tid & 63, wv = tid >> 6;
    const int cb = (lane >> 4) * 512 + (lane & 15) * 8;
    float4 gq[8], kq[8];
#pragma unroll
    for (int u = 0; u < 4; ++u) { gq[2 * u] = *(const float4*)(gng + cb + u * 128); gq[2 * u + 1] = *(const float4*)(gng + cb + u * 128 + 4); kq[2 * u] = *(const float4*)(skip + cb + u * 128); kq[2 * u + 1] = *(const float4*)(skip + cb + u * 128 + 4); }
    for (int r = bid * 8 + wv; r < NH; r += nb * 8) {
        const size_t base = (size_t)r * 2048 + cb;
        float o[32]; float s1 = 0.f;
#pragma unroll
        for (int u = 0; u < 4; ++u) { float a[8], b[8]; unpack8(*(const uint4*)(Of + base + u * 128), a); unpack8(*(const uint4*)(Ob + base + u * 128), b);
#pragma unroll
            for (int e = 0; e < 8; ++e) { o[8 * u + e] = a[e] + b[e]; s1 += o[8 * u + e]; } }
#pragma unroll
        for (int m = 8; m >= 1; m >>= 1) s1 += __shfl_xor(s1, m);
        const float mu = s1 * (1.f / 512.f); float s2 = 0.f;
#pragma unroll
        for (int e = 0; e < 32; ++e) { const float d = o[e] - mu; s2 += d * d; }
#pragma unroll
        for (int m = 8; m >= 1; m >>= 1) s2 += __shfl_xor(s2, m);
        const float rn = rsqrtf(s2 * (1.f / 512.f) + LN_EPS);
#pragma unroll
        for (int u = 0; u < 4; ++u) { float z[8], xc[8], w[8]; unpack8(*(const uint4*)(Z + base + u * 128), z); unpack8(*(const uint4*)(XC + base + u * 128), xc);
            const float4 g0 = gq[2 * u], g1 = gq[2 * u + 1], k0 = kq[2 * u], k1 = kq[2 * u + 1];
            const float gg[8] = {g0.x, g0.y, g0.z, g0.w, g1.x, g1.y, g1.z, g1.w}, kk[8] = {k0.x, k0.y, k0.z, k0.w, k1.x, k1.y, k1.z, k1.w};
#pragma unroll
            for (int e = 0; e < 8; ++e) w[e] = ((o[8 * u + e] - mu) * rn * gg[e] + kk[e] * xc[e]) * siluf(z[e]);
            *(uint4*)(Z + base + u * 128) = pack8(w); }
    }
}

PHASE_FN void phase_mlprep(const bf16_t* XM, bf16_t* XCONV, const bf16_t* Gt, const float* convw, const float* convb, const float* gateb,
                           float* gG, float* gPM, float* gB, float* cBL, float* cPML, LAS unsigned char* L, int bid, int nb) {
    const int tid = tid_opq(), lane = tid & 63, wave = __builtin_amdgcn_readfirstlane(tid >> 6);
    LAS unsigned char* XMS = L; LAS unsigned char* XCS = L + 16896; LAS unsigned char* GT1 = L + 33280; LAS unsigned char* GT2 = L + 35328; LAS float* GOUT = (LAS float*)(L + 37376);
    LAS float* CW = (LAS float*)(L + 45568);
    for (int i = tid; i < 2048; i += NTHR) { *(LAS f32x4*)(CW + 4 * i) = (i < 1536) ? *(const f32x4*)(convw + 4 * i) : *(const f32x4*)(convb + 4 * (i - 1536)); }
    const int tr = tid >> 3, tc = tid & 7;
    for (int item = bid; item < 4 * NCH; item += nb) {
        const int bl_ = item / NCH, c = item - bl_ * NCH; const size_t r0 = (size_t)bl_ * SP + 128 * c;
        const bool has_prev = (c != 0 && c != 2), has_next = (c != 1 && c != NCH - 1);
        f32x4 acc[1][1]; acc[0][0] = (f32x4){0.f, 0.f, 0.f, 0.f};
        uint4 RX[3], RGt[2];
#define MLP_LOAD(cs_) do { _Pragma("unroll") for (int u = 0; u < 3; ++u) { const int e = tid + 512 * u; RX[u] = make_uint4(0u, 0u, 0u, 0u); if (e < 1040) { const int tr_ = (e >> 3) - 1; \
            const bool ok = (tr_ >= 0 && tr_ < 128) || (tr_ < 0 && has_prev) || (tr_ >= 128 && has_next); if (ok) RX[u] = *(const uint4*)(XM + (size_t)((long)r0 + tr_) * 2048 + (cs_) * 64 + (e & 7) * 8); } } \
            if (tid < 128) { RGt[0] = *(const uint4*)(Gt + (size_t)tr * 4096 + (cs_) * 64 + tc * 8); RGt[1] = *(const uint4*)(Gt + (size_t)tr * 4096 + 2048 + (cs_) * 64 + tc * 8); } } while (0)
        MLP_LOAD(0);
        for (int cs = 0; cs < 32; ++cs) {
            wg_sync();
#pragma unroll
            for (int u = 0; u < 3; ++u) { const int e = tid + 512 * u; if (e < 1040) lds_st16(XMS, e >> 3, e & 7, RX[u]); }
            if (tid < 128) { lds_st16(GT1, tr, tc, RGt[0]); lds_st16(GT2, tr, tc, RGt[1]); }
            { const int cn = (cs + 1 < 32) ? cs + 1 : cs; MLP_LOAD(cn); }
            wg_sync();
#pragma unroll
            for (int u = 0; u < 2; ++u) { const int e = tid + 512 * u, row = e >> 3, ch = e & 7, cg = cs * 64 + ch * 8; float xa[8], xb[8], xc[8], o[8];
                unpack8(lds_ld16(XMS, row, ch), xa); unpack8(lds_ld16(XMS, row + 1, ch), xb); unpack8(lds_ld16(XMS, row + 2, ch), xc);
#pragma unroll
                for (int q4 = 0; q4 < 2; ++q4) { const f32x4 wb_ = *(const LAS f32x4*)(CW + 6144 + cg + 4 * q4), w0_ = *(const LAS f32x4*)(CW + cg + 4 * q4), w1_ = *(const LAS f32x4*)(CW + 2048 + cg + 4 * q4), w2_ = *(const LAS f32x4*)(CW + 4096 + cg + 4 * q4);
#pragma unroll
                    for (int qq = 0; qq < 4; ++qq) { const int q = 4 * q4 + qq; const float pre = wb_[qq] + w0_[qq] * xa[q] + w1_[qq] * xb[q] + w2_[qq] * xc[q]; o[q] = siluf(pre); } }
                const uint4 pk = pack8(o); lds_st16(XCS, row, ch, pk); *(uint4*)(XCONV + (r0 + row) * 2048 + cg) = pk; }
            wg_sync();
            mma_slab<1, 1>(acc, XCS, 16 * wave, GT1, 0, lane);
            mma_slab<1, 1>(acc, XMS, 16 * wave + 1, GT2, 0, lane);
        }
#undef MLP_LOAD
        mfma_drain();
        { const int o = lane & 15;
#pragma unroll
            for (int e = 0; e < 4; ++e) GOUT[(16 * wave + 4 * (lane >> 4) + e) * 16 + o] = acc[0][0][e] + gateb[o]; }
        wg_sync();
        { const int d = wave >> 2, hh = wave & 3, bh = bl_ * 4 + hh;
            const int u0 = 2 * lane, u1 = u0 + 1, t0 = d ? 127 - u0 : u0, t1 = d ? 127 - u1 : u1;
            const float i0 = GOUT[t0 * 16 + d * 8 + hh], i1 = GOUT[t1 * 16 + d * 8 + hh], f0 = GOUT[t0 * 16 + d * 8 + 4 + hh], f1 = GOUT[t1 * 16 + d * 8 + 4 + hh];
            const float l0 = fminf(f0, 0.f) - log1pf(__expf(-fabsf(f0))), l1 = fminf(f1, 0.f) - log1pf(__expf(-fabsf(f1)));
            float tot = l0 + l1, inc = tot;
#pragma unroll
            for (int s = 1; s < 64; s <<= 1) { const float v = __shfl_up(inc, s); if (lane >= s) inc += v; }
            const float off = inc - tot, b0 = off + l0, b1 = off + l0 + l1, g0 = i0 - b0, g1 = i1 - b1;
            float pmx = fmaxf(g0, g1), pinc = pmx;
#pragma unroll
            for (int s = 1; s < 64; s <<= 1) { const float v = __shfl_up(pinc, s); if (lane >= s) pinc = fmaxf(pinc, v); }
            float pexc = __shfl_up(pinc, 1); if (lane == 0) pexc = -3.0e38f;
            const float pm0 = fmaxf(pexc, g0), pm1 = fmaxf(pexc, pmx);
            const size_t gb = ((size_t)d * 16 + bh) * SP + 128 * c;
            gG[gb + t0] = g0; gG[gb + t1] = g1; gPM[gb + t0] = pm0; gPM[gb + t1] = pm1; gB[gb + t0] = b0; gB[gb + t1] = b1;
            if (lane == 63) { cBL[(d * 16 + bh) * NCH + c] = b1; cPML[(d * 16 + bh) * NCH + c] = pm1; } }
    }
}

PHASE_FN void phase_rkmix(const bf16_t* H, bf16_t* A2, int bid, int nb) {
    const int tid = tid_opq(), lane = tid & 63, wv = tid >> 6;
    for (int R = bid * 8 + wv; R < NTOK; R += nb * 8) {
        const int b = R / SP, s = R - b * SP;
#pragma unroll
        for (int u = 0; u < 2; ++u) { const int c = 8 * lane + 512 * u; int src = -1;
            if (s < CTXL) { if (u == 0) { if (s > 0) src = R - 1; } else { if (s < CTXL - 1) src = R + 1; } }
            else { const int t = s - CTXL, row = t >> 6, col = t & 63, qd = c >> 8;
                if (qd == 0) { if (col > 0) src = R - 1; } else if (qd == 1) { if (col < 63) src = R + 1; } else if (qd == 2) { if (row > 0) src = R - 64; } else { if (row < 63) src = R + 64; } }
            const uint4 hv = *(const uint4*)(H + (size_t)R * DM + c); uint4 sv = make_uint4(0u, 0u, 0u, 0u); if (src >= 0) sv = *(const uint4*)(H + (size_t)src * DM + c);
            *(uint4*)(A2 + (size_t)R * 2048 + c) = hv; *(uint4*)(A2 + (size_t)R * 2048 + 1024 + c) = sv; }
    }
}

PHASE_FN void phase_rkmix2(const bf16_t* H, bf16_t* X2, const float* mix, int j1, int j2, int bid, int nb) {
    const int tid = tid_opq(), lane = tid & 63, wv = tid >> 6;
    float4 mq[2][4];
#pragma unroll
    for (int u = 0; u < 2; ++u) { const int c = 8 * lane + 512 * u; mq[u][0] = *(const float4*)(mix + j1 * 1024 + c); mq[u][1] = *(const float4*)(mix + j1 * 1024 + c + 4); mq[u][2] = *(const float4*)(mix + j2 * 1024 + c); mq[u][3] = *(const float4*)(mix + j2 * 1024 + c + 4); }
    for (int R = bid * 8 + wv; R < NTOK; R += nb * 8) {
        const int b = R / SP, s = R - b * SP;
#pragma unroll
        for (int u = 0; u < 2; ++u) { const int c = 8 * lane + 512 * u; int src = -1;
            if (s < CTXL) { if (u == 0) { if (s > 0) src = R - 1; } else { if (s < CTXL - 1) src = R + 1; } }
            else { const int t = s - CTXL, row = t >> 6, col = t & 63, qd = c >> 8;
                if (qd == 0) { if (col > 0) src = R - 1; } else if (qd == 1) { if (col < 63) src = R + 1; } else if (qd == 2) { if (row > 0) src = R - 64; } else { if (row < 63) src = R + 64; } }
            float hv[8], sv[8], o1[8], o2[8]; unpack8(*(const uint4*)(H + (size_t)R * DM + c), hv);
            if (src >= 0) unpack8(*(const uint4*)(H + (size_t)src * DM + c), sv); else {
#pragma unroll
                for (int e = 0; e < 8; ++e) sv[e] = 0.f; }
            const float4 m1a = mq[u][0], m1b = mq[u][1], m2a = mq[u][2], m2b = mq[u][3];
            const float m1[8] = {m1a.x, m1a.y, m1a.z, m1a.w, m1b.x, m1b.y, m1b.z, m1b.w}, m2[8] = {m2a.x, m2a.y, m2a.z, m2a.w, m2b.x, m2b.y, m2b.z, m2b.w};
#pragma unroll
            for (int e = 0; e < 8; ++e) { const float xx = sv[e] - hv[e]; o1[e] = hv[e] + xx * m1[e]; o2[e] = hv[e] + xx * m2[e]; }
            *(uint4*)(X2 + (size_t)R * DM + c) = pack8(o1); *(uint4*)(X2 + ((size_t)NTOK + R) * DM + c) = pack8(o2); }
    }
}

PHASE_FN void phase_rkscan(const bf16_t* Rr, const bf16_t* Kk, const bf16_t* Vv, const bf16_t* T, const float* w0, const float* w2, const float* a0, const float* a2,
                           const float* k_k, const float* k_a, const float* r_k, bf16_t* Yf, bf16_t* Yb, float* bon, LAS unsigned char* L, int bid, int nb) {
    if (bid >= 256) return;
    const int tid = tid_opq(), lane = tid & 63, wave = __builtin_amdgcn_readfirstlane(tid >> 6);
    const int b = bid >> 5, h = (bid >> 1) & 15, d = bid & 1;
    LAS float* WB = (LAS float*)L; LAS float* AD = WB + 2048; LAS float* RB = AD + 2048; LAS float* KD = RB + 2048; LAS float* VB = KD + 2048; LAS float* AB = VB + 2048; LAS float* BB = AB + 2048; LAS float* YB = BB + 2048;
    bf16_t* Y = d ? Yb : Yf;
    const int tt = wave >> 2, ct = wave & 3;
    bf16x8 bw[2], ba[2];
#pragma unroll
    for (int ks = 0; ks < 2; ++ks) { float fw[8], fa[8];
#pragma unroll
        for (int j = 0; j < 8; ++j) { const int m = 8 * (lane >> 4) + j + 32 * ks, cc = 64 * h + 16 * ct + (lane & 15); fw[j] = w2[((size_t)d * 64 + m) * 1024 + cc]; fa[j] = a2[((size_t)d * 64 + m) * 1024 + cc]; }
        const uint4 pw = pack8(fw), pa = pack8(fa); bw[ks] = *(const bf16x8*)&pw; ba[ks] = *(const bf16x8*)&pa; }
    const int cch = 64 * h + 16 * ct + (lane & 15);
    const float w0c = w0[d * 1024 + cch], a0c = a0[d * 1024 + cch];
    const int etok = tid >> 4, ecg = tid & 15, ec = 64 * h + 4 * ecg;
    const float4 kk4 = *(const float4*)(k_k + ec), ka4 = *(const float4*)(k_a + ec), rk4 = *(const float4*)(r_k + ec);
    const int pr = tid >> 4, rq = tid & 15;
    float S[2][4];
#pragma unroll
    for (int r = 0; r < 2; ++r)
#pragma unroll
        for (int e = 0; e < 4; ++e) S[r][e] = 0.f;
#define RK_SLO(kb_) (d ? ((kb_) < 8 ? CTXL - 32 * ((kb_) + 1) : SP - 32 * ((kb_) - 8 + 1)) : 32 * (kb_))
    uint4 tw[2], ta[2]; u32x2 rw, kw, vw;
#define RK_GLOAD(kb_) do { const size_t Rn_ = (size_t)b * SP + RK_SLO(kb_); const bf16_t* trow_ = T + (Rn_ + 16 * tt + (lane & 15)) * 256 + 8 * (lane >> 4); \
        _Pragma("unroll") for (int ks = 0; ks < 2; ++ks) { tw[ks] = *(const uint4*)(trow_ + 64 * d + 32 * ks); ta[ks] = *(const uint4*)(trow_ + 128 + 64 * d + 32 * ks); } \
        const size_t g_ = (Rn_ + etok) * 1024 + ec; rw = *(const u32x2*)(Rr + g_); kw = *(const u32x2*)(Kk + g_); vw = *(const u32x2*)(Vv + g_); } while (0)
    RK_GLOAD(0);
    for (int kb = 0; kb < SP / 32; ++kb) {
        const int slo = RK_SLO(kb);
        const size_t Rb = (size_t)b * SP + slo;
        wg_sync();
        { f32x4 dw = (f32x4){0.f, 0.f, 0.f, 0.f}, da = (f32x4){0.f, 0.f, 0.f, 0.f};
#pragma unroll
            for (int ks = 0; ks < 2; ++ks) {
                dw = __builtin_amdgcn_mfma_f32_16x16x32_bf16(*(const bf16x8*)&tw[ks], bw[ks], dw, 0, 0, 0);
                da = __builtin_amdgcn_mfma_f32_16x16x32_bf16(*(const bf16x8*)&ta[ks], ba[ks], da, 0, 0, 0); }
            mfma_drain();
#pragma unroll
            for (int e = 0; e < 4; ++e) { const int tok = 16 * tt + 4 * (lane >> 4) + e, cc = 16 * ct + (lane & 15);
                const float x = -(w0c + dw[e]);
                const float sp = fmaxf(x, 0.f) + log1pf(__expf(-fabsf(x)));
                WB[tok * 64 + cc] = __expf(-__expf(-sp - 0.5f));
                AD[tok * 64 + cc] = sigmf(a0c + da[e]); } }
        const float r[4] = {bflo(rw.x), bfhi(rw.x), bflo(rw.y), bfhi(rw.y)}, k[4] = {bflo(kw.x), bfhi(kw.x), bflo(kw.y), bfhi(kw.y)}, v[4] = {bflo(vw.x), bfhi(vw.x), bflo(vw.y), bfhi(vw.y)};
        { const int kn = (kb + 1 < SP / 32) ? kb + 1 : kb; RK_GLOAD(kn); }
        wg_sync();
        {   const float kkc[4] = {kk4.x, kk4.y, kk4.z, kk4.w}, kac[4] = {ka4.x, ka4.y, ka4.z, ka4.w}, rkc[4] = {rk4.x, rk4.y, rk4.z, rk4.w};
            float kr[4], ss = 0.f;
#pragma unroll
            for (int e = 0; e < 4; ++e) { kr[e] = k[e] * kkc[e]; ss += kr[e] * kr[e]; }
            ss = red16(ss); const float inv = 1.f / fmaxf(sqrtf(ss), 1e-12f); float bs = 0.f;
#pragma unroll
            for (int e = 0; e < 4; ++e) { const int o = etok * 64 + 4 * ecg + e; const float ad = AD[o], kkn = kr[e] * inv, kd = k[e] * (1.f + (ad - 1.f) * kac[e]);
                RB[o] = r[e]; KD[o] = kd; VB[o] = v[e]; AB[o] = -kkn; BB[o] = kkn * ad; bs += r[e] * kd * rkc[e]; }
            bs = red16(bs); if (ecg == 0) bon[((size_t)d * NTOK + Rb + etok) * 16 + h] = bs; }
        wg_sync();
#define RK_LOAD(SET, u_) do { const int o_ = (u_) * 64 + 4 * rq; SET##a = *(const LAS f32x4*)(AB + o_); SET##w = *(const LAS f32x4*)(WB + o_); SET##k = *(const LAS f32x4*)(KD + o_); SET##b = *(const LAS f32x4*)(BB + o_); \
            SET##r = *(const LAS f32x4*)(RB + o_); SET##v = *(const LAS f32x2v*)(VB + (u_) * 64 + 2 * pr); } while (0)
#define RK_STEP(SET, u_) do { \
            const float sa0 = red16((S[0][0] * SET##a[0] + S[0][1] * SET##a[1]) + (S[0][2] * SET##a[2] + S[0][3] * SET##a[3])); \
            const float sa1 = red16((S[1][0] * SET##a[0] + S[1][1] * SET##a[1]) + (S[1][2] * SET##a[2] + S[1][3] * SET##a[3])); \
            _Pragma("unroll") for (int e = 0; e < 4; ++e) { S[0][e] = S[0][e] * SET##w[e] + sa0 * SET##b[e] + SET##v[0] * SET##k[e]; S[1][e] = S[1][e] * SET##w[e] + sa1 * SET##b[e] + SET##v[1] * SET##k[e]; } \
            const float y0 = red16((S[0][0] * SET##r[0] + S[0][1] * SET##r[1]) + (S[0][2] * SET##r[2] + S[0][3] * SET##r[3])); \
            const float y1 = red16((S[1][0] * SET##r[0] + S[1][1] * SET##r[1]) + (S[1][2] * SET##r[2] + S[1][3] * SET##r[3])); \
            if (rq == 0) { f32x2v yy; yy[0] = y0; yy[1] = y1; *(LAS f32x2v*)(YB + (u_) * 64 + 2 * pr) = yy; } } while (0)
        { f32x4 Aa, Aw, Ak, Ab, Ar, Ba, Bw, Bk, Bb, Br; f32x2v Av, Bv;
            RK_LOAD(A, d ? 31 : 0);
            for (int t2 = 0; t2 < 32; t2 += 2) { const int u0 = d ? 31 - t2 : t2, u1 = d ? 30 - t2 : t2 + 1, u2 = d ? (t2 + 2 < 32 ? 29 - t2 : 0) : (t2 + 2 < 32 ? t2 + 2 : 31);
                RK_LOAD(B, u1); RK_STEP(A, u0);
                RK_LOAD(A, u2); RK_STEP(B, u1); } }
#undef RK_LOAD
#undef RK_STEP
        wg_sync();
        { const int o = etok * 64 + 4 * ecg; u32x2 w; w.x = pk2(YB[o], YB[o + 1]); w.y = pk2(YB[o + 2], YB[o + 3]); *(u32x2*)(Y + (Rb + etok) * 1024 + ec) = w; }
    }
#undef RK_GLOAD
#undef RK_SLO
}

template <int CTRL> __device__ __forceinline__ float dppz(float v) { return __int_as_float(__builtin_amdgcn_update_dpp(0, __float_as_int(v), CTRL, 0xF, 0xF, true)); }
__device__ __forceinline__ unsigned short f2bf(float x) { return (unsigned short)(pk2(x, 0.f) & 0xffffu); }
PHASE_FN void phase_rkscan2(const bf16_t* Rr, const bf16_t* Kk, const bf16_t* Vv, const bf16_t* T, const float* w0, const float* w2, const float* a0, const float* a2,
                            const float* k_k, const float* k_a, const float* r_k, bf16_t* Yf, bf16_t* Yb, float* bon, LAS unsigned char* L, int bid, int nb, unsigned long long* prof = nullptr) {
    unsigned long long psec0 = 0, psec1 = 0, psec2 = 0, psec3 = 0, psec4 = 0, psec5 = 0, pt = 0;
#define PSTAMP(k) do { if (prof) { const unsigned long long n_ = clock64(); psec##k += n_ - pt; pt = n_; } } while (0)
    if (bid >= 256) return;
    const int tid = tid_opq(), lane = tid & 63, wave = __builtin_amdgcn_readfirstlane(tid >> 6);
    const int b = bid >> 5, h = (bid >> 1) & 15, d = bid & 1;
    LAS float* WB = (LAS float*)L; LAS float* AD = WB + 2112; LAS float* RB = AD + 2112; LAS float* KD = RB + 2112; LAS float* VB = KD + 2112; LAS float* AB = VB + 2112; LAS float* BB = AB + 2112;
    LAS float* YB = (LAS float*)(L + 121856);
    LAS unsigned char* AT = L + 65536; LAS unsigned char* RT = L + 70144; LAS unsigned char* BT = L + 74752; LAS unsigned char* KT = L + 79360;
    LAS unsigned char* BKt = L + 83968; LAS unsigned char* UVt = L + 94208;
    LAS unsigned char* SB = L + 104448;
    LAS unsigned char* ARK = L + 113664; LAS unsigned char* AK0 = L + 114944;
    LAS float* AAB = (LAS float*)(L + 116224); LAS float* XF = (LAS float*)(L + 117248); LAS float* GL = (LAS float*)(L + 121344);
    bf16_t* Y = d ? Yb : Yf;
    const int tt = wave >> 2, ct = wave & 3;
    bf16x8 bw[2], ba[2];
#pragma unroll
    for (int ks = 0; ks < 2; ++ks) { float fw[8], fa[8];
#pragma unroll
        for (int j = 0; j < 8; ++j) { const int m = 8 * (lane >> 4) + j + 32 * ks, cc = 64 * h + 16 * ct + (lane & 15); fw[j] = w2[((size_t)d * 64 + m) * 1024 + cc]; fa[j] = a2[((size_t)d * 64 + m) * 1024 + cc]; }
        const uint4 pw = pack8(fw), pa = pack8(fa); bw[ks] = *(const bf16x8*)&pw; ba[ks] = *(const bf16x8*)&pa; }
    const int cch = 64 * h + 16 * ct + (lane & 15);
    const float w0c = w0[d * 1024 + cch], a0c = a0[d * 1024 + cch];
    const int etok = tid >> 4, ecg = tid & 15, ec = 64 * h + 4 * ecg;
    const float4 kk4 = *(const float4*)(k_k + ec), ka4 = *(const float4*)(k_a + ec), rk4 = *(const float4*)(r_k + ec);
    for (int i = tid; i < (121856 - 83968) / 4; i += NTHR) ((LAS unsigned*)(L + 83968))[i] = 0u;
    f32x4 Sacc[2];
    Sacc[0] = (f32x4){0.f, 0.f, 0.f, 0.f}; Sacc[1] = (f32x4){0.f, 0.f, 0.f, 0.f};
#define RK_SLO(kb_) (d ? ((kb_) < 8 ? CTXL - 32 * ((kb_) + 1) : SP - 32 * ((kb_) - 8 + 1)) : 32 * (kb_))
    uint4 tw[2], ta[2]; u32x2 rw, kw, vw;
#define RK_GLOAD(kb_) do { const size_t Rn_ = (size_t)b * SP + RK_SLO(kb_); const bf16_t* trow_ = T + (Rn_ + 16 * tt + (lane & 15)) * 256 + 8 * (lane >> 4); \
        _Pragma("unroll") for (int ks = 0; ks < 2; ++ks) { tw[ks] = *(const uint4*)(trow_ + 64 * d + 32 * ks); ta[ks] = *(const uint4*)(trow_ + 128 + 64 * d + 32 * ks); } \
        const size_t g_ = (Rn_ + etok) * 1024 + ec; rw = *(const u32x2*)(Rr + g_); kw = *(const u32x2*)(Kk + g_); vw = *(const u32x2*)(Vv + g_); } while (0)
#define FRAG(base, row, pitchB, koffB) (*(const LAS bf16x8*)((base) + (row) * (pitchB) + (koffB) + (lane >> 4) * 16))
    RK_GLOAD(0);
    for (int kb = 0; kb < SP / 32; ++kb) {
        const int slo = RK_SLO(kb);
        const size_t Rb = (size_t)b * SP + slo;
        if (prof) pt = clock64();
        wg_sync();
        { f32x4 dw = (f32x4){0.f, 0.f, 0.f, 0.f}, da = (f32x4){0.f, 0.f, 0.f, 0.f};
#pragma unroll
            for (int ks = 0; ks < 2; ++ks) {
                dw = __builtin_amdgcn_mfma_f32_16x16x32_bf16(*(const bf16x8*)&tw[ks], bw[ks], dw, 0, 0, 0);
                da = __builtin_amdgcn_mfma_f32_16x16x32_bf16(*(const bf16x8*)&ta[ks], ba[ks], da, 0, 0, 0); }
            mfma_drain();
#pragma unroll
            for (int e = 0; e < 4; ++e) { const int tok = 16 * tt + 4 * (lane >> 4) + e, cc = 16 * ct + (lane & 15);
                const float x = -(w0c + dw[e]);
                const float sp = fmaxf(x, 0.f) + log1pf(__expf(-fabsf(x)));
                WB[tok * 65 + cc] = -__expf(-sp - 0.5f) * 1.4426950408889634f;
                AD[tok * 65 + cc] = sigmf(a0c + da[e]); } }
        const float r[4] = {bflo(rw.x), bfhi(rw.x), bflo(rw.y), bfhi(rw.y)}, k[4] = {bflo(kw.x), bfhi(kw.x), bflo(kw.y), bfhi(kw.y)}, v[4] = {bflo(vw.x), bfhi(vw.x), bflo(vw.y), bfhi(vw.y)};
        { const int kn = (kb + 1 < SP / 32) ? kb + 1 : kb; RK_GLOAD(kn); }
        wg_sync();
        {   const float kkc[4] = {kk4.x, kk4.y, kk4.z, kk4.w}, kac[4] = {ka4.x, ka4.y, ka4.z, ka4.w}, rkc[4] = {rk4.x, rk4.y, rk4.z, rk4.w};
            float kr[4], ss = 0.f;
#pragma unroll
            for (int e = 0; e < 4; ++e) { kr[e] = k[e] * kkc[e]; ss += kr[e] * kr[e]; }
            ss = red16(ss); const float inv = 1.f / fmaxf(sqrtf(ss), 1e-12f); float bs = 0.f;
#pragma unroll
            for (int e = 0; e < 4; ++e) { const int o = etok * 65 + 4 * ecg + e; const float ad = AD[o], kkn = kr[e] * inv, kd = k[e] * (1.f + (ad - 1.f) * kac[e]);
                RB[o] = r[e]; KD[o] = kd; VB[o] = v[e]; AB[o] = -kkn; BB[o] = kkn * ad; bs += r[e] * kd * rkc[e]; }
            bs = red16(bs); if (ecg == 0) bon[((size_t)d * NTOK + Rb + etok) * 16 + h] = bs; }
        wg_sync();
        PSTAMP(0);
        { const int kq = tid >> 4, t = tid & 15;
#pragma unroll
            for (int c = 0; c < 2; ++c) { const int u = d ? 31 - 16 * c - t : 16 * c + t;
#pragma unroll
                for (int hh = 0; hh < 2; ++hh) { const int kk = kq + 32 * hh, o = u * 65 + kk;
                    const float lw = WB[o]; float cs = lw;
                    cs += dppz<0x111>(cs); cs += dppz<0x112>(cs); cs += dppz<0x114>(cs); cs += dppz<0x118>(cs);
                    const float g = exp2f(cs), gp = exp2f(cs - lw), ig = exp2f(-cs);
                    const float av = AB[o] * gp, rv = RB[o] * g, bv = BB[o] * ig, kv = KD[o] * ig;
                    const int ro = c * 2304 + t * 144 + kk * 2;
                    *(LAS unsigned short*)(AT + ro) = f2bf(av); *(LAS unsigned short*)(RT + ro) = f2bf(rv); *(LAS unsigned short*)(BT + ro) = f2bf(bv); *(LAS unsigned short*)(KT + ro) = f2bf(kv);
                    *(LAS unsigned short*)(BKt + c * 5120 + kk * 80 + t * 2) = f2bf(bv); *(LAS unsigned short*)(BKt + c * 5120 + kk * 80 + 32 + t * 2) = f2bf(kv);
                    *(LAS unsigned short*)(UVt + c * 5120 + kk * 80 + 32 + t * 2) = f2bf(VB[o]);
                    if (t == 15) GL[c * 64 + kk] = g; } } }
        wg_sync();
        PSTAMP(1);
#pragma unroll
        for (int c = 0; c < 2; ++c) {
            f32x4 accx = (f32x4){0.f, 0.f, 0.f, 0.f}, acca = (f32x4){0.f, 0.f, 0.f, 0.f};
            if (wave < 4) {
                LAS unsigned char* Aa = (wave < 2) ? AT : RT; LAS unsigned char* Bb = (wave & 1) ? KT : BT;
#pragma unroll
                for (int ks = 0; ks < 2; ++ks) { const bf16x8 fa = FRAG(AT + c * 2304, lane & 15, 144, ks * 64), fs = FRAG(SB, 16 * wave + (lane & 15), 144, ks * 64);
                    accx = __builtin_amdgcn_mfma_f32_16x16x32_bf16(fa, fs, accx, 0, 0, 0);
                    const bf16x8 f1 = FRAG(Aa + c * 2304, lane & 15, 144, ks * 64), f2 = FRAG(Bb + c * 2304, lane & 15, 144, ks * 64);
                    acca = __builtin_amdgcn_mfma_f32_16x16x32_bf16(f1, f2, acca, 0, 0, 0); }
                mfma_drain();
#pragma unroll
                for (int e = 0; e < 4; ++e) { const int t = 4 * (lane >> 4) + e, ta_ = lane & 15; const bool strict = ta_ < t, incl = ta_ <= t; const float val = acca[e];
                    if (wave == 0) AAB[ta_ * 16 + t] = strict ? val : 0.f;
                    else if (wave == 1) *(LAS unsigned short*)(AK0 + t * 80 + 32 + ta_ * 2) = f2bf(strict ? val : 0.f);
                    else if (wave == 2) *(LAS unsigned short*)(ARK + t * 80 + ta_ * 2) = f2bf(incl ? val : 0.f);
                    else *(LAS unsigned short*)(ARK + t * 80 + 32 + ta_ * 2) = f2bf(incl ? val : 0.f); }
            } else {
#pragma unroll
                for (int ks = 0; ks < 2; ++ks) { const bf16x8 fr = FRAG(RT + c * 2304, lane & 15, 144, ks * 64), fs = FRAG(SB, 16 * (wave - 4) + (lane & 15), 144, ks * 64);
                    accx = __builtin_amdgcn_mfma_f32_16x16x32_bf16(fr, fs, accx, 0, 0, 0); }
            }
            wg_sync();
            PSTAMP(2);
            if (wave < 4) { const bf16x8 fk = FRAG(AK0, lane & 15, 80, 0), fv = FRAG(UVt + c * 5120, 16 * wave + (lane & 15), 80, 0);
                accx = __builtin_amdgcn_mfma_f32_16x16x32_bf16(fk, fv, accx, 0, 0, 0);
                mfma_drain();
#pragma unroll
                for (int e = 0; e < 4; ++e) XF[(4 * (lane >> 4) + e) * 64 + 16 * wave + (lane & 15)] = accx[e]; }
            wg_sync();
            PSTAMP(3);
            if (wave == 0) { float uu[16];
#pragma unroll
                for (int t = 0; t < 16; ++t) uu[t] = XF[t * 64 + lane];
#pragma unroll
                for (int q = 0; q < 15; ++q) { const f32x4 c0 = *(const LAS f32x4*)(AAB + q * 16), c1 = *(const LAS f32x4*)(AAB + q * 16 + 4), c2 = *(const LAS f32x4*)(AAB + q * 16 + 8), c3 = *(const LAS f32x4*)(AAB + q * 16 + 12);
                    const float col[16] = {c0[0], c0[1], c0[2], c0[3], c1[0], c1[1], c1[2], c1[3], c2[0], c2[1], c2[2], c2[3], c3[0], c3[1], c3[2], c3[3]};
#pragma unroll
                    for (int t = q + 1; t < 16; ++t) uu[t] += col[t] * uu[q];
                    if (q & 1) asm volatile("" ::: "memory"); }
                uint4 p0, p1; p0.x = pk2(uu[0], uu[1]); p0.y = pk2(uu[2], uu[3]); p0.z = pk2(uu[4], uu[5]); p0.w = pk2(uu[6], uu[7]); p1.x = pk2(uu[8], uu[9]); p1.y = pk2(uu[10], uu[11]); p1.z = pk2(uu[12], uu[13]); p1.w = pk2(uu[14], uu[15]);
                u32x4 q0, q1; q0.x = p0.x; q0.y = p0.y; q0.z = p0.z; q0.w = p0.w; q1.x = p1.x; q1.y = p1.y; q1.z = p1.z; q1.w = p1.w;
                *(LAS u32x4*)(UVt + c * 5120 + lane * 80) = q0; *(LAS u32x4*)(UVt + c * 5120 + lane * 80 + 16) = q1; }
            wg_sync();
            PSTAMP(4);
            if (wave >= 4) { const bf16x8 fr = FRAG(ARK, lane & 15, 80, 0), fu = FRAG(UVt + c * 5120, 16 * (wave - 4) + (lane & 15), 80, 0);
                accx = __builtin_amdgcn_mfma_f32_16x16x32_bf16(fr, fu, accx, 0, 0, 0);
                mfma_drain();
#pragma unroll
                for (int e = 0; e < 4; ++e) { const int t = 4 * (lane >> 4) + e, u = d ? 31 - 16 * c - t : 16 * c + t; YB[u * 64 + 16 * (wave - 4) + (lane & 15)] = accx[e]; } }
            { const int kt = wave & 3; const bf16x8 fb = FRAG(BKt + c * 5120, 16 * kt + (lane & 15), 80, 0);
#pragma unroll
                for (int x = 0; x < 2; ++x) { const int it = 2 * (wave >> 2) + x; const bf16x8 fu = FRAG(UVt + c * 5120, 16 * it + (lane & 15), 80, 0);
                    Sacc[x] = __builtin_amdgcn_mfma_f32_16x16x32_bf16(fb, fu, Sacc[x], 0, 0, 0); }
                mfma_drain();
                const f32x4 gl = *(const LAS f32x4*)(GL + c * 64 + 16 * kt + 4 * (lane >> 4));
#pragma unroll
                for (int x = 0; x < 2; ++x) { const int it = 2 * (wave >> 2) + x; Sacc[x] *= gl;
                    u32x2 w_; w_.x = pk2(Sacc[x][0], Sacc[x][1]); w_.y = pk2(Sacc[x][2], Sacc[x][3]);
                    *(LAS u32x2*)(SB + (16 * it + (lane & 15)) * 144 + (16 * kt + 4 * (lane >> 4)) * 2) = w_; } }
            wg_sync();
            PSTAMP(5);
        }
        { const int o = etok * 64 + 4 * ecg; u32x2 w; w.x = pk2(YB[o], YB[o + 1]); w.y = pk2(YB[o + 2], YB[o + 3]); *(u32x2*)(Y + (Rb + etok) * 1024 + ec) = w; }
    }
    if (prof && bid == 0 && tid == 0) { prof[0] = psec0; prof[1] = psec1; prof[2] = psec2; prof[3] = psec3; prof[4] = psec4; prof[5] = psec5; }
#undef PSTAMP
#undef FRAG
#undef RK_GLOAD
#undef RK_SLO
}

PHASE_FN void phase_rkscan3(const bf16_t* Rr, const bf16_t* Kk, const bf16_t* Vv, const bf16_t* T, const float* w0, const float* w2, const float* a0, const float* a2,
                            const float* k_k, const float* k_a, const float* r_k, bf16_t* Yf, bf16_t* Yb, float* bon, LAS unsigned char* L, int bid, int nb) {
    if (bid >= 256) return;
    const int tid = tid_opq(), lane = tid & 63, wave = __builtin_amdgcn_readfirstlane(tid >> 6);
    const int b = bid >> 5, h = (bid >> 1) & 15, d = bid & 1;
    LAS float* WB = (LAS float*)L; LAS float* AD = WB + 2112; LAS float* RB = AD + 2112; LAS float* KD = RB + 2112; LAS float* VB = KD + 2112; LAS float* AB = VB + 2112; LAS float* BB = AB + 2112;
    LAS float* YB = (LAS float*)(L + 121856);
    LAS unsigned char* AT = L + 65536; LAS unsigned char* RT = L + 70144; LAS unsigned char* BT = L + 74752; LAS unsigned char* KT = L + 79360;
    LAS unsigned char* BKt = L + 83968; LAS unsigned char* UVt = L + 94208;
    LAS unsigned char* SB = L + 104448;
    LAS unsigned char* ARK = L + 113664; LAS unsigned char* AK0 = L + 114944;
    LAS float* AAB = (LAS float*)(L + 116224); LAS float* XF = (LAS float*)(L + 117248); LAS float* GL = (LAS float*)(L + 121344);
    bf16_t* Y = d ? Yb : Yf;
    const int tt = wave >> 2, ct = wave & 3;
    bf16x8 bw[2], ba[2];
#pragma unroll
    for (int ks = 0; ks < 2; ++ks) { float fw[8], fa[8];
#pragma unroll
        for (int j = 0; j < 8; ++j) { const int m = 8 * (lane >> 4) + j + 32 * ks, cc = 64 * h + 16 * ct + (lane & 15); fw[j] = w2[((size_t)d * 64 + m) * 1024 + cc]; fa[j] = a2[((size_t)d * 64 + m) * 1024 + cc]; }
        const uint4 pw = pack8(fw), pa = pack8(fa); bw[ks] = *(const bf16x8*)&pw; ba[ks] = *(const bf16x8*)&pa; }
    const int cch = 64 * h + 16 * ct + (lane & 15);
    const float w0c = w0[d * 1024 + cch], a0c = a0[d * 1024 + cch];
    const int etok = tid >> 4, ecg = tid & 15, ec = 64 * h + 4 * ecg;
    const float4 kk4 = *(const float4*)(k_k + ec), ka4 = *(const float4*)(k_a + ec), rk4 = *(const float4*)(r_k + ec);
    for (int i = tid; i < (121856 - 83968) / 4; i += NTHR) ((LAS unsigned*)(L + 83968))[i] = 0u;
    f32x4 Sacc[2];
    Sacc[0] = (f32x4){0.f, 0.f, 0.f, 0.f}; Sacc[1] = (f32x4){0.f, 0.f, 0.f, 0.f};
#define RK_SLO(kb_) (d ? ((kb_) < 8 ? CTXL - 32 * ((kb_) + 1) : SP - 32 * ((kb_) - 8 + 1)) : 32 * (kb_))
    uint4 tw[2], ta[2]; u32x2 rw, kw, vw;
#define RK_GLOAD(kb_) do { const size_t Rn_ = (size_t)b * SP + RK_SLO(kb_); const bf16_t* trow_ = T + (Rn_ + 16 * tt + (lane & 15)) * 256 + 8 * (lane >> 4); \
        _Pragma("unroll") for (int ks = 0; ks < 2; ++ks) { tw[ks] = *(const uint4*)(trow_ + 64 * d + 32 * ks); ta[ks] = *(const uint4*)(trow_ + 128 + 64 * d + 32 * ks); } \
        const size_t g_ = (Rn_ + etok) * 1024 + ec; rw = *(const u32x2*)(Rr + g_); kw = *(const u32x2*)(Kk + g_); vw = *(const u32x2*)(Vv + g_); } while (0)
#define FRAG(base, row, pitchB, koffB) (*(const LAS bf16x8*)((base) + (row) * (pitchB) + (koffB) + (lane >> 4) * 16))
#define RK_PREP_A() do { f32x4 dw = (f32x4){0.f, 0.f, 0.f, 0.f}, da = (f32x4){0.f, 0.f, 0.f, 0.f}; \
        _Pragma("unroll") for (int ks = 0; ks < 2; ++ks) { \
            dw = __builtin_amdgcn_mfma_f32_16x16x32_bf16(*(const bf16x8*)&tw[ks], bw[ks], dw, 0, 0, 0); \
            da = __builtin_amdgcn_mfma_f32_16x16x32_bf16(*(const bf16x8*)&ta[ks], ba[ks], da, 0, 0, 0); } \
        mfma_drain(); \
        _Pragma("unroll") for (int e = 0; e < 4; ++e) { const int tok = 16 * tt + 4 * (lane >> 4) + e, cc = 16 * ct + (lane & 15); \
            WB[tok * 65 + cc] = -0.8750388f * sigmf(w0c + dw[e]);     \
            AD[tok * 65 + cc] = sigmf(a0c + da[e]); } } while (0)
#define RK_PREP_B1(Rb_, kl_) do { \
        const float r[4] = {bflo(rw.x), bfhi(rw.x), bflo(rw.y), bfhi(rw.y)}, k[4] = {bflo(kw.x), bfhi(kw.x), bflo(kw.y), bfhi(kw.y)}, v[4] = {bflo(vw.x), bfhi(vw.x), bflo(vw.y), bfhi(vw.y)}; \
        if ((kl_) >= 0) RK_GLOAD(kl_); \
        const float kkc[4] = {kk4.x, kk4.y, kk4.z, kk4.w}, kac[4] = {ka4.x, ka4.y, ka4.z, ka4.w}, rkc[4] = {rk4.x, rk4.y, rk4.z, rk4.w}; \
        float kr[4], ss = 0.f; \
        _Pragma("unroll") for (int e = 0; e < 4; ++e) { kr[e] = k[e] * kkc[e]; ss += kr[e] * kr[e]; } \
        ss = red16(ss); const float inv = 1.f / fmaxf(sqrtf(ss), 1e-12f); float bs = 0.f; \
        _Pragma("unroll") for (int e = 0; e < 4; ++e) { const int o = etok * 65 + 4 * ecg + e; const float ad = AD[o], kkn = kr[e] * inv, kd = k[e] * (1.f + (ad - 1.f) * kac[e]); \
            RB[o] = r[e]; KD[o] = kd; VB[o] = v[e]; AB[o] = -kkn; BB[o] = kkn * ad; bs += r[e] * kd * rkc[e]; } \
        bs = red16(bs); if (ecg == 0) bon[((size_t)d * NTOK + (Rb_) + etok) * 16 + h] = bs; } while (0)
#define RK_PREP_B2(c_) do { const int kq = tid >> 4, t = tid & 15; const int u = d ? 31 - 16 * (c_) - t : 16 * (c_) + t; \
        _Pragma("unroll") for (int hh = 0; hh < 2; ++hh) { const int kk = kq + 32 * hh, o = u * 65 + kk; \
            const float lw = WB[o]; float cs = lw; \
            cs += dppz<0x111>(cs); cs += dppz<0x112>(cs); cs += dppz<0x114>(cs); cs += dppz<0x118>(cs); \
            const float g = __builtin_amdgcn_exp2f(cs), gp = __builtin_amdgcn_exp2f(cs - lw), ig = __builtin_amdgcn_exp2f(-cs); \
            const float av = AB[o] * gp, rv = RB[o] * g, bv = BB[o] * ig, kv = KD[o] * ig; \
            const int ro = (c_) * 2304 + t * 144 + kk * 2; \
            *(LAS unsigned short*)(AT + ro) = f2bf(av); *(LAS unsigned short*)(RT + ro) = f2bf(rv); *(LAS unsigned short*)(BT + ro) = f2bf(bv); *(LAS unsigned short*)(KT + ro) = f2bf(kv); \
            *(LAS unsigned short*)(BKt + (c_) * 5120 + kk * 80 + t * 2) = f2bf(bv); *(LAS unsigned short*)(BKt + (c_) * 5120 + kk * 80 + 32 + t * 2) = f2bf(kv); \
            *(LAS unsigned short*)(UVt + (c_) * 5120 + kk * 80 + 32 + t * 2) = f2bf(VB[o]); \
            if (t == 15) GL[(c_) * 64 + kk] = g; } } while (0)
    RK_GLOAD(0);
    wg_sync();
    RK_PREP_A();
    wg_sync();
    { const size_t Rb0 = (size_t)b * SP + RK_SLO(0); RK_PREP_B1(Rb0, 1); }
    wg_sync();
    RK_PREP_B2(0);
    wg_sync();
    constexpr int NBLK = SP / 32;
    for (int kb = 0; kb < NBLK; ++kb) {
        const int slo = RK_SLO(kb);
        const size_t Rb = (size_t)b * SP + slo;
        const bool more = (kb + 1 < NBLK);
#pragma unroll
        for (int c = 0; c < 2; ++c) {
            f32x4 accx = (f32x4){0.f, 0.f, 0.f, 0.f}, acca = (f32x4){0.f, 0.f, 0.f, 0.f};
            if (wave < 4) {
                LAS unsigned char* Aa = (wave < 2) ? AT : RT; LAS unsigned char* Bb = (wave & 1) ? KT : BT;
#pragma unroll
                for (int ks = 0; ks < 2; ++ks) { const bf16x8 fa = FRAG(AT + c * 2304, lane & 15, 144, ks * 64), fs = FRAG(SB, 16 * wave + (lane & 15), 144, ks * 64);
                    accx = __builtin_amdgcn_mfma_f32_16x16x32_bf16(fa, fs, accx, 0, 0, 0);
                    const bf16x8 f1 = FRAG(Aa + c * 2304, lane & 15, 144, ks * 64), f2 = FRAG(Bb + c * 2304, lane & 15, 144, ks * 64);
                    acca = __builtin_amdgcn_mfma_f32_16x16x32_bf16(f1, f2, acca, 0, 0, 0); }
                mfma_drain();
#pragma unroll
                for (int e = 0; e < 4; ++e) { const int t = 4 * (lane >> 4) + e, ta_ = lane & 15; const bool strict = ta_ < t, incl = ta_ <= t; const float val = acca[e];
                    if (wave == 0) AAB[ta_ * 16 + t] = strict ? val : 0.f;
                    else if (wave == 1) *(LAS unsigned short*)(AK0 + t * 80 + 32 + ta_ * 2) = f2bf(strict ? val : 0.f);
                    else if (wave == 2) *(LAS unsigned short*)(ARK + t * 80 + ta_ * 2) = f2bf(incl ? val : 0.f);
                    else *(LAS unsigned short*)(ARK + t * 80 + 32 + ta_ * 2) = f2bf(incl ? val : 0.f); }
            } else {
#pragma unroll
                for (int ks = 0; ks < 2; ++ks) { const bf16x8 fr = FRAG(RT + c * 2304, lane & 15, 144, ks * 64), fs = FRAG(SB, 16 * (wave - 4) + (lane & 15), 144, ks * 64);
                    accx = __builtin_amdgcn_mfma_f32_16x16x32_bf16(fr, fs, accx, 0, 0, 0); }
            }
            if (c == 0) { RK_PREP_B2(1); }
            else if (more) { RK_PREP_B2(0); }
            wg_sync();
            if (wave < 4) { const bf16x8 fk = FRAG(AK0, lane & 15, 80, 0), fv = FRAG(UVt + c * 5120, 16 * wave + (lane & 15), 80, 0);
                accx = __builtin_amdgcn_mfma_f32_16x16x32_bf16(fk, fv, accx, 0, 0, 0);
                mfma_drain();
#pragma unroll
                for (int e = 0; e < 4; ++e) XF[(4 * (lane >> 4) + e) * 64 + 16 * wave + (lane & 15)] = accx[e]; }
            if (c == 0 && more) { RK_PREP_A(); }
            wg_sync();
            if (wave == 0) { float uu[16];
#pragma unroll
                for (int t = 0; t < 16; ++t) uu[t] = XF[t * 64 + lane];
#pragma unroll
                for (int q = 0; q < 15; ++q) { const f32x4 c0 = *(const LAS f32x4*)(AAB + q * 16), c1 = *(const LAS f32x4*)(AAB + q * 16 + 4), c2 = *(const LAS f32x4*)(AAB + q * 16 + 8), c3 = *(const LAS f32x4*)(AAB + q * 16 + 12);
                    const float col[16] = {c0[0], c0[1], c0[2], c0[3], c1[0], c1[1], c1[2], c1[3], c2[0], c2[1], c2[2], c2[3], c3[0], c3[1], c3[2], c3[3]};
#pragma unroll
                    for (int t = q + 1; t < 16; ++t) uu[t] += col[t] * uu[q];
                    if (q & 1) asm volatile("" ::: "memory"); }
                uint4 p0, p1; p0.x = pk2(uu[0], uu[1]); p0.y = pk2(uu[2], uu[3]); p0.z = pk2(uu[4], uu[5]); p0.w = pk2(uu[6], uu[7]); p1.x = pk2(uu[8], uu[9]); p1.y = pk2(uu[10], uu[11]); p1.z = pk2(uu[12], uu[13]); p1.w = pk2(uu[14], uu[15]);
                u32x4 q0, q1; q0.x = p0.x; q0.y = p0.y; q0.z = p0.z; q0.w = p0.w; q1.x = p1.x; q1.y = p1.y; q1.z = p1.z; q1.w = p1.w;
                *(LAS u32x4*)(UVt + c * 5120 + lane * 80) = q0; *(LAS u32x4*)(UVt + c * 5120 + lane * 80 + 16) = q1; }
            wg_sync();
            if (wave >= 4) { const bf16x8 fr = FRAG(ARK, lane & 15, 80, 0), fu = FRAG(UVt + c * 5120, 16 * (wave - 4) + (lane & 15), 80, 0);
                accx = __builtin_amdgcn_mfma_f32_16x16x32_bf16(fr, fu, accx, 0, 0, 0);
                mfma_drain();
#pragma unroll
                for (int e = 0; e < 4; ++e) { const int t = 4 * (lane >> 4) + e, u = d ? 31 - 16 * c - t : 16 * c + t; YB[u * 64 + 16 * (wave - 4) + (lane & 15)] = accx[e]; } }
            { const int kt = wave & 3; const bf16x8 fb = FRAG(BKt + c * 5120, 16 * kt + (lane & 15), 80, 0);
#pragma unroll
                for (int x = 0; x < 2; ++x) { const int it = 2 * (wave >> 2) + x; const bf16x8 fu = FRAG(UVt + c * 5120, 16 * it + (lane & 15), 80, 0);
                    Sacc[x] = __builtin_amdgcn_mfma_f32_16x16x32_bf16(fb, fu, Sacc[x], 0, 0, 0); }
                mfma_drain();
                const f32x4 gl = *(const LAS f32x4*)(GL + c * 64 + 16 * kt + 4 * (lane >> 4));
#pragma unroll
                for (int x = 0; x < 2; ++x) { const int it = 2 * (wave >> 2) + x; Sacc[x] *= gl;
                    u32x2 w_; w_.x = pk2(Sacc[x][0], Sacc[x][1]); w_.y = pk2(Sacc[x][2], Sacc[x][3]);
                    *(LAS u32x2*)(SB + (16 * it + (lane & 15)) * 144 + (16 * kt + 4 * (lane >> 4)) * 2) = w_; } }
            if (c == 0 && more) { const size_t Rb1 = (size_t)b * SP + RK_SLO(kb + 1); const int kl = (kb + 2 < NBLK) ? kb + 2 : -1; RK_PREP_B1(Rb1, kl); }
            wg_sync();
        }
        { const int o = etok * 64 + 4 * ecg; u32x2 w; w.x = pk2(YB[o], YB[o + 1]); w.y = pk2(YB[o + 2], YB[o + 3]); *(u32x2*)(Y + (Rb + etok) * 1024 + ec) = w; }
    }
#undef RK_PREP_A
#undef RK_PREP_B1
#undef RK_PREP_B2
#undef FRAG
#undef RK_GLOAD
#undef RK_SLO
}

#define RK_CENSUS_LDS 163812
PHASE_FN void phase_rkscan4(const bf16_t* Rr, const bf16_t* Kk, const bf16_t* Vv, const bf16_t* T, const float* w0, const float* w2, const float* a0, const float* a2,
                            const float* k_k, const float* k_a, const float* r_k, bf16_t* Yf, bf16_t* Yb, float* bon, LAS unsigned char* L, int bid, int nb, unsigned long long* prof = nullptr) {
    if (bid >= 256) return;
    unsigned long long ps0 = 0, ps1 = 0, ps2 = 0, ps3 = 0, ps4 = 0, ps5 = 0, pt = 0;
#define RKP(k) do { if (prof) { const unsigned long long n_ = clock64(); ps##k += n_ - pt; pt = n_; } } while (0)
    const int tid0 = tid_opq(), lane = tid0 & 63, lane0 = lane;
    int role, widx;
    {   const unsigned simd = ((unsigned)__builtin_amdgcn_s_getreg((1 << 11) | (4 << 6) | 4)) & 3u;
        unsigned old = 0u;
        if (lane == 0) old = __hip_atomic_fetch_add((LAS unsigned*)RK_CENSUS_LDS, 1u << (8u * simd), __ATOMIC_RELAXED, __HIP_MEMORY_SCOPE_WORKGROUP);
        old = (unsigned)__builtin_amdgcn_readfirstlane((int)old);
        wg_sync();
        const unsigned all = *(volatile LAS unsigned*)RK_CENSUS_LDS;
        const unsigned mine = (old >> (8u * simd)) & 0xffu;
        if (all == 0x02020202u) { role = (int)mine; widx = (int)simd; } else { role = (tid0 >> 6) >> 2; widx = (tid0 >> 6) & 3; }
        role = __builtin_amdgcn_readfirstlane(role); widx = __builtin_amdgcn_readfirstlane(widx); }
    const int gtid = role * 256 + widx * 64 + lane;
    const int b = bid >> 5, h = (bid >> 1) & 15, d = bid & 1;
    LAS float* WB = (LAS float*)L; LAS float* AD = WB + 2176; LAS float* RB = AD + 2176; LAS float* KD = RB + 2176; LAS float* VB = KD + 2176; LAS float* AB = VB + 2176; LAS float* BB = AB + 2176;
    LAS float* WB2 = (LAS float*)(L + 130048);
    LAS float* YB = (LAS float*)(L + 121856);
    LAS unsigned char* AT = L + 65536; LAS unsigned char* RT = L + 70144; LAS unsigned char* BT = L + 74752; LAS unsigned char* KT = L + 79360;
    LAS unsigned char* BKt = L + 83968; LAS unsigned char* UVt = L + 94208;
    LAS unsigned char* SB = L + 104448;
    LAS unsigned char* ARK = L + 113664; LAS unsigned char* AK0 = L + 114944;
    LAS float* AAB = (LAS float*)(L + 116224); LAS float* XF = (LAS float*)(L + 117248); LAS float* GL = (LAS float*)(L + 121344);
    bf16_t* Y = d ? Yb : Yf;
    const int ptid = widx * 64 + lane, ct = widx;
    bf16x8 bw[2], ba[2];
    float w0c = 0.f, a0c = 0.f;
    const int ecg = ptid & 15, ec = 64 * h + 4 * ecg, etok0 = ptid >> 4;
    float4 kk4 = make_float4(0.f, 0.f, 0.f, 0.f), ka4 = kk4, rk4 = kk4;
    if (role == 1) {
#pragma unroll
        for (int ks = 0; ks < 2; ++ks) { float fw[8], fa[8];
#pragma unroll
            for (int j = 0; j < 8; ++j) { const int m = 8 * (lane >> 4) + j + 32 * ks, cc = 64 * h + 16 * ct + (lane & 15); fw[j] = w2[((size_t)d * 64 + m) * 1024 + cc]; fa[j] = a2[((size_t)d * 64 + m) * 1024 + cc]; }
            const uint4 pw = pack8(fw), pa = pack8(fa); bw[ks] = *(const bf16x8*)&pw; ba[ks] = *(const bf16x8*)&pa; }
        const int cch = 64 * h + 16 * ct + (lane & 15);
        w0c = w0[d * 1024 + cch]; a0c = a0[d * 1024 + cch];
        kk4 = *(const float4*)(k_k + ec); ka4 = *(const float4*)(k_a + ec); rk4 = *(const float4*)(r_k + ec);
    } else { const uint4 z = make_uint4(0u, 0u, 0u, 0u); bw[0] = *(const bf16x8*)&z; bw[1] = bw[0]; ba[0] = bw[0]; ba[1] = bw[0]; }
    for (int i = gtid; i < (121856 - 83968) / 4; i += NTHR) ((LAS unsigned*)(L + 83968))[i] = 0u;
    f32x4 Sacc[4];
#pragma unroll
    for (int x = 0; x < 4; ++x) Sacc[x] = (f32x4){0.f, 0.f, 0.f, 0.f};
#define RK_SLO(kb_) (d ? ((kb_) < 8 ? CTXL - 32 * ((kb_) + 1) : SP - 32 * ((kb_) - 8 + 1)) : 32 * (kb_))
    uint4 tw[2][2], ta[2][2]; u32x2 rw[2], kw[2], vw[2];
#define RK_GLOAD_T(kb_) do { const size_t Rn_ = (size_t)b * SP + RK_SLO(kb_); \
        _Pragma("unroll") for (int tt = 0; tt < 2; ++tt) { const bf16_t* trow_ = T + (Rn_ + 16 * tt + (lane & 15)) * 256 + 8 * (lane >> 4); \
            _Pragma("unroll") for (int ks = 0; ks < 2; ++ks) { tw[tt][ks] = *(const uint4*)(trow_ + 64 * d + 32 * ks); ta[tt][ks] = *(const uint4*)(trow_ + 128 + 64 * d + 32 * ks); } } } while (0)
#define RK_GLOAD_RKV(kb_) do { const size_t Rn_ = (size_t)b * SP + RK_SLO(kb_); \
        _Pragma("unroll") for (int j = 0; j < 2; ++j) { const size_t g_ = (Rn_ + etok0 + 16 * j) * 1024 + ec; rw[j] = *(const u32x2*)(Rr + g_); kw[j] = *(const u32x2*)(Kk + g_); vw[j] = *(const u32x2*)(Vv + g_); } } while (0)
#define FRAG(base, row, pitchB, koffB) (*(const LAS bf16x8*)((base) + (row) * (pitchB) + (koffB) + (lane >> 4) * 16))
#define RK_SHADOW int lane = lane0; asm volatile("" : "+v"(lane)); const int ptid = widx * 64 + lane, ecg = ptid & 15, ec = 64 * h + 4 * ecg, etok0 = ptid >> 4; (void)ec; (void)etok0; (void)ecg
#define RK_PREP_A(WBD) do { _Pragma("unroll") for (int tt = 0; tt < 2; ++tt) { f32x4 dw = (f32x4){0.f, 0.f, 0.f, 0.f}, da = (f32x4){0.f, 0.f, 0.f, 0.f}; \
        _Pragma("unroll") for (int ks = 0; ks < 2; ++ks) { \
            dw = __builtin_amdgcn_mfma_f32_16x16x32_bf16(*(const bf16x8*)&tw[tt][ks], bw[ks], dw, 0, 0, 0); \
            da = __builtin_amdgcn_mfma_f32_16x16x32_bf16(*(const bf16x8*)&ta[tt][ks], ba[ks], da, 0, 0, 0); } \
        mfma_drain(); \
        _Pragma("unroll") for (int e = 0; e < 4; ++e) { const int tok = 16 * tt + 4 * (lane >> 4) + e, cc = 16 * ct + (lane & 15); \
            (WBD)[tok * 68 + cc] = -0.8750388f * __builtin_amdgcn_rcpf(1.f + __expf(-(w0c + dw[e])));     \
            AD[tok * 68 + cc] = __builtin_amdgcn_rcpf(1.f + __expf(-(a0c + da[e]))); } } } while (0)
#define RK_PREP_B1(Rb_, kl_) do { \
        float r[2][4], k[2][4], v[2][4]; \
        _Pragma("unroll") for (int j = 0; j < 2; ++j) { r[j][0] = bflo(rw[j].x); r[j][1] = bfhi(rw[j].x); r[j][2] = bflo(rw[j].y); r[j][3] = bfhi(rw[j].y); k[j][0] = bflo(kw[j].x); k[j][1] = bfhi(kw[j].x); k[j][2] = bflo(kw[j].y); k[j][3] = bfhi(kw[j].y); \
            v[j][0] = bflo(vw[j].x); v[j][1] = bfhi(vw[j].x); v[j][2] = bflo(vw[j].y); v[j][3] = bfhi(vw[j].y); } \
        if ((kl_) >= 0) RK_GLOAD_RKV(kl_); \
        const float kkc[4] = {kk4.x, kk4.y, kk4.z, kk4.w}, kac[4] = {ka4.x, ka4.y, ka4.z, ka4.w}, rkc[4] = {rk4.x, rk4.y, rk4.z, rk4.w}; \
        _Pragma("unroll") for (int j = 0; j < 2; ++j) { const int etok = etok0 + 16 * j; float kr[4], ss = 0.f; \
            _Pragma("unroll") for (int e = 0; e < 4; ++e) { kr[e] = k[j][e] * kkc[e]; ss += kr[e] * kr[e]; } \
            ss = red16(ss); const float inv = __builtin_amdgcn_rsqf(fmaxf(ss, 1e-24f)); float bs = 0.f; \
            const int o4 = etok * 68 + 4 * ecg; const f32x4 ad4 = *(const LAS f32x4*)(AD + o4); f32x4 r4, kd4, v4, a4, b4; \
            _Pragma("unroll") for (int e = 0; e < 4; ++e) { const float ad = ad4[e], kkn = kr[e] * inv, kd = k[j][e] * (1.f + (ad - 1.f) * kac[e]); \
                r4[e] = r[j][e]; kd4[e] = kd; v4[e] = v[j][e]; a4[e] = -kkn; b4[e] = kkn * ad; bs += r[j][e] * kd * rkc[e]; } \
            *(LAS f32x4*)(RB + o4) = r4; *(LAS f32x4*)(KD + o4) = kd4; *(LAS f32x4*)(VB + o4) = v4; *(LAS f32x4*)(AB + o4) = a4; *(LAS f32x4*)(BB + o4) = b4; \
            bs = red16(bs); if (ecg == 0) bon[((size_t)d * NTOK + (Rb_) + etok) * 16 + h] = bs; } } while (0)
    typedef float f32x2w __attribute__((ext_vector_type(2)));
#define RK_PREP_B2(c_, half_, WBS) do { const int t = ptid & 15, kk0 = 2 * ((ptid >> 4) + 16 * (half_)); const int u = d ? 31 - 16 * (c_) - t : 16 * (c_) + t; const int o = u * 68 + kk0; \
        const f32x2w lw = *(const LAS f32x2w*)((WBS) + o), a2_ = *(const LAS f32x2w*)(AB + o), r2_ = *(const LAS f32x2w*)(RB + o), b2_ = *(const LAS f32x2w*)(BB + o), k2_ = *(const LAS f32x2w*)(KD + o), v2_ = *(const LAS f32x2w*)(VB + o); \
        float cs0 = lw[0], cs1 = lw[1]; \
        cs0 += dppz<0x111>(cs0); cs1 += dppz<0x111>(cs1); cs0 += dppz<0x112>(cs0); cs1 += dppz<0x112>(cs1); cs0 += dppz<0x114>(cs0); cs1 += dppz<0x114>(cs1); cs0 += dppz<0x118>(cs0); cs1 += dppz<0x118>(cs1); \
        const float g0 = __builtin_amdgcn_exp2f(cs0), gp0 = __builtin_amdgcn_exp2f(cs0 - lw[0]), ig0 = __builtin_amdgcn_exp2f(-cs0), g1 = __builtin_amdgcn_exp2f(cs1), gp1 = __builtin_amdgcn_exp2f(cs1 - lw[1]), ig1 = __builtin_amdgcn_exp2f(-cs1); \
        const unsigned avp = pk2(a2_[0] * gp0, a2_[1] * gp1), rvp = pk2(r2_[0] * g0, r2_[1] * g1), bvp = pk2(b2_[0] * ig0, b2_[1] * ig1), kvp = pk2(k2_[0] * ig0, k2_[1] * ig1), vvp = pk2(v2_[0], v2_[1]); \
        const int ro = (c_) * 2304 + t * 144 + kk0 * 2; \
        *(LAS unsigned*)(AT + ro) = avp; *(LAS unsigned*)(RT + ro) = rvp; *(LAS unsigned*)(BT + ro) = bvp; *(LAS unsigned*)(KT + ro) = kvp; \
        LAS unsigned char* bk_ = BKt + (c_) * 5120 + kk0 * 80 + t * 2; LAS unsigned char* uv_ = UVt + (c_) * 5120 + kk0 * 80 + 32 + t * 2; \
        *(LAS unsigned short*)(bk_) = (unsigned short)(bvp & 0xffffu); *(LAS unsigned short*)(bk_ + 80) = (unsigned short)(bvp >> 16); \
        *(LAS unsigned short*)(bk_ + 32) = (unsigned short)(kvp & 0xffffu); *(LAS unsigned short*)(bk_ + 112) = (unsigned short)(kvp >> 16); \
        *(LAS unsigned short*)(uv_) = (unsigned short)(vvp & 0xffffu); *(LAS unsigned short*)(uv_ + 80) = (unsigned short)(vvp >> 16); \
        if (t == 15) { f32x2w gg; gg[0] = g0; gg[1] = g1; *(LAS f32x2w*)(GL + (c_) * 64 + kk0) = gg; } } while (0)
    if (role == 1) { RK_SHADOW; RK_GLOAD_T(0); RK_GLOAD_RKV(0); }
    wg_sync();
    if (role == 1) { RK_SHADOW; RK_PREP_A(WB); RK_GLOAD_T(1); }
    wg_sync();
    if (role == 1) { RK_SHADOW; const size_t Rb0 = (size_t)b * SP + RK_SLO(0); RK_PREP_B1(Rb0, 1); }
    wg_sync();
    if (role == 1) { { RK_SHADOW; RK_PREP_A(WB2); RK_GLOAD_T(2); } { RK_SHADOW; RK_PREP_B2(0, 0, WB); } { RK_SHADOW; RK_PREP_B2(0, 1, WB); } }
    wg_sync();
    constexpr int NBLK = SP / 32;
    for (int kb = 0; kb < NBLK; ++kb) {
        const int slo = RK_SLO(kb);
        const size_t Rb = (size_t)b * SP + slo;
        const bool more = (kb + 1 < NBLK);
        LAS float* WBc = (kb & 1) ? WB2 : WB; LAS float* WBn = (kb & 1) ? WB : WB2;
        if (prof) { if (kb == 0) pt = clock64(); else RKP(5); }
#pragma unroll
        for (int c = 0; c < 2; ++c) {
            f32x4 accx = (f32x4){0.f, 0.f, 0.f, 0.f}, acca = (f32x4){0.f, 0.f, 0.f, 0.f}, accy = (f32x4){0.f, 0.f, 0.f, 0.f};
            if (role == 0) { RK_SHADOW;
                LAS unsigned char* Aa = (widx < 2) ? AT : RT; LAS unsigned char* Bb = (widx & 1) ? KT : BT;
#pragma unroll
                for (int ks = 0; ks < 2; ++ks) { const bf16x8 fa = FRAG(AT + c * 2304, lane & 15, 144, ks * 64), fs = FRAG(SB, 16 * widx + (lane & 15), 144, ks * 64), fr = FRAG(RT + c * 2304, lane & 15, 144, ks * 64);
                    accx = __builtin_amdgcn_mfma_f32_16x16x32_bf16(fa, fs, accx, 0, 0, 0);
                    accy = __builtin_amdgcn_mfma_f32_16x16x32_bf16(fr, fs, accy, 0, 0, 0);
                    const bf16x8 f1 = FRAG(Aa + c * 2304, lane & 15, 144, ks * 64), f2 = FRAG(Bb + c * 2304, lane & 15, 144, ks * 64);
                    acca = __builtin_amdgcn_mfma_f32_16x16x32_bf16(f1, f2, acca, 0, 0, 0); }
                mfma_drain();
#pragma unroll
                for (int e = 0; e < 4; ++e) { const int t = 4 * (lane >> 4) + e, ta_ = lane & 15; const bool strict = ta_ < t, incl = ta_ <= t; const float val = acca[e];
                    if (widx == 0) { }
                    else if (widx == 1) *(LAS unsigned short*)(AK0 + t * 80 + 32 + ta_ * 2) = f2bf(strict ? val : 0.f);
                    else if (widx == 2) *(LAS unsigned short*)(ARK + t * 80 + ta_ * 2) = f2bf(incl ? val : 0.f);
                    else *(LAS unsigned short*)(ARK + t * 80 + 32 + ta_ * 2) = f2bf(incl ? val : 0.f); }
            } else { RK_SHADOW;
                if (c == 0) { RK_PREP_B2(1, 0, WBc); }
                else if (more) { RK_PREP_B2(0, 0, WBn); }
            }
            wg_sync(); RKP(0);
            if (role == 0) { RK_SHADOW; const bf16x8 fk = FRAG(AK0, lane & 15, 80, 0), fv = FRAG(UVt + c * 5120, 16 * widx + (lane & 15), 80, 0);
                accx = __builtin_amdgcn_mfma_f32_16x16x32_bf16(fk, fv, accx, 0, 0, 0);
                mfma_drain();
#pragma unroll
                for (int e = 0; e < 4; ++e) XF[(4 * (lane >> 4) + e) * 64 + 16 * widx + (lane & 15)] = accx[e];
            } else { RK_SHADOW;
                if (c == 0) { RK_PREP_B2(1, 1, WBc); }
                else if (more) { RK_PREP_B2(0, 1, WBn); }
            }
            wg_sync(); RKP(1);
            if (role == 0) { RK_SHADOW;
                if (widx == 0) { float uu[16];
#pragma unroll
                    for (int t = 0; t < 16; ++t) uu[t] = XF[t * 64 + lane];
#pragma unroll
                    for (int q = 0; q < 15; ++q) {
#pragma unroll
                        for (int t = q + 1; t < 16; ++t) { const float aq = __int_as_float(__builtin_amdgcn_readlane(__float_as_int(acca[t & 3]), q + 16 * (t >> 2))); uu[t] += aq * uu[q]; } }
                    uint4 p0, p1; p0.x = pk2(uu[0], uu[1]); p0.y = pk2(uu[2], uu[3]); p0.z = pk2(uu[4], uu[5]); p0.w = pk2(uu[6], uu[7]); p1.x = pk2(uu[8], uu[9]); p1.y = pk2(uu[10], uu[11]); p1.z = pk2(uu[12], uu[13]); p1.w = pk2(uu[14], uu[15]);
                    u32x4 q0, q1; q0.x = p0.x; q0.y = p0.y; q0.z = p0.z; q0.w = p0.w; q1.x = p1.x; q1.y = p1.y; q1.z = p1.z; q1.w = p1.w;
                    *(LAS u32x4*)(UVt + c * 5120 + lane * 80) = q0; *(LAS u32x4*)(UVt + c * 5120 + lane * 80 + 16) = q1; }
            } else { RK_SHADOW;
                if (c == 0) { if (more) { const size_t Rb1 = (size_t)b * SP + RK_SLO(kb + 1); const int kl = (kb + 2 < NBLK) ? kb + 2 : -1; RK_PREP_B1(Rb1, kl); } }
                else if (kb + 2 < NBLK) { RK_PREP_A(WBc); if (kb + 3 < NBLK) RK_GLOAD_T(kb + 3); }
            }
            wg_sync(); RKP(2);
            if (role == 0) { RK_SHADOW;
                { const bf16x8 fr = FRAG(ARK, lane & 15, 80, 0), fu = FRAG(UVt + c * 5120, 16 * widx + (lane & 15), 80, 0);
                    accy = __builtin_amdgcn_mfma_f32_16x16x32_bf16(fr, fu, accy, 0, 0, 0); }
                const int kt = widx; const bf16x8 fb = FRAG(BKt + c * 5120, 16 * kt + (lane & 15), 80, 0);
#pragma unroll
                for (int x = 0; x < 4; ++x) { const bf16x8 fu = FRAG(UVt + c * 5120, 16 * x + (lane & 15), 80, 0);
                    Sacc[x] = __builtin_amdgcn_mfma_f32_16x16x32_bf16(fb, fu, Sacc[x], 0, 0, 0); }
                mfma_drain();
#pragma unroll
                for (int e = 0; e < 4; ++e) { const int t = 4 * (lane >> 4) + e, u = d ? 31 - 16 * c - t : 16 * c + t; YB[u * 64 + 16 * widx + (lane & 15)] = accy[e]; }
                const f32x4 gl = *(const LAS f32x4*)(GL + c * 64 + 16 * kt + 4 * (lane >> 4));
#pragma unroll
                for (int x = 0; x < 4; ++x) { Sacc[x] *= gl;
                    u32x2 w_; w_.x = pk2(Sacc[x][0], Sacc[x][1]); w_.y = pk2(Sacc[x][2], Sacc[x][3]);
                    *(LAS u32x2*)(SB + (16 * x + (lane & 15)) * 144 + (16 * kt + 4 * (lane >> 4)) * 2) = w_; }
            } else { RK_SHADOW;
            }
            wg_sync(); if (c == 0) RKP(3); else RKP(4);
        }
        { const int etok = gtid >> 4, eg = gtid & 15; const int o = etok * 64 + 4 * eg; u32x2 w; w.x = pk2(YB[o], YB[o + 1]); w.y = pk2(YB[o + 2], YB[o + 3]); *(u32x2*)(Y + (Rb + etok) * 1024 + 64 * h + 4 * eg) = w; }
    }
#undef RK_PREP_A
#undef RK_PREP_B1
#undef RK_PREP_B2
#undef FRAG
#undef RK_SHADOW
#undef RK_GLOAD_T
#undef RK_GLOAD_RKV
    if (prof && bid == 0 && gtid == 0) { prof[0] = ps0; prof[1] = ps1; prof[2] = ps2; prof[3] = ps3; prof[4] = ps4; prof[5] = ps5; }
#undef RKP
#undef RK_SLO
}


PHASE_FN void phase_fin_rk(const bf16_t* Yf, const bf16_t* Yb, const bf16_t* Vv, bf16_t* G, const float* bon, const float* gng, const float* gnb, int bid, int nb) {
    const int tid = tid_opq(), lane = tid & 63, wv = tid >> 6;
    const int hd = lane >> 2, c0 = 64 * hd + 16 * (lane & 3);
    float gqv[16], bqv[16];
#pragma unroll
    for (int u = 0; u < 4; ++u) { const float4 g_ = *(const float4*)(gng + c0 + 4 * u), b_ = *(const float4*)(gnb + c0 + 4 * u);
        gqv[4 * u] = g_.x; gqv[4 * u + 1] = g_.y; gqv[4 * u + 2] = g_.z; gqv[4 * u + 3] = g_.w; bqv[4 * u] = b_.x; bqv[4 * u + 1] = b_.y; bqv[4 * u + 2] = b_.z; bqv[4 * u + 3] = b_.w; }
    for (int R = bid * 8 + wv; R < NTOK; R += nb * 8) {
        const size_t base = (size_t)R * 1024 + c0;
        float y[16]; float s1 = 0.f;
#pragma unroll
        for (int u = 0; u < 2; ++u) { float a[8], b[8]; unpack8(*(const uint4*)(Yf + base + 8 * u), a); unpack8(*(const uint4*)(Yb + base + 8 * u), b);
#pragma unroll
            for (int e = 0; e < 8; ++e) { y[8 * u + e] = a[e] + b[e]; s1 += y[8 * u + e]; } }
        s1 = red4(s1); const float mu = s1 * (1.f / 64.f); float s2 = 0.f;
#pragma unroll
        for (int e = 0; e < 16; ++e) { const float dd = y[e] - mu; s2 += dd * dd; }
        s2 = red4(s2); const float rn = rsqrtf(s2 * (1.f / 64.f) + 64e-5f);
        const float bsum = bon[(size_t)R * 16 + hd] + bon[((size_t)NTOK + R) * 16 + hd];
#pragma unroll
        for (int u = 0; u < 2; ++u) { float v[8], g[8], w[8]; unpack8(*(const uint4*)(Vv + base + 8 * u), v); unpack8(*(const uint4*)(G + base + 8 * u), g);
#pragma unroll
            for (int e = 0; e < 8; ++e) { w[e] = ((y[8 * u + e] - mu) * rn * gqv[8 * u + e] + bqv[8 * u + e] + bsum * v[e]) * siluf(g[e]); }
            *(uint4*)(G + base + 8 * u) = pack8(w); }
    }
}

PHASE_FN void wcvt_ret(const float* w_in, const float* w_out, bf16_t* W, LAS unsigned char* L, int bid, int nb) {
    LAS float* T = (LAS float*)L; int tb = 0;
    cvt_tiles(W, 1024, 0, 6144, 1024, [=](int k, int n) -> float {
        int col = n; float sc = 1.f;
        if (n < 2048) { const int sec = n >> 10, hn = n & 1023, hh = hn >> 8, pp = hn & 255, hb = pp & 128, i2 = pp & 127, i = i2 >> 1; col = sec * 1024 + hh * 256 + hb + ((i2 & 1) ? 64 + i : i); if (sec == 1) sc = 0.0625f; }
        return w_in[(size_t)k * 6144 + col] * sc; }, T, bid, nb, tb);
    cvt_tiles(W + (size_t)6144 * 1024, 2048, 0, 1024, 2048, [=](int k, int n) -> float { return w_out[(size_t)k * 1024 + n]; }, T, bid, nb, tb);
}
PHASE_FN void wcvt_ret_qkv(const float* w_in, bf16_t* W, LAS unsigned char* L, int bid, int nb) {
    LAS float* T = (LAS float*)L; int tb = 0;
    cvt_tiles(W, 1024, 0, 4096, 1024, [=](int k, int n) -> float {
        int col = n; float sc = 1.f;
        if (n < 2048) { const int sec = n >> 10, hn = n & 1023, hh = hn >> 8, pp = hn & 255, hb = pp & 128, i2 = pp & 127, i = i2 >> 1; col = sec * 1024 + hh * 256 + hb + ((i2 & 1) ? 64 + i : i); if (sec == 1) sc = 0.0625f; }
        return w_in[(size_t)k * 6144 + col] * sc; }, T, bid, nb, tb);
}
PHASE_FN void wcvt_ret_go(const float* w_in, const float* w_out, bf16_t* W, LAS unsigned char* L, int bid, int nb) {
    LAS float* T = (LAS float*)L; int tb = 0;
    cvt_tiles(W + (size_t)4096 * 1024, 1024, 0, 2048, 1024, [=](int k, int n) -> float { return w_in[(size_t)k * 6144 + 4096 + n]; }, T, bid, nb, tb);
    cvt_tiles(W + (size_t)6144 * 1024, 2048, 0, 1024, 2048, [=](int k, int n) -> float { return w_out[(size_t)k * 1024 + n]; }, T, bid, nb, tb);
}
PHASE_FN void wcvt_ml_in(const float* w_in, bf16_t* Wdst, LAS unsigned char* L, int bid, int nb) {
    LAS float* T = (LAS float*)L; int tb = 0;
    cvt_tiles(Wdst, 1024, 0, 4096, 1024, [=](int k, int n) -> float { return w_in[(size_t)k * 4096 + n]; }, T, bid, nb, tb);
}
PHASE_FN void wcvt_ml(const float* w_out, const float* wqkv, const float* gw, bf16_t* W, LAS unsigned char* L, int bid, int nb) {
    LAS float* T = (LAS float*)L; int tb = 0;
    cvt_tiles(W + (size_t)4096 * 1024, 2048, 0, 1024, 2048, [=](int k, int n) -> float { return w_out[(size_t)k * 1024 + n]; }, T, bid, nb, tb);
    bf16_t* Gt = W + (size_t)6144 * 1024;
    for (int idx = bid * NTHR + tid_opq(); idx < 65536; idx += nb * NTHR) { const int o = idx >> 12, c = idx & 4095, d = o >> 3, gi = o & 7; float val = 0.f;
        if (c < 2048) { const int grp = c >> 2, ci = c & 3;
#pragma unroll
            for (int eo = 0; eo < 4; ++eo) val += wqkv[(size_t)(grp) * 16 + ci * 4 + eo] * gw[((size_t)d * 6144 + 4 * grp + eo) * 8 + gi] + wqkv[(size_t)(512 + grp) * 16 + ci * 4 + eo] * gw[((size_t)d * 6144 + 2048 + 4 * grp + eo) * 8 + gi];
        } else { const int c2 = c - 2048, grp = c2 >> 2, ci = c2 & 3;
#pragma unroll
            for (int eo = 0; eo < 4; ++eo) val += wqkv[(size_t)(1024 + grp) * 16 + ci * 4 + eo] * gw[((size_t)d * 6144 + 4096 + 4 * grp + eo) * 8 + gi]; }
        Gt[idx] = (bf16_t)(pk2(val, 0.f) & 0xffffu); }
}
PHASE_FN void wcvt_rk(const float* mix, const float* wrkvg, const float* w1, const float* a1, const float* w_out, bf16_t* W, LAS unsigned char* L, int bid, int nb) {
    LAS float* T = (LAS float*)L; int tb = 0;
    cvt_tiles(W, 2048, 0, 4608, 2048, [=](int k, int n) -> float {
        const int kk = k & 1023; float w, mx;
        if (n < 4096) { const int j = n >> 10, cc = n & 1023; const int mj = (j == 0) ? 0 : (j == 1 ? 2 : (j == 2 ? 3 : 5)); w = wrkvg[((size_t)j * 1024 + kk) * 1024 + cc]; mx = mix[mj * 1024 + kk]; }
        else { const int n2 = n - 4096, blk = n2 >> 8, cc = n2 & 255; if (cc >= 128) return 0.f; const int d = cc >> 6, m = cc & 63;
            w = (blk == 0 ? w1 : a1)[((size_t)d * 1024 + kk) * 64 + m]; mx = mix[(blk == 0 ? 1 : 4) * 1024 + kk]; }
        return w * (k < 1024 ? 1.f - mx : mx); }, T, bid, nb, tb);
    cvt_tiles(W + (size_t)4608 * 2048, 1024, 0, 1024, 1024, [=](int k, int n) -> float { return w_out[(size_t)k * 1024 + n]; }, T, bid, nb, tb);
}

PHASE_FN void wcvt_rk2(const float* wrkvg, const float* w1, const float* a1, const float* w_out, bf16_t* W, LAS unsigned char* L, int bid, int nb) {
    LAS float* T = (LAS float*)L; int tb = 0;
    cvt_tiles(W, 1024, 0, 4608, 1024, [=](int k, int n) -> float {
        if (n < 4096) { const int j = n >> 10, cc = n & 1023; return wrkvg[((size_t)j * 1024 + k) * 1024 + cc]; }
        const int n2 = n - 4096, blk = n2 >> 8, cc = n2 & 255; if (cc >= 128) return 0.f; const int d = cc >> 6, mm = cc & 63;
        return (blk == 0 ? w1 : a1)[((size_t)d * 1024 + k) * 64 + mm]; }, T, bid, nb, tb);
    cvt_tiles(W + (size_t)4608 * 1024, 1024, 0, 1024, 1024, [=](int k, int n) -> float { return w_out[(size_t)k * 1024 + n]; }, T, bid, nb, tb);
}
PHASE_FN void wcvt_rk2a(const float* wrkvg, bf16_t* W, int nlo, LAS unsigned char* L, int bid, int nb) {
    LAS float* T = (LAS float*)L; int tb = 0;
    cvt_tiles(W + (size_t)nlo * 1024, 1024, 0, 2048, 1024, [=](int k, int n) -> float { const int n2 = n + nlo, j = n2 >> 10, cc = n2 & 1023; return wrkvg[((size_t)j * 1024 + k) * 1024 + cc]; }, T, bid, nb, tb);
}
PHASE_FN void wcvt_rk2b(const float* w1, const float* a1, const float* w_out, bf16_t* W, LAS unsigned char* L, int bid, int nb) {
    LAS float* T = (LAS float*)L; int tb = 0;
    cvt_tiles(W + (size_t)4096 * 1024, 1024, 0, 512, 1024, [=](int k, int n2) -> float {
        const int blk = n2 >> 8, cc = n2 & 255; if (cc >= 128) return 0.f; const int d = cc >> 6, mm = cc & 63;
        return (blk == 0 ? w1 : a1)[((size_t)d * 1024 + k) * 64 + mm]; }, T, bid, nb, tb);
    cvt_tiles(W + (size_t)4608 * 1024, 1024, 0, 1024, 1024, [=](int k, int n) -> float { return w_out[(size_t)k * 1024 + n]; }, T, bid, nb, tb);
}

#define R_Q ((bf16_t*)(S))
#define R_K ((bf16_t*)(S + U34))
#define R_V ((bf16_t*)(S + U68))
#define R_P ((bf16_t*)(S + 2 * U68))
#define R_KT ((bf16_t*)(S + 2 * U68 + U34))
#define R_VT ((bf16_t*)(S + 3 * U68))
#define R_OF ((bf16_t*)(S + 4 * U68))
#define R_OB ((bf16_t*)(S + 5 * U68))
#define R_CA(JJ) ChunkArgs ca{}; ca.qsrc = R_Q; ca.ksrc = R_K; ca.vsrc = R_V; ca.ldq = 1024; ca.ldv = 2048; ca.Kt = R_KT; ca.Vt = R_VT; ca.P = R_P; ca.Of = R_OF; ca.Ob = R_OB; ca.decay = IN(9) + (JJ) * 8
#define AH(half) (H + (size_t)(half) * NH * DM)
#define HB(half) ((half) * NH)
#define RET_QKV_ARGS(half) AH(half), W, NH, 4096, 1024, EpiRetQKV{R_Q, R_K, R_V, rope, HB(half)}
#define RET_OUT_ARGS(YM) R_VT, W + (size_t)6144 * 1024, NH, 1024, 2048, EpiBf{YM, 1024}
#define RET_MID(half, JJ, EXTRA, LASTF) \
        PHG(1, R_CA(JJ); (phase_s1<256, false>(ca, L, bid, nb))); \
        PHG(2, R_CA(JJ); if (bid < 128) phase_s2w(ca, L, bid, 128); else { gemm_run<EpiBf>(AH(half), W + (size_t)4096 * 1024, NH, 2048, 1024, EpiBf{R_V, 2048}, L, bid - 128, 128); EXTRA; }); \
        PHG(5, phase_fin_ret(R_OF, R_OB, R_V, R_VT, LASTF, bid, nb));
#define RET_LN_ROWS(half, YM, LI, XL_IN, XC_IN, RA, RB_, BID, NBL) \
        phase_ln(XL_IN, XC_IN, out, xctx, (const bf16_t*)(YM) + (size_t)(RA) * DM, mod + (size_t)(LI) * 9 * 3072, mod + (size_t)((LI) + 1) * 9 * 3072, IN(6) + (LI) * 1024, IN(7) + (LI) * 1024, H, HB(half) + (RA), HB(half) + (RB_), 0, BID, NBL)
#define RET_LN_CALL(half, YM, LI, XL_IN, XC_IN, LAST, BID, NBL) \
        phase_ln(XL_IN, XC_IN, out, xctx, (const bf16_t*)(YM), mod + (size_t)(LI) * 9 * 3072, mod + (size_t)((LI) + 1 < 4 ? (LI) + 1 : 3) * 9 * 3072, IN(6) + (LI) * 1024, IN(7) + (LI) * 1024, H, HB(half), HB(half) + NH, LAST, BID, NBL)
#define RET_LAYER(LI, JJ, XL_IN, XC_IN, LAST, NEXT_WCVT, PRE_EXTRA, FINAL_LN, OUT1) \
    { \
        PHG(10, gemm_run<EpiRetQKV, GSTAMP != 0>(RET_QKV_ARGS(0), L, bid, nb, GSTAMP_PTR); if (bid >= 64) wcvt_ret_go(IN(8) + (size_t)(JJ) * 1024 * 6144, IN(10) + (size_t)(JJ) * 2048 * 1024, W, L, bid - 64, 192)); \
        RET_MID(0, JJ, PRE_EXTRA, LAST) \
        PHG(12, gemm_dual(RET_OUT_ARGS(AH(0)), 1, 0, RET_QKV_ARGS(1), 3, 16, L, bid, nb, LAST)); \
        RET_MID(1, JJ, RET_LN_CALL(0, AH(0), LI, XL_IN, XC_IN, LAST, bid - 128, 128), LAST) \
        PHG(12, OUT1); \
        PHG(6, FINAL_LN; NEXT_WCVT); \
    }
#define M_XM ((bf16_t*)(S))
#define M_XC ((bf16_t*)(S + U68))
#define M_KT ((bf16_t*)(S + 2 * U68))
#define M_VT ((bf16_t*)(S + 3 * U68))
#define M_P ((bf16_t*)(S + 4 * U68))
#define M_OB ((bf16_t*)(S + 4 * U68 + U34))
#define M_GAR ((float*)(S + 5 * U68 + U34))
#define M_GG (M_GAR)
#define M_GPM (M_GAR + 2 * 16 * SP)
#define M_GB (M_GAR + 4 * 16 * SP)
#define M_RS (M_GAR + 6 * 16 * SP)
#define M_CBL (M_GAR + 8 * 16 * SP)
#define M_CPML (M_GAR + 8 * 16 * SP + 2 * 16 * NCH)
#define M_CA ChunkArgs ca{}; ca.qsrc = M_XC; ca.ksrc = M_XC; ca.vsrc = M_XM; ca.ldq = 2048; ca.ldv = 2048; ca.Kt = M_KT; ca.Vt = M_VT; ca.P = M_P; ca.Of = M_XM; ca.Ob = M_OB; ca.wqkv = IN(14); \
        ca.gG = M_GG; ca.gPM = M_GPM; ca.gB = M_GB; ca.cBL = M_CBL; ca.cPML = M_CPML; ca.RS = M_RS
#define K_A2 ((bf16_t*)(S))
#define K_RKVG ((bf16_t*)(S + 2 * U68))
#define K_T (H)
#define K_BON ((float*)((unsigned char*)H + 17 * MiB))
#define K_R (K_RKVG)
#define K_K (K_RKVG + (size_t)NTOK * 1024)
#define K_V (K_RKVG + (size_t)2 * NTOK * 1024)
#define K_G (K_RKVG + (size_t)3 * NTOK * 1024)
#define K_YF ((bf16_t*)(S))
#define K_YB ((bf16_t*)(S + U68))

#define ML_MID(half, PREP) \
        PHG(4, PREP); \
        PHG(17, M_CA; (phase_s1<512, true>(ca, L, bid, nb))); \
        PHG(18, M_CA; (phase_s2<512, true>(ca, L, bid, nb))); \
        PHG(16, gemm_run<EpiBf>(AH(half), W_MLIN + (size_t)2048 * 1024, NH, 2048, 1024, EpiBf{M_KT, 2048}, L, bid, nb)); \
        PHG(5, phase_fin_ml(M_XM, M_OB, M_XC, M_KT, IN(18), IN(17), bid, nb));
#define ML_PREP(BID, NBL) phase_mlprep(M_XM, M_XC, W + (size_t)6144 * 1024, IN(12), IN(13), IN(16), M_GG, M_GPM, M_GB, M_CBL, M_CPML, L, BID, NBL)
#define W_MLIN (W + (size_t)8192 * 1024)
#define ML_XM_ARGS(half) AH(half), W_MLIN, NH, 2048, 1024, EpiBf{M_XM, 2048}
#define ML_OUT_ARGS(YM) M_KT, W + (size_t)4096 * 1024, NH, 1024, 2048, EpiBf{YM, 1024}
#define ML_LN_CALL(half, YM, BID, NBL) \
        phase_ln(out, xctx, out, xctx, (const bf16_t*)(YM), mod + (size_t)1 * 9 * 3072, mod + (size_t)2 * 9 * 3072, IN(6) + 1024, IN(7) + 1024, H, HB(half), HB(half) + NH, 0, BID, NBL)
#define LN_SPLIT 17408
#define ML_LN_ROWS(half, YM, RA, RB_, BID, NBL) \
        phase_ln(out, xctx, out, xctx, (const bf16_t*)(YM) + (size_t)(RA) * DM, mod + (size_t)1 * 9 * 3072, mod + (size_t)2 * 9 * 3072, IN(6) + 1024, IN(7) + 1024, H, HB(half) + (RA), HB(half) + (RB_), 0, BID, NBL)
#define ML_LAYER(NEXT_WCVT, PREV_LN, PREV_LN_TAIL) \
    { \
        ML_MID(0, if (bid < 136) { ML_PREP(bid, 136); PREV_LN_TAIL; } else { PREV_LN; }) \
        PHG(15, gemm_dual(ML_OUT_ARGS(AH(0)), 1, 0, ML_XM_ARGS(1), 1, 16, L, bid, nb)); \
        ML_MID(1, if (bid < 136) { ML_PREP(bid, 136); ML_LN_ROWS(0, AH(0), LN_SPLIT, NH, bid, 136); } else { ML_LN_ROWS(0, AH(0), 0, LN_SPLIT, bid - 136, 120); wcvt_rk2a(IN(21), W, 2048, L, bid - 136, 120); }) \
        PHG(15, gemm_run<EpiBf>(ML_OUT_ARGS(M_VT), L, bid, nb)); \
        PHG(6, ML_LN_CALL(1, M_VT, bid, nb); NEXT_WCVT); \
    }

#ifndef HOTPROBE
#define HOTPROBE 0
#endif
#if HOTPROBE
#define HOTPHASE PHG(7, gemm_hot(H, W, (bf16_t*)(S + 64 * MiB), 0, 1024, L, bid, nb, GSTAMP_PTR)); \
    PHG(7, gemm_hot((const bf16_t*)S, (const bf16_t*)(S + 40 * MiB), (bf16_t*)(S + 64 * MiB), 0, 1024, L, bid, nb, GSTAMP_PTR + 16384));
#else
#define HOTPHASE
#endif
#define FORWARD_PROGRAM() \
    PHG(7, phase_mod(IN(1), IN(3), IN(4), IN(5), mod, rope, L, bid, nb); wcvt_ret_qkv(IN(8), W, L, bid, nb)); \
    PHG(7, phase_h0(IN(0), IN(2), mod, H, 0, NH, bid, nb)); \
    HOTPHASE \
    RET_LAYER(0, 0, IN(0), IN(2), 0, wcvt_ml(IN(19), IN(14), IN(15), W, L, bid, nb), phase_h0(IN(0), IN(2), mod, H, NH, NTOK, bid - 128, 128); wcvt_ml_in(IN(11), W_MLIN, L, bid - 128, 128), (void)0, \
              gemm_dual(RET_OUT_ARGS(R_P), 1, 0, ML_XM_ARGS(0), 1, 16, L, bid, nb)) \
    ML_LAYER(wcvt_rk2b(IN(23), IN(26), IN(33), W, L, bid, nb), RET_LN_ROWS(1, R_P, 0, IN(0), IN(2), 0, LN_SPLIT, bid - 136, 120); wcvt_rk2a(IN(21), W, 0, L, bid - 136, 120), RET_LN_ROWS(1, R_P, 0, IN(0), IN(2), LN_SPLIT, NH, bid, 136)) \
    PHG(7, phase_rkmix2(H, K_A2, IN(20), 0, 2, bid, nb)); \
    PHG(13, gemm_pair(K_A2, W, 4, 0, EpiRwkv2{K_RKVG, K_T}, L, bid, nb)); \
    PHG(7, phase_rkmix2(H, K_A2, IN(20), 3, 5, bid, nb)); \
    PHG(13, gemm_pair(K_A2, W, 4, 8, EpiRwkv2{K_RKVG, K_T}, L, bid, nb)); \
    PHG(7, phase_rkmix2(H, K_A2, IN(20), 1, 4, bid, nb)); \
    PHG(13, gemm_pair(K_A2, W, 1, 16, EpiRwkv2{K_RKVG, K_T}, L, bid, nb)); \
    PHG(3, phase_rkscan4(K_R, K_K, K_V, K_T, IN(22), IN(24), IN(25), IN(27), IN(28), IN(29), IN(30), K_YF, K_YB, K_BON, L, bid, nb, S2PROF_PTR)); \
    PHG(5, phase_fin_rk(K_YF, K_YB, K_V, K_G, K_BON, IN(31), IN(32), bid, nb)); \
    PHG(14, gemm_run<EpiBf>(K_G, W + (size_t)4608 * 1024, NTOK, 1024, 1024, EpiBf{H, 1024}, L, bid, nb); if (bid >= 32) wcvt_ret_qkv(IN(8) + (size_t)1024 * 6144, W, L, bid - 32, 224)); \
    PHG(6, phase_ln(out, xctx, out, xctx, (const bf16_t*)H, mod + (size_t)2 * 9 * 3072, mod + (size_t)3 * 9 * 3072, IN(6) + 2048, IN(7) + 2048, H, 0, NH, 0, bid, nb)); \
    RET_LAYER(3, 1, out, xctx, 1, (void)0, phase_ln(out, xctx, out, xctx, (const bf16_t*)(H + (size_t)NH * DM), mod + (size_t)2 * 9 * 3072, mod + (size_t)3 * 9 * 3072, IN(6) + 2048, IN(7) + 2048, H, NH, NTOK, 0, bid - 128, 128), RET_LN_CALL(1, R_P, 3, out, xctx, 1, bid, nb), gemm_deal<EpiBf>(RET_OUT_ARGS(R_P), 1, L, bid, nb))


#if MK_MULTI
template <class F> __global__ void __launch_bounds__(NTHR, 2) kphase(F f) {
    extern __shared__ __attribute__((aligned(16))) unsigned char lds_raw[];
    f((LAS unsigned char*)lds_raw, (int)blockIdx.x, (int)gridDim.x);
}
template <class F> static void launch_phase(hipStream_t st, F f) {
    static int attr_done = 0;
    if (!attr_done) { (void)hipFuncSetAttribute((const void*)kphase<F>, hipFuncAttributeMaxDynamicSharedMemorySize, LDS_BYTES); attr_done = 1; }
    hipLaunchKernelGGL(kphase<F>, dim3(256), dim3(NTHR), LDS_BYTES, st, f);
}
extern "C" void kernel_launch(void* const* d_in, const int* in_sizes, int n_in, void* d_out, int out_size, void* d_ws, size_t ws_size, hipStream_t stream) {
    if (n_in != 34 || ws_size < WS_END) { fprintf(stderr, "kernel_launch: expected 34 inputs and >= %zu bytes of workspace (got %d, %zu)\n", (size_t)WS_END, n_in, ws_size); return; }
    (void)in_sizes; (void)out_size;
    const float* in[34]; for (int i = 0; i < 34; ++i) in[i] = (const float*)d_in[i];
    float* out = (float*)d_out; unsigned char* ws = (unsigned char*)d_ws;
    float* mod = (float*)(ws + WS_MOD); float* rope = (float*)(ws + WS_ROPE); float* xctx = (float*)(ws + WS_XCTX);
    bf16_t* H = (bf16_t*)(ws + WS_H); bf16_t* W = (bf16_t*)(ws + WS_W); unsigned char* S = ws + WS_S; unsigned* dbgcnt = (unsigned*)(ws + WS_ROPE + 32768);
#define IN(i) in[i]
#define S2PROF_PTR ((unsigned long long*)nullptr)
#define GSTAMP_PTR ((unsigned long long*)nullptr)
#define PHG(g, ...) launch_phase(stream, [=] __device__ (LAS unsigned char* L, int bid, int nb) { __VA_ARGS__; })
    FORWARD_PROGRAM()
#undef PHG
#undef IN
}
#else
#ifndef TIMING_PROBE
#define TIMING_PROBE 0
#endif
#define GSTAMP_PTR ((unsigned long long*)(ws + MiB))
#ifndef XCCPROBE
#define XCCPROBE 0
#endif
#ifndef S2PROF
#define S2PROF 0
#endif
#define SP_A 4
#define SP_B 5
#define TP_A 4
#define TP_B 15
#define AS4 __attribute__((address_space(4)))
__device__ __forceinline__ const float* karg_ptr(unsigned off) { asm volatile("" : "+s"(off)); const unsigned char AS4* ka = (const unsigned char AS4*)__builtin_amdgcn_kernarg_segment_ptr(); return *(const float* const AS4*)(ka + off); }
__global__ void __launch_bounds__(NTHR, 2) hybrid_fwd(Prm p) {
    extern __shared__ __attribute__((aligned(16))) unsigned char lds_raw[];
    LAS unsigned char* L = (LAS unsigned char*)lds_raw;
    const int nb = gridDim.x;
    volatile LAS unsigned* st = (volatile LAS unsigned*)(L + LDS_BYTES - 16);
    if (threadIdx.x == 0) { st[0] = 0u; st[1] = 0u; st[2] = 0u; st[3] = 0u; *(volatile LAS unsigned*)(L + TID_TICKET_LDS) = 0u; *(volatile LAS unsigned*)(L + TID_TICKET_LDS + 4) = 0u; }
    __syncthreads();
    { XcdBarrier bar0 = xcd_barrier_post((unsigned*)((unsigned char*)karg_ptr(280) + WS_BAR), st); (void)bar0; }
#define IN(i) karg_ptr(8u * (i))
#define out ((float*)karg_ptr(272))
#define ws ((unsigned char*)karg_ptr(280))
#define mod ((float*)(ws + WS_MOD))
#define rope ((float*)(ws + WS_ROPE))
#define xctx ((float*)(ws + WS_XCTX))
#define H ((bf16_t*)(ws + WS_H))
#define W ((bf16_t*)(ws + WS_W))
#define S (ws + WS_S)
#if TIMING_PROBE
#define TSTAMP(g) { const int tq_ = tid_opq(); if (tq_ == 0 && blockIdx.x == 0) { unsigned long long* tsb = (unsigned long long*)(ws + WS_BAR + 14336); tsb[tsk] = (unsigned long long)wall_clock64(); ((unsigned*)(tsb + 64))[tsk] = (g); } ++tsk; }
#else
#define TSTAMP(g)
#endif
#if S2PROF
#define S2PROF_PTR ((unsigned long long*)(ws + WS_BAR + 15360))
#else
#define S2PROF_PTR ((unsigned long long*)nullptr)
#endif
#define PHG(g, ...) { const int bid = bid_opq(); __VA_ARGS__; XcdBarrier bar; bar.bar = (unsigned*)(ws + WS_BAR); bar.x = xb_xcc_id(); bar.st = (volatile LAS unsigned*)(L + LDS_BYTES - 16); xcd_barrier(bar, tid_opq()); TSTAMP(g) }
    int tsk = 0; TSTAMP(9)
#if XCCPROBE
    { unsigned* xc = (unsigned*)(ws + WS_BAR + 15872); const unsigned x = xb_xcc_id(); if (threadIdx.x == 0) { if (x == (blockIdx.x & 7u)) atomicAdd(xc, 1u); if (x == (blockIdx.x >> 5)) atomicAdd(xc + 1, 1u); } }
#endif
    FORWARD_PROGRAM()
#if GSTAMP
    { const int bid = bid_opq(); phase_gstamp(out, GSTAMP_PTR, bid, nb); }
#endif
#if HOTPROBE
    { const int bid = bid_opq(); phase_hotprobe(out, GSTAMP_PTR, bid, nb); }
#endif
#if XCCPROBE
    { const int bid = bid_opq(); phase_xccprobe(out, (unsigned*)(ws + WS_BAR + 15872), bid, nb); }
#endif
#if S2PROF
    { const int bid = bid_opq(); phase_prof6(out, (const unsigned long long*)(ws + WS_BAR + 15360), SP_A, SP_B, bid, nb); }
#endif
#if TIMING_PROBE
    { XcdBarrier bar; bar.bar = (unsigned*)(ws + WS_BAR); bar.x = xb_xcc_id(); bar.st = (volatile LAS unsigned*)(L + LDS_BYTES - 16); xcd_barrier(bar, tid_opq()); }
    { const int bid = bid_opq(); phase_timing(out, (const unsigned long long*)(ws + WS_BAR + 14336), tsk, bid, nb, TP_A, TP_B); }
#endif
#undef PHG
#undef IN
#undef out
#undef ws
#undef mod
#undef rope
#undef xctx
#undef H
#undef W
#undef S
    (void)p;
}
extern "C" void kernel_launch(void* const* d_in, const int* in_sizes, int n_in, void* d_out, int out_size, void* d_ws, size_t ws_size, hipStream_t stream) {
    static int ready = 0;
    if (!ready) {
        if (n_in != 34 || ws_size < WS_END) { fprintf(stderr, "kernel_launch: expected 34 inputs and >= %zu bytes of workspace (got %d, %zu)\n", (size_t)WS_END, n_in, ws_size); ready = -1; return; }
        if (hipFuncSetAttribute((const void*)hybrid_fwd, hipFuncAttributeMaxDynamicSharedMemorySize, LDS_BYTES) != hipSuccess) { fprintf(stderr, "kernel_launch: hipFuncSetAttribute failed\n"); ready = -1; return; }
        ready = 1;
    }
    if (ready < 0) return;
    (void)in_sizes; (void)out_size;
    (void)hipMemsetAsync((char*)d_ws + WS_BAR, 0, 16384, stream);
    Prm p{};
    for (int i = 0; i < 34; ++i) p.in[i] = (const float*)d_in[i];
    p.out = (float*)d_out; p.ws = (unsigned char*)d_ws;
    hipLaunchKernelGGL(hybrid_fwd, dim3(256), dim3(NTHR), LDS_BYTES, stream, p);
}
#endif
```
